# Optimizing an MI355X kernel written in HIP

```python
import jax
import jax.numpy as jnp
from jax import lax
import numpy as np

D_MODEL = 2048
BATCH = 4
SEQ = 4096
DEPTH = 4

HEAD_DIM = 64
N_MIXERS = 4
GROUP_WIDTH = D_MODEL // N_MIXERS
GROUP_HEADS = GROUP_WIDTH // HEAD_DIM
BLOCK = 128
NORM_EPS = 1e-6
LN_EPS = 1e-5
NEG_INF = -1e30
RWKV_DECAY_RANK = 32
RWKV_ICLR_RANK = 32
RWKV_GATE_RANK = 96
RWKV_GN_EPS = 64e-5
RWKV_IN = 3 * GROUP_WIDTH + RWKV_DECAY_RANK + RWKV_ICLR_RANK + RWKV_GATE_RANK
SWA_KV_HEADS = 2
SWA_GROUPS = GROUP_HEADS // SWA_KV_HEADS
SWA_WINDOW = 128
SWA_IN = GROUP_WIDTH + 2 * SWA_KV_HEADS * HEAD_DIM
SGU_CHUNK = 128
SGU_TRI = SGU_CHUNK * (SGU_CHUNK + 1) // 2
SGU_IN = 2 * GROUP_WIDTH
FOX_IN = 4 * GROUP_WIDTH + GROUP_HEADS
N_IN = RWKV_IN + SWA_IN + SGU_IN + FOX_IN
FFN_HIDDEN = ((8 * D_MODEL + 3 * 256 - 1) // (3 * 256)) * 256

kernel_name = 'hybrid_rwkv7_swa_sgu_fox_adaln_trunk'


def _split(t, sizes):
    out, o = [], 0
    for s in sizes:
        out.append(t[..., o:o + s])
        o += s
    return out


def rms_norm(x, g, eps=NORM_EPS):
    xf = x.astype(jnp.float32)
    y = xf * lax.rsqrt(jnp.mean(xf * xf, axis=-1, keepdims=True) + eps)
    return y.astype(x.dtype) * g


def layer_norm(x, g, b, eps=LN_EPS):
    xf = x.astype(jnp.float32)
    mu = jnp.mean(xf, axis=-1, keepdims=True)
    var = jnp.mean(jnp.square(xf - mu), axis=-1, keepdims=True)
    return ((xf - mu) * lax.rsqrt(var + eps)).astype(x.dtype) * g + b


def wkv7_scan(r, w, k, v, a, b):
    bsz, _, nh, n = r.shape

    def step(S, inp):
        r_t, w_t, k_t, v_t, a_t, b_t = inp
        sa = jnp.einsum('bhij,bhj->bhi', S, a_t)
        S = S * w_t[:, :, None, :] + sa[..., None] * b_t[:, :, None, :] + v_t[..., None] * k_t[:, :, None, :]
        return S, jnp.einsum('bhij,bhj->bhi', S, r_t)

    xs = tuple(jnp.moveaxis(t, 1, 0) for t in (r, w, k, v, a, b))
    S0 = jnp.zeros((bsz, nh, n, n), jnp.float32)
    _, y = lax.scan(step, S0, xs)
    return jnp.moveaxis(y, 0, 1)


def rwkv7_mix(p, mu, w0, w2, a0, a2, g2, k_k, k_a, r_k, lnx_g, lnx_b):
    bsz, t, _ = p.shape
    p_prev = jnp.pad(p, ((0, 0), (1, 0), (0, 0)))[:, :-1]
    p = p + (p_prev - p) * mu
    r, k, v, wd, ad, gd = _split(p, (GROUP_WIDTH, GROUP_WIDTH, GROUP_WIDTH,
                                      RWKV_DECAY_RANK, RWKV_ICLR_RANK, RWKV_GATE_RANK))
    w = -jax.nn.softplus(-(w0 + jnp.tanh(wd) @ w2)) - 0.5
    a = jax.nn.sigmoid(a0 + ad @ a2)
    g = jax.nn.sigmoid(gd) @ g2
    hs = lambda z: z.reshape(bsz, t, GROUP_HEADS, HEAD_DIM).astype(jnp.float32)
    kk = hs(k * k_k)
    kk = kk / jnp.maximum(jnp.sqrt(jnp.sum(kk * kk, axis=-1, keepdims=True)), 1e-12)
    k = k * (1 + (a - 1) * k_a)
    rh, kh, vh, ah = hs(r), hs(k), hs(v), hs(a)
    decay = jnp.exp(-jnp.exp(hs(w)))
    y = wkv7_scan(rh, decay, kh, vh, -kk, kk * ah)
    mean = jnp.mean(y, axis=-1, keepdims=True)
    var = jnp.mean(jnp.square(y - mean), axis=-1, keepdims=True)
    y = (y - mean) * lax.rsqrt(var + RWKV_GN_EPS)
    y = y.reshape(bsz, t, GROUP_WIDTH).astype(p.dtype) * lnx_g + lnx_b
    bonus = jnp.sum(rh * kh * r_k.astype(jnp.float32), axis=-1, keepdims=True) * vh
    y = y + bonus.reshape(bsz, t, GROUP_WIDTH).astype(p.dtype)
    return y * g


def swa_sink_mix(p, qn_g, kn_g, sinks):
    bsz, t, _ = p.shape
    nb = t // BLOCK
    q, k, v = _split(p, (GROUP_WIDTH, SWA_KV_HEADS * HEAD_DIM, SWA_KV_HEADS * HEAD_DIM))
    q = rms_norm(q.reshape(bsz, t, GROUP_HEADS, HEAD_DIM), qn_g)
    k = rms_norm(k.reshape(bsz, t, SWA_KV_HEADS, HEAD_DIM), kn_g)
    q = q.reshape(bsz, nb, BLOCK, SWA_KV_HEADS, SWA_GROUPS, HEAD_DIM)
    k = k.reshape(bsz, nb, BLOCK, SWA_KV_HEADS, HEAD_DIM)
    v = v.reshape(bsz, nb, BLOCK, SWA_KV_HEADS, HEAD_DIM)
    shift = lambda z: jnp.pad(z, ((0, 0), (1, 0), (0, 0), (0, 0), (0, 0)))[:, :-1]
    k2 = jnp.concatenate([shift(k), k], axis=2)
    v2 = jnp.concatenate([shift(v), v], axis=2)
    s = jnp.einsum('bnqhgd,bnkhd->bnhgqk', q, k2).astype(jnp.float32) * (HEAD_DIM ** -0.5)
    i = jnp.arange(BLOCK)[:, None]
    j = jnp.arange(2 * BLOCK)[None, :]
    band = (j <= i + BLOCK) & (j > i + BLOCK - SWA_WINDOW)
    first = jnp.arange(nb)[:, None, None] > 0
    mask = band[None] & (first | (j >= BLOCK)[None])
    s = jnp.where(mask[None, :, None, None], s, NEG_INF)
    sink = sinks.astype(jnp.float32).reshape(SWA_KV_HEADS, SWA_GROUPS)[None, None, :, :, None, None]
    logits = jnp.concatenate([s, jnp.broadcast_to(sink, s.shape[:-1] + (1,))], axis=-1)
    probs = jax.nn.softmax(logits, axis=-1)[..., :-1]
    o = jnp.einsum('bnhgqk,bnkhd->bnqhgd', probs.astype(v2.dtype), v2)
    return o.reshape(bsz, t, GROUP_WIDTH)


def sgu_mix(p, ln_g, ln_b, ws_packed, bs):
    bsz, t, _ = p.shape
    nc = t // SGU_CHUNK
    u, v = _split(p, (GROUP_WIDTH, GROUP_WIDTH))
    u = jax.nn.gelu(u, approximate=False)
    v = layer_norm(jax.nn.gelu(v, approximate=False), ln_g, ln_b)
    rows, cols = np.tril_indices(SGU_CHUNK)
    w_s = jnp.zeros((GROUP_HEADS, SGU_CHUNK, SGU_CHUNK), ws_packed.dtype).at[:, rows, cols].set(ws_packed)
    v = v.reshape(bsz, nc, SGU_CHUNK, GROUP_HEADS, HEAD_DIM)
    z = jnp.einsum('gts,bnsgc->bntgc', w_s, v) + jnp.transpose(bs)[None, None, :, :, None]
    return u * z.reshape(bsz, t, GROUP_WIDTH)


def fox_mix(p, qn_g, kn_g, f_b):
    bsz, t, _ = p.shape
    nb = t // BLOCK
    q, k, v, fl, gl = _split(p, (GROUP_WIDTH, GROUP_WIDTH, GROUP_WIDTH, GROUP_HEADS, GROUP_WIDTH))
    q = rms_norm(q.reshape(bsz, t, GROUP_HEADS, HEAD_DIM), qn_g)
    k = rms_norm(k.reshape(bsz, t, GROUP_HEADS, HEAD_DIM), kn_g)
    v = v.reshape(bsz, t, GROUP_HEADS, HEAD_DIM)
    log_f = jax.nn.log_sigmoid((fl + f_b).astype(jnp.float32))
    cum = jnp.transpose(jnp.cumsum(log_f, axis=1), (0, 2, 1))
    qb = jnp.moveaxis(q.reshape(bsz, nb, BLOCK, GROUP_HEADS, HEAD_DIM), 1, 0)
    cb = jnp.moveaxis(cum.reshape(bsz, GROUP_HEADS, nb, BLOCK), 2, 0)
    s_pos = jnp.arange(t)

    def one_block(args):
        q_i, c_i, n = args
        s = jnp.einsum('bqhd,bkhd->bhqk', q_i, k).astype(jnp.float32) * (HEAD_DIM ** -0.5)
        s = s + c_i[..., None] - cum[:, :, None, :]
        t_pos = n * BLOCK + jnp.arange(BLOCK)
        s = jnp.where((s_pos[None, :] <= t_pos[:, None])[None, None], s, NEG_INF)
        pr = jax.nn.softmax(s, axis=-1)
        return jnp.einsum('bhqk,bkhd->bqhd', pr.astype(v.dtype), v)

    o = lax.map(one_block, (qb, cb, jnp.arange(nb)))
    o = jnp.moveaxis(o, 0, 1).reshape(bsz, t, GROUP_WIDTH)
    return o * jax.nn.sigmoid(gl)


def setup_inputs(seed: int = 0) -> dict:
    key = jax.random.key(seed)
    ks = iter(jax.random.split(key, 40))
    L, D, GW, H = DEPTH, D_MODEL, GROUP_WIDTH, GROUP_HEADS
    nrm = lambda shape, scale: jax.random.normal(next(ks), shape, jnp.float32) * scale
    gain = lambda shape: 1.0 + nrm(shape, 0.05)
    return {
        'x': nrm((BATCH, SEQ, D), 1.0),
        'c': nrm((BATCH, D), 1.0),
        'w_mod': nrm((L, D, 6 * D), 0.5 * D ** -0.5),
        'b_mod': nrm((L, 6 * D), 0.02),
        'norm1_g': gain((L, D)),
        'norm2_g': gain((L, D)),
        'w_in': nrm((L, D, N_IN), D ** -0.5),
        'w_out': nrm((L, D, D), D ** -0.5),
        'rwkv_mu': jax.random.uniform(next(ks), (L, RWKV_IN), jnp.float32),
        'rwkv_w0': jax.random.uniform(next(ks), (L, GW), jnp.float32, minval=-5.0, maxval=1.0),
        'rwkv_w2': nrm((L, RWKV_DECAY_RANK, GW), 0.5 * RWKV_DECAY_RANK ** -0.5),
        'rwkv_a0': nrm((L, GW), 0.5),
        'rwkv_a2': nrm((L, RWKV_ICLR_RANK, GW), 0.5 * RWKV_ICLR_RANK ** -0.5),
        'rwkv_g2': nrm((L, RWKV_GATE_RANK, GW), RWKV_GATE_RANK ** -0.5),
        'rwkv_kk': 0.85 + nrm((L, GW), 0.1),
        'rwkv_ka': 1.0 + nrm((L, GW), 0.1),
        'rwkv_rk': nrm((L, H, HEAD_DIM), 0.1),
        'rwkv_lnx_g': gain((L, GW)),
        'rwkv_lnx_b': nrm((L, GW), 0.02),
        'swa_qn_g': gain((L, HEAD_DIM)),
        'swa_kn_g': gain((L, HEAD_DIM)),
        'swa_sinks': nrm((L, H), 1.0),
        'sgu_ln_g': gain((L, GW)),
        'sgu_ln_b': nrm((L, GW), 0.02),
        'sgu_ws': nrm((L, H, SGU_TRI), SGU_CHUNK ** -0.5),
        'sgu_b': 1.0 + nrm((L, H, SGU_CHUNK), 0.1),
        'fox_qn_g': gain((L, HEAD_DIM)),
        'fox_kn_g': gain((L, HEAD_DIM)),
        'fox_fb': jax.random.uniform(next(ks), (L, H), jnp.float32, minval=1.0, maxval=3.0),
        'ffn_w1': nrm((L, D, FFN_HIDDEN), D ** -0.5),
        'ffn_w3': nrm((L, D, FFN_HIDDEN), D ** -0.5),
        'ffn_w2': nrm((L, FFN_HIDDEN, D), FFN_HIDDEN ** -0.5),
    }


def reference(x, c, w_mod, b_mod, norm1_g, norm2_g, w_in, w_out,
              rwkv_mu, rwkv_w0, rwkv_w2, rwkv_a0, rwkv_a2, rwkv_g2, rwkv_kk, rwkv_ka, rwkv_rk,
              rwkv_lnx_g, rwkv_lnx_b, swa_qn_g, swa_kn_g, swa_sinks,
              sgu_ln_g, sgu_ln_b, sgu_ws, sgu_b, fox_qn_g, fox_kn_g, fox_fb,
              ffn_w1, ffn_w3, ffn_w2):
    c_act = jax.nn.silu(c)
    for l in range(DEPTH):
        mod = c_act @ w_mod[l] + b_mod[l]
        shift1, scale1, gate1, shift2, scale2, gate2 = [m[:, None, :] for m in jnp.split(mod, 6, axis=-1)]
        h = rms_norm(x, norm1_g[l]) * (1 + scale1) + shift1
        proj = h @ w_in[l]
        pa, pb, pc, pd = _split(proj, (RWKV_IN, SWA_IN, SGU_IN, FOX_IN))
        ya = rwkv7_mix(pa, rwkv_mu[l], rwkv_w0[l], rwkv_w2[l], rwkv_a0[l], rwkv_a2[l], rwkv_g2[l],
                       rwkv_kk[l], rwkv_ka[l], rwkv_rk[l], rwkv_lnx_g[l], rwkv_lnx_b[l])
        yb = swa_sink_mix(pb, swa_qn_g[l], swa_kn_g[l], swa_sinks[l])
        yc = sgu_mix(pc, sgu_ln_g[l], sgu_ln_b[l], sgu_ws[l], sgu_b[l])
        yd = fox_mix(pd, fox_qn_g[l], fox_kn_g[l], fox_fb[l])
        y = jnp.concatenate([ya, yb, yc, yd], axis=-1) @ w_out[l]
        x = x + gate1 * y
        h = rms_norm(x, norm2_g[l]) * (1 + scale2) + shift2
        f = jax.nn.silu(h @ ffn_w1[l]) * (h @ ffn_w3[l])
        x = x + gate2 * (f @ ffn_w2[l])
    return x
```

```cpp
#include <hip/hip_runtime.h>
#include <cstdio>
#include <cstdint>
#ifndef MK_ONE_LAUNCH
#define MK_ONE_LAUNCH 0
#endif
namespace pg8 {
#define PG8_LAS __attribute__((address_space(3)))
typedef unsigned short bf16_t;
typedef short bf16x8 __attribute__((ext_vector_type(8)));
typedef float f32x4 __attribute__((ext_vector_type(4)));
typedef unsigned u32x4 __attribute__((ext_vector_type(4)));
constexpr int BM = 256, BK = 64, HALF = 128, HTB = HALF * BK * 2  , STAGE_BYTES = 8 * HTB, NXCD = 8, WGM = 8;

__host__ __device__ __forceinline__ int lds_byte(int r, int c) { const int st = (r >> 4) * 2 + (c >> 5), rr = r & 15, cc = c & 31, ob = rr * 64 + cc * 2; return st * 1024 + (ob ^ (((ob >> 9) & 1) << 5)); }
__host__ __device__ __forceinline__ void stage_rc(int b, int& R, int& C) { const int st = b / 1024, sb = b % 1024, swz = sb ^ (((sb >> 9) & 1) << 5); R = (st >> 1) * 16 + swz / 64; C = (st & 1) * 32 + (swz % 64) / 2; }
__host__ __device__ __forceinline__ int perm32(int rho) { const int n = rho >> 4, i = rho & 15; return 8 * (i >> 2) + 4 * n + (i & 3); }

struct Unit { int pm, pn; };
struct Gemm { const bf16_t* A; const bf16_t* Bt; int M, N, K; };

struct StaticOrder {
    int nM, nN, nwg, G, c;
    __host__ __device__ void init(int M, int N, int G_, int c_) { nM = M / BM; nN = N / BM; nwg = nM * nN; G = G_; c = c_; }
    __host__ __device__ bool next(int i, Unit& u) const {
        const long L = (long)i * G + c; if (L >= nwg) return false;
        int wgid = (int)L; { const int q = nwg / NXCD, r = nwg % NXCD, xcd = wgid % NXCD, off = wgid / NXCD; wgid = (xcd < r ? xcd * (q + 1) : r * (q + 1) + (xcd - r) * q) + off; }
        const int nig = WGM * nN, gid = wgid / nig, fm = gid * WGM, gsz = (nM - fm) < WGM ? (nM - fm) : WGM;
        u.pm = fm + ((wgid % nig) % gsz); u.pn = (wgid % nig) / gsz; return true;
    }
    __device__ __forceinline__ void a_ready(const Unit&) const {}
    __device__ __forceinline__ void done(const Unit&) const {}
};

__device__ __forceinline__ unsigned cvt_pk_bf16(float lo, float hi) { unsigned r; asm volatile("v_cvt_pk_bf16_f32 %0, %1, %2" : "=v"(r) : "v"(lo), "v"(hi)); return r; }
typedef float f32x2 __attribute__((ext_vector_type(2)));
__device__ __forceinline__ f32x2 gelu_pk(f32x2 v) {
    const f32x2 av = __builtin_elementwise_abs(v), d = av * 0.2316418882f + 1.0f;
    f32x2 t; t.x = __builtin_amdgcn_rcpf(d.x); t.y = __builtin_amdgcn_rcpf(d.y);
    f32x2 q = t * 0.5307027145f + (-0.7265760135f); q = q * t + 0.7107068705f; q = q * t + (-0.142248368f); q = q * t + 0.127414796f; q = q * t;
    const f32x2 s = (v * v) * (-0.72134752044f);
    f32x2 e; e.x = __builtin_amdgcn_exp2f(s.x); e.y = __builtin_amdgcn_exp2f(s.y);
    const f32x2 m = v * (q * e), r = v - m;
    f32x2 o; o.x = v.x < 0.f ? m.x : r.x; o.y = v.y < 0.f ? m.y : r.y; return o;
}

struct EpiStoreBf16 {
    static constexpr bool PERM = true, AFTER_DRAIN = false;
    bf16_t* O; int ldc;
    __device__ __forceinline__ void operator()(const f32x4 (&acc)[2][2][4][2], const Unit& u, int wr, int wc, int fr, int fq) const {
        const int row0 = u.pm * BM + wr * 64 + fr, col0 = u.pn * BM + wc * 32 + 8 * fq;
#pragma unroll
        for (int ai = 0; ai < 2; ++ai)
#pragma unroll
            for (int m = 0; m < 4; ++m) { bf16_t* rowp = O + (size_t)(row0 + ai * HALF + m * 16) * ldc + col0;
#pragma unroll
                for (int bj = 0; bj < 2; ++bj) { const f32x4 v0 = acc[ai][bj][m][0], v1 = acc[ai][bj][m][1];
                    u32x4 w; w.x = cvt_pk_bf16(v0[0], v0[1]); w.y = cvt_pk_bf16(v0[2], v0[3]); w.z = cvt_pk_bf16(v1[0], v1[1]); w.w = cvt_pk_bf16(v1[2], v1[3]);
                    *(u32x4*)(rowp + bj * HALF) = w; } }
    }
};
struct EpiResid {
    static constexpr bool PERM = false, AFTER_DRAIN = false;
    const float* base; float* out; int ldc; const float* gate; int gate_stride; int rows_per_batch;
    __device__ __forceinline__ void operator()(const f32x4 (&acc)[2][2][4][2], const Unit& u, int wr, int wc, int fr, int fq) const {
        const int row0 = u.pm * BM + wr * 64 + fr, col0 = u.pn * BM + wc * 32 + 4 * fq;
        const float* gp = gate + (size_t)((u.pm * BM) / rows_per_batch) * gate_stride + col0;
        f32x4 gv[2][2];
#pragma unroll
        for (int bj = 0; bj < 2; ++bj)
#pragma unroll
            for (int n = 0; n < 2; ++n) gv[bj][n] = *(const f32x4*)(gp + bj * HALF + n * 16);
#pragma unroll
        for (int ai = 0; ai < 2; ++ai)
#pragma unroll
            for (int m = 0; m < 4; ++m) { const size_t off = (size_t)(row0 + ai * HALF + m * 16) * ldc + col0;
#pragma unroll
                for (int bj = 0; bj < 2; ++bj)
#pragma unroll
                    for (int n = 0; n < 2; ++n) { const f32x4 x = *(const f32x4*)(base + off + bj * HALF + n * 16);
                        *(f32x4*)(out + off + bj * HALF + n * 16) = x + gv[bj][n] * acc[ai][bj][m][n]; } }
    }
};
struct EpiSwiGLU {
    static constexpr bool PERM = true, AFTER_DRAIN = false;
    bf16_t* O; int ldc;
    __device__ __forceinline__ void operator()(const f32x4 (&acc)[2][2][4][2], const Unit& u, int wr, int wc, int fr, int fq) const {
        const int row0 = u.pm * BM + wr * 64 + fr, col0 = u.pn * HALF + wc * 32 + 8 * fq;
#pragma unroll
        for (int ai = 0; ai < 2; ++ai)
#pragma unroll
            for (int m = 0; m < 4; ++m) { bf16_t* rowp = O + (size_t)(row0 + ai * HALF + m * 16) * ldc + col0;
                float f[8];
#pragma unroll
                for (int n = 0; n < 2; ++n)
#pragma unroll
                    for (int e = 0; e < 4; ++e) { const float g = acc[ai][0][m][n][e], up = acc[ai][1][m][n][e];
                        f[n * 4 + e] = g * up * __builtin_amdgcn_rcpf(1.0f + __builtin_amdgcn_exp2f(-1.4426950408889634f * g)); }
                u32x4 w; w.x = cvt_pk_bf16(f[0], f[1]); w.y = cvt_pk_bf16(f[2], f[3]); w.z = cvt_pk_bf16(f[4], f[5]); w.w = cvt_pk_bf16(f[6], f[7]);
                *(u32x4*)rowp = w; }
    }
};

template <class Epi, class Sched, bool ALIGN_EPI = false, bool SP2 = false>
__device__ __forceinline__ void gemm_phase(PG8_LAS unsigned char* lds, const Gemm g, const Sched& S, const Epi& E) {
    const int tid = threadIdx.x, wid = __builtin_amdgcn_readfirstlane(tid >> 6), lane = tid & 63, wr = wid >> 2, wc = wid & 3, fr = lane & 15, fq = lane >> 4;
    const int K = g.K, nt = K / BK;
    unsigned voffA[2], voffB[2];
#pragma unroll
    for (int i = 0; i < 2; ++i) { int R, C; stage_rc(tid * 16 + i * 8192, R, C); const int Rb = Epi::PERM ? ((R & ~31) + perm32(R & 31)) : R;
        voffA[i] = (unsigned)(R * K + C) * 2u; voffB[i] = (unsigned)(Rb * K + C) * 2u; }
    const size_t kstep = (size_t)(BK * 2);
    const size_t hstep = (size_t)HALF * K * 2;
    const size_t tstep = 2 * hstep;
    const unsigned ldsw = (unsigned)wid * 1024u;
    const int aoff = lds_byte(wr * 64 + fr, fq * 8), boff = lds_byte(wc * 32 + fr, fq * 8);
#define PG8_SA(b, h) (((b) * 2 + (h)) * HTB)
#define PG8_SB(b, h) ((4 + (b) * 2 + (h)) * HTB)
#define PG8_STAGE(bufoff, gbase, voff) do { _Pragma("unroll") for (int _i = 0; _i < 2; ++_i) \
        __builtin_amdgcn_global_load_lds((const unsigned*)((const char*)(gbase) + (voff)[_i]), (PG8_LAS unsigned*)(lds + (bufoff) + ldsw + _i * 8192), 16, 0, 0); } while (0)
#define PG8_LDA(dst, b, h) do { _Pragma("unroll") for (int m = 0; m < 4; ++m) _Pragma("unroll") for (int k = 0; k < 2; ++k) dst[m][k] = *(const PG8_LAS bf16x8*)(lds + PG8_SA(b, h) + aoff + m * 2048 + k * 1024); } while (0)
#define PG8_LDB(dst, b, h) do { _Pragma("unroll") for (int n = 0; n < 2; ++n) _Pragma("unroll") for (int k = 0; k < 2; ++k) dst[n][k] = *(const PG8_LAS bf16x8*)(lds + PG8_SB(b, h) + boff + n * 2048 + k * 1024); } while (0)
#define PG8_MMA(ai, bj, At, Bt) do { __builtin_amdgcn_s_setprio(1); _Pragma("unroll") for (int m = 0; m < 4; ++m) _Pragma("unroll") for (int n = 0; n < 2; ++n) _Pragma("unroll") for (int k = 0; k < 2; ++k) \
        acc[ai][bj][m][n] = __builtin_amdgcn_mfma_f32_16x16x32_bf16(Bt[n][k], At[m][k], acc[ai][bj][m][n], 0, 0, 0); __builtin_amdgcn_s_setprio(0); } while (0)
#define PG8_WAIT_V(n) asm volatile("s_waitcnt vmcnt(" #n ")" ::: "memory")
#define PG8_WAIT_L(n) asm volatile("s_waitcnt lgkmcnt(" #n ")" ::: "memory")
#define PG8_BAR __builtin_amdgcn_s_barrier()
#define PG8_SCHED __builtin_amdgcn_sched_barrier(0)
    Unit cur, nxt; int ui = 0;
    if (!S.next(0, cur)) return;
    f32x4 acc[2][2][4][2];
#pragma unroll
    for (int a = 0; a < 2; ++a)
#pragma unroll
        for (int b = 0; b < 2; ++b)
#pragma unroll
            for (int m = 0; m < 4; ++m)
#pragma unroll
                for (int n = 0; n < 2; ++n) acc[a][b][m][n] = (f32x4){0.f, 0.f, 0.f, 0.f};
    bf16x8 At[4][2], B0[2][2], B1[2][2];
    const char* cA = (const char*)g.A + (size_t)cur.pm * tstep; const char* cB = (const char*)g.Bt + (size_t)cur.pn * tstep;
    S.a_ready(cur);
    if constexpr (SP2) {
        PG8_STAGE(PG8_SB(0, 0), cB, voffB); PG8_STAGE(PG8_SB(0, 1), cB + hstep, voffB); PG8_STAGE(PG8_SA(0, 0), cA, voffA); PG8_STAGE(PG8_SA(0, 1), cA + hstep, voffA);
        if (wr == 1) PG8_BAR;
        PG8_WAIT_V(2); PG8_BAR;
        PG8_STAGE(PG8_SB(1, 0), cB + kstep, voffB); PG8_STAGE(PG8_SA(1, 0), cA + kstep, voffA); PG8_STAGE(PG8_SB(1, 1), cB + hstep + kstep, voffB);
        PG8_WAIT_V(6); PG8_BAR;
    } else {
        PG8_STAGE(PG8_SB(0, 0), cB, voffB); PG8_STAGE(PG8_SA(0, 0), cA, voffA); PG8_STAGE(PG8_SB(0, 1), cB + hstep, voffB); PG8_STAGE(PG8_SA(0, 1), cA + hstep, voffA);
        if (wr == 1) PG8_BAR;
        PG8_WAIT_V(4); PG8_BAR;
        PG8_STAGE(PG8_SB(1, 0), cB + kstep, voffB); PG8_STAGE(PG8_SA(1, 0), cA + kstep, voffA); PG8_STAGE(PG8_SB(1, 1), cB + hstep + kstep, voffB);
        PG8_WAIT_V(6); PG8_BAR;
    }
    for (;;) {
        const bool has_next = S.next(ui + 1, nxt);
        const char* nA = has_next ? (const char*)g.A + (size_t)nxt.pm * tstep : cA; const char* nB = has_next ? (const char*)g.Bt + (size_t)nxt.pn * tstep : cB;
        for (int t = 0; t < nt; t += 2) {
            const bool last = (t == nt - 2);
            const char* a1 = cA + (size_t)(t + 1) * kstep;
            const char* a2 = last ? nA : cA + (size_t)(t + 2) * kstep; const char* b2 = last ? nB : cB + (size_t)(t + 2) * kstep;
            const char* a3 = a2 + kstep; const char* b3 = b2 + kstep;
            if (last && has_next) S.a_ready(nxt);
            if constexpr (SP2) {
            PG8_LDB(B0, 0, 0); PG8_LDB(B1, 0, 1); PG8_SCHED; PG8_LDA(At, 0, 0); PG8_STAGE(PG8_SA(1, 1), a1 + hstep, voffA);
            PG8_WAIT_V(8); PG8_WAIT_L(0); PG8_BAR; PG8_MMA(0, 0, At, B0); PG8_MMA(0, 1, At, B1); PG8_BAR; PG8_SCHED;
            PG8_LDA(At, 0, 1); PG8_STAGE(PG8_SB(0, 0), b2, voffB); PG8_STAGE(PG8_SB(0, 1), b2 + hstep, voffB); PG8_STAGE(PG8_SA(0, 0), a2, voffA);
            PG8_WAIT_V(8); PG8_WAIT_L(0); PG8_BAR; PG8_MMA(1, 0, At, B0); PG8_MMA(1, 1, At, B1); PG8_BAR; PG8_SCHED;
            PG8_LDB(B0, 1, 0); PG8_LDB(B1, 1, 1); PG8_SCHED; PG8_LDA(At, 1, 0); PG8_STAGE(PG8_SA(0, 1), a2 + hstep, voffA);
            PG8_WAIT_V(8); PG8_WAIT_L(0); PG8_BAR; PG8_MMA(0, 0, At, B0); PG8_MMA(0, 1, At, B1); PG8_BAR; PG8_SCHED;
            PG8_LDA(At, 1, 1); PG8_STAGE(PG8_SB(1, 0), b3, voffB); PG8_STAGE(PG8_SB(1, 1), b3 + hstep, voffB); PG8_STAGE(PG8_SA(1, 0), a3, voffA);
            PG8_WAIT_V(8); PG8_WAIT_L(0); PG8_BAR; PG8_MMA(1, 0, At, B0); PG8_MMA(1, 1, At, B1); PG8_BAR; PG8_SCHED;
            } else {
            PG8_LDB(B0, 0, 0); PG8_SCHED; PG8_LDA(At, 0, 0); PG8_STAGE(PG8_SA(1, 1), a1 + hstep, voffA);
            PG8_WAIT_L(8); PG8_BAR; PG8_WAIT_L(0); PG8_MMA(0, 0, At, B0); PG8_BAR; PG8_SCHED;
            PG8_LDB(B1, 0, 1); PG8_STAGE(PG8_SB(0, 0), b2, voffB);
            PG8_BAR; PG8_WAIT_L(0); PG8_MMA(0, 1, At, B1); PG8_BAR;
            PG8_LDA(At, 0, 1); PG8_STAGE(PG8_SA(0, 0), a2, voffA);
            PG8_BAR; PG8_WAIT_L(0); PG8_MMA(1, 0, At, B0); PG8_BAR; PG8_SCHED;
            PG8_STAGE(PG8_SB(0, 1), b2 + hstep, voffB);
            PG8_WAIT_V(6); PG8_BAR; PG8_MMA(1, 1, At, B1); PG8_BAR;
            PG8_LDB(B0, 1, 0); PG8_SCHED; PG8_LDA(At, 1, 0); PG8_STAGE(PG8_SA(0, 1), a2 + hstep, voffA);
            PG8_WAIT_L(8); PG8_BAR; PG8_WAIT_L(0); PG8_MMA(0, 0, At, B0); PG8_BAR; PG8_SCHED;
            PG8_LDB(B1, 1, 1); PG8_STAGE(PG8_SB(1, 0), b3, voffB);
            PG8_BAR; PG8_WAIT_L(0); PG8_MMA(0, 1, At, B1); PG8_BAR;
            PG8_LDA(At, 1, 1); PG8_STAGE(PG8_SA(1, 0), a3, voffA);
            PG8_BAR; PG8_WAIT_L(0); PG8_MMA(1, 0, At, B0); PG8_BAR; PG8_SCHED;
            PG8_STAGE(PG8_SB(1, 1), b3 + hstep, voffB);
            PG8_WAIT_V(6); PG8_BAR; PG8_MMA(1, 1, At, B1); PG8_BAR;
            }
        }
        if constexpr (ALIGN_EPI) { if (wr == 0) PG8_BAR; }
        if constexpr (!Epi::AFTER_DRAIN) { E(acc, cur, wr, wc, fr, fq); S.done(cur); }
        if (!has_next) break;
#pragma unroll
        for (int a = 0; a < 2; ++a)
#pragma unroll
            for (int b = 0; b < 2; ++b)
#pragma unroll
                for (int m = 0; m < 4; ++m)
#pragma unroll
                    for (int n = 0; n < 2; ++n) acc[a][b][m][n] = (f32x4){0.f, 0.f, 0.f, 0.f};
        cur = nxt; cA = nA; cB = nB; ++ui;
        if constexpr (ALIGN_EPI) { if (wr == 1) PG8_BAR; }
    }
    PG8_WAIT_V(0);
    if constexpr (!ALIGN_EPI) { if (wr == 0) PG8_BAR; }
    PG8_BAR;
    if constexpr (Epi::AFTER_DRAIN) { E.fused(acc, cur, wr, wc, fr, fq, lds, wid, lane); S.done(cur); }
#undef PG8_SA
#undef PG8_SB
#undef PG8_STAGE
#undef PG8_LDA
#undef PG8_LDB
#undef PG8_MMA
#undef PG8_WAIT_V
#undef PG8_WAIT_L
#undef PG8_BAR
#undef PG8_SCHED
}
}
constexpr int NWAVES = 8, NTHREADS = 512;
constexpr int D = 2048, NB = 4, T = 4096, M = NB * T, DEPTH = 4, GW = 512, NH = 8, HD = 64;
constexpr int NIN = 5544, NP = 5632, FF = 5632, MODW = 6 * D;
constexpr int PC_RR = 0, PC_RK = 512, PC_RV = 1024, PC_SQ = 1536, PC_SK = 2048, PC_SV = 2176, PC_GU = 2304, PC_GV = 2816;
constexpr int PC_FQ = 3328, PC_FK = 3840, PC_FV = 4352, PC_FG = 4864, PC_RW = 5376, PC_FL = 5536;
constexpr int YC_A = 0, YC_B = 512, YC_C = 1024, YC_D = 1536;
constexpr int SGU_TRI = 8256;
enum { I_X = 0, I_C, I_WMOD, I_BMOD, I_N1G, I_N2G, I_WIN, I_WOUT, I_RMU, I_RW0, I_RW2, I_RA0, I_RA2, I_RG2, I_RKK, I_RKA, I_RRK, I_RLG, I_RLB,
       I_SQG, I_SKG, I_SSINK, I_GLG, I_GLB, I_GWS, I_GB, I_FQG, I_FKG, I_FFB, I_W1, I_W3, I_W2, N_INPUTS };

constexpr size_t MiB = 1u << 20;
constexpr size_t WS_CTL = 0, CTL_ZERO_BYTES = 1 * MiB;
constexpr size_t WS_MOD = 1 * MiB;
constexpr size_t WS_MODP = 2 * MiB;
constexpr size_t WS_WIN = 8 * MiB;
constexpr size_t WS_WOUT = 96 * MiB;
constexpr size_t WS_W13 = 128 * MiB;
constexpr size_t WS_W2 = 304 * MiB;
constexpr size_t WS_H = 392 * MiB;
constexpr size_t WS_PROJ = 456 * MiB;
constexpr size_t WS_YCAT = 632 * MiB;
constexpr size_t WS_F = 696 * MiB;
constexpr size_t WS_RIN = 872 * MiB;
constexpr size_t WS_RG = 1064 * MiB;
constexpr size_t WS_RY = 1096 * MiB;
constexpr size_t WS_END = 1128 * MiB;
constexpr int CW_BAR = 4096;

constexpr int RING_BYTES = 131072;
constexpr int LDSCTL_OFF = RING_BYTES, MISC_OFF = LDSCTL_OFF + 320;
constexpr int LDS_BYTES = 147456;

#define GAS __attribute__((address_space(1)))
#define LAS __attribute__((address_space(3)))
typedef unsigned short bf16;
typedef short bf16x8 __attribute__((ext_vector_type(8)));
typedef float f32x4 __attribute__((ext_vector_type(4)));
typedef float f32x16 __attribute__((ext_vector_type(16)));
typedef unsigned v4u __attribute__((ext_vector_type(4)));
#define LDS_WAIT() asm volatile("s_waitcnt lgkmcnt(0)" ::: "memory")
__device__ __forceinline__ float bf2f(unsigned short b) { return __uint_as_float(((unsigned)b) << 16); }
__device__ __forceinline__ unsigned f2bf(float f) { unsigned u = __float_as_uint(f); return (u + 0x7fffu + ((u >> 16) & 1u)) >> 16; }
__device__ __forceinline__ unsigned pk2(float lo, float hi) { return f2bf(lo) | (f2bf(hi) << 16); }
__device__ __forceinline__ float bflo(unsigned w) { return __uint_as_float(w << 16); }
__device__ __forceinline__ float bfhi(unsigned w) { return __uint_as_float(w & 0xffff0000u); }
__device__ __forceinline__ float wave_sum(float v) {
#pragma unroll
    for (int o = 1; o < 64; o <<= 1) v += __shfl_xor(v, o);
    return v;
}
__device__ __forceinline__ float sigmoidf_(float x) { return 1.0f / (1.0f + __expf(-x)); }
__device__ __forceinline__ float gelu_f(float v) {
    const float av = fabsf(v), t = __builtin_amdgcn_rcpf(av * 0.2316418882f + 1.0f);
    float q = t * 0.5307027145f + (-0.7265760135f); q = q * t + 0.7107068705f; q = q * t + (-0.142248368f); q = q * t + 0.127414796f; q = q * t;
    const float e = __builtin_amdgcn_exp2f((v * v) * (-0.72134752044f));
    const float m = v * (q * e);
    return v < 0.f ? m : v - m;
}
__device__ __forceinline__ int crow(int r, int hi) { return (r & 3) + 8 * (r >> 2) + 4 * hi; }

#define XB_TMO      128
#define XB_XCNT(j)  (256  + 64 * (j))
#define XB_XSUB(j)  (1280 + 64 * (j))
#define XB_XGEN(j)  (2304 + 64 * (j))
#define XB_TOP      3328
#define XB_TOPGEN   3392
#define XCD_BAR_WORDS 3456
#define XB_SPIN_CAP (1u << 18)

__device__ __forceinline__ unsigned xb_ld(unsigned* p)              { return __hip_atomic_load(p, __ATOMIC_RELAXED, __HIP_MEMORY_SCOPE_AGENT); }
__device__ __forceinline__ unsigned xb_add(unsigned* p, unsigned v) { return __hip_atomic_fetch_add(p, v, __ATOMIC_RELAXED, __HIP_MEMORY_SCOPE_AGENT); }
__device__ __forceinline__ unsigned xb_xcc_id() { return (unsigned)__builtin_amdgcn_s_getreg((3 << 11) | 20) & 0xFu; }
#define XB_SPIN(cond, bar) do { unsigned _sp = 0; while (cond) { __builtin_amdgcn_s_sleep(1); \
    if ((++_sp & 255u) == 0u) { if (xb_ld(&(bar)[XB_TMO])) break; if (_sp > XB_SPIN_CAP) { atomicAdd(&(bar)[XB_TMO], 1u); break; } } } } while (0)

struct XcdBarrier {
    unsigned* bar; unsigned x;
    volatile LAS unsigned* st;
};

__device__ __forceinline__ XcdBarrier xcd_barrier_post(unsigned* bar, volatile LAS unsigned* st) {
    XcdBarrier b; b.bar = bar; b.x = xb_xcc_id(); b.st = st;
    if (threadIdx.x == 0) (void)xb_add(&bar[XB_XCNT(b.x)], 1u);
    return b;
}
__device__ __forceinline__ void xcd_barrier_complete(unsigned* bar, unsigned x, unsigned& nloc, unsigned& nx) {
    const unsigned G = gridDim.x * gridDim.y * gridDim.z;
    unsigned sum, cnt, mine, sp = 0u;
    for (;;) {
        sum = 0u; cnt = 0u; mine = 0u;
#pragma unroll
        for (unsigned j = 0; j < 16; ++j) { const unsigned c = xb_ld(&bar[XB_XCNT(j)]); sum += c; cnt += (c > 0u) ? 1u : 0u; mine = (j == x) ? c : mine; }
        if (sum == G) break;
        __builtin_amdgcn_s_sleep(1);
        if ((++sp & 255u) == 0u) { if (xb_ld(&bar[XB_TMO])) break; if (sp > XB_SPIN_CAP) { atomicAdd(&bar[XB_TMO], 1u); break; } }
    }
    nloc = mine > 0u ? mine : 1u; nx = cnt > 0u ? cnt : 1u;
}

__device__ __forceinline__ void xcd_barrier(const XcdBarrier& b) {
    asm volatile("s_waitcnt vmcnt(0)" ::: "memory");
    __syncthreads();
    if (threadIdx.x == 0) {
        unsigned* bar = b.bar;
        __builtin_amdgcn_s_waitcnt(0);
        unsigned nloc = b.st[0], nx = b.st[1];
        if (nloc == 0u) { xcd_barrier_complete(bar, b.x, nloc, nx); b.st[0] = nloc; b.st[1] = nx; }
        const unsigned old = xb_add(&bar[XB_XSUB(b.x)], 1u);
        const unsigned gen = old / nloc;
        if (old + 1u == (gen + 1u) * nloc) {
            __builtin_amdgcn_fence(__ATOMIC_RELEASE, "agent");
            asm volatile("s_waitcnt vmcnt(0)" ::: "memory");
            const unsigned og = xb_add(&bar[XB_TOP], 1u);
            const unsigned tg = og / nx;
            if (og + 1u == (tg + 1u) * nx) xb_add(&bar[XB_TOPGEN], 1u);
            else XB_SPIN(xb_ld(&bar[XB_TOPGEN]) == tg, bar);
            __builtin_amdgcn_fence(__ATOMIC_ACQUIRE, "agent");
            xb_add(&bar[XB_XGEN(b.x)], 1u);
            asm volatile("s_waitcnt vmcnt(0)" ::: "memory");
        } else {
            XB_SPIN(xb_ld(&bar[XB_XGEN(b.x)]) == gen, bar);
            __builtin_amdgcn_fence(__ATOMIC_ACQUIRE, "agent");
            asm volatile("s_waitcnt vmcnt(0)" ::: "memory");
        }
    }
    __syncthreads();
}

struct Args { const float* in[N_INPUTS]; float* out; unsigned char* ws; int ph_lo, ph_hi; };
static_assert(sizeof(Args) == (N_INPUTS + 2) * 8 + 8, "Args has no padding");

struct Ctx {
    LAS unsigned char* lds; int tid, lane, wave, G, bid;
};

__device__ __forceinline__ void tr_item(const float* __restrict__ W, int N, int col0, int nvalid, int k0, bf16* __restrict__ WT, int K, int n0, LAS float* scr, int lane) {
#pragma unroll 8
    for (int i = 0; i < 32; ++i) { const int kk = 2 * i + (lane >> 5), nn = lane & 31; float v = 0.f; if (nn < nvalid) v = W[(size_t)(k0 + kk) * N + col0 + nn]; scr[kk * 33 + nn] = v; }
    LDS_WAIT(); asm volatile("" ::: "memory");
    const int c = lane & 7;
#pragma unroll
    for (int j = 0; j < 4; ++j) { const int n = (lane >> 3) + 8 * j; const LAS float* s = scr + (8 * c) * 33 + n;
        v4u o; o.x = pk2(s[0 * 33], s[1 * 33]); o.y = pk2(s[2 * 33], s[3 * 33]); o.z = pk2(s[4 * 33], s[5 * 33]); o.w = pk2(s[6 * 33], s[7 * 33]);
        *(v4u*)(WT + (size_t)(n0 + n) * K + k0 + 8 * c) = o; }
    LDS_WAIT(); asm volatile("" ::: "memory");
}
__device__ __forceinline__ void ph_prologue(const Args& A, const Ctx& C) {
    LAS float* csilu = (LAS float*)(C.lds + 73728);
    for (int i = C.tid; i < NB * D; i += NTHREADS) { const float c = A.in[I_C][i]; csilu[i] = c / (1.0f + __expf(-c)); }
    __syncthreads();
    LAS float* scr = (LAS float*)(C.lds + C.wave * 8704);
    const int gw = C.bid * NWAVES + C.wave, NGW = C.G * NWAVES;
    constexpr int I_IN = (D / 64) * (NP / 32), I_OUT = (D / 64) * (D / 32), I_13 = (D / 64) * (2 * FF / 32), I_2 = (FF / 64) * (D / 32), PER_L = I_IN + I_OUT + I_13 + I_2;
    for (int it = gw; it < DEPTH * PER_L; it += NGW) {
        const int l = it / PER_L; int r = it % PER_L;
        if (r < I_IN) { const int kb = r / (NP / 32), nb = r % (NP / 32), n0 = 32 * nb; int col0, nv = 32;
            if (n0 < 1536) col0 = n0; else if (n0 < 4864) col0 = n0 + 160; else if (n0 < 5376) col0 = n0 + 168; else if (n0 < 5536) col0 = n0 - 3840;
            else if (n0 == 5536) { col0 = 5024; nv = 8; } else { col0 = 0; nv = 0; }
            tr_item(A.in[I_WIN] + (size_t)l * D * NIN, NIN, col0, nv, 64 * kb, (bf16*)(A.ws + WS_WIN) + (size_t)l * NP * D, D, n0, scr, C.lane); continue; }
        r -= I_IN;
        if (r < I_OUT) { const int kb = r / (D / 32), nb = r % (D / 32);
            tr_item(A.in[I_WOUT] + (size_t)l * D * D, D, 32 * nb, 32, 64 * kb, (bf16*)(A.ws + WS_WOUT) + (size_t)l * D * D, D, 32 * nb, scr, C.lane); continue; }
        r -= I_OUT;
        if (r < I_13) { const int kb = r / (2 * FF / 32), nb = r % (2 * FF / 32), n0 = 32 * nb, pn = n0 >> 8, j = n0 & 255;
            const float* src = (j < 128 ? A.in[I_W1] : A.in[I_W3]) + (size_t)l * D * FF;
            tr_item(src, FF, 128 * pn + (j & 127), 32, 64 * kb, (bf16*)(A.ws + WS_W13) + (size_t)l * 2 * FF * D, D, n0, scr, C.lane); continue; }
        r -= I_13;
        { const int kb = r / (D / 32), nb = r % (D / 32);
            tr_item(A.in[I_W2] + (size_t)l * FF * D, D, 32 * nb, 32, 64 * kb, (bf16*)(A.ws + WS_W2) + (size_t)l * D * FF, FF, 32 * nb, scr, C.lane); }
    }
    for (int it = gw; it < 8 * DEPTH * (MODW / 256); it += NGW) {
        const int cg = it % (DEPTH * (MODW / 256)), ks = it / (DEPTH * (MODW / 256)), l = cg / (MODW / 256), n0 = (cg % (MODW / 256)) * 256, k0 = ks * 256;
        const float* wp = A.in[I_WMOD] + ((size_t)l * D + k0) * MODW + n0 + 4 * C.lane;
        f32x4 a0 = {0.f, 0.f, 0.f, 0.f}, a1 = a0, a2 = a0, a3 = a0;
#pragma unroll 8
        for (int k = 0; k < 256; ++k) { const f32x4 w = *(const f32x4*)(wp + (size_t)k * MODW);
            a0 += w * csilu[0 * D + k0 + k]; a1 += w * csilu[1 * D + k0 + k]; a2 += w * csilu[2 * D + k0 + k]; a3 += w * csilu[3 * D + k0 + k]; }
        float* mp = (float*)(A.ws + WS_MODP) + ((size_t)(ks * DEPTH + l) * NB) * MODW + n0 + 4 * C.lane;
        *(f32x4*)(mp + 0 * MODW) = a0; *(f32x4*)(mp + 1 * MODW) = a1; *(f32x4*)(mp + 2 * MODW) = a2; *(f32x4*)(mp + 3 * MODW) = a3;
    }
}
__device__ __forceinline__ void ph_modreduce(const Args& A, const Ctx& C) {
    const float* mp = (const float*)(A.ws + WS_MODP); float* mod = (float*)(A.ws + WS_MOD);
    for (int i = C.bid * NTHREADS + C.tid; i < DEPTH * NB * MODW; i += C.G * NTHREADS) {
        const int l = i / (NB * MODW), n = i % MODW; float s = A.in[I_BMOD][l * MODW + n];
#pragma unroll
        for (int ks = 0; ks < 8; ++ks) s += mp[(size_t)ks * DEPTH * NB * MODW + i];
        mod[i] = s;
    }
}
__device__ __forceinline__ void ph_norm(const Ctx& C, const float* x, const float* g, const float* shift, const float* scale, bf16* H) {
    const int gw = C.bid * NWAVES + C.wave, NGW = C.G * NWAVES;
    for (int m = gw; m < M; m += NGW) {
        const int b = m / T; const f32x4* xr = (const f32x4*)(x + (size_t)m * D) + C.lane;
        f32x4 v[8]; float ss = 0.f;
#pragma unroll
        for (int j = 0; j < 8; ++j) { v[j] = xr[64 * j]; ss += (v[j].x * v[j].x + v[j].y * v[j].y) + (v[j].z * v[j].z + v[j].w * v[j].w); }
        const float rstd = 1.0f / sqrtf(wave_sum(ss) * (1.0f / D) + 1e-6f);
        unsigned long long* o8 = (unsigned long long*)(H + (size_t)m * D) + C.lane;
#pragma unroll
        for (int j = 0; j < 8; ++j) { const int c = 4 * (C.lane + 64 * j);
            const f32x4 gg = *(const f32x4*)(g + c), sc = *(const f32x4*)(scale + (size_t)b * MODW + c), sh = *(const f32x4*)(shift + (size_t)b * MODW + c);
            const f32x4 y = v[j] * rstd * gg * (sc + 1.0f) + sh;
            o8[64 * j] = (unsigned long long)pk2(y.x, y.y) | ((unsigned long long)pk2(y.z, y.w) << 32); }
    }
}

__device__ __forceinline__ f32x16 mma32(const LAS bf16* Ap, const LAS bf16* Bp, int ksteps, f32x16 acc) {
    for (int k = 0; k < ksteps; ++k) { const bf16x8 a = *(const LAS bf16x8*)(Ap + 16 * k), b = *(const LAS bf16x8*)(Bp + 16 * k);
        acc = __builtin_amdgcn_mfma_f32_32x32x16_bf16(a, b, acc, 0, 0, 0); }
    return acc;
}
constexpr int AP = 72;
constexpr int A_Q = 0, A_K = 18432, A_VT = 27648, A_S = 36864, A_P = 71680, A_AL = 90112, A_CUM = 90624, A_END = 107008;
constexpr int SP = 68;
template <int MODE>
__device__ __forceinline__ void attn_unit(const Args& A, const Ctx& C, int l, int b, int h, int qb) {
    const bf16* proj = (const bf16*)(A.ws + WS_PROJ); bf16* ycat = (bf16*)(A.ws + WS_YCAT);
    const int tid = C.tid, lane = C.lane, wave = C.wave, r32 = lane & 31, hi = lane >> 5;
    const int q0 = qb * 128; const size_t rowb = (size_t)b * T;
    const int qcol = (MODE == 0 ? PC_SQ : PC_FQ) + h * 64;
    const int kcol = (MODE == 0) ? PC_SK + (h >> 2) * 64 : PC_FK + h * 64;
    const int vcol = (MODE == 0) ? PC_SV + (h >> 2) * 64 : PC_FV + h * 64;
    const float* qg = A.in[MODE == 0 ? I_SQG : I_FQG] + l * 64; const float* kg = A.in[MODE == 0 ? I_SKG : I_FKG] + l * 64;
    LAS bf16* Qs = (LAS bf16*)(C.lds + A_Q); LAS bf16* Ks = (LAS bf16*)(C.lds + A_K); LAS bf16* Vt = (LAS bf16*)(C.lds + A_VT);
    LAS float* Ss = (LAS float*)(C.lds + A_S); LAS bf16* Ps = (LAS bf16*)(C.lds + A_P); LAS float* AL = (LAS float*)(C.lds + A_AL); LAS float* cum = (LAS float*)(C.lds + A_CUM);
    __syncthreads();
    if (MODE == 1) {
        const int n = q0 + 128; const float fb = A.in[I_FFB][l * NH + h];
        float loc[8]; float s = 0.f;
#pragma unroll
        for (int i = 0; i < 8; ++i) { const int pos = 8 * tid + i; float v = 0.f;
            if (pos < n) { const float x = bf2f(proj[(rowb + pos) * NP + PC_FL + h]) + fb; v = (x < 0.f) ? x - log1pf(expf(x)) : -log1pf(expf(-x)); }
            s += v; loc[i] = s; }
        float ws_ = s;
#pragma unroll
        for (int o = 1; o < 64; o <<= 1) { const float t_ = __shfl_up(ws_, o); if (lane >= o) ws_ += t_; }
        if (lane == 63) AL[wave] = ws_;
        __syncthreads();
        float base = ws_ - s;
        for (int w = 0; w < wave; ++w) base += AL[w];
#pragma unroll
        for (int i = 0; i < 8; ++i) { const int pos = 8 * tid + i; if (pos < n) cum[pos] = base + loc[i]; }
    }
    {
        const int row = tid >> 2, dq = (tid & 3) * 16;
        const v4u* src = (const v4u*)(proj + (rowb + q0 + row) * NP + qcol + dq);
        const v4u r0 = src[0], r1 = src[1];
        float f[16];
        f[0] = bflo(r0.x); f[1] = bfhi(r0.x); f[2] = bflo(r0.y); f[3] = bfhi(r0.y); f[4] = bflo(r0.z); f[5] = bfhi(r0.z); f[6] = bflo(r0.w); f[7] = bfhi(r0.w);
        f[8] = bflo(r1.x); f[9] = bfhi(r1.x); f[10] = bflo(r1.y); f[11] = bfhi(r1.y); f[12] = bflo(r1.z); f[13] = bfhi(r1.z); f[14] = bflo(r1.w); f[15] = bfhi(r1.w);
        float ss = 0.f;
#pragma unroll
        for (int i = 0; i < 16; ++i) ss += f[i] * f[i];
        ss += __shfl_xor(ss, 1); ss += __shfl_xor(ss, 2);
        const float rs = 0.125f / sqrtf(ss * (1.0f / 64.0f) + 1e-6f);
#pragma unroll
        for (int i = 0; i < 16; ++i) f[i] = f[i] * rs * qg[dq + i];
        v4u o0, o1; o0.x = pk2(f[0], f[1]); o0.y = pk2(f[2], f[3]); o0.z = pk2(f[4], f[5]); o0.w = pk2(f[6], f[7]);
        o1.x = pk2(f[8], f[9]); o1.y = pk2(f[10], f[11]); o1.z = pk2(f[12], f[13]); o1.w = pk2(f[14], f[15]);
        *(LAS v4u*)(Qs + row * AP + dq) = o0; *(LAS v4u*)(Qs + row * AP + dq + 8) = o1;
    }
    const int ks_begin = (MODE == 0) ? (q0 >= 128 ? q0 - 128 : 0) : 0, ks_end = q0 + 128;
    float m_run = -1e30f, l_run = 0.f;
    f32x16 o;
#pragma unroll
    for (int r = 0; r < 16; ++r) o[r] = 0.f;
    const int qi = wave >> 1, cj = wave & 1;
    for (int ks = ks_begin; ks < ks_end; ks += 64) {
        {
            const int row = tid >> 3, dc = (tid & 7) * 8;
            const v4u kr = *(const v4u*)(proj + (rowb + ks + row) * NP + kcol + dc);
            float f[8]; f[0] = bflo(kr.x); f[1] = bfhi(kr.x); f[2] = bflo(kr.y); f[3] = bfhi(kr.y); f[4] = bflo(kr.z); f[5] = bfhi(kr.z); f[6] = bflo(kr.w); f[7] = bfhi(kr.w);
            float ss = 0.f;
#pragma unroll
            for (int i = 0; i < 8; ++i) ss += f[i] * f[i];
            ss += __shfl_xor(ss, 1); ss += __shfl_xor(ss, 2); ss += __shfl_xor(ss, 4);
            const float rs = 1.0f / sqrtf(ss * (1.0f / 64.0f) + 1e-6f);
#pragma unroll
            for (int i = 0; i < 8; ++i) f[i] = f[i] * rs * kg[dc + i];
            v4u ko; ko.x = pk2(f[0], f[1]); ko.y = pk2(f[2], f[3]); ko.z = pk2(f[4], f[5]); ko.w = pk2(f[6], f[7]);
            *(LAS v4u*)(Ks + row * AP + dc) = ko;
            const v4u vr = *(const v4u*)(proj + (rowb + ks + row) * NP + vcol + dc);
            Vt[(dc + 0) * AP + row] = (bf16)(vr.x & 0xffffu); Vt[(dc + 1) * AP + row] = (bf16)(vr.x >> 16);
            Vt[(dc + 2) * AP + row] = (bf16)(vr.y & 0xffffu); Vt[(dc + 3) * AP + row] = (bf16)(vr.y >> 16);
            Vt[(dc + 4) * AP + row] = (bf16)(vr.z & 0xffffu); Vt[(dc + 5) * AP + row] = (bf16)(vr.z >> 16);
            Vt[(dc + 6) * AP + row] = (bf16)(vr.w & 0xffffu); Vt[(dc + 7) * AP + row] = (bf16)(vr.w >> 16);
        }
        __syncthreads();
        {
            f32x16 acc;
#pragma unroll
            for (int r = 0; r < 16; ++r) acc[r] = 0.f;
            acc = mma32(Qs + (32 * qi + r32) * AP + 8 * hi, Ks + (32 * cj + r32) * AP + 8 * hi, 4, acc);
#pragma unroll
            for (int r = 0; r < 16; ++r) Ss[(32 * qi + crow(r, hi)) * SP + 32 * cj + r32] = acc[r];
        }
        __syncthreads();
        {
            const int row = tid >> 2, c0 = (tid & 3) * 16, qp = q0 + row;
            float s[16];
#pragma unroll
            for (int i = 0; i < 4; ++i) { const f32x4 t4 = *(const LAS f32x4*)(Ss + row * SP + c0 + 4 * i); s[4 * i] = t4.x; s[4 * i + 1] = t4.y; s[4 * i + 2] = t4.z; s[4 * i + 3] = t4.w; }
            float cq = 0.f; if (MODE == 1) cq = cum[qp];
            float mx = -1e30f;
#pragma unroll
            for (int i = 0; i < 16; ++i) { const int kp = ks + c0 + i;
                if (MODE == 1) s[i] += cq - cum[kp];
                const bool ok = (MODE == 1) ? (kp <= qp) : (kp <= qp && kp > qp - 128);
                s[i] = ok ? s[i] : -1e30f; mx = fmaxf(mx, s[i]); }
            mx = fmaxf(mx, __shfl_xor(mx, 1)); mx = fmaxf(mx, __shfl_xor(mx, 2));
            const float m_new = fmaxf(m_run, mx), alpha = __expf(m_run - m_new);
            float p[16], rsum = 0.f;
#pragma unroll
            for (int i = 0; i < 16; ++i) { p[i] = (s[i] > -1e29f) ? __expf(s[i] - m_new) : 0.f; rsum += p[i]; }
            rsum += __shfl_xor(rsum, 1); rsum += __shfl_xor(rsum, 2);
            l_run = l_run * alpha + rsum; m_run = m_new;
            v4u o0, o1; o0.x = pk2(p[0], p[1]); o0.y = pk2(p[2], p[3]); o0.z = pk2(p[4], p[5]); o0.w = pk2(p[6], p[7]);
            o1.x = pk2(p[8], p[9]); o1.y = pk2(p[10], p[11]); o1.z = pk2(p[12], p[13]); o1.w = pk2(p[14], p[15]);
            *(LAS v4u*)(Ps + row * AP + c0) = o0; *(LAS v4u*)(Ps + row * AP + c0 + 8) = o1;
            if ((tid & 3) == 0) AL[row] = alpha;
        }
        __syncthreads();
        {
#pragma unroll
            for (int r = 0; r < 16; ++r) o[r] *= AL[32 * qi + crow(r, hi)];
            o = mma32(Ps + (32 * qi + r32) * AP + 8 * hi, Vt + (32 * cj + r32) * AP + 8 * hi, 4, o);
        }
        __syncthreads();
    }
    {
        if (MODE == 0) l_run += __expf(A.in[I_SSINK][l * NH + h] - m_run);
        if ((tid & 3) == 0) AL[tid >> 2] = 1.0f / l_run;
    }
    __syncthreads();
#pragma unroll
    for (int r = 0; r < 16; ++r) { const int row = 32 * qi + crow(r, hi), d = 32 * cj + r32; const size_t m = rowb + q0 + row;
        float val = o[r] * AL[row];
        if (MODE == 1) val *= sigmoidf_(bf2f(proj[m * NP + PC_FG + h * 64 + d]));
        ycat[m * D + (MODE == 0 ? YC_B : YC_D) + h * 64 + d] = (bf16)f2bf(val); }
}
constexpr int GP = 136;
constexpr int G_W = 0, G_VT = 34816, G_ST = 52224;
__device__ __forceinline__ void sgu_unit(const Args& A, const Ctx& C, int l, int b, int chunk, int ghalf) {
    const bf16* proj = (const bf16*)(A.ws + WS_PROJ); bf16* ycat = (bf16*)(A.ws + WS_YCAT);
    const int tid = C.tid, lane = C.lane, wave = C.wave, r32 = lane & 31, hi = lane >> 5;
    const size_t m0 = (size_t)b * T + chunk * 128;
    LAS bf16* Wd = (LAS bf16*)(C.lds + G_W); LAS bf16* Vt = (LAS bf16*)(C.lds + G_VT); LAS float* ST = (LAS float*)(C.lds + G_ST);
    __syncthreads();
    {
        const int tok = tid >> 2, part = tid & 3; const v4u* src = (const v4u*)(proj + (m0 + tok) * NP + PC_GV + part * 128);
        float s1 = 0.f, s2 = 0.f;
#pragma unroll 4
        for (int i = 0; i < 16; ++i) { const v4u w = src[i];
            const float e0 = gelu_f(bflo(w.x)), e1 = gelu_f(bfhi(w.x)), e2 = gelu_f(bflo(w.y)), e3 = gelu_f(bfhi(w.y)), e4 = gelu_f(bflo(w.z)), e5 = gelu_f(bfhi(w.z)), e6 = gelu_f(bflo(w.w)), e7 = gelu_f(bfhi(w.w));
            s1 += ((e0 + e1) + (e2 + e3)) + ((e4 + e5) + (e6 + e7));
            s2 += ((e0 * e0 + e1 * e1) + (e2 * e2 + e3 * e3)) + ((e4 * e4 + e5 * e5) + (e6 * e6 + e7 * e7)); }
        s1 += __shfl_xor(s1, 1); s1 += __shfl_xor(s1, 2); s2 += __shfl_xor(s2, 1); s2 += __shfl_xor(s2, 2);
        const float mean = s1 * (1.0f / 512.0f), var = fmaxf(s2 * (1.0f / 512.0f) - mean * mean, 0.f);
        if (part == 0) { ST[2 * tok] = mean; ST[2 * tok + 1] = 1.0f / sqrtf(var + 1e-5f); }
    }
    __syncthreads();
    const int ti = wave >> 1, cj = wave & 1;
    for (int gi = 0; gi < 4; ++gi) {
        const int g = ghalf * 4 + gi;
        {
            const int row = tid >> 2, s0 = (tid & 3) * 32; const float* wsrc = A.in[I_GWS] + (size_t)(l * NH + g) * SGU_TRI + (row * (row + 1)) / 2;
#pragma unroll
            for (int i = 0; i < 32; i += 2) { const int s = s0 + i; const float w0 = (s <= row) ? wsrc[s] : 0.f, w1 = (s + 1 <= row) ? wsrc[s + 1] : 0.f;
                *(LAS unsigned*)(Wd + row * GP + s) = pk2(w0, w1); }
        }
        {
            const int tok = tid >> 2, c0 = (tid & 3) * 16; const v4u* src = (const v4u*)(proj + (m0 + tok) * NP + PC_GV + g * 64 + c0);
            const v4u r0 = src[0], r1 = src[1]; const float mean = ST[2 * tok], rstd = ST[2 * tok + 1];
            const float* lg = A.in[I_GLG] + l * GW + g * 64 + c0; const float* lb = A.in[I_GLB] + l * GW + g * 64 + c0;
            float f[16];
            f[0] = bflo(r0.x); f[1] = bfhi(r0.x); f[2] = bflo(r0.y); f[3] = bfhi(r0.y); f[4] = bflo(r0.z); f[5] = bfhi(r0.z); f[6] = bflo(r0.w); f[7] = bfhi(r0.w);
            f[8] = bflo(r1.x); f[9] = bfhi(r1.x); f[10] = bflo(r1.y); f[11] = bfhi(r1.y); f[12] = bflo(r1.z); f[13] = bfhi(r1.z); f[14] = bflo(r1.w); f[15] = bfhi(r1.w);
#pragma unroll
            for (int i = 0; i < 16; ++i) { const float y = (gelu_f(f[i]) - mean) * rstd * lg[i] + lb[i]; Vt[(c0 + i) * GP + tok] = (bf16)f2bf(y); }
        }
        __syncthreads();
        {
            f32x16 acc;
#pragma unroll
            for (int r = 0; r < 16; ++r) acc[r] = 0.f;
            acc = mma32(Wd + (32 * ti + r32) * GP + 8 * hi, Vt + (32 * cj + r32) * GP + 8 * hi, 2 * (ti + 1), acc);
            const float* bs = A.in[I_GB] + (size_t)(l * NH + g) * 128;
#pragma unroll
            for (int r = 0; r < 16; ++r) { const int t = 32 * ti + crow(r, hi), c = 32 * cj + r32; const size_t m = m0 + t;
                const float z = acc[r] + bs[t], u = gelu_f(bf2f(proj[m * NP + PC_GU + g * 64 + c]));
                ycat[m * D + YC_C + g * 64 + c] = (bf16)f2bf(u * z); }
        }
        __syncthreads();
    }
}
__device__ __forceinline__ float shifted(const bf16* proj, size_t m, int t, int col, float mu) {
    const float p = bf2f(proj[m * NP + col]); const float pp = (t > 0) ? bf2f(proj[(m - 1) * NP + col]) : 0.f; return p + (pp - p) * mu;
}
__device__ __forceinline__ void rwkv_prep_unit(const Args& A, const Ctx& C, int l, int tile) {
    const bf16* proj = (const bf16*)(A.ws + WS_PROJ);
    const int tid = C.tid, lane = C.lane, wave = C.wave;
    const size_t m0 = (size_t)tile * 64; const int b = (int)(m0 / T), t0 = (int)(m0 % T);
    LAS float* LR = (LAS float*)C.lds;
    const float* mu = A.in[I_RMU] + l * 1696;
    __syncthreads();
    for (int e = tid; e < 64 * 160; e += NTHREADS) { const int tok = e / 160, j = e % 160;
        const float x = shifted(proj, m0 + tok, t0 + tok, PC_RW + j, mu[1536 + j]);
        LR[e] = (j < 32) ? tanhf(x) : (j < 64 ? x : sigmoidf_(x)); }
    __syncthreads();
    const int c = tid;
    const float* w2 = A.in[I_RW2] + (size_t)l * 32 * GW + c; const float* a2 = A.in[I_RA2] + (size_t)l * 32 * GW + c; const float* g2 = A.in[I_RG2] + (size_t)l * 96 * GW + c;
    const float w0 = A.in[I_RW0][l * GW + c], a0 = A.in[I_RA0][l * GW + c], kkc = A.in[I_RKK][l * GW + c], kac = A.in[I_RKA][l * GW + c];
    const float mur = mu[c], muk = mu[512 + c], muv = mu[1024 + c];
    float* rin = (float*)(A.ws + WS_RIN) + ((size_t)(b * NH + wave) * T + t0) * 384 + lane;
    float* rg = (float*)(A.ws + WS_RG) + m0 * GW + c;
    for (int tg = 0; tg < 4; ++tg) {
        float aw[16], aa[16], ag[16];
#pragma unroll
        for (int k = 0; k < 16; ++k) { aw[k] = 0.f; aa[k] = 0.f; ag[k] = 0.f; }
        const LAS float* lr = LR + tg * 16 * 160;
        for (int m4 = 0; m4 < 8; ++m4) {
            const float wv0 = w2[(4 * m4 + 0) * GW], wv1 = w2[(4 * m4 + 1) * GW], wv2 = w2[(4 * m4 + 2) * GW], wv3 = w2[(4 * m4 + 3) * GW];
            const float av0 = a2[(4 * m4 + 0) * GW], av1 = a2[(4 * m4 + 1) * GW], av2 = a2[(4 * m4 + 2) * GW], av3 = a2[(4 * m4 + 3) * GW];
#pragma unroll
            for (int k = 0; k < 16; ++k) { const f32x4 x = *(const LAS f32x4*)(lr + k * 160 + 4 * m4), y = *(const LAS f32x4*)(lr + k * 160 + 32 + 4 * m4);
                aw[k] += (x.x * wv0 + x.y * wv1) + (x.z * wv2 + x.w * wv3); aa[k] += (y.x * av0 + y.y * av1) + (y.z * av2 + y.w * av3); }
        }
        for (int m4 = 0; m4 < 24; ++m4) {
            const float gv0 = g2[(4 * m4 + 0) * GW], gv1 = g2[(4 * m4 + 1) * GW], gv2 = g2[(4 * m4 + 2) * GW], gv3 = g2[(4 * m4 + 3) * GW];
#pragma unroll
            for (int k = 0; k < 16; ++k) { const f32x4 x = *(const LAS f32x4*)(lr + k * 160 + 64 + 4 * m4); ag[k] += (x.x * gv0 + x.y * gv1) + (x.z * gv2 + x.w * gv3); }
        }
#pragma unroll
        for (int k = 0; k < 16; ++k) { const int tok = tg * 16 + k; const size_t m = m0 + tok; const int t = t0 + tok;
            const float r = shifted(proj, m, t, PC_RR + c, mur), kx = shifted(proj, m, t, PC_RK + c, muk), v = shifted(proj, m, t, PC_RV + c, muv);
            const float decay = __expf(-0.6065306597126334f * sigmoidf_(w0 + aw[k]));
            const float ia = sigmoidf_(a0 + aa[k]);
            float kk = kx * kkc; const float n2 = wave_sum(kk * kk); kk = kk / fmaxf(sqrtf(n2), 1e-12f);
            const float kp = kx * (1.0f + (ia - 1.0f) * kac);
            float* o = rin + (size_t)tok * 384;
            o[0] = r; o[64] = decay; o[128] = kp; o[192] = v; o[256] = -kk; o[320] = kk * ia;
            rg[(size_t)tok * GW] = ag[k]; }
    }
}
__device__ __forceinline__ void rwkv_scan_unit(const Args& A, const Ctx& C, int bh) {
    const int tid = C.tid, lane = C.lane, wave = C.wave, il = lane >> 3, jq = lane & 7, irow = 8 * wave + il;
    const f32x4* rin4 = (const f32x4*)((const float*)(A.ws + WS_RIN) + (size_t)bh * T * 384);
    float* ry = (float*)(A.ws + WS_RY) + (size_t)(bh >> 3) * T * GW + (bh & 7) * 64 + irow;
    LAS f32x4* buf4 = (LAS f32x4*)C.lds;
    float S[8];
#pragma unroll
    for (int j = 0; j < 8; ++j) S[j] = 0.f;
    __syncthreads();
    { const f32x4 x0 = rin4[tid], x1 = rin4[tid + 512], x2 = rin4[tid + 1024]; buf4[tid] = x0; buf4[tid + 512] = x1; buf4[tid + 1024] = x2; }
    __syncthreads();
    for (int c = 0; c < T / 16; ++c) {
        f32x4 n0, n1, n2;
        const bool more = (c + 1 < T / 16);
        if (more) { const f32x4* src = rin4 + (size_t)(c + 1) * 1536; n0 = src[tid]; n1 = src[tid + 512]; n2 = src[tid + 1024]; }
        const LAS f32x4* cb = buf4 + (c & 1) * 1536;
        for (int tk = 0; tk < 16; ++tk) {
            const LAS f32x4* tb = cb + tk * 96;
            const f32x4 r0 = tb[0 * 16 + 2 * jq], r1 = tb[0 * 16 + 2 * jq + 1], w0 = tb[1 * 16 + 2 * jq], w1 = tb[1 * 16 + 2 * jq + 1], k0 = tb[2 * 16 + 2 * jq], k1 = tb[2 * 16 + 2 * jq + 1];
            const f32x4 a0 = tb[4 * 16 + 2 * jq], a1 = tb[4 * 16 + 2 * jq + 1], b0 = tb[5 * 16 + 2 * jq], b1 = tb[5 * 16 + 2 * jq + 1];
            const float v = ((const LAS float*)tb)[192 + irow];
            float sa = ((S[0] * a0.x + S[1] * a0.y) + (S[2] * a0.z + S[3] * a0.w)) + ((S[4] * a1.x + S[5] * a1.y) + (S[6] * a1.z + S[7] * a1.w));
            sa += __shfl_xor(sa, 1); sa += __shfl_xor(sa, 2); sa += __shfl_xor(sa, 4);
            S[0] = S[0] * w0.x + sa * b0.x + v * k0.x; S[1] = S[1] * w0.y + sa * b0.y + v * k0.y; S[2] = S[2] * w0.z + sa * b0.z + v * k0.z; S[3] = S[3] * w0.w + sa * b0.w + v * k0.w;
            S[4] = S[4] * w1.x + sa * b1.x + v * k1.x; S[5] = S[5] * w1.y + sa * b1.y + v * k1.y; S[6] = S[6] * w1.z + sa * b1.z + v * k1.z; S[7] = S[7] * w1.w + sa * b1.w + v * k1.w;
            float y = ((S[0] * r0.x + S[1] * r0.y) + (S[2] * r0.z + S[3] * r0.w)) + ((S[4] * r1.x + S[5] * r1.y) + (S[6] * r1.z + S[7] * r1.w));
            y += __shfl_xor(y, 1); y += __shfl_xor(y, 2); y += __shfl_xor(y, 4);
            if (jq == 0) ry[(size_t)(c * 16 + tk) * GW] = y;
        }
        if (more) { LAS f32x4* nb = buf4 + ((c + 1) & 1) * 1536; nb[tid] = n0; nb[tid + 512] = n1; nb[tid + 1024] = n2; }
        __syncthreads();
    }
}
__device__ __forceinline__ void ph_rwkv_post(const Args& A, const Ctx& C, int l) {
    const int gw = C.bid * NWAVES + C.wave, NGW = C.G * NWAVES, lane = C.lane;
    const float* RY = (const float*)(A.ws + WS_RY); const float* RG = (const float*)(A.ws + WS_RG); const float* RIN = (const float*)(A.ws + WS_RIN); bf16* ycat = (bf16*)(A.ws + WS_YCAT);
    for (int it = gw; it < M * NH; it += NGW) {
        const int m = it >> 3, h = it & 7, b = m / T, t = m % T, ch = h * 64 + lane;
        const float y = RY[(size_t)m * GW + ch];
        const float mean = wave_sum(y) * (1.0f / 64.0f), d = y - mean, var = wave_sum(d * d) * (1.0f / 64.0f);
        const float yn = d * (1.0f / sqrtf(var + 64e-5f)) * A.in[I_RLG][l * GW + ch] + A.in[I_RLB][l * GW + ch];
        const float* rin = RIN + ((size_t)(b * NH + h) * T + t) * 384 + lane;
        const float r = rin[0], k = rin[128], v = rin[192];
        const float bonus = wave_sum(r * k * A.in[I_RRK][l * GW + ch]) * v;
        ycat[(size_t)m * D + YC_A + ch] = (bf16)f2bf((yn + bonus) * RG[(size_t)m * GW + ch]);
    }
}
__device__ __forceinline__ void ph_mix1(const Args& A, const Ctx& C, int l) {
    for (int u = C.bid; u < 256 + 1024 + 256; u += C.G) {
        if (u < 256) rwkv_prep_unit(A, C, l, u);
        else if (u < 1280) { const int v = u - 256; attn_unit<0>(A, C, l, v >> 8, (v >> 5) & 7, v & 31); }
        else { const int v = u - 1280; sgu_unit(A, C, l, v >> 6, (v >> 1) & 31, v & 1); }
    }
}
__device__ __forceinline__ void ph_mix2(const Args& A, const Ctx& C, int l) {
    if (C.bid < 32 && C.G > 32) { rwkv_scan_unit(A, C, C.bid); return; }
    if (C.G <= 32) { for (int u = C.bid; u < 32; u += C.G) rwkv_scan_unit(A, C, u); }
    const int nf = (C.G > 32) ? C.G - 32 : C.G, f0 = (C.G > 32) ? C.bid - 32 : C.bid;
    for (int u = f0; u < 1024; u += nf) { const int qb = 31 - (u >> 5), bh = u & 31; attn_unit<1>(A, C, l, bh >> 3, bh & 7, qb); }
}
constexpr int N_PHASES = 2 + 9 * DEPTH;
#define IN(k) (lo <= (k) && (k) < hi)
#define SEAM(k) do { if (IN((k) + 1)) xcd_barrier(bar); } while (0)
template <int l>
__device__ __forceinline__ void layer_phases(const Args& A, const Ctx& C, const XcdBarrier& bar, const int lo, const int hi) {
    bf16* const H = (bf16*)(A.ws + WS_H); bf16* const PROJ = (bf16*)(A.ws + WS_PROJ); bf16* const YCAT = (bf16*)(A.ws + WS_YCAT); bf16* const FB = (bf16*)(A.ws + WS_F);
    constexpr int p0 = 2 + 9 * l;
    const float* xin = (l == 0) ? A.in[I_X] : A.out;
    const float* modl = (const float*)(A.ws + WS_MOD) + (size_t)l * NB * MODW;
    if (IN(p0 + 0)) { ph_norm(C, xin, A.in[I_N1G] + l * D, modl + 0 * D, modl + 1 * D, H); SEAM(p0 + 0); }
    if (IN(p0 + 1)) {
        pg8::Gemm g{H, (const bf16*)(A.ws + WS_WIN) + (size_t)l * NP * D, M, NP, D}; pg8::StaticOrder S; S.init(M, NP, C.G, C.bid);
        pg8::EpiStoreBf16 E{PROJ, NP};
        pg8::gemm_phase<pg8::EpiStoreBf16, pg8::StaticOrder, true, true>(C.lds, g, S, E);
        SEAM(p0 + 1); }
    if (IN(p0 + 2)) { ph_mix1(A, C, l); SEAM(p0 + 2); }
    if (IN(p0 + 3)) { ph_mix2(A, C, l); SEAM(p0 + 3); }
    if (IN(p0 + 4)) { ph_rwkv_post(A, C, l); SEAM(p0 + 4); }
    if (IN(p0 + 5)) {
        pg8::Gemm g{YCAT, (const bf16*)(A.ws + WS_WOUT) + (size_t)l * D * D, M, D, D}; pg8::StaticOrder S; S.init(M, D, C.G, C.bid);
        pg8::EpiResid E{xin, A.out, D, modl + 2 * D, MODW, T};
        pg8::gemm_phase<pg8::EpiResid, pg8::StaticOrder, true, true>(C.lds, g, S, E);
        SEAM(p0 + 5); }
    if (IN(p0 + 6)) { ph_norm(C, A.out, A.in[I_N2G] + l * D, modl + 3 * D, modl + 4 * D, H); SEAM(p0 + 6); }
    if (IN(p0 + 7)) {
        pg8::Gemm g{H, (const bf16*)(A.ws + WS_W13) + (size_t)l * 2 * FF * D, M, 2 * FF, D}; pg8::StaticOrder S; S.init(M, 2 * FF, C.G, C.bid);
        pg8::EpiSwiGLU E{FB, FF};
        pg8::gemm_phase<pg8::EpiSwiGLU, pg8::StaticOrder, true, true>(C.lds, g, S, E);
        SEAM(p0 + 7); }
    if (IN(p0 + 8)) {
        pg8::Gemm g{FB, (const bf16*)(A.ws + WS_W2) + (size_t)l * D * FF, M, D, FF}; pg8::StaticOrder S; S.init(M, D, C.G, C.bid);
        pg8::EpiResid E{A.out, A.out, D, modl + 5 * D, MODW, T};
        pg8::gemm_phase<pg8::EpiResid, pg8::StaticOrder, true, true>(C.lds, g, S, E);
        SEAM(p0 + 8); }
}
__global__ void __launch_bounds__(NTHREADS, 2) fwd_kernel(Args A) {
    extern __shared__ __attribute__((aligned(16))) unsigned char lds_raw[];
    Ctx C; C.lds = (LAS unsigned char*)lds_raw; C.tid = threadIdx.x; C.lane = C.tid & 63; C.wave = __builtin_amdgcn_readfirstlane(C.tid >> 6); C.G = gridDim.x; C.bid = blockIdx.x;
    volatile LAS unsigned* MISC = (volatile LAS unsigned*)(C.lds + MISC_OFF);
    for (int u = C.tid; u < (LDS_BYTES - LDSCTL_OFF) / 4; u += NTHREADS) ((LAS unsigned*)(C.lds + LDSCTL_OFF))[u] = 0u;
    __syncthreads();
    const int lo = A.ph_lo, hi = A.ph_hi;
    const bool multi = (hi - lo) > 1;
    XcdBarrier bar; bar.bar = (unsigned*)(A.ws + WS_CTL) + CW_BAR; bar.x = 0; bar.st = nullptr;
    if (multi) bar = xcd_barrier_post((unsigned*)(A.ws + WS_CTL) + CW_BAR, MISC + 8);
    if (IN(0)) { ph_prologue(A, C); SEAM(0); }
    if (IN(1)) { ph_modreduce(A, C); SEAM(1); }
    layer_phases<0>(A, C, bar, lo, hi);
    layer_phases<1>(A, C, bar, lo, hi);
    layer_phases<2>(A, C, bar, lo, hi);
    layer_phases<3>(A, C, bar, lo, hi);
}
#undef IN
#undef SEAM

extern "C" void kernel_launch(void* const* d_in, const int* in_sizes, int n_in, void* d_out, int out_size, void* d_ws, size_t ws_size, hipStream_t stream) {
    static int grid = 0;
    if (grid == 0) {
        if (n_in != N_INPUTS || out_size != M * D || ws_size < WS_END) { fprintf(stderr, "kernel_launch: unexpected problem (n_in %d, out %d, ws %zu; need %zu)\n", n_in, out_size, ws_size, (size_t)WS_END); grid = -1; return; }
        int dev = 0, cus = 0, per_cu = 0;
        if (hipGetDevice(&dev) != hipSuccess || hipDeviceGetAttribute(&cus, hipDeviceAttributeMultiprocessorCount, dev) != hipSuccess) { grid = -1; return; }
        if (hipFuncSetAttribute((const void*)fwd_kernel, hipFuncAttributeMaxDynamicSharedMemorySize, LDS_BYTES) != hipSuccess) { fprintf(stderr, "kernel_launch: hipFuncSetAttribute failed\n"); grid = -1; return; }
        if (hipOccupancyMaxActiveBlocksPerMultiprocessor(&per_cu, (const void*)fwd_kernel, NTHREADS, LDS_BYTES) != hipSuccess || per_cu < 1) fprintf(stderr, "kernel_launch: occupancy query reports %d\n", per_cu);
        (void)hipGetLastError();
        grid = cus;
    }
    if (grid < 0) return;
    (void)hipMemsetAsync((char*)d_ws + WS_CTL, 0, CTL_ZERO_BYTES, stream);
    Args a{};
    for (int i = 0; i < N_INPUTS; ++i) a.in[i] = (const float*)d_in[i];
    a.out = (float*)d_out; a.ws = (unsigned char*)d_ws;
#if MK_ONE_LAUNCH
    a.ph_lo = 0; a.ph_hi = N_PHASES;
    hipLaunchKernelGGL(fwd_kernel, dim3(grid), dim3(NTHREADS), LDS_BYTES, stream, a);
#else
    for (int p = 0; p < N_PHASES; ++p) { a.ph_lo = p; a.ph_hi = p + 1; hipLaunchKernelGGL(fwd_kernel, dim3(grid), dim3(NTHREADS), LDS_BYTES, stream, a); }
#endif
    const hipError_t le = hipPeekAtLastError();
    if (le != hipSuccess) fprintf(stderr, "kernel_launch: launch failed: %s\n", hipGetErrorName(le));
}
```

```cpp
#include <hip/hip_runtime.h>
#include <cstdio>
#include <cstdint>
#ifndef MK_ONE_LAUNCH
#define MK_ONE_LAUNCH 1
#endif
namespace pg8 {
#define PG8_LAS __attribute__((address_space(3)))
typedef unsigned short bf16_t;
typedef short bf16x8 __attribute__((ext_vector_type(8)));
typedef float f32x4 __attribute__((ext_vector_type(4)));
typedef unsigned u32x4 __attribute__((ext_vector_type(4)));
constexpr int BM = 256, BK = 64, HALF = 128, HTB = HALF * BK * 2  , STAGE_BYTES = 8 * HTB, NXCD = 8, WGM = 8;

__host__ __device__ __forceinline__ int lds_byte(int r, int c) { const int st = (r >> 4) * 2 + (c >> 5), rr = r & 15, cc = c & 31, ob = rr * 64 + cc * 2; return st * 1024 + (ob ^ (((ob >> 9) & 1) << 5)); }
__host__ __device__ __forceinline__ void stage_rc(int b, int& R, int& C) { const int st = b / 1024, sb = b % 1024, swz = sb ^ (((sb >> 9) & 1) << 5); R = (st >> 1) * 16 + swz / 64; C = (st & 1) * 32 + (swz % 64) / 2; }
__host__ __device__ __forceinline__ int perm32(int rho) { const int n = rho >> 4, i = rho & 15; return 8 * (i >> 2) + 4 * n + (i & 3); }

struct Unit { int pm, pn; };
struct Gemm { const bf16_t* A; const bf16_t* Bt; int M, N, K; };

struct StaticOrder {
    int nM, nN, nwg, G, c;
    __host__ __device__ void init(int M, int N, int G_, int c_) { nM = M / BM; nN = N / BM; nwg = nM * nN; G = G_; c = c_; }
    __host__ __device__ bool next(int i, Unit& u) const {
        const long L = (long)i * G + c; if (L >= nwg) return false;
        int wgid = (int)L; { const int q = nwg / NXCD, r = nwg % NXCD, xcd = wgid % NXCD, off = wgid / NXCD; wgid = (xcd < r ? xcd * (q + 1) : r * (q + 1) + (xcd - r) * q) + off; }
        const int nig = WGM * nN, gid = wgid / nig, fm = gid * WGM, gsz = (nM - fm) < WGM ? (nM - fm) : WGM;
        u.pm = fm + ((wgid % nig) % gsz); u.pn = (wgid % nig) / gsz; return true;
    }
    __device__ __forceinline__ void a_ready(const Unit&) const {}
    __device__ __forceinline__ void done(const Unit&) const {}
};

__device__ __forceinline__ unsigned cvt_pk_bf16(float lo, float hi) { unsigned r; asm volatile("v_cvt_pk_bf16_f32 %0, %1, %2" : "=v"(r) : "v"(lo), "v"(hi)); return r; }
typedef float f32x2 __attribute__((ext_vector_type(2)));
__device__ __forceinline__ f32x2 gelu_pk(f32x2 v) {
    const f32x2 av = __builtin_elementwise_abs(v), d = av * 0.2316418882f + 1.0f;
    f32x2 t; t.x = __builtin_amdgcn_rcpf(d.x); t.y = __builtin_amdgcn_rcpf(d.y);
    f32x2 q = t * 0.5307027145f + (-0.7265760135f); q = q * t + 0.7107068705f; q = q * t + (-0.142248368f); q = q * t + 0.127414796f; q = q * t;
    const f32x2 s = (v * v) * (-0.72134752044f);
    f32x2 e; e.x = __builtin_amdgcn_exp2f(s.x); e.y = __builtin_amdgcn_exp2f(s.y);
    const f32x2 m = v * (q * e), r = v - m;
    f32x2 o; o.x = v.x < 0.f ? m.x : r.x; o.y = v.y < 0.f ? m.y : r.y; return o;
}

struct EpiStoreBf16 {
    static constexpr bool PERM = true, AFTER_DRAIN = false;
    bf16_t* O; int ldc;
    __device__ __forceinline__ void operator()(const f32x4 (&acc)[2][2][4][2], const Unit& u, int wr, int wc, int fr, int fq) const {
        const int row0 = u.pm * BM + wr * 64 + fr, col0 = u.pn * BM + wc * 32 + 8 * fq;
#pragma unroll
        for (int ai = 0; ai < 2; ++ai)
#pragma unroll
            for (int m = 0; m < 4; ++m) { bf16_t* rowp = O + (size_t)(row0 + ai * HALF + m * 16) * ldc + col0;
#pragma unroll
                for (int bj = 0; bj < 2; ++bj) { const f32x4 v0 = acc[ai][bj][m][0], v1 = acc[ai][bj][m][1];
                    u32x4 w; w.x = cvt_pk_bf16(v0[0], v0[1]); w.y = cvt_pk_bf16(v0[2], v0[3]); w.z = cvt_pk_bf16(v1[0], v1[1]); w.w = cvt_pk_bf16(v1[2], v1[3]);
                    *(u32x4*)(rowp + bj * HALF) = w; } }
    }
};
struct EpiResid {
    static constexpr bool PERM = false, AFTER_DRAIN = false;
    const float* base; float* out; int ldc; const float* gate; int gate_stride; int rows_per_batch;
    __device__ __forceinline__ void operator()(const f32x4 (&acc)[2][2][4][2], const Unit& u, int wr, int wc, int fr, int fq) const {
        const int row0 = u.pm * BM + wr * 64 + fr, col0 = u.pn * BM + wc * 32 + 4 * fq;
        const float* gp = gate + (size_t)((u.pm * BM) / rows_per_batch) * gate_stride + col0;
        f32x4 gv[2][2];
#pragma unroll
        for (int bj = 0; bj < 2; ++bj)
#pragma unroll
            for (int n = 0; n < 2; ++n) gv[bj][n] = *(const f32x4*)(gp + bj * HALF + n * 16);
#pragma unroll
        for (int ai = 0; ai < 2; ++ai)
#pragma unroll
            for (int m = 0; m < 4; ++m) { const size_t off = (size_t)(row0 + ai * HALF + m * 16) * ldc + col0;
#pragma unroll
                for (int bj = 0; bj < 2; ++bj)
#pragma unroll
                    for (int n = 0; n < 2; ++n) { const f32x4 x = *(const f32x4*)(base + off + bj * HALF + n * 16);
                        *(f32x4*)(out + off + bj * HALF + n * 16) = x + gv[bj][n] * acc[ai][bj][m][n]; } }
    }
};
struct EpiSwiGLU {
    static constexpr bool PERM = true, AFTER_DRAIN = false;
    bf16_t* O; int ldc;
    __device__ __forceinline__ void operator()(const f32x4 (&acc)[2][2][4][2], const Unit& u, int wr, int wc, int fr, int fq) const {
        const int row0 = u.pm * BM + wr * 64 + fr, col0 = u.pn * HALF + wc * 32 + 8 * fq;
#pragma unroll
        for (int ai = 0; ai < 2; ++ai)
#pragma unroll
            for (int m = 0; m < 4; ++m) { bf16_t* rowp = O + (size_t)(row0 + ai * HALF + m * 16) * ldc + col0;
                float f[8];
#pragma unroll
                for (int n = 0; n < 2; ++n)
#pragma unroll
                    for (int e = 0; e < 4; ++e) { const float g = acc[ai][0][m][n][e], up = acc[ai][1][m][n][e];
                        f[n * 4 + e] = g * up * __builtin_amdgcn_rcpf(1.0f + __builtin_amdgcn_exp2f(-1.4426950408889634f * g)); }
                u32x4 w; w.x = cvt_pk_bf16(f[0], f[1]); w.y = cvt_pk_bf16(f[2], f[3]); w.z = cvt_pk_bf16(f[4], f[5]); w.w = cvt_pk_bf16(f[6], f[7]);
                *(u32x4*)rowp = w; }
    }
};

template <class Epi, class Sched, bool ALIGN_EPI = false, bool SP2 = false>
__device__ __forceinline__ void gemm_phase(PG8_LAS unsigned char* lds, const Gemm g, const Sched& S, const Epi& E) {
    const int tid = threadIdx.x, wid = __builtin_amdgcn_readfirstlane(tid >> 6), lane = tid & 63, wr = wid >> 2, wc = wid & 3, fr = lane & 15, fq = lane >> 4;
    const int K = g.K, nt = K / BK;
    unsigned voffA[2], voffB[2];
#pragma unroll
    for (int i = 0; i < 2; ++i) { int R, C; stage_rc(tid * 16 + i * 8192, R, C); const int Rb = Epi::PERM ? ((R & ~31) + perm32(R & 31)) : R;
        voffA[i] = (unsigned)(R * K + C) * 2u; voffB[i] = (unsigned)(Rb * K + C) * 2u; }
    const size_t kstep = (size_t)(BK * 2);
    const size_t hstep = (size_t)HALF * K * 2;
    const size_t tstep = 2 * hstep;
    const unsigned ldsw = (unsigned)wid * 1024u;
    const int aoff = lds_byte(wr * 64 + fr, fq * 8), boff = lds_byte(wc * 32 + fr, fq * 8);
#define PG8_SA(b, h) (((b) * 2 + (h)) * HTB)
#define PG8_SB(b, h) ((4 + (b) * 2 + (h)) * HTB)
#define PG8_STAGE(bufoff, gbase, voff) do { _Pragma("unroll") for (int _i = 0; _i < 2; ++_i) \
        __builtin_amdgcn_global_load_lds((const unsigned*)((const char*)(gbase) + (voff)[_i]), (PG8_LAS unsigned*)(lds + (bufoff) + ldsw + _i * 8192), 16, 0, 0); } while (0)
#define PG8_LDA(dst, b, h) do { _Pragma("unroll") for (int m = 0; m < 4; ++m) _Pragma("unroll") for (int k = 0; k < 2; ++k) dst[m][k] = *(const PG8_LAS bf16x8*)(lds + PG8_SA(b, h) + aoff + m * 2048 + k * 1024); } while (0)
#define PG8_LDB(dst, b, h) do { _Pragma("unroll") for (int n = 0; n < 2; ++n) _Pragma("unroll") for (int k = 0; k < 2; ++k) dst[n][k] = *(const PG8_LAS bf16x8*)(lds + PG8_SB(b, h) + boff + n * 2048 + k * 1024); } while (0)
#define PG8_MMA(ai, bj, At, Bt) do { __builtin_amdgcn_s_setprio(1); _Pragma("unroll") for (int m = 0; m < 4; ++m) _Pragma("unroll") for (int n = 0; n < 2; ++n) _Pragma("unroll") for (int k = 0; k < 2; ++k) \
        acc[ai][bj][m][n] = __builtin_amdgcn_mfma_f32_16x16x32_bf16(Bt[n][k], At[m][k], acc[ai][bj][m][n], 0, 0, 0); __builtin_amdgcn_s_setprio(0); } while (0)
#define PG8_WAIT_V(n) asm volatile("s_waitcnt vmcnt(" #n ")" ::: "memory")
#define PG8_WAIT_L(n) asm volatile("s_waitcnt lgkmcnt(" #n ")" ::: "memory")
#define PG8_BAR __builtin_amdgcn_s_barrier()
#define PG8_SCHED __builtin_amdgcn_sched_barrier(0)
    Unit cur, nxt; int ui = 0;
    if (!S.next(0, cur)) return;
    f32x4 acc[2][2][4][2];
#pragma unroll
    for (int a = 0; a < 2; ++a)
#pragma unroll
        for (int b = 0; b < 2; ++b)
#pragma unroll
            for (int m = 0; m < 4; ++m)
#pragma unroll
                for (int n = 0; n < 2; ++n) acc[a][b][m][n] = (f32x4){0.f, 0.f, 0.f, 0.f};
    bf16x8 At[4][2], B0[2][2], B1[2][2];
    const char* cA = (const char*)g.A + (size_t)cur.pm * tstep; const char* cB = (const char*)g.Bt + (size_t)cur.pn * tstep;
    S.a_ready(cur);
    if constexpr (SP2) {
        PG8_STAGE(PG8_SB(0, 0), cB, voffB); PG8_STAGE(PG8_SB(0, 1), cB + hstep, voffB); PG8_STAGE(PG8_SA(0, 0), cA, voffA); PG8_STAGE(PG8_SA(0, 1), cA + hstep, voffA);
        if (wr == 1) PG8_BAR;
        PG8_WAIT_V(2); PG8_BAR;
        PG8_STAGE(PG8_SB(1, 0), cB + kstep, voffB); PG8_STAGE(PG8_SA(1, 0), cA + kstep, voffA); PG8_STAGE(PG8_SB(1, 1), cB + hstep + kstep, voffB);
        PG8_WAIT_V(6); PG8_BAR;
    } else {
        PG8_STAGE(PG8_SB(0, 0), cB, voffB); PG8_STAGE(PG8_SA(0, 0), cA, voffA); PG8_STAGE(PG8_SB(0, 1), cB + hstep, voffB); PG8_STAGE(PG8_SA(0, 1), cA + hstep, voffA);
        if (wr == 1) PG8_BAR;
        PG8_WAIT_V(4); PG8_BAR;
        PG8_STAGE(PG8_SB(1, 0), cB + kstep, voffB); PG8_STAGE(PG8_SA(1, 0), cA + kstep, voffA); PG8_STAGE(PG8_SB(1, 1), cB + hstep + kstep, voffB);
        PG8_WAIT_V(6); PG8_BAR;
    }
    for (;;) {
        const bool has_next = S.next(ui + 1, nxt);
        const char* nA = has_next ? (const char*)g.A + (size_t)nxt.pm * tstep : cA; const char* nB = has_next ? (const char*)g.Bt + (size_t)nxt.pn * tstep : cB;
        for (int t = 0; t < nt; t += 2) {
            const bool last = (t == nt - 2);
            const char* a1 = cA + (size_t)(t + 1) * kstep;
            const char* a2 = last ? nA : cA + (size_t)(t + 2) * kstep; const char* b2 = last ? nB : cB + (size_t)(t + 2) * kstep;
            const char* a3 = a2 + kstep; const char* b3 = b2 + kstep;
            if (last && has_next) S.a_ready(nxt);
            if constexpr (SP2) {
            PG8_LDB(B0, 0, 0); PG8_LDB(B1, 0, 1); PG8_SCHED; PG8_LDA(At, 0, 0); PG8_STAGE(PG8_SA(1, 1), a1 + hstep, voffA);
            PG8_WAIT_V(8); PG8_WAIT_L(0); PG8_BAR; PG8_MMA(0, 0, At, B0); PG8_MMA(0, 1, At, B1); PG8_BAR; PG8_SCHED;
            PG8_LDA(At, 0, 1); PG8_STAGE(PG8_SB(0, 0), b2, voffB); PG8_STAGE(PG8_SB(0, 1), b2 + hstep, voffB); PG8_STAGE(PG8_SA(0, 0), a2, voffA);
            PG8_WAIT_V(8); PG8_WAIT_L(0); PG8_BAR; PG8_MMA(1, 0, At, B0); PG8_MMA(1, 1, At, B1); PG8_BAR; PG8_SCHED;
            PG8_LDB(B0, 1, 0); PG8_LDB(B1, 1, 1); PG8_SCHED; PG8_LDA(At, 1, 0); PG8_STAGE(PG8_SA(0, 1), a2 + hstep, voffA);
            PG8_WAIT_V(8); PG8_WAIT_L(0); PG8_BAR; PG8_MMA(0, 0, At, B0); PG8_MMA(0, 1, At, B1); PG8_BAR; PG8_SCHED;
            PG8_LDA(At, 1, 1); PG8_STAGE(PG8_SB(1, 0), b3, voffB); PG8_STAGE(PG8_SB(1, 1), b3 + hstep, voffB); PG8_STAGE(PG8_SA(1, 0), a3, voffA);
            PG8_WAIT_V(8); PG8_WAIT_L(0); PG8_BAR; PG8_MMA(1, 0, At, B0); PG8_MMA(1, 1, At, B1); PG8_BAR; PG8_SCHED;
            } else {
            PG8_LDB(B0, 0, 0); PG8_SCHED; PG8_LDA(At, 0, 0); PG8_STAGE(PG8_SA(1, 1), a1 + hstep, voffA);
            PG8_WAIT_L(8); PG8_BAR; PG8_WAIT_L(0); PG8_MMA(0, 0, At, B0); PG8_BAR; PG8_SCHED;
            PG8_LDB(B1, 0, 1); PG8_STAGE(PG8_SB(0, 0), b2, voffB);
            PG8_BAR; PG8_WAIT_L(0); PG8_MMA(0, 1, At, B1); PG8_BAR;
            PG8_LDA(At, 0, 1); PG8_STAGE(PG8_SA(0, 0), a2, voffA);
            PG8_BAR; PG8_WAIT_L(0); PG8_MMA(1, 0, At, B0); PG8_BAR; PG8_SCHED;
            PG8_STAGE(PG8_SB(0, 1), b2 + hstep, voffB);
            PG8_WAIT_V(6); PG8_BAR; PG8_MMA(1, 1, At, B1); PG8_BAR;
            PG8_LDB(B0, 1, 0); PG8_SCHED; PG8_LDA(At, 1, 0); PG8_STAGE(PG8_SA(0, 1), a2 + hstep, voffA);
            PG8_WAIT_L(8); PG8_BAR; PG8_WAIT_L(0); PG8_MMA(0, 0, At, B0); PG8_BAR; PG8_SCHED;
            PG8_LDB(B1, 1, 1); PG8_STAGE(PG8_SB(1, 0), b3, voffB);
            PG8_BAR; PG8_WAIT_L(0); PG8_MMA(0, 1, At, B1); PG8_BAR;
            PG8_LDA(At, 1, 1); PG8_STAGE(PG8_SA(1, 0), a3, voffA);
            PG8_BAR; PG8_WAIT_L(0); PG8_MMA(1, 0, At, B0); PG8_BAR; PG8_SCHED;
            PG8_STAGE(PG8_SB(1, 1), b3 + hstep, voffB);
            PG8_WAIT_V(6); PG8_BAR; PG8_MMA(1, 1, At, B1); PG8_BAR;
            }
        }
        if constexpr (ALIGN_EPI) { if (wr == 0) PG8_BAR; }
        if constexpr (!Epi::AFTER_DRAIN) { E(acc, cur, wr, wc, fr, fq); S.done(cur); }
        if (!has_next) break;
#pragma unroll
        for (int a = 0; a < 2; ++a)
#pragma unroll
            for (int b = 0; b < 2; ++b)
#pragma unroll
                for (int m = 0; m < 4; ++m)
#pragma unroll
                    for (int n = 0; n < 2; ++n) acc[a][b][m][n] = (f32x4){0.f, 0.f, 0.f, 0.f};
        cur = nxt; cA = nA; cB = nB; ++ui;
        if constexpr (ALIGN_EPI) { if (wr == 1) PG8_BAR; }
    }
    PG8_WAIT_V(0);
    if constexpr (!ALIGN_EPI) { if (wr == 0) PG8_BAR; }
    PG8_BAR;
    if constexpr (Epi::AFTER_DRAIN) { E.fused(acc, cur, wr, wc, fr, fq, lds, wid, lane); S.done(cur); }
#undef PG8_SA
#undef PG8_SB
#undef PG8_STAGE
#undef PG8_LDA
#undef PG8_LDB
#undef PG8_MMA
#undef PG8_WAIT_V
#undef PG8_WAIT_L
#undef PG8_BAR
#undef PG8_SCHED
}
}
constexpr int NWAVES = 8, NTHREADS = 512;
constexpr int D = 2048, NB = 4, T = 4096, M = NB * T, DEPTH = 4, GW = 512, NH = 8, HD = 64;
constexpr int NIN = 5544, NP = 5632, FF = 5632, MODW = 6 * D;
constexpr int PC_RR = 0, PC_RK = 512, PC_RV = 1024, PC_SQ = 1536, PC_SK = 2048, PC_SV = 2176, PC_GU = 2304, PC_GV = 2816;
constexpr int PC_FQ = 3328, PC_FK = 3840, PC_FV = 4352, PC_FG = 4864, PC_RW = 5376, PC_FL = 5536;
constexpr int YC_A = 0, YC_B = 512, YC_C = 1024, YC_D = 1536;
constexpr int SGU_TRI = 8256;
enum { I_X = 0, I_C, I_WMOD, I_BMOD, I_N1G, I_N2G, I_WIN, I_WOUT, I_RMU, I_RW0, I_RW2, I_RA0, I_RA2, I_RG2, I_RKK, I_RKA, I_RRK, I_RLG, I_RLB,
       I_SQG, I_SKG, I_SSINK, I_GLG, I_GLB, I_GWS, I_GB, I_FQG, I_FKG, I_FFB, I_W1, I_W3, I_W2, N_INPUTS };

constexpr size_t MiB = 1u << 20;
constexpr size_t WS_CTL = 0, CTL_ZERO_BYTES = 1 * MiB;
constexpr size_t WS_MOD = 1 * MiB;
constexpr size_t WS_MODP = 2 * MiB;
constexpr size_t WS_WIN = 8 * MiB;
constexpr size_t WS_WOUT = 96 * MiB;
constexpr size_t WS_W13 = 128 * MiB;
constexpr size_t WS_W2 = 304 * MiB;
constexpr size_t WS_H = 392 * MiB;
constexpr size_t WS_PROJ = 456 * MiB;
constexpr size_t WS_YCAT = 632 * MiB;
constexpr size_t WS_F = 696 * MiB;
constexpr size_t WS_RIN = 872 * MiB;
constexpr size_t WS_RG = 1064 * MiB;
constexpr size_t WS_RY = 1096 * MiB;
constexpr size_t WS_END = 1128 * MiB;
constexpr int CW_BAR = 4096;

constexpr int RING_BYTES = 131072;
constexpr int LDSCTL_OFF = RING_BYTES, MISC_OFF = LDSCTL_OFF + 320;
constexpr int LDS_BYTES = 147456;

#define GAS __attribute__((address_space(1)))
#define LAS __attribute__((address_space(3)))
typedef unsigned short bf16;
typedef short bf16x8 __attribute__((ext_vector_type(8)));
typedef float f32x4 __attribute__((ext_vector_type(4)));
typedef float f32x16 __attribute__((ext_vector_type(16)));
typedef unsigned v4u __attribute__((ext_vector_type(4)));
#define LDS_WAIT() asm volatile("s_waitcnt lgkmcnt(0)" ::: "memory")
__device__ __forceinline__ float bf2f(unsigned short b) { return __uint_as_float(((unsigned)b) << 16); }
__device__ __forceinline__ unsigned f2bf(float f) { unsigned u = __float_as_uint(f); return (u + 0x7fffu + ((u >> 16) & 1u)) >> 16; }
__device__ __forceinline__ unsigned pk2(float lo, float hi) { return f2bf(lo) | (f2bf(hi) << 16); }
__device__ __forceinline__ float bflo(unsigned w) { return __uint_as_float(w << 16); }
__device__ __forceinline__ float bfhi(unsigned w) { return __uint_as_float(w & 0xffff0000u); }
__device__ __forceinline__ float wave_sum(float v) {
#pragma unroll
    for (int o = 1; o < 64; o <<= 1) v += __shfl_xor(v, o);
    return v;
}
__device__ __forceinline__ float sigmoidf_(float x) { return 1.0f / (1.0f + __expf(-x)); }
__device__ __forceinline__ float gelu_f(float v) {
    const float av = fabsf(v), t = __builtin_amdgcn_rcpf(av * 0.2316418882f + 1.0f);
    float q = t * 0.5307027145f + (-0.7265760135f); q = q * t + 0.7107068705f; q = q * t + (-0.142248368f); q = q * t + 0.127414796f; q = q * t;
    const float e = __builtin_amdgcn_exp2f((v * v) * (-0.72134752044f));
    const float m = v * (q * e);
    return v < 0.f ? m : v - m;
}
__device__ __forceinline__ int crow(int r, int hi) { return (r & 3) + 8 * (r >> 2) + 4 * hi; }

#define XB_TMO      128
#define XB_XCNT(j)  (256  + 64 * (j))
#define XB_XSUB(j)  (1280 + 64 * (j))
#define XB_XGEN(j)  (2304 + 64 * (j))
#define XB_TOP      3328
#define XB_TOPGEN   3392
#define XCD_BAR_WORDS 3456
#define XB_SPIN_CAP (1u << 18)

__device__ __forceinline__ unsigned xb_ld(unsigned* p)              { return __hip_atomic_load(p, __ATOMIC_RELAXED, __HIP_MEMORY_SCOPE_AGENT); }
__device__ __forceinline__ unsigned xb_add(unsigned* p, unsigned v) { return __hip_atomic_fetch_add(p, v, __ATOMIC_RELAXED, __HIP_MEMORY_SCOPE_AGENT); }
__device__ __forceinline__ unsigned xb_xcc_id() { return (unsigned)__builtin_amdgcn_s_getreg((3 << 11) | 20) & 0xFu; }
#define XB_SPIN(cond, bar) do { unsigned _sp = 0; while (cond) { __builtin_amdgcn_s_sleep(1); \
    if ((++_sp & 255u) == 0u) { if (xb_ld(&(bar)[XB_TMO])) break; if (_sp > XB_SPIN_CAP) { atomicAdd(&(bar)[XB_TMO], 1u); break; } } } } while (0)

struct XcdBarrier {
    unsigned* bar; unsigned x;
    volatile LAS unsigned* st;
};

__device__ __forceinline__ XcdBarrier xcd_barrier_post(unsigned* bar, volatile LAS unsigned* st) {
    XcdBarrier b; b.bar = bar; b.x = xb_xcc_id(); b.st = st;
    if (threadIdx.x == 0) (void)xb_add(&bar[XB_XCNT(b.x)], 1u);
    return b;
}
__device__ __forceinline__ void xcd_barrier_complete(unsigned* bar, unsigned x, unsigned& nloc, unsigned& nx) {
    const unsigned G = gridDim.x * gridDim.y * gridDim.z;
    unsigned sum, cnt, mine, sp = 0u;
    for (;;) {
        sum = 0u; cnt = 0u; mine = 0u;
#pragma unroll
        for (unsigned j = 0; j < 16; ++j) { const unsigned c = xb_ld(&bar[XB_XCNT(j)]); sum += c; cnt += (c > 0u) ? 1u : 0u; mine = (j == x) ? c : mine; }
        if (sum == G) break;
        __builtin_amdgcn_s_sleep(1);
        if ((++sp & 255u) == 0u) { if (xb_ld(&bar[XB_TMO])) break; if (sp > XB_SPIN_CAP) { atomicAdd(&bar[XB_TMO], 1u); break; } }
    }
    nloc = mine > 0u ? mine : 1u; nx = cnt > 0u ? cnt : 1u;
}

__device__ __forceinline__ void xcd_barrier(const XcdBarrier& b) {
    asm volatile("s_waitcnt vmcnt(0)" ::: "memory");
    __syncthreads();
    if (threadIdx.x == 0) {
        unsigned* bar = b.bar;
        __builtin_amdgcn_s_waitcnt(0);
        unsigned nloc = b.st[0], nx = b.st[1];
        if (nloc == 0u) { xcd_barrier_complete(bar, b.x, nloc, nx); b.st[0] = nloc; b.st[1] = nx; }
        const unsigned old = xb_add(&bar[XB_XSUB(b.x)], 1u);
        const unsigned gen = old / nloc;
        if (old + 1u == (gen + 1u) * nloc) {
            __builtin_amdgcn_fence(__ATOMIC_RELEASE, "agent");
            asm volatile("s_waitcnt vmcnt(0)" ::: "memory");
            const unsigned og = xb_add(&bar[XB_TOP], 1u);
            const unsigned tg = og / nx;
            if (og + 1u == (tg + 1u) * nx) xb_add(&bar[XB_TOPGEN], 1u);
            else XB_SPIN(xb_ld(&bar[XB_TOPGEN]) == tg, bar);
            __builtin_amdgcn_fence(__ATOMIC_ACQUIRE, "agent");
            xb_add(&bar[XB_XGEN(b.x)], 1u);
            asm volatile("s_waitcnt vmcnt(0)" ::: "memory");
        } else {
            XB_SPIN(xb_ld(&bar[XB_XGEN(b.x)]) == gen, bar);
            __builtin_amdgcn_fence(__ATOMIC_ACQUIRE, "agent");
            asm volatile("s_waitcnt vmcnt(0)" ::: "memory");
        }
    }
    __syncthreads();
}

struct Args { const float* in[N_INPUTS]; float* out; unsigned char* ws; int ph_lo, ph_hi; };
static_assert(sizeof(Args) == (N_INPUTS + 2) * 8 + 8, "Args has no padding");

struct Ctx {
    LAS unsigned char* lds; int tid, lane, wave, G, bid;
};

__device__ __forceinline__ void tr_item(const float* __restrict__ W, int N, int col0, int nvalid, int k0, bf16* __restrict__ WT, int K, int n0, LAS float* scr, int lane) {
#pragma unroll 8
    for (int i = 0; i < 32; ++i) { const int kk = 2 * i + (lane >> 5), nn = lane & 31; float v = 0.f; if (nn < nvalid) v = W[(size_t)(k0 + kk) * N + col0 + nn]; scr[kk * 33 + nn] = v; }
    LDS_WAIT(); asm volatile("" ::: "memory");
    const int c = lane & 7;
#pragma unroll
    for (int j = 0; j < 4; ++j) { const int n = (lane >> 3) + 8 * j; const LAS float* s = scr + (8 * c) * 33 + n;
        v4u o; o.x = pk2(s[0 * 33], s[1 * 33]); o.y = pk2(s[2 * 33], s[3 * 33]); o.z = pk2(s[4 * 33], s[5 * 33]); o.w = pk2(s[6 * 33], s[7 * 33]);
        *(v4u*)(WT + (size_t)(n0 + n) * K + k0 + 8 * c) = o; }
    LDS_WAIT(); asm volatile("" ::: "memory");
}
__device__ __forceinline__ void ph_prologue(const Args& A, const Ctx& C) {
    LAS float* csilu = (LAS float*)(C.lds + 73728);
    for (int i = C.tid; i < NB * D; i += NTHREADS) { const float c = A.in[I_C][i]; csilu[i] = c / (1.0f + __expf(-c)); }
    __syncthreads();
    LAS float* scr = (LAS float*)(C.lds + C.wave * 8704);
    const int gw = C.bid * NWAVES + C.wave, NGW = C.G * NWAVES;
    constexpr int I_IN = (D / 64) * (NP / 32), I_OUT = (D / 64) * (D / 32), I_13 = (D / 64) * (2 * FF / 32), I_2 = (FF / 64) * (D / 32), PER_L = I_IN + I_OUT + I_13 + I_2;
    for (int it = gw; it < DEPTH * PER_L; it += NGW) {
        const int l = it / PER_L; int r = it % PER_L;
        if (r < I_IN) { const int kb = r / (NP / 32), nb = r % (NP / 32), n0 = 32 * nb; int col0, nv = 32;
            if (n0 < 1536) col0 = n0; else if (n0 < 4864) col0 = n0 + 160; else if (n0 < 5376) col0 = n0 + 168; else if (n0 < 5536) col0 = n0 - 3840;
            else if (n0 == 5536) { col0 = 5024; nv = 8; } else { col0 = 0; nv = 0; }
            tr_item(A.in[I_WIN] + (size_t)l * D * NIN, NIN, col0, nv, 64 * kb, (bf16*)(A.ws + WS_WIN) + (size_t)l * NP * D, D, n0, scr, C.lane); continue; }
        r -= I_IN;
        if (r < I_OUT) { const int kb = r / (D / 32), nb = r % (D / 32);
            tr_item(A.in[I_WOUT] + (size_t)l * D * D, D, 32 * nb, 32, 64 * kb, (bf16*)(A.ws + WS_WOUT) + (size_t)l * D * D, D, 32 * nb, scr, C.lane); continue; }
        r -= I_OUT;
        if (r < I_13) { const int kb = r / (2 * FF / 32), nb = r % (2 * FF / 32), n0 = 32 * nb, pn = n0 >> 8, j = n0 & 255;
            const float* src = (j < 128 ? A.in[I_W1] : A.in[I_W3]) + (size_t)l * D * FF;
            tr_item(src, FF, 128 * pn + (j & 127), 32, 64 * kb, (bf16*)(A.ws + WS_W13) + (size_t)l * 2 * FF * D, D, n0, scr, C.lane); continue; }
        r -= I_13;
        { const int kb = r / (D / 32), nb = r % (D / 32);
            tr_item(A.in[I_W2] + (size_t)l * FF * D, D, 32 * nb, 32, 64 * kb, (bf16*)(A.ws + WS_W2) + (size_t)l * D * FF, FF, 32 * nb, scr, C.lane); }
    }
    for (int it = gw; it < 8 * DEPTH * (MODW / 256); it += NGW) {
        const int cg = it % (DEPTH * (MODW / 256)), ks = it / (DEPTH * (MODW / 256)), l = cg / (MODW / 256), n0 = (cg % (MODW / 256)) * 256, k0 = ks * 256;
        const float* wp = A.in[I_WMOD] + ((size_t)l * D + k0) * MODW + n0 + 4 * C.lane;
        f32x4 a0 = {0.f, 0.f, 0.f, 0.f}, a1 = a0, a2 = a0, a3 = a0;
#pragma unroll 8
        for (int k = 0; k < 256; ++k) { const f32x4 w = *(const f32x4*)(wp + (size_t)k * MODW);
            a0 += w * csilu[0 * D + k0 + k]; a1 += w * csilu[1 * D + k0 + k]; a2 += w * csilu[2 * D + k0 + k]; a3 += w * csilu[3 * D + k0 + k]; }
        float* mp = (float*)(A.ws + WS_MODP) + ((size_t)(ks * DEPTH + l) * NB) * MODW + n0 + 4 * C.lane;
        *(f32x4*)(mp + 0 * MODW) = a0; *(f32x4*)(mp + 1 * MODW) = a1; *(f32x4*)(mp + 2 * MODW) = a2; *(f32x4*)(mp + 3 * MODW) = a3;
    }
}
__device__ __forceinline__ void ph_modreduce(const Args& A, const Ctx& C) {
    const float* mp = (const float*)(A.ws + WS_MODP); float* mod = (float*)(A.ws + WS_MOD);
    for (int i = C.bid * NTHREADS + C.tid; i < DEPTH * NB * MODW; i += C.G * NTHREADS) {
        const int l = i / (NB * MODW), n = i % MODW; float s = A.in[I_BMOD][l * MODW + n];
#pragma unroll
        for (int ks = 0; ks < 8; ++ks) s += mp[(size_t)ks * DEPTH * NB * MODW + i];
        mod[i] = s;
    }
}
__device__ __forceinline__ void ph_norm(const Ctx& C, const float* x, const float* g, const float* shift, const float* scale, bf16* H) {
    const int gw = C.bid * NWAVES + C.wave, NGW = C.G * NWAVES;
    for (int m = gw; m < M; m += NGW) {
        const int b = m / T; const f32x4* xr = (const f32x4*)(x + (size_t)m * D) + C.lane;
        f32x4 v[8]; float ss = 0.f;
#pragma unroll
        for (int j = 0; j < 8; ++j) { v[j] = xr[64 * j]; ss += (v[j].x * v[j].x + v[j].y * v[j].y) + (v[j].z * v[j].z + v[j].w * v[j].w); }
        const float rstd = 1.0f / sqrtf(wave_sum(ss) * (1.0f / D) + 1e-6f);
        unsigned long long* o8 = (unsigned long long*)(H + (size_t)m * D) + C.lane;
#pragma unroll
        for (int j = 0; j < 8; ++j) { const int c = 4 * (C.lane + 64 * j);
            const f32x4 gg = *(const f32x4*)(g + c), sc = *(const f32x4*)(scale + (size_t)b * MODW + c), sh = *(const f32x4*)(shift + (size_t)b * MODW + c);
            const f32x4 y = v[j] * rstd * gg * (sc + 1.0f) + sh;
            o8[64 * j] = (unsigned long long)pk2(y.x, y.y) | ((unsigned long long)pk2(y.z, y.w) << 32); }
    }
}

__device__ __forceinline__ f32x16 mma32(const LAS bf16* Ap, const LAS bf16* Bp, int ksteps, f32x16 acc) {
    for (int k = 0; k < ksteps; ++k) { const bf16x8 a = *(const LAS bf16x8*)(Ap + 16 * k), b = *(const LAS bf16x8*)(Bp + 16 * k);
        acc = __builtin_amdgcn_mfma_f32_32x32x16_bf16(a, b, acc, 0, 0, 0); }
    return acc;
}
constexpr int AP = 72;
constexpr int A_Q = 0, A_K = 18432, A_VT = 27648, A_S = 36864, A_P = 71680, A_AL = 90112, A_CUM = 90624, A_END = 107008;
constexpr int SP = 68;
template <int MODE>
__device__ __forceinline__ void attn_unit(const Args& A, const Ctx& C, int l, int b, int h, int qb) {
    const bf16* proj = (const bf16*)(A.ws + WS_PROJ); bf16* ycat = (bf16*)(A.ws + WS_YCAT);
    const int tid = C.tid, lane = C.lane, wave = C.wave, r32 = lane & 31, hi = lane >> 5;
    const int q0 = qb * 128; const size_t rowb = (size_t)b * T;
    const int qcol = (MODE == 0 ? PC_SQ : PC_FQ) + h * 64;
    const int kcol = (MODE == 0) ? PC_SK + (h >> 2) * 64 : PC_FK + h * 64;
    const int vcol = (MODE == 0) ? PC_SV + (h >> 2) * 64 : PC_FV + h * 64;
    const float* qg = A.in[MODE == 0 ? I_SQG : I_FQG] + l * 64; const float* kg = A.in[MODE == 0 ? I_SKG : I_FKG] + l * 64;
    LAS bf16* Qs = (LAS bf16*)(C.lds + A_Q); LAS bf16* Ks = (LAS bf16*)(C.lds + A_K); LAS bf16* Vt = (LAS bf16*)(C.lds + A_VT);
    LAS float* Ss = (LAS float*)(C.lds + A_S); LAS bf16* Ps = (LAS bf16*)(C.lds + A_P); LAS float* AL = (LAS float*)(C.lds + A_AL); LAS float* cum = (LAS float*)(C.lds + A_CUM);
    __syncthreads();
    if (MODE == 1) {
        const int n = q0 + 128; const float fb = A.in[I_FFB][l * NH + h];
        float loc[8]; float s = 0.f;
#pragma unroll
        for (int i = 0; i < 8; ++i) { const int pos = 8 * tid + i; float v = 0.f;
            if (pos < n) { const float x = bf2f(proj[(rowb + pos) * NP + PC_FL + h]) + fb; v = (x < 0.f) ? x - log1pf(expf(x)) : -log1pf(expf(-x)); }
            s += v; loc[i] = s; }
        float ws_ = s;
#pragma unroll
        for (int o = 1; o < 64; o <<= 1) { const float t_ = __shfl_up(ws_, o); if (lane >= o) ws_ += t_; }
        if (lane == 63) AL[wave] = ws_;
        __syncthreads();
        float base = ws_ - s;
        for (int w = 0; w < wave; ++w) base += AL[w];
#pragma unroll
        for (int i = 0; i < 8; ++i) { const int pos = 8 * tid + i; if (pos < n) cum[pos] = base + loc[i]; }
    }
    {
        const int row = tid >> 2, dq = (tid & 3) * 16;
        const v4u* src = (const v4u*)(proj + (rowb + q0 + row) * NP + qcol + dq);
        const v4u r0 = src[0], r1 = src[1];
        float f[16];
        f[0] = bflo(r0.x); f[1] = bfhi(r0.x); f[2] = bflo(r0.y); f[3] = bfhi(r0.y); f[4] = bflo(r0.z); f[5] = bfhi(r0.z); f[6] = bflo(r0.w); f[7] = bfhi(r0.w);
        f[8] = bflo(r1.x); f[9] = bfhi(r1.x); f[10] = bflo(r1.y); f[11] = bfhi(r1.y); f[12] = bflo(r1.z); f[13] = bfhi(r1.z); f[14] = bflo(r1.w); f[15] = bfhi(r1.w);
        float ss = 0.f;
#pragma unroll
        for (int i = 0; i < 16; ++i) ss += f[i] * f[i];
        ss += __shfl_xor(ss, 1); ss += __shfl_xor(ss, 2);
        const float rs = 0.125f / sqrtf(ss * (1.0f / 64.0f) + 1e-6f);
#pragma unroll
        for (int i = 0; i < 16; ++i) f[i] = f[i] * rs * qg[dq + i];
        v4u o0, o1; o0.x = pk2(f[0], f[1]); o0.y = pk2(f[2], f[3]); o0.z = pk2(f[4], f[5]); o0.w = pk2(f[6], f[7]);
        o1.x = pk2(f[8], f[9]); o1.y = pk2(f[10], f[11]); o1.z = pk2(f[12], f[13]); o1.w = pk2(f[14], f[15]);
        *(LAS v4u*)(Qs + row * AP + dq) = o0; *(LAS v4u*)(Qs + row * AP + dq + 8) = o1;
    }
    const int ks_begin = (MODE == 0) ? (q0 >= 128 ? q0 - 128 : 0) : 0, ks_end = q0 + 128;
    float m_run = -1e30f, l_run = 0.f;
    f32x16 o;
#pragma unroll
    for (int r = 0; r < 16; ++r) o[r] = 0.f;
    const int qi = wave >> 1, cj = wave & 1;
    for (int ks = ks_begin; ks < ks_end; ks += 64) {
        {
            const int row = tid >> 3, dc = (tid & 7) * 8;
            const v4u kr = *(const v4u*)(proj + (rowb + ks + row) * NP + kcol + dc);
            float f[8]; f[0] = bflo(kr.x); f[1] = bfhi(kr.x); f[2] = bflo(kr.y); f[3] = bfhi(kr.y); f[4] = bflo(kr.z); f[5] = bfhi(kr.z); f[6] = bflo(kr.w); f[7] = bfhi(kr.w);
            float ss = 0.f;
#pragma unroll
            for (int i = 0; i < 8; ++i) ss += f[i] * f[i];
            ss += __shfl_xor(ss, 1); ss += __shfl_xor(ss, 2); ss += __shfl_xor(ss, 4);
            const float rs = 1.0f / sqrtf(ss * (1.0f / 64.0f) + 1e-6f);
#pragma unroll
            for (int i = 0; i < 8; ++i) f[i] = f[i] * rs * kg[dc + i];
            v4u ko; ko.x = pk2(f[0], f[1]); ko.y = pk2(f[2], f[3]); ko.z = pk2(f[4], f[5]); ko.w = pk2(f[6], f[7]);
            *(LAS v4u*)(Ks + row * AP + dc) = ko;
            const v4u vr = *(const v4u*)(proj + (rowb + ks + row) * NP + vcol + dc);
            Vt[(dc + 0) * AP + row] = (bf16)(vr.x & 0xffffu); Vt[(dc + 1) * AP + row] = (bf16)(vr.x >> 16);
            Vt[(dc + 2) * AP + row] = (bf16)(vr.y & 0xffffu); Vt[(dc + 3) * AP + row] = (bf16)(vr.y >> 16);
            Vt[(dc + 4) * AP + row] = (bf16)(vr.z & 0xffffu); Vt[(dc + 5) * AP + row] = (bf16)(vr.z >> 16);
            Vt[(dc + 6) * AP + row] = (bf16)(vr.w & 0xffffu); Vt[(dc + 7) * AP + row] = (bf16)(vr.w >> 16);
        }
        __syncthreads();
        {
            f32x16 acc;
#pragma unroll
            for (int r = 0; r < 16; ++r) acc[r] = 0.f;
            acc = mma32(Qs + (32 * qi + r32) * AP + 8 * hi, Ks + (32 * cj + r32) * AP + 8 * hi, 4, acc);
#pragma unroll
            for (int r = 0; r < 16; ++r) Ss[(32 * qi + crow(r, hi)) * SP + 32 * cj + r32] = acc[r];
        }
        __syncthreads();
        {
            const int row = tid >> 2, c0 = (tid & 3) * 16, qp = q0 + row;
            float s[16];
#pragma unroll
            for (int i = 0; i < 4; ++i) { const f32x4 t4 = *(const LAS f32x4*)(Ss + row * SP + c0 + 4 * i); s[4 * i] = t4.x; s[4 * i + 1] = t4.y; s[4 * i + 2] = t4.z; s[4 * i + 3] = t4.w; }
            float cq = 0.f; if (MODE == 1) cq = cum[qp];
            float mx = -1e30f;
#pragma unroll
            for (int i = 0; i < 16; ++i) { const int kp = ks + c0 + i;
                if (MODE == 1) s[i] += cq - cum[kp];
                const bool ok = (MODE == 1) ? (kp <= qp) : (kp <= qp && kp > qp - 128);
                s[i] = ok ? s[i] : -1e30f; mx = fmaxf(mx, s[i]); }
            mx = fmaxf(mx, __shfl_xor(mx, 1)); mx = fmaxf(mx, __shfl_xor(mx, 2));
            const float m_new = fmaxf(m_run, mx), alpha = __expf(m_run - m_new);
            float p[16], rsum = 0.f;
#pragma unroll
            for (int i = 0; i < 16; ++i) { p[i] = (s[i] > -1e29f) ? __expf(s[i] - m_new) : 0.f; rsum += p[i]; }
            rsum += __shfl_xor(rsum, 1); rsum += __shfl_xor(rsum, 2);
            l_run = l_run * alpha + rsum; m_run = m_new;
            v4u o0, o1; o0.x = pk2(p[0], p[1]); o0.y = pk2(p[2], p[3]); o0.z = pk2(p[4], p[5]); o0.w = pk2(p[6], p[7]);
            o1.x = pk2(p[8], p[9]); o1.y = pk2(p[10], p[11]); o1.z = pk2(p[12], p[13]); o1.w = pk2(p[14], p[15]);
            *(LAS v4u*)(Ps + row * AP + c0) = o0; *(LAS v4u*)(Ps + row * AP + c0 + 8) = o1;
            if ((tid & 3) == 0) AL[row] = alpha;
        }
        __syncthreads();
        {
#pragma unroll
            for (int r = 0; r < 16; ++r) o[r] *= AL[32 * qi + crow(r, hi)];
            o = mma32(Ps + (32 * qi + r32) * AP + 8 * hi, Vt + (32 * cj + r32) * AP + 8 * hi, 4, o);
        }
        __syncthreads();
    }
    {
        if (MODE == 0) l_run += __expf(A.in[I_SSINK][l * NH + h] - m_run);
        if ((tid & 3) == 0) AL[tid >> 2] = 1.0f / l_run;
    }
    __syncthreads();
#pragma unroll
    for (int r = 0; r < 16; ++r) { const int row = 32 * qi + crow(r, hi), d = 32 * cj + r32; const size_t m = rowb + q0 + row;
        float val = o[r] * AL[row];
        if (MODE == 1) val *= sigmoidf_(bf2f(proj[m * NP + PC_FG + h * 64 + d]));
        ycat[m * D + (MODE == 0 ? YC_B : YC_D) + h * 64 + d] = (bf16)f2bf(val); }
}
constexpr int GP = 136;
constexpr int G_W = 0, G_VT = 34816, G_ST = 52224;
__device__ __forceinline__ void sgu_unit(const Args& A, const Ctx& C, int l, int b, int chunk, int ghalf) {
    const bf16* proj = (const bf16*)(A.ws + WS_PROJ); bf16* ycat = (bf16*)(A.ws + WS_YCAT);
    const int tid = C.tid, lane = C.lane, wave = C.wave, r32 = lane & 31, hi = lane >> 5;
    const size_t m0 = (size_t)b * T + chunk * 128;
    LAS bf16* Wd = (LAS bf16*)(C.lds + G_W); LAS bf16* Vt = (LAS bf16*)(C.lds + G_VT); LAS float* ST = (LAS float*)(C.lds + G_ST);
    __syncthreads();
    {
        const int tok = tid >> 2, part = tid & 3; const v4u* src = (const v4u*)(proj + (m0 + tok) * NP + PC_GV + part * 128);
        float s1 = 0.f, s2 = 0.f;
#pragma unroll 4
        for (int i = 0; i < 16; ++i) { const v4u w = src[i];
            const float e0 = gelu_f(bflo(w.x)), e1 = gelu_f(bfhi(w.x)), e2 = gelu_f(bflo(w.y)), e3 = gelu_f(bfhi(w.y)), e4 = gelu_f(bflo(w.z)), e5 = gelu_f(bfhi(w.z)), e6 = gelu_f(bflo(w.w)), e7 = gelu_f(bfhi(w.w));
            s1 += ((e0 + e1) + (e2 + e3)) + ((e4 + e5) + (e6 + e7));
            s2 += ((e0 * e0 + e1 * e1) + (e2 * e2 + e3 * e3)) + ((e4 * e4 + e5 * e5) + (e6 * e6 + e7 * e7)); }
        s1 += __shfl_xor(s1, 1); s1 += __shfl_xor(s1, 2); s2 += __shfl_xor(s2, 1); s2 += __shfl_xor(s2, 2);
        const float mean = s1 * (1.0f / 512.0f), var = fmaxf(s2 * (1.0f / 512.0f) - mean * mean, 0.f);
        if (part == 0) { ST[2 * tok] = mean; ST[2 * tok + 1] = 1.0f / sqrtf(var + 1e-5f); }
    }
    __syncthreads();
    const int ti = wave >> 1, cj = wave & 1;
    for (int gi = 0; gi < 4; ++gi) {
        const int g = ghalf * 4 + gi;
        {
            const int row = tid >> 2, s0 = (tid & 3) * 32; const float* wsrc = A.in[I_GWS] + (size_t)(l * NH + g) * SGU_TRI + (row * (row + 1)) / 2;
#pragma unroll
            for (int i = 0; i < 32; i += 2) { const int s = s0 + i; const float w0 = (s <= row) ? wsrc[s] : 0.f, w1 = (s + 1 <= row) ? wsrc[s + 1] : 0.f;
                *(LAS unsigned*)(Wd + row * GP + s) = pk2(w0, w1); }
        }
        {
            const int tok = tid >> 2, c0 = (tid & 3) * 16; const v4u* src = (const v4u*)(proj + (m0 + tok) * NP + PC_GV + g * 64 + c0);
            const v4u r0 = src[0], r1 = src[1]; const float mean = ST[2 * tok], rstd = ST[2 * tok + 1];
            const float* lg = A.in[I_GLG] + l * GW + g * 64 + c0; const float* lb = A.in[I_GLB] + l * GW + g * 64 + c0;
            float f[16];
            f[0] = bflo(r0.x); f[1] = bfhi(r0.x); f[2] = bflo(r0.y); f[3] = bfhi(r0.y); f[4] = bflo(r0.z); f[5] = bfhi(r0.z); f[6] = bflo(r0.w); f[7] = bfhi(r0.w);
            f[8] = bflo(r1.x); f[9] = bfhi(r1.x); f[10] = bflo(r1.y); f[11] = bfhi(r1.y); f[12] = bflo(r1.z); f[13] = bfhi(r1.z); f[14] = bflo(r1.w); f[15] = bfhi(r1.w);
#pragma unroll
            for (int i = 0; i < 16; ++i) { const float y = (gelu_f(f[i]) - mean) * rstd * lg[i] + lb[i]; Vt[(c0 + i) * GP + tok] = (bf16)f2bf(y); }
        }
        __syncthreads();
        {
            f32x16 acc;
#pragma unroll
            for (int r = 0; r < 16; ++r) acc[r] = 0.f;
            acc = mma32(Wd + (32 * ti + r32) * GP + 8 * hi, Vt + (32 * cj + r32) * GP + 8 * hi, 2 * (ti + 1), acc);
            const float* bs = A.in[I_GB] + (size_t)(l * NH + g) * 128;
#pragma unroll
            for (int r = 0; r < 16; ++r) { const int t = 32 * ti + crow(r, hi), c = 32 * cj + r32; const size_t m = m0 + t;
                const float z = acc[r] + bs[t], u = gelu_f(bf2f(proj[m * NP + PC_GU + g * 64 + c]));
                ycat[m * D + YC_C + g * 64 + c] = (bf16)f2bf(u * z); }
        }
        __syncthreads();
    }
}
__device__ __forceinline__ float shifted(const bf16* proj, size_t m, int t, int col, float mu) {
    const float p = bf2f(proj[m * NP + col]); const float pp = (t > 0) ? bf2f(proj[(m - 1) * NP + col]) : 0.f; return p + (pp - p) * mu;
}
__device__ __forceinline__ void rwkv_prep_unit(const Args& A, const Ctx& C, int l, int tile) {
    const bf16* proj = (const bf16*)(A.ws + WS_PROJ);
    const int tid = C.tid, lane = C.lane, wave = C.wave;
    const size_t m0 = (size_t)tile * 64; const int b = (int)(m0 / T), t0 = (int)(m0 % T);
    LAS float* LR = (LAS float*)C.lds;
    const float* mu = A.in[I_RMU] + l * 1696;
    __syncthreads();
    for (int e = tid; e < 64 * 160; e += NTHREADS) { const int tok = e / 160, j = e % 160;
        const float x = shifted(proj, m0 + tok, t0 + tok, PC_RW + j, mu[1536 + j]);
        LR[e] = (j < 32) ? tanhf(x) : (j < 64 ? x : sigmoidf_(x)); }
    __syncthreads();
    const int c = tid;
    const float* w2 = A.in[I_RW2] + (size_t)l * 32 * GW + c; const float* a2 = A.in[I_RA2] + (size_t)l * 32 * GW + c; const float* g2 = A.in[I_RG2] + (size_t)l * 96 * GW + c;
    const float w0 = A.in[I_RW0][l * GW + c], a0 = A.in[I_RA0][l * GW + c], kkc = A.in[I_RKK][l * GW + c], kac = A.in[I_RKA][l * GW + c];
    const float mur = mu[c], muk = mu[512 + c], muv = mu[1024 + c];
    float* rin = (float*)(A.ws + WS_RIN) + ((size_t)(b * NH + wave) * T + t0) * 384 + lane;
    float* rg = (float*)(A.ws + WS_RG) + m0 * GW + c;
    for (int tg = 0; tg < 4; ++tg) {
        float aw[16], aa[16], ag[16];
#pragma unroll
        for (int k = 0; k < 16; ++k) { aw[k] = 0.f; aa[k] = 0.f; ag[k] = 0.f; }
        const LAS float* lr = LR + tg * 16 * 160;
        for (int m4 = 0; m4 < 8; ++m4) {
            const float wv0 = w2[(4 * m4 + 0) * GW], wv1 = w2[(4 * m4 + 1) * GW], wv2 = w2[(4 * m4 + 2) * GW], wv3 = w2[(4 * m4 + 3) * GW];
            const float av0 = a2[(4 * m4 + 0) * GW], av1 = a2[(4 * m4 + 1) * GW], av2 = a2[(4 * m4 + 2) * GW], av3 = a2[(4 * m4 + 3) * GW];
#pragma unroll
            for (int k = 0; k < 16; ++k) { const f32x4 x = *(const LAS f32x4*)(lr + k * 160 + 4 * m4), y = *(const LAS f32x4*)(lr + k * 160 + 32 + 4 * m4);
                aw[k] += (x.x * wv0 + x.y * wv1) + (x.z * wv2 + x.w * wv3); aa[k] += (y.x * av0 + y.y * av1) + (y.z * av2 + y.w * av3); }
        }
        for (int m4 = 0; m4 < 24; ++m4) {
            const float gv0 = g2[(4 * m4 + 0) * GW], gv1 = g2[(4 * m4 + 1) * GW], gv2 = g2[(4 * m4 + 2) * GW], gv3 = g2[(4 * m4 + 3) * GW];
#pragma unroll
            for (int k = 0; k < 16; ++k) { const f32x4 x = *(const LAS f32x4*)(lr + k * 160 + 64 + 4 * m4); ag[k] += (x.x * gv0 + x.y * gv1) + (x.z * gv2 + x.w * gv3); }
        }
#pragma unroll
        for (int k = 0; k < 16; ++k) { const int tok = tg * 16 + k; const size_t m = m0 + tok; const int t = t0 + tok;
            const float r = shifted(proj, m, t, PC_RR + c, mur), kx = shifted(proj, m, t, PC_RK + c, muk), v = shifted(proj, m, t, PC_RV + c, muv);
            const float decay = __expf(-0.6065306597126334f * sigmoidf_(w0 + aw[k]));
            const float ia = sigmoidf_(a0 + aa[k]);
            float kk = kx * kkc; const float n2 = wave_sum(kk * kk); kk = kk / fmaxf(sqrtf(n2), 1e-12f);
            const float kp = kx * (1.0f + (ia - 1.0f) * kac);
            float* o = rin + (size_t)tok * 384;
            o[0] = r; o[64] = decay; o[128] = kp; o[192] = v; o[256] = -kk; o[320] = kk * ia;
            rg[(size_t)tok * GW] = ag[k]; }
    }
}
__device__ __forceinline__ void rwkv_scan_unit(const Args& A, const Ctx& C, int bh) {
    const int tid = C.tid, lane = C.lane, wave = C.wave, il = lane >> 3, jq = lane & 7, irow = 8 * wave + il;
    const f32x4* rin4 = (const f32x4*)((const float*)(A.ws + WS_RIN) + (size_t)bh * T * 384);
    float* ry = (float*)(A.ws + WS_RY) + (size_t)(bh >> 3) * T * GW + (bh & 7) * 64 + irow;
    LAS f32x4* buf4 = (LAS f32x4*)C.lds;
    float S[8];
#pragma unroll
    for (int j = 0; j < 8; ++j) S[j] = 0.f;
    __syncthreads();
    { const f32x4 x0 = rin4[tid], x1 = rin4[tid + 512], x2 = rin4[tid + 1024]; buf4[tid] = x0; buf4[tid + 512] = x1; buf4[tid + 1024] = x2; }
    __syncthreads();
    for (int c = 0; c < T / 16; ++c) {
        f32x4 n0, n1, n2;
        const bool more = (c + 1 < T / 16);
        if (more) { const f32x4* src = rin4 + (size_t)(c + 1) * 1536; n0 = src[tid]; n1 = src[tid + 512]; n2 = src[tid + 1024]; }
        const LAS f32x4* cb = buf4 + (c & 1) * 1536;
        for (int tk = 0; tk < 16; ++tk) {
            const LAS f32x4* tb = cb + tk * 96;
            const f32x4 r0 = tb[0 * 16 + 2 * jq], r1 = tb[0 * 16 + 2 * jq + 1], w0 = tb[1 * 16 + 2 * jq], w1 = tb[1 * 16 + 2 * jq + 1], k0 = tb[2 * 16 + 2 * jq], k1 = tb[2 * 16 + 2 * jq + 1];
            const f32x4 a0 = tb[4 * 16 + 2 * jq], a1 = tb[4 * 16 + 2 * jq + 1], b0 = tb[5 * 16 + 2 * jq], b1 = tb[5 * 16 + 2 * jq + 1];
            const float v = ((const LAS float*)tb)[192 + irow];
            float sa = ((S[0] * a0.x + S[1] * a0.y) + (S[2] * a0.z + S[3] * a0.w)) + ((S[4] * a1.x + S[5] * a1.y) + (S[6] * a1.z + S[7] * a1.w));
            sa += __shfl_xor(sa, 1); sa += __shfl_xor(sa, 2); sa += __shfl_xor(sa, 4);
            S[0] = S[0] * w0.x + sa * b0.x + v * k0.x; S[1] = S[1] * w0.y + sa * b0.y + v * k0.y; S[2] = S[2] * w0.z + sa * b0.z + v * k0.z; S[3] = S[3] * w0.w + sa * b0.w + v * k0.w;
            S[4] = S[4] * w1.x + sa * b1.x + v * k1.x; S[5] = S[5] * w1.y + sa * b1.y + v * k1.y; S[6] = S[6] * w1.z + sa * b1.z + v * k1.z; S[7] = S[7] * w1.w + sa * b1.w + v * k1.w;
            float y = ((S[0] * r0.x + S[1] * r0.y) + (S[2] * r0.z + S[3] * r0.w)) + ((S[4] * r1.x + S[5] * r1.y) + (S[6] * r1.z + S[7] * r1.w));
            y += __shfl_xor(y, 1); y += __shfl_xor(y, 2); y += __shfl_xor(y, 4);
            if (jq == 0) ry[(size_t)(c * 16 + tk) * GW] = y;
        }
        if (more) { LAS f32x4* nb = buf4 + ((c + 1) & 1) * 1536; nb[tid] = n0; nb[tid + 512] = n1; nb[tid + 1024] = n2; }
        __syncthreads();
    }
}
__device__ __forceinline__ void ph_rwkv_post(const Args& A, const Ctx& C, int l) {
    const int gw = C.bid * NWAVES + C.wave, NGW = C.G * NWAVES, lane = C.lane;
    const float* RY = (const float*)(A.ws + WS_RY); const float* RG = (const float*)(A.ws + WS_RG); const float* RIN = (const float*)(A.ws + WS_RIN); bf16* ycat = (bf16*)(A.ws + WS_YCAT);
    for (int it = gw; it < M * NH; it += NGW) {
        const int m = it >> 3, h = it & 7, b = m / T, t = m % T, ch = h * 64 + lane;
        const float y = RY[(size_t)m * GW + ch];
        const float mean = wave_sum(y) * (1.0f / 64.0f), d = y - mean, var = wave_sum(d * d) * (1.0f / 64.0f);
        const float yn = d * (1.0f / sqrtf(var + 64e-5f)) * A.in[I_RLG][l * GW + ch] + A.in[I_RLB][l * GW + ch];
        const float* rin = RIN + ((size_t)(b * NH + h) * T + t) * 384 + lane;
        const float r = rin[0], k = rin[128], v = rin[192];
        const float bonus = wave_sum(r * k * A.in[I_RRK][l * GW + ch]) * v;
        ycat[(size_t)m * D + YC_A + ch] = (bf16)f2bf((yn + bonus) * RG[(size_t)m * GW + ch]);
    }
}
__device__ __forceinline__ void ph_mix1(const Args& A, const Ctx& C, int l) {
    for (int u = C.bid; u < 256 + 1024 + 256; u += C.G) {
        if (u < 256) rwkv_prep_unit(A, C, l, u);
        else if (u < 1280) { const int v = u - 256; attn_unit<0>(A, C, l, v >> 8, (v >> 5) & 7, v & 31); }
        else { const int v = u - 1280; sgu_unit(A, C, l, v >> 6, (v >> 1) & 31, v & 1); }
    }
}
__device__ __forceinline__ void ph_mix2(const Args& A, const Ctx& C, int l) {
    if (C.bid < 32 && C.G > 32) { rwkv_scan_unit(A, C, C.bid); return; }
    if (C.G <= 32) { for (int u = C.bid; u < 32; u += C.G) rwkv_scan_unit(A, C, u); }
    const int nf = (C.G > 32) ? C.G - 32 : C.G, f0 = (C.G > 32) ? C.bid - 32 : C.bid;
    for (int u = f0; u < 1024; u += nf) { const int qb = 31 - (u >> 5), bh = u & 31; attn_unit<1>(A, C, l, bh >> 3, bh & 7, qb); }
}
constexpr int N_PHASES = 2 + 9 * DEPTH;
#define IN(k) (lo <= (k) && (k) < hi)
#define SEAM(k) do { if (IN((k) + 1)) xcd_barrier(bar); } while (0)
template <int l>
__device__ __forceinline__ void layer_phases(const Args& A, const Ctx& C, const XcdBarrier& bar, const int lo, const int hi) {
    bf16* const H = (bf16*)(A.ws + WS_H); bf16* const PROJ = (bf16*)(A.ws + WS_PROJ); bf16* const YCAT = (bf16*)(A.ws + WS_YCAT); bf16* const FB = (bf16*)(A.ws + WS_F);
    constexpr int p0 = 2 + 9 * l;
    const float* xin = (l == 0) ? A.in[I_X] : A.out;
    const float* modl = (const float*)(A.ws + WS_MOD) + (size_t)l * NB * MODW;
    if (IN(p0 + 0)) { ph_norm(C, xin, A.in[I_N1G] + l * D, modl + 0 * D, modl + 1 * D, H); SEAM(p0 + 0); }
    if (IN(p0 + 1)) {
        pg8::Gemm g{H, (const bf16*)(A.ws + WS_WIN) + (size_t)l * NP * D, M, NP, D}; pg8::StaticOrder S; S.init(M, NP, C.G, C.bid);
        pg8::EpiStoreBf16 E{PROJ, NP};
        pg8::gemm_phase<pg8::EpiStoreBf16, pg8::StaticOrder, true, true>(C.lds, g, S, E);
        SEAM(p0 + 1); }
    if (IN(p0 + 2)) { ph_mix1(A, C, l); SEAM(p0 + 2); }
    if (IN(p0 + 3)) { ph_mix2(A, C, l); SEAM(p0 + 3); }
    if (IN(p0 + 4)) { ph_rwkv_post(A, C, l); SEAM(p0 + 4); }
    if (IN(p0 + 5)) {
        pg8::Gemm g{YCAT, (const bf16*)(A.ws + WS_WOUT) + (size_t)l * D * D, M, D, D}; pg8::StaticOrder S; S.init(M, D, C.G, C.bid);
        pg8::EpiResid E{xin, A.out, D, modl + 2 * D, MODW, T};
        pg8::gemm_phase<pg8::EpiResid, pg8::StaticOrder, true, true>(C.lds, g, S, E);
        SEAM(p0 + 5); }
    if (IN(p0 + 6)) { ph_norm(C, A.out, A.in[I_N2G] + l * D, modl + 3 * D, modl + 4 * D, H); SEAM(p0 + 6); }
    if (IN(p0 + 7)) {
        pg8::Gemm g{H, (const bf16*)(A.ws + WS_W13) + (size_t)l * 2 * FF * D, M, 2 * FF, D}; pg8::StaticOrder S; S.init(M, 2 * FF, C.G, C.bid);
        pg8::EpiSwiGLU E{FB, FF};
        pg8::gemm_phase<pg8::EpiSwiGLU, pg8::StaticOrder, true, true>(C.lds, g, S, E);
        SEAM(p0 + 7); }
    if (IN(p0 + 8)) {
        pg8::Gemm g{FB, (const bf16*)(A.ws + WS_W2) + (size_t)l * D * FF, M, D, FF}; pg8::StaticOrder S; S.init(M, D, C.G, C.bid);
        pg8::EpiResid E{A.out, A.out, D, modl + 5 * D, MODW, T};
        pg8::gemm_phase<pg8::EpiResid, pg8::StaticOrder, true, true>(C.lds, g, S, E);
        SEAM(p0 + 8); }
}
__global__ void __launch_bounds__(NTHREADS, 2) fwd_kernel(Args A) {
    extern __shared__ __attribute__((aligned(16))) unsigned char lds_raw[];
    Ctx C; C.lds = (LAS unsigned char*)lds_raw; C.tid = threadIdx.x; C.lane = C.tid & 63; C.wave = __builtin_amdgcn_readfirstlane(C.tid >> 6); C.G = gridDim.x; C.bid = blockIdx.x;
    volatile LAS unsigned* MISC = (volatile LAS unsigned*)(C.lds + MISC_OFF);
    for (int u = C.tid; u < (LDS_BYTES - LDSCTL_OFF) / 4; u += NTHREADS) ((LAS unsigned*)(C.lds + LDSCTL_OFF))[u] = 0u;
    __syncthreads();
    const int lo = A.ph_lo, hi = A.ph_hi;
    const bool multi = (hi - lo) > 1;
    XcdBarrier bar; bar.bar = (unsigned*)(A.ws + WS_CTL) + CW_BAR; bar.x = 0; bar.st = nullptr;
    if (multi) bar = xcd_barrier_post((unsigned*)(A.ws + WS_CTL) + CW_BAR, MISC + 8);
    if (IN(0)) { ph_prologue(A, C); SEAM(0); }
    if (IN(1)) { ph_modreduce(A, C); SEAM(1); }
    layer_phases<0>(A, C, bar, lo, hi);
    layer_phases<1>(A, C, bar, lo, hi);
    layer_phases<2>(A, C, bar, lo, hi);
    layer_phases<3>(A, C, bar, lo, hi);
}
#undef IN
#undef SEAM

extern "C" void kernel_launch(void* const* d_in, const int* in_sizes, int n_in, void* d_out, int out_size, void* d_ws, size_t ws_size, hipStream_t stream) {
    static int grid = 0;
    if (grid == 0) {
        if (n_in != N_INPUTS || out_size != M * D || ws_size < WS_END) { fprintf(stderr, "kernel_launch: unexpected problem (n_in %d, out %d, ws %zu; need %zu)\n", n_in, out_size, ws_size, (size_t)WS_END); grid = -1; return; }
        int dev = 0, cus = 0, per_cu = 0;
        if (hipGetDevice(&dev) != hipSuccess || hipDeviceGetAttribute(&cus, hipDeviceAttributeMultiprocessorCount, dev) != hipSuccess) { grid = -1; return; }
        if (hipFuncSetAttribute((const void*)fwd_kernel, hipFuncAttributeMaxDynamicSharedMemorySize, LDS_BYTES) != hipSuccess) { fprintf(stderr, "kernel_launch: hipFuncSetAttribute failed\n"); grid = -1; return; }
        if (hipOccupancyMaxActiveBlocksPerMultiprocessor(&per_cu, (const void*)fwd_kernel, NTHREADS, LDS_BYTES) != hipSuccess || per_cu < 1) fprintf(stderr, "kernel_launch: occupancy query reports %d\n", per_cu);
        (void)hipGetLastError();
        grid = cus;
    }
    if (grid < 0) return;
    (void)hipMemsetAsync((char*)d_ws + WS_CTL, 0, CTL_ZERO_BYTES, stream);
    Args a{};
    for (int i = 0; i < N_INPUTS; ++i) a.in[i] = (const float*)d_in[i];
    a.out = (float*)d_out; a.ws = (unsigned char*)d_ws;
#if MK_ONE_LAUNCH
    a.ph_lo = 0; a.ph_hi = N_PHASES;
    hipLaunchKernelGGL(fwd_kernel, dim3(grid), dim3(NTHREADS), LDS_BYTES, stream, a);
#else
    for (int p = 0; p < N_PHASES; ++p) { a.ph_lo = p; a.ph_hi = p + 1; hipLaunchKernelGGL(fwd_kernel, dim3(grid), dim3(NTHREADS), LDS_BYTES, stream, a); }
#endif
    const hipError_t le = hipPeekAtLastError();
    if (le != hipSuccess) fprintf(stderr, "kernel_launch: launch failed: %s\n", hipGetErrorName(le));
}
```

```cpp
#include <hip/hip_runtime.h>
#include <cstdio>
#include <cstdint>
#ifndef MK_ONE_LAUNCH
#define MK_ONE_LAUNCH 1
#endif
namespace pg8 {
#define PG8_LAS __attribute__((address_space(3)))
typedef unsigned short bf16_t;
typedef short bf16x8 __attribute__((ext_vector_type(8)));
typedef float f32x4 __attribute__((ext_vector_type(4)));
typedef unsigned u32x4 __attribute__((ext_vector_type(4)));
constexpr int BM = 256, BK = 64, HALF = 128, HTB = HALF * BK * 2  , STAGE_BYTES = 8 * HTB, NXCD = 8, WGM = 8;

__host__ __device__ __forceinline__ int lds_byte(int r, int c) { const int st = (r >> 4) * 2 + (c >> 5), rr = r & 15, cc = c & 31, ob = rr * 64 + cc * 2; return st * 1024 + (ob ^ (((ob >> 9) & 1) << 5)); }
__host__ __device__ __forceinline__ void stage_rc(int b, int& R, int& C) { const int st = b / 1024, sb = b % 1024, swz = sb ^ (((sb >> 9) & 1) << 5); R = (st >> 1) * 16 + swz / 64; C = (st & 1) * 32 + (swz % 64) / 2; }
__host__ __device__ __forceinline__ int perm32(int rho) { const int n = rho >> 4, i = rho & 15; return 8 * (i >> 2) + 4 * n + (i & 3); }

struct Unit { int pm, pn; };
struct Gemm { const bf16_t* A; const bf16_t* Bt; int M, N, K; };

struct StaticOrder {
    int nM, nN, nwg, G, c;
    __host__ __device__ void init(int M, int N, int G_, int c_) { nM = M / BM; nN = N / BM; nwg = nM * nN; G = G_; c = c_; }
    __host__ __device__ bool next(int i, Unit& u) const {
        const long L = (long)i * G + c; if (L >= nwg) return false;
        int wgid = (int)L; { const int q = nwg / NXCD, r = nwg % NXCD, xcd = wgid % NXCD, off = wgid / NXCD; wgid = (xcd < r ? xcd * (q + 1) : r * (q + 1) + (xcd - r) * q) + off; }
        const int nig = WGM * nN, gid = wgid / nig, fm = gid * WGM, gsz = (nM - fm) < WGM ? (nM - fm) : WGM;
        u.pm = fm + ((wgid % nig) % gsz); u.pn = (wgid % nig) / gsz; return true;
    }
    __device__ __forceinline__ void a_ready(const Unit&) const {}
    __device__ __forceinline__ void done(const Unit&) const {}
};

__device__ __forceinline__ unsigned cvt_pk_bf16(float lo, float hi) { unsigned r; asm volatile("v_cvt_pk_bf16_f32 %0, %1, %2" : "=v"(r) : "v"(lo), "v"(hi)); return r; }
typedef float f32x2 __attribute__((ext_vector_type(2)));
__device__ __forceinline__ f32x2 gelu_pk(f32x2 v) {
    const f32x2 av = __builtin_elementwise_abs(v), d = av * 0.2316418882f + 1.0f;
    f32x2 t; t.x = __builtin_amdgcn_rcpf(d.x); t.y = __builtin_amdgcn_rcpf(d.y);
    f32x2 q = t * 0.5307027145f + (-0.7265760135f); q = q * t + 0.7107068705f; q = q * t + (-0.142248368f); q = q * t + 0.127414796f; q = q * t;
    const f32x2 s = (v * v) * (-0.72134752044f);
    f32x2 e; e.x = __builtin_amdgcn_exp2f(s.x); e.y = __builtin_amdgcn_exp2f(s.y);
    const f32x2 m = v * (q * e), r = v - m;
    f32x2 o; o.x = v.x < 0.f ? m.x : r.x; o.y = v.y < 0.f ? m.y : r.y; return o;
}

struct EpiStoreBf16 {
    static constexpr bool PERM = true, AFTER_DRAIN = false;
    bf16_t* O; int ldc;
    __device__ __forceinline__ void operator()(const f32x4 (&acc)[2][2][4][2], const Unit& u, int wr, int wc, int fr, int fq) const {
        const int row0 = u.pm * BM + wr * 64 + fr, col0 = u.pn * BM + wc * 32 + 8 * fq;
#pragma unroll
        for (int ai = 0; ai < 2; ++ai)
#pragma unroll
            for (int m = 0; m < 4; ++m) { bf16_t* rowp = O + (size_t)(row0 + ai * HALF + m * 16) * ldc + col0;
#pragma unroll
                for (int bj = 0; bj < 2; ++bj) { const f32x4 v0 = acc[ai][bj][m][0], v1 = acc[ai][bj][m][1];
                    u32x4 w; w.x = cvt_pk_bf16(v0[0], v0[1]); w.y = cvt_pk_bf16(v0[2], v0[3]); w.z = cvt_pk_bf16(v1[0], v1[1]); w.w = cvt_pk_bf16(v1[2], v1[3]);
                    *(u32x4*)(rowp + bj * HALF) = w; } }
    }
};
struct EpiResid {
    static constexpr bool PERM = false, AFTER_DRAIN = false;
    const float* base; float* out; int ldc; const float* gate; int gate_stride; int rows_per_batch;
    __device__ __forceinline__ void operator()(const f32x4 (&acc)[2][2][4][2], const Unit& u, int wr, int wc, int fr, int fq) const {
        const int row0 = u.pm * BM + wr * 64 + fr, col0 = u.pn * BM + wc * 32 + 4 * fq;
        const float* gp = gate + (size_t)((u.pm * BM) / rows_per_batch) * gate_stride + col0;
        f32x4 gv[2][2];
#pragma unroll
        for (int bj = 0; bj < 2; ++bj)
#pragma unroll
            for (int n = 0; n < 2; ++n) gv[bj][n] = *(const f32x4*)(gp + bj * HALF + n * 16);
#pragma unroll
        for (int ai = 0; ai < 2; ++ai)
#pragma unroll
            for (int m = 0; m < 4; ++m) { const size_t off = (size_t)(row0 + ai * HALF + m * 16) * ldc + col0;
#pragma unroll
                for (int bj = 0; bj < 2; ++bj)
#pragma unroll
                    for (int n = 0; n < 2; ++n) { const f32x4 x = *(const f32x4*)(base + off + bj * HALF + n * 16);
                        *(f32x4*)(out + off + bj * HALF + n * 16) = x + gv[bj][n] * acc[ai][bj][m][n]; } }
    }
};
struct EpiSwiGLU {
    static constexpr bool PERM = true, AFTER_DRAIN = false;
    bf16_t* O; int ldc;
    __device__ __forceinline__ void operator()(const f32x4 (&acc)[2][2][4][2], const Unit& u, int wr, int wc, int fr, int fq) const {
        const int row0 = u.pm * BM + wr * 64 + fr, col0 = u.pn * HALF + wc * 32 + 8 * fq;
#pragma unroll
        for (int ai = 0; ai < 2; ++ai)
#pragma unroll
            for (int m = 0; m < 4; ++m) { bf16_t* rowp = O + (size_t)(row0 + ai * HALF + m * 16) * ldc + col0;
                float f[8];
#pragma unroll
                for (int n = 0; n < 2; ++n)
#pragma unroll
                    for (int e = 0; e < 4; ++e) { const float g = acc[ai][0][m][n][e], up = acc[ai][1][m][n][e];
                        f[n * 4 + e] = g * up * __builtin_amdgcn_rcpf(1.0f + __builtin_amdgcn_exp2f(-1.4426950408889634f * g)); }
                u32x4 w; w.x = cvt_pk_bf16(f[0], f[1]); w.y = cvt_pk_bf16(f[2], f[3]); w.z = cvt_pk_bf16(f[4], f[5]); w.w = cvt_pk_bf16(f[6], f[7]);
                *(u32x4*)rowp = w; }
    }
};

template <class Epi, class Sched, bool ALIGN_EPI = false, bool SP2 = false>
__device__ __forceinline__ void gemm_phase(PG8_LAS unsigned char* lds, const Gemm g, const Sched& S, const Epi& E) {
    const int tid = threadIdx.x, wid = __builtin_amdgcn_readfirstlane(tid >> 6), lane = tid & 63, wr = wid >> 2, wc = wid & 3, fr = lane & 15, fq = lane >> 4;
    const int K = g.K, nt = K / BK;
    unsigned voffA[2], voffB[2];
#pragma unroll
    for (int i = 0; i < 2; ++i) { int R, C; stage_rc(tid * 16 + i * 8192, R, C); const int Rb = Epi::PERM ? ((R & ~31) + perm32(R & 31)) : R;
        voffA[i] = (unsigned)(R * K + C) * 2u; voffB[i] = (unsigned)(Rb * K + C) * 2u; }
    const size_t kstep = (size_t)(BK * 2);
    const size_t hstep = (size_t)HALF * K * 2;
    const size_t tstep = 2 * hstep;
    const unsigned ldsw = (unsigned)wid * 1024u;
    const int aoff = lds_byte(wr * 64 + fr, fq * 8), boff = lds_byte(wc * 32 + fr, fq * 8);
#define PG8_SA(b, h) (((b) * 2 + (h)) * HTB)
#define PG8_SB(b, h) ((4 + (b) * 2 + (h)) * HTB)
#define PG8_STAGE(bufoff, gbase, voff) do { _Pragma("unroll") for (int _i = 0; _i < 2; ++_i) \
        __builtin_amdgcn_global_load_lds((const unsigned*)((const char*)(gbase) + (voff)[_i]), (PG8_LAS unsigned*)(lds + (bufoff) + ldsw + _i * 8192), 16, 0, 0); } while (0)
#define PG8_LDA(dst, b, h) do { _Pragma("unroll") for (int m = 0; m < 4; ++m) _Pragma("unroll") for (int k = 0; k < 2; ++k) dst[m][k] = *(const PG8_LAS bf16x8*)(lds + PG8_SA(b, h) + aoff + m * 2048 + k * 1024); } while (0)
#define PG8_LDB(dst, b, h) do { _Pragma("unroll") for (int n = 0; n < 2; ++n) _Pragma("unroll") for (int k = 0; k < 2; ++k) dst[n][k] = *(const PG8_LAS bf16x8*)(lds + PG8_SB(b, h) + boff + n * 2048 + k * 1024); } while (0)
#define PG8_MMA(ai, bj, At, Bt) do { __builtin_amdgcn_s_setprio(1); _Pragma("unroll") for (int m = 0; m < 4; ++m) _Pragma("unroll") for (int n = 0; n < 2; ++n) _Pragma("unroll") for (int k = 0; k < 2; ++k) \
        acc[ai][bj][m][n] = __builtin_amdgcn_mfma_f32_16x16x32_bf16(Bt[n][k], At[m][k], acc[ai][bj][m][n], 0, 0, 0); __builtin_amdgcn_s_setprio(0); } while (0)
#define PG8_WAIT_V(n) asm volatile("s_waitcnt vmcnt(" #n ")" ::: "memory")
#define PG8_WAIT_L(n) asm volatile("s_waitcnt lgkmcnt(" #n ")" ::: "memory")
#define PG8_BAR __builtin_amdgcn_s_barrier()
#define PG8_SCHED __builtin_amdgcn_sched_barrier(0)
    Unit cur, nxt; int ui = 0;
    if (!S.next(0, cur)) return;
    f32x4 acc[2][2][4][2];
#pragma unroll
    for (int a = 0; a < 2; ++a)
#pragma unroll
        for (int b = 0; b < 2; ++b)
#pragma unroll
            for (int m = 0; m < 4; ++m)
#pragma unroll
                for (int n = 0; n < 2; ++n) acc[a][b][m][n] = (f32x4){0.f, 0.f, 0.f, 0.f};
    bf16x8 At[4][2], B0[2][2], B1[2][2];
    const char* cA = (const char*)g.A + (size_t)cur.pm * tstep; const char* cB = (const char*)g.Bt + (size_t)cur.pn * tstep;
    S.a_ready(cur);
    if constexpr (SP2) {
        PG8_STAGE(PG8_SB(0, 0), cB, voffB); PG8_STAGE(PG8_SB(0, 1), cB + hstep, voffB); PG8_STAGE(PG8_SA(0, 0), cA, voffA); PG8_STAGE(PG8_SA(0, 1), cA + hstep, voffA);
        if (wr == 1) PG8_BAR;
        PG8_WAIT_V(2); PG8_BAR;
        PG8_STAGE(PG8_SB(1, 0), cB + kstep, voffB); PG8_STAGE(PG8_SA(1, 0), cA + kstep, voffA); PG8_STAGE(PG8_SB(1, 1), cB + hstep + kstep, voffB);
        PG8_WAIT_V(6); PG8_BAR;
    } else {
        PG8_STAGE(PG8_SB(0, 0), cB, voffB); PG8_STAGE(PG8_SA(0, 0), cA, voffA); PG8_STAGE(PG8_SB(0, 1), cB + hstep, voffB); PG8_STAGE(PG8_SA(0, 1), cA + hstep, voffA);
        if (wr == 1) PG8_BAR;
        PG8_WAIT_V(4); PG8_BAR;
        PG8_STAGE(PG8_SB(1, 0), cB + kstep, voffB); PG8_STAGE(PG8_SA(1, 0), cA + kstep, voffA); PG8_STAGE(PG8_SB(1, 1), cB + hstep + kstep, voffB);
        PG8_WAIT_V(6); PG8_BAR;
    }
    for (;;) {
        const bool has_next = S.next(ui + 1, nxt);
        const char* nA = has_next ? (const char*)g.A + (size_t)nxt.pm * tstep : cA; const char* nB = has_next ? (const char*)g.Bt + (size_t)nxt.pn * tstep : cB;
        for (int t = 0; t < nt; t += 2) {
            const bool last = (t == nt - 2);
            const char* a1 = cA + (size_t)(t + 1) * kstep;
            const char* a2 = last ? nA : cA + (size_t)(t + 2) * kstep; const char* b2 = last ? nB : cB + (size_t)(t + 2) * kstep;
            const char* a3 = a2 + kstep; const char* b3 = b2 + kstep;
            if (last && has_next) S.a_ready(nxt);
            if constexpr (SP2) {
            PG8_LDB(B0, 0, 0); PG8_LDB(B1, 0, 1); PG8_SCHED; PG8_LDA(At, 0, 0); PG8_STAGE(PG8_SA(1, 1), a1 + hstep, voffA);
            PG8_WAIT_V(8); PG8_WAIT_L(0); PG8_BAR; PG8_MMA(0, 0, At, B0); PG8_MMA(0, 1, At, B1); PG8_BAR; PG8_SCHED;
            PG8_LDA(At, 0, 1); PG8_STAGE(PG8_SB(0, 0), b2, voffB); PG8_STAGE(PG8_SB(0, 1), b2 + hstep, voffB); PG8_STAGE(PG8_SA(0, 0), a2, voffA);
            PG8_WAIT_V(8); PG8_WAIT_L(0); PG8_BAR; PG8_MMA(1, 0, At, B0); PG8_MMA(1, 1, At, B1); PG8_BAR; PG8_SCHED;
            PG8_LDB(B0, 1, 0); PG8_LDB(B1, 1, 1); PG8_SCHED; PG8_LDA(At, 1, 0); PG8_STAGE(PG8_SA(0, 1), a2 + hstep, voffA);
            PG8_WAIT_V(8); PG8_WAIT_L(0); PG8_BAR; PG8_MMA(0, 0, At, B0); PG8_MMA(0, 1, At, B1); PG8_BAR; PG8_SCHED;
            PG8_LDA(At, 1, 1); PG8_STAGE(PG8_SB(1, 0), b3, voffB); PG8_STAGE(PG8_SB(1, 1), b3 + hstep, voffB); PG8_STAGE(PG8_SA(1, 0), a3, voffA);
            PG8_WAIT_V(8); PG8_WAIT_L(0); PG8_BAR; PG8_MMA(1, 0, At, B0); PG8_MMA(1, 1, At, B1); PG8_BAR; PG8_SCHED;
            } else {
            PG8_LDB(B0, 0, 0); PG8_SCHED; PG8_LDA(At, 0, 0); PG8_STAGE(PG8_SA(1, 1), a1 + hstep, voffA);
            PG8_WAIT_L(8); PG8_BAR; PG8_WAIT_L(0); PG8_MMA(0, 0, At, B0); PG8_BAR; PG8_SCHED;
            PG8_LDB(B1, 0, 1); PG8_STAGE(PG8_SB(0, 0), b2, voffB);
            PG8_BAR; PG8_WAIT_L(0); PG8_MMA(0, 1, At, B1); PG8_BAR;
            PG8_LDA(At, 0, 1); PG8_STAGE(PG8_SA(0, 0), a2, voffA);
            PG8_BAR; PG8_WAIT_L(0); PG8_MMA(1, 0, At, B0); PG8_BAR; PG8_SCHED;
            PG8_STAGE(PG8_SB(0, 1), b2 + hstep, voffB);
            PG8_WAIT_V(6); PG8_BAR; PG8_MMA(1, 1, At, B1); PG8_BAR;
            PG8_LDB(B0, 1, 0); PG8_SCHED; PG8_LDA(At, 1, 0); PG8_STAGE(PG8_SA(0, 1), a2 + hstep, voffA);
            PG8_WAIT_L(8); PG8_BAR; PG8_WAIT_L(0); PG8_MMA(0, 0, At, B0); PG8_BAR; PG8_SCHED;
            PG8_LDB(B1, 1, 1); PG8_STAGE(PG8_SB(1, 0), b3, voffB);
            PG8_BAR; PG8_WAIT_L(0); PG8_MMA(0, 1, At, B1); PG8_BAR;
            PG8_LDA(At, 1, 1); PG8_STAGE(PG8_SA(1, 0), a3, voffA);
            PG8_BAR; PG8_WAIT_L(0); PG8_MMA(1, 0, At, B0); PG8_BAR; PG8_SCHED;
            PG8_STAGE(PG8_SB(1, 1), b3 + hstep, voffB);
            PG8_WAIT_V(6); PG8_BAR; PG8_MMA(1, 1, At, B1); PG8_BAR;
            }
        }
        if constexpr (ALIGN_EPI) { if (wr == 0) PG8_BAR; }
        if constexpr (!Epi::AFTER_DRAIN) { E(acc, cur, wr, wc, fr, fq); S.done(cur); }
        if (!has_next) break;
#pragma unroll
        for (int a = 0; a < 2; ++a)
#pragma unroll
            for (int b = 0; b < 2; ++b)
#pragma unroll
                for (int m = 0; m < 4; ++m)
#pragma unroll
                    for (int n = 0; n < 2; ++n) acc[a][b][m][n] = (f32x4){0.f, 0.f, 0.f, 0.f};
        cur = nxt; cA = nA; cB = nB; ++ui;
        if constexpr (ALIGN_EPI) { if (wr == 1) PG8_BAR; }
    }
    PG8_WAIT_V(0);
    if constexpr (!ALIGN_EPI) { if (wr == 0) PG8_BAR; }
    PG8_BAR;
    if constexpr (Epi::AFTER_DRAIN) { E.fused(acc, cur, wr, wc, fr, fq, lds, wid, lane); S.done(cur); }
#undef PG8_SA
#undef PG8_SB
#undef PG8_STAGE
#undef PG8_LDA
#undef PG8_LDB
#undef PG8_MMA
#undef PG8_WAIT_V
#undef PG8_WAIT_L
#undef PG8_BAR
#undef PG8_SCHED
}
}
constexpr int NWAVES = 8, NTHREADS = 512;
constexpr int D = 2048, NB = 4, T = 4096, M = NB * T, DEPTH = 4, GW = 512, NH = 8, HD = 64;
constexpr int NIN = 5544, NP = 5632, FF = 5632, MODW = 6 * D;
constexpr int PC_RR = 0, PC_RK = 512, PC_RV = 1024, PC_SQ = 1536, PC_SK = 2048, PC_SV = 2176, PC_GU = 2304, PC_GV = 2816;
constexpr int PC_FQ = 3328, PC_FK = 3840, PC_FV = 4352, PC_FG = 4864, PC_RW = 5376, PC_FL = 5536;
constexpr int YC_A = 0, YC_B = 512, YC_C = 1024, YC_D = 1536;
constexpr int SGU_TRI = 8256;
enum { I_X = 0, I_C, I_WMOD, I_BMOD, I_N1G, I_N2G, I_WIN, I_WOUT, I_RMU, I_RW0, I_RW2, I_RA0, I_RA2, I_RG2, I_RKK, I_RKA, I_RRK, I_RLG, I_RLB,
       I_SQG, I_SKG, I_SSINK, I_GLG, I_GLB, I_GWS, I_GB, I_FQG, I_FKG, I_FFB, I_W1, I_W3, I_W2, N_INPUTS };

constexpr size_t MiB = 1u << 20;
constexpr size_t WS_CTL = 0, CTL_ZERO_BYTES = 1 * MiB;
constexpr size_t WS_MOD = 1 * MiB;
constexpr size_t WS_MODP = 2 * MiB;
constexpr size_t WS_WIN = 8 * MiB;
constexpr size_t WS_WOUT = 96 * MiB;
constexpr size_t WS_W13 = 128 * MiB;
constexpr size_t WS_W2 = 304 * MiB;
constexpr size_t WS_H = 392 * MiB;
constexpr size_t WS_PROJ = 456 * MiB;
constexpr size_t WS_YCAT = 632 * MiB;
constexpr size_t WS_F = 696 * MiB;
constexpr size_t WS_RIN = 872 * MiB;
constexpr size_t WS_RG = 1064 * MiB;
constexpr size_t WS_RY = 1096 * MiB;
constexpr size_t WS_END = 1128 * MiB;
constexpr int CW_BAR = 4096;

constexpr int RING_BYTES = 131072;
constexpr int LDSCTL_OFF = RING_BYTES, MISC_OFF = LDSCTL_OFF + 320;
constexpr int LDS_BYTES = 147456;

#define GAS __attribute__((address_space(1)))
#define LAS __attribute__((address_space(3)))
typedef unsigned short bf16;
typedef short bf16x8 __attribute__((ext_vector_type(8)));
typedef float f32x4 __attribute__((ext_vector_type(4)));
typedef float f32x16 __attribute__((ext_vector_type(16)));
typedef unsigned v4u __attribute__((ext_vector_type(4)));
typedef unsigned v2u __attribute__((ext_vector_type(2)));
#define LDS_WAIT() asm volatile("s_waitcnt lgkmcnt(0)" ::: "memory")
__device__ __forceinline__ float bf2f(unsigned short b) { return __uint_as_float(((unsigned)b) << 16); }
__device__ __forceinline__ unsigned f2bf(float f) { unsigned u = __float_as_uint(f); return (u + 0x7fffu + ((u >> 16) & 1u)) >> 16; }
__device__ __forceinline__ unsigned pk2(float lo, float hi) { return f2bf(lo) | (f2bf(hi) << 16); }
__device__ __forceinline__ float bflo(unsigned w) { return __uint_as_float(w << 16); }
__device__ __forceinline__ float bfhi(unsigned w) { return __uint_as_float(w & 0xffff0000u); }
__device__ __forceinline__ float wave_sum(float v) {
#pragma unroll
    for (int o = 1; o < 64; o <<= 1) v += __shfl_xor(v, o);
    return v;
}
__device__ __forceinline__ float sigmoidf_(float x) { return 1.0f / (1.0f + __expf(-x)); }
__device__ __forceinline__ float gelu_f(float v) {
    const float av = fabsf(v), t = __builtin_amdgcn_rcpf(av * 0.2316418882f + 1.0f);
    float q = t * 0.5307027145f + (-0.7265760135f); q = q * t + 0.7107068705f; q = q * t + (-0.142248368f); q = q * t + 0.127414796f; q = q * t;
    const float e = __builtin_amdgcn_exp2f((v * v) * (-0.72134752044f));
    const float m = v * (q * e);
    return v < 0.f ? m : v - m;
}
__device__ __forceinline__ int crow(int r, int hi) { return (r & 3) + 8 * (r >> 2) + 4 * hi; }

#define XB_TMO      128
#define XB_XCNT(j)  (256  + 64 * (j))
#define XB_XSUB(j)  (1280 + 64 * (j))
#define XB_XGEN(j)  (2304 + 64 * (j))
#define XB_TOP      3328
#define XB_TOPGEN   3392
#define XCD_BAR_WORDS 3456
#define XB_SPIN_CAP (1u << 18)

__device__ __forceinline__ unsigned xb_ld(unsigned* p)              { return __hip_atomic_load(p, __ATOMIC_RELAXED, __HIP_MEMORY_SCOPE_AGENT); }
__device__ __forceinline__ unsigned xb_add(unsigned* p, unsigned v) { return __hip_atomic_fetch_add(p, v, __ATOMIC_RELAXED, __HIP_MEMORY_SCOPE_AGENT); }
__device__ __forceinline__ unsigned xb_xcc_id() { return (unsigned)__builtin_amdgcn_s_getreg((3 << 11) | 20) & 0xFu; }
#define XB_SPIN(cond, bar) do { unsigned _sp = 0; while (cond) { __builtin_amdgcn_s_sleep(1); \
    if ((++_sp & 255u) == 0u) { if (xb_ld(&(bar)[XB_TMO])) break; if (_sp > XB_SPIN_CAP) { atomicAdd(&(bar)[XB_TMO], 1u); break; } } } } while (0)

struct XcdBarrier {
    unsigned* bar; unsigned x;
    volatile LAS unsigned* st;
};

__device__ __forceinline__ XcdBarrier xcd_barrier_post(unsigned* bar, volatile LAS unsigned* st) {
    XcdBarrier b; b.bar = bar; b.x = xb_xcc_id(); b.st = st;
    if (threadIdx.x == 0) (void)xb_add(&bar[XB_XCNT(b.x)], 1u);
    return b;
}
__device__ __forceinline__ void xcd_barrier_complete(unsigned* bar, unsigned x, unsigned& nloc, unsigned& nx) {
    const unsigned G = gridDim.x * gridDim.y * gridDim.z;
    unsigned sum, cnt, mine, sp = 0u;
    for (;;) {
        sum = 0u; cnt = 0u; mine = 0u;
#pragma unroll
        for (unsigned j = 0; j < 16; ++j) { const unsigned c = xb_ld(&bar[XB_XCNT(j)]); sum += c; cnt += (c > 0u) ? 1u : 0u; mine = (j == x) ? c : mine; }
        if (sum == G) break;
        __builtin_amdgcn_s_sleep(1);
        if ((++sp & 255u) == 0u) { if (xb_ld(&bar[XB_TMO])) break; if (sp > XB_SPIN_CAP) { atomicAdd(&bar[XB_TMO], 1u); break; } }
    }
    nloc = mine > 0u ? mine : 1u; nx = cnt > 0u ? cnt : 1u;
}

__device__ __forceinline__ void xcd_barrier(const XcdBarrier& b) {
    asm volatile("s_waitcnt vmcnt(0)" ::: "memory");
    __syncthreads();
    if (threadIdx.x == 0) {
        unsigned* bar = b.bar;
        __builtin_amdgcn_s_waitcnt(0);
        unsigned nloc = b.st[0], nx = b.st[1];
        if (nloc == 0u) { xcd_barrier_complete(bar, b.x, nloc, nx); b.st[0] = nloc; b.st[1] = nx; }
        const unsigned old = xb_add(&bar[XB_XSUB(b.x)], 1u);
        const unsigned gen = old / nloc;
        if (old + 1u == (gen + 1u) * nloc) {
            __builtin_amdgcn_fence(__ATOMIC_RELEASE, "agent");
            asm volatile("s_waitcnt vmcnt(0)" ::: "memory");
            const unsigned og = xb_add(&bar[XB_TOP], 1u);
            const unsigned tg = og / nx;
            if (og + 1u == (tg + 1u) * nx) xb_add(&bar[XB_TOPGEN], 1u);
            else XB_SPIN(xb_ld(&bar[XB_TOPGEN]) == tg, bar);
            __builtin_amdgcn_fence(__ATOMIC_ACQUIRE, "agent");
            xb_add(&bar[XB_XGEN(b.x)], 1u);
            asm volatile("s_waitcnt vmcnt(0)" ::: "memory");
        } else {
            XB_SPIN(xb_ld(&bar[XB_XGEN(b.x)]) == gen, bar);
            __builtin_amdgcn_fence(__ATOMIC_ACQUIRE, "agent");
            asm volatile("s_waitcnt vmcnt(0)" ::: "memory");
        }
    }
    __syncthreads();
}

struct Args { const float* in[N_INPUTS]; float* out; unsigned char* ws; int ph_lo, ph_hi; };
static_assert(sizeof(Args) == (N_INPUTS + 2) * 8 + 8, "Args has no padding");

struct Ctx {
    LAS unsigned char* lds; int tid, lane, wave, G, bid;
};
typedef const Args __attribute__((address_space(4))) KArgs;
__device__ __forceinline__ KArgs* ka_ptr() { KArgs* p = (KArgs*)__builtin_amdgcn_kernarg_segment_ptr(); asm volatile("" : "+s"(p)); return p; }
#define KA_DECL KArgs& A = *ka_ptr()

__device__ __forceinline__ void tr_item(const float* __restrict__ W, int N, int col0, int nvalid, int k0, bf16* __restrict__ WT, int K, int n0, LAS float* scr, int lane) {
#pragma unroll 8
    for (int i = 0; i < 32; ++i) { const int kk = 2 * i + (lane >> 5), nn = lane & 31; float v = 0.f; if (nn < nvalid) v = W[(size_t)(k0 + kk) * N + col0 + nn]; scr[kk * 33 + nn] = v; }
    LDS_WAIT(); asm volatile("" ::: "memory");
    const int c = lane & 7;
#pragma unroll
    for (int j = 0; j < 4; ++j) { const int n = (lane >> 3) + 8 * j; const LAS float* s = scr + (8 * c) * 33 + n;
        v4u o; o.x = pk2(s[0 * 33], s[1 * 33]); o.y = pk2(s[2 * 33], s[3 * 33]); o.z = pk2(s[4 * 33], s[5 * 33]); o.w = pk2(s[6 * 33], s[7 * 33]);
        *(v4u*)(WT + (size_t)(n0 + n) * K + k0 + 8 * c) = o; }
    LDS_WAIT(); asm volatile("" ::: "memory");
}
__device__ __forceinline__ void ph_prologue(const Ctx& C) {
    KA_DECL;
    LAS float* csilu = (LAS float*)(C.lds + 73728);
    for (int i = C.tid; i < NB * D; i += NTHREADS) { const float c = A.in[I_C][i]; csilu[i] = c / (1.0f + __expf(-c)); }
    __syncthreads();
    LAS float* scr = (LAS float*)(C.lds + C.wave * 8704);
    const int gw = C.bid * NWAVES + C.wave, NGW = C.G * NWAVES;
    constexpr int I_IN = (D / 64) * (NP / 32), I_OUT = (D / 64) * (D / 32), I_13 = (D / 64) * (2 * FF / 32), I_2 = (FF / 64) * (D / 32), PER_L = I_IN + I_OUT + I_13 + I_2;
    for (int it = gw; it < DEPTH * PER_L; it += NGW) {
        const int l = it / PER_L; int r = it % PER_L;
        if (r < I_IN) { const int kb = r / (NP / 32), nb = r % (NP / 32), n0 = 32 * nb; int col0, nv = 32;
            if (n0 < 1536) col0 = n0; else if (n0 < 4864) col0 = n0 + 160; else if (n0 < 5376) col0 = n0 + 168; else if (n0 < 5536) col0 = n0 - 3840;
            else if (n0 == 5536) { col0 = 5024; nv = 8; } else { col0 = 0; nv = 0; }
            tr_item(A.in[I_WIN] + (size_t)l * D * NIN, NIN, col0, nv, 64 * kb, (bf16*)(A.ws + WS_WIN) + (size_t)l * NP * D, D, n0, scr, C.lane); continue; }
        r -= I_IN;
        if (r < I_OUT) { const int kb = r / (D / 32), nb = r % (D / 32);
            tr_item(A.in[I_WOUT] + (size_t)l * D * D, D, 32 * nb, 32, 64 * kb, (bf16*)(A.ws + WS_WOUT) + (size_t)l * D * D, D, 32 * nb, scr, C.lane); continue; }
        r -= I_OUT;
        if (r < I_13) { const int kb = r / (2 * FF / 32), nb = r % (2 * FF / 32), n0 = 32 * nb, pn = n0 >> 8, j = n0 & 255;
            const float* src = (j < 128 ? A.in[I_W1] : A.in[I_W3]) + (size_t)l * D * FF;
            tr_item(src, FF, 128 * pn + (j & 127), 32, 64 * kb, (bf16*)(A.ws + WS_W13) + (size_t)l * 2 * FF * D, D, n0, scr, C.lane); continue; }
        r -= I_13;
        { const int kb = r / (D / 32), nb = r % (D / 32);
            tr_item(A.in[I_W2] + (size_t)l * FF * D, D, 32 * nb, 32, 64 * kb, (bf16*)(A.ws + WS_W2) + (size_t)l * D * FF, FF, 32 * nb, scr, C.lane); }
    }
    for (int it = gw; it < 8 * DEPTH * (MODW / 256); it += NGW) {
        const int cg = it % (DEPTH * (MODW / 256)), ks = it / (DEPTH * (MODW / 256)), l = cg / (MODW / 256), n0 = (cg % (MODW / 256)) * 256, k0 = ks * 256;
        const float* wp = A.in[I_WMOD] + ((size_t)l * D + k0) * MODW + n0 + 4 * C.lane;
        f32x4 a0 = {0.f, 0.f, 0.f, 0.f}, a1 = a0, a2 = a0, a3 = a0;
#pragma unroll 8
        for (int k = 0; k < 256; ++k) { const f32x4 w = *(const f32x4*)(wp + (size_t)k * MODW);
            a0 += w * csilu[0 * D + k0 + k]; a1 += w * csilu[1 * D + k0 + k]; a2 += w * csilu[2 * D + k0 + k]; a3 += w * csilu[3 * D + k0 + k]; }
        float* mp = (float*)(A.ws + WS_MODP) + ((size_t)(ks * DEPTH + l) * NB) * MODW + n0 + 4 * C.lane;
        *(f32x4*)(mp + 0 * MODW) = a0; *(f32x4*)(mp + 1 * MODW) = a1; *(f32x4*)(mp + 2 * MODW) = a2; *(f32x4*)(mp + 3 * MODW) = a3;
    }
}
__device__ __forceinline__ void ph_modreduce(const Ctx& C) {
    KA_DECL;
    const float* mp = (const float*)(A.ws + WS_MODP); float* mod = (float*)(A.ws + WS_MOD);
    for (int i = C.bid * NTHREADS + C.tid; i < DEPTH * NB * MODW; i += C.G * NTHREADS) {
        const int l = i / (NB * MODW), n = i % MODW; float s = A.in[I_BMOD][l * MODW + n];
#pragma unroll
        for (int ks = 0; ks < 8; ++ks) s += mp[(size_t)ks * DEPTH * NB * MODW + i];
        mod[i] = s;
    }
}
__device__ __forceinline__ void ph_norm(const Ctx& C, const float* x, const float* g, const float* shift, const float* scale, bf16* H) {
    const int gw = C.bid * NWAVES + C.wave, NGW = C.G * NWAVES;
    for (int m = gw; m < M; m += NGW) {
        const int b = m / T; const f32x4* xr = (const f32x4*)(x + (size_t)m * D) + C.lane;
        f32x4 v[8]; float ss = 0.f;
#pragma unroll
        for (int j = 0; j < 8; ++j) { v[j] = xr[64 * j]; ss += (v[j].x * v[j].x + v[j].y * v[j].y) + (v[j].z * v[j].z + v[j].w * v[j].w); }
        const float rstd = 1.0f / sqrtf(wave_sum(ss) * (1.0f / D) + 1e-6f);
        unsigned long long* o8 = (unsigned long long*)(H + (size_t)m * D) + C.lane;
#pragma unroll
        for (int j = 0; j < 8; ++j) { const int c = 4 * (C.lane + 64 * j);
            const f32x4 gg = *(const f32x4*)(g + c), sc = *(const f32x4*)(scale + (size_t)b * MODW + c), sh = *(const f32x4*)(shift + (size_t)b * MODW + c);
            const f32x4 y = v[j] * rstd * gg * (sc + 1.0f) + sh;
            o8[64 * j] = (unsigned long long)pk2(y.x, y.y) | ((unsigned long long)pk2(y.z, y.w) << 32); }
    }
}

__device__ __forceinline__ f32x16 mma32(const LAS bf16* Ap, const LAS bf16* Bp, int ksteps, f32x16 acc) {
    for (int k = 0; k < ksteps; ++k) { const bf16x8 a = *(const LAS bf16x8*)(Ap + 16 * k), b = *(const LAS bf16x8*)(Bp + 16 * k);
        acc = __builtin_amdgcn_mfma_f32_32x32x16_bf16(a, b, acc, 0, 0, 0); }
    return acc;
}
constexpr int AP = 72;
constexpr int A_Q = 0, A_K = 18432, A_VT = 27648, A_S = 36864, A_P = 71680, A_AL = 90112, A_CUM = 90624, A_END = 107008;
constexpr int SP = 68;
template <int MODE>
__device__ __forceinline__ void attn_unit(const Ctx& C, int l, int b, int h, int qb) {
    KA_DECL; asm volatile("" : "+s"(l));
    const bf16* proj = (const bf16*)(A.ws + WS_PROJ); bf16* ycat = (bf16*)(A.ws + WS_YCAT);
    const int tid = C.tid, lane = C.lane, wave = C.wave, r32 = lane & 31, hi = lane >> 5;
    const int q0 = qb * 128; const size_t rowb = (size_t)b * T;
    const int qcol = (MODE == 0 ? PC_SQ : PC_FQ) + h * 64;
    const int kcol = (MODE == 0) ? PC_SK + (h >> 2) * 64 : PC_FK + h * 64;
    const int vcol = (MODE == 0) ? PC_SV + (h >> 2) * 64 : PC_FV + h * 64;
    const float* qg = A.in[MODE == 0 ? I_SQG : I_FQG] + l * 64; const float* kg = A.in[MODE == 0 ? I_SKG : I_FKG] + l * 64;
    LAS bf16* Qs = (LAS bf16*)(C.lds + A_Q); LAS bf16* Ks = (LAS bf16*)(C.lds + A_K); LAS bf16* Vt = (LAS bf16*)(C.lds + A_VT);
    LAS float* Ss = (LAS float*)(C.lds + A_S); LAS bf16* Ps = (LAS bf16*)(C.lds + A_P); LAS float* AL = (LAS float*)(C.lds + A_AL); LAS float* cum = (LAS float*)(C.lds + A_CUM);
    __syncthreads();
    if (MODE == 1) {
        const int n = q0 + 128; const float fb = A.in[I_FFB][l * NH + h];
        float loc[8]; float s = 0.f;
#pragma unroll
        for (int i = 0; i < 8; ++i) { const int pos = 8 * tid + i; float v = 0.f;
            if (pos < n) { const float x = bf2f(proj[(rowb + pos) * NP + PC_FL + h]) + fb; v = (x < 0.f) ? x - log1pf(expf(x)) : -log1pf(expf(-x)); }
            s += v; loc[i] = s; }
        float ws_ = s;
#pragma unroll
        for (int o = 1; o < 64; o <<= 1) { const float t_ = __shfl_up(ws_, o); if (lane >= o) ws_ += t_; }
        if (lane == 63) AL[wave] = ws_;
        __syncthreads();
        float base = ws_ - s;
        for (int w = 0; w < wave; ++w) base += AL[w];
#pragma unroll
        for (int i = 0; i < 8; ++i) { const int pos = 8 * tid + i; if (pos < n) cum[pos] = base + loc[i]; }
    }
    {
        const int row = tid >> 2, dq = (tid & 3) * 16;
        const v4u* src = (const v4u*)(proj + (rowb + q0 + row) * NP + qcol + dq);
        const v4u r0 = src[0], r1 = src[1];
        float f[16];
        f[0] = bflo(r0.x); f[1] = bfhi(r0.x); f[2] = bflo(r0.y); f[3] = bfhi(r0.y); f[4] = bflo(r0.z); f[5] = bfhi(r0.z); f[6] = bflo(r0.w); f[7] = bfhi(r0.w);
        f[8] = bflo(r1.x); f[9] = bfhi(r1.x); f[10] = bflo(r1.y); f[11] = bfhi(r1.y); f[12] = bflo(r1.z); f[13] = bfhi(r1.z); f[14] = bflo(r1.w); f[15] = bfhi(r1.w);
        float ss = 0.f;
#pragma unroll
        for (int i = 0; i < 16; ++i) ss += f[i] * f[i];
        ss += __shfl_xor(ss, 1); ss += __shfl_xor(ss, 2);
        const float rs = 0.125f / sqrtf(ss * (1.0f / 64.0f) + 1e-6f);
#pragma unroll
        for (int i = 0; i < 16; ++i) f[i] = f[i] * rs * qg[dq + i];
        v4u o0, o1; o0.x = pk2(f[0], f[1]); o0.y = pk2(f[2], f[3]); o0.z = pk2(f[4], f[5]); o0.w = pk2(f[6], f[7]);
        o1.x = pk2(f[8], f[9]); o1.y = pk2(f[10], f[11]); o1.z = pk2(f[12], f[13]); o1.w = pk2(f[14], f[15]);
        *(LAS v4u*)(Qs + row * AP + dq) = o0; *(LAS v4u*)(Qs + row * AP + dq + 8) = o1;
    }
    const int ks_begin = (MODE == 0) ? (q0 >= 128 ? q0 - 128 : 0) : 0, ks_end = q0 + 128;
    float m_run = -1e30f, l_run = 0.f;
    f32x16 o;
#pragma unroll
    for (int r = 0; r < 16; ++r) o[r] = 0.f;
    const int qi = wave >> 1, cj = wave & 1;
    for (int ks = ks_begin; ks < ks_end; ks += 64) {
        {
            const int row = tid >> 3, dc = (tid & 7) * 8;
            const v4u kr = *(const v4u*)(proj + (rowb + ks + row) * NP + kcol + dc);
            float f[8]; f[0] = bflo(kr.x); f[1] = bfhi(kr.x); f[2] = bflo(kr.y); f[3] = bfhi(kr.y); f[4] = bflo(kr.z); f[5] = bfhi(kr.z); f[6] = bflo(kr.w); f[7] = bfhi(kr.w);
            float ss = 0.f;
#pragma unroll
            for (int i = 0; i < 8; ++i) ss += f[i] * f[i];
            ss += __shfl_xor(ss, 1); ss += __shfl_xor(ss, 2); ss += __shfl_xor(ss, 4);
            const float rs = 1.0f / sqrtf(ss * (1.0f / 64.0f) + 1e-6f);
#pragma unroll
            for (int i = 0; i < 8; ++i) f[i] = f[i] * rs * kg[dc + i];
            v4u ko; ko.x = pk2(f[0], f[1]); ko.y = pk2(f[2], f[3]); ko.z = pk2(f[4], f[5]); ko.w = pk2(f[6], f[7]);
            *(LAS v4u*)(Ks + row * AP + dc) = ko;
            const v4u vr = *(const v4u*)(proj + (rowb + ks + row) * NP + vcol + dc);
            Vt[(dc + 0) * AP + row] = (bf16)(vr.x & 0xffffu); Vt[(dc + 1) * AP + row] = (bf16)(vr.x >> 16);
            Vt[(dc + 2) * AP + row] = (bf16)(vr.y & 0xffffu); Vt[(dc + 3) * AP + row] = (bf16)(vr.y >> 16);
            Vt[(dc + 4) * AP + row] = (bf16)(vr.z & 0xffffu); Vt[(dc + 5) * AP + row] = (bf16)(vr.z >> 16);
            Vt[(dc + 6) * AP + row] = (bf16)(vr.w & 0xffffu); Vt[(dc + 7) * AP + row] = (bf16)(vr.w >> 16);
        }
        __syncthreads();
        {
            f32x16 acc;
#pragma unroll
            for (int r = 0; r < 16; ++r) acc[r] = 0.f;
            acc = mma32(Qs + (32 * qi + r32) * AP + 8 * hi, Ks + (32 * cj + r32) * AP + 8 * hi, 4, acc);
#pragma unroll
            for (int r = 0; r < 16; ++r) Ss[(32 * qi + crow(r, hi)) * SP + 32 * cj + r32] = acc[r];
        }
        __syncthreads();
        {
            const int row = tid >> 2, c0 = (tid & 3) * 16, qp = q0 + row;
            float s[16];
#pragma unroll
            for (int i = 0; i < 4; ++i) { const f32x4 t4 = *(const LAS f32x4*)(Ss + row * SP + c0 + 4 * i); s[4 * i] = t4.x; s[4 * i + 1] = t4.y; s[4 * i + 2] = t4.z; s[4 * i + 3] = t4.w; }
            float cq = 0.f; if (MODE == 1) cq = cum[qp];
            float mx = -1e30f;
#pragma unroll
            for (int i = 0; i < 16; ++i) { const int kp = ks + c0 + i;
                if (MODE == 1) s[i] += cq - cum[kp];
                const bool ok = (MODE == 1) ? (kp <= qp) : (kp <= qp && kp > qp - 128);
                s[i] = ok ? s[i] : -1e30f; mx = fmaxf(mx, s[i]); }
            mx = fmaxf(mx, __shfl_xor(mx, 1)); mx = fmaxf(mx, __shfl_xor(mx, 2));
            const float m_new = fmaxf(m_run, mx), alpha = __expf(m_run - m_new);
            float p[16], rsum = 0.f;
#pragma unroll
            for (int i = 0; i < 16; ++i) { p[i] = (s[i] > -1e29f) ? __expf(s[i] - m_new) : 0.f; rsum += p[i]; }
            rsum += __shfl_xor(rsum, 1); rsum += __shfl_xor(rsum, 2);
            l_run = l_run * alpha + rsum; m_run = m_new;
            v4u o0, o1; o0.x = pk2(p[0], p[1]); o0.y = pk2(p[2], p[3]); o0.z = pk2(p[4], p[5]); o0.w = pk2(p[6], p[7]);
            o1.x = pk2(p[8], p[9]); o1.y = pk2(p[10], p[11]); o1.z = pk2(p[12], p[13]); o1.w = pk2(p[14], p[15]);
            *(LAS v4u*)(Ps + row * AP + c0) = o0; *(LAS v4u*)(Ps + row * AP + c0 + 8) = o1;
            if ((tid & 3) == 0) AL[row] = alpha;
        }
        __syncthreads();
        {
#pragma unroll
            for (int r = 0; r < 16; ++r) o[r] *= AL[32 * qi + crow(r, hi)];
            o = mma32(Ps + (32 * qi + r32) * AP + 8 * hi, Vt + (32 * cj + r32) * AP + 8 * hi, 4, o);
        }
        __syncthreads();
    }
    {
        if (MODE == 0) l_run += __expf(A.in[I_SSINK][l * NH + h] - m_run);
        if ((tid & 3) == 0) AL[tid >> 2] = 1.0f / l_run;
    }
    __syncthreads();
#pragma unroll
    for (int r = 0; r < 16; ++r) { const int row = 32 * qi + crow(r, hi), d = 32 * cj + r32; const size_t m = rowb + q0 + row;
        float val = o[r] * AL[row];
        if (MODE == 1) val *= sigmoidf_(bf2f(proj[m * NP + PC_FG + h * 64 + d]));
        ycat[m * D + (MODE == 0 ? YC_B : YC_D) + h * 64 + d] = (bf16)f2bf(val); }
}
constexpr int GP = 136;
constexpr int G_W = 0, G_VT = 34816, G_ST = 52224;
__device__ __forceinline__ void sgu_unit(const Ctx& C, int l, int b, int chunk, int ghalf) {
    KA_DECL; asm volatile("" : "+s"(l));
    const bf16* proj = (const bf16*)(A.ws + WS_PROJ); bf16* ycat = (bf16*)(A.ws + WS_YCAT);
    const int tid = C.tid, lane = C.lane, wave = C.wave, r32 = lane & 31, hi = lane >> 5;
    const size_t m0 = (size_t)b * T + chunk * 128;
    LAS bf16* Wd = (LAS bf16*)(C.lds + G_W); LAS bf16* Vt = (LAS bf16*)(C.lds + G_VT); LAS float* ST = (LAS float*)(C.lds + G_ST);
    __syncthreads();
    {
        const int tok = tid >> 2, part = tid & 3; const v4u* src = (const v4u*)(proj + (m0 + tok) * NP + PC_GV + part * 128);
        float s1 = 0.f, s2 = 0.f;
#pragma unroll 4
        for (int i = 0; i < 16; ++i) { const v4u w = src[i];
            const float e0 = gelu_f(bflo(w.x)), e1 = gelu_f(bfhi(w.x)), e2 = gelu_f(bflo(w.y)), e3 = gelu_f(bfhi(w.y)), e4 = gelu_f(bflo(w.z)), e5 = gelu_f(bfhi(w.z)), e6 = gelu_f(bflo(w.w)), e7 = gelu_f(bfhi(w.w));
            s1 += ((e0 + e1) + (e2 + e3)) + ((e4 + e5) + (e6 + e7));
            s2 += ((e0 * e0 + e1 * e1) + (e2 * e2 + e3 * e3)) + ((e4 * e4 + e5 * e5) + (e6 * e6 + e7 * e7)); }
        s1 += __shfl_xor(s1, 1); s1 += __shfl_xor(s1, 2); s2 += __shfl_xor(s2, 1); s2 += __shfl_xor(s2, 2);
        const float mean = s1 * (1.0f / 512.0f), var = fmaxf(s2 * (1.0f / 512.0f) - mean * mean, 0.f);
        if (part == 0) { ST[2 * tok] = mean; ST[2 * tok + 1] = 1.0f / sqrtf(var + 1e-5f); }
    }
    __syncthreads();
    const int ti = wave >> 1, cj = wave & 1;
    for (int gi = 0; gi < 4; ++gi) {
        const int g = ghalf * 4 + gi;
        {
            const int row = tid >> 2, s0 = (tid & 3) * 32; const float* wsrc = A.in[I_GWS] + (size_t)(l * NH + g) * SGU_TRI + (row * (row + 1)) / 2;
#pragma unroll
            for (int i = 0; i < 32; i += 2) { const int s = s0 + i; const float w0 = (s <= row) ? wsrc[s] : 0.f, w1 = (s + 1 <= row) ? wsrc[s + 1] : 0.f;
                *(LAS unsigned*)(Wd + row * GP + s) = pk2(w0, w1); }
        }
        {
            const int tok = tid >> 2, c0 = (tid & 3) * 16; const v4u* src = (const v4u*)(proj + (m0 + tok) * NP + PC_GV + g * 64 + c0);
            const v4u r0 = src[0], r1 = src[1]; const float mean = ST[2 * tok], rstd = ST[2 * tok + 1];
            const float* lg = A.in[I_GLG] + l * GW + g * 64 + c0; const float* lb = A.in[I_GLB] + l * GW + g * 64 + c0;
            float f[16];
            f[0] = bflo(r0.x); f[1] = bfhi(r0.x); f[2] = bflo(r0.y); f[3] = bfhi(r0.y); f[4] = bflo(r0.z); f[5] = bfhi(r0.z); f[6] = bflo(r0.w); f[7] = bfhi(r0.w);
            f[8] = bflo(r1.x); f[9] = bfhi(r1.x); f[10] = bflo(r1.y); f[11] = bfhi(r1.y); f[12] = bflo(r1.z); f[13] = bfhi(r1.z); f[14] = bflo(r1.w); f[15] = bfhi(r1.w);
#pragma unroll
            for (int i = 0; i < 16; ++i) { const float y = (gelu_f(f[i]) - mean) * rstd * lg[i] + lb[i]; Vt[(c0 + i) * GP + tok] = (bf16)f2bf(y); }
        }
        __syncthreads();
        {
            f32x16 acc;
#pragma unroll
            for (int r = 0; r < 16; ++r) acc[r] = 0.f;
            acc = mma32(Wd + (32 * ti + r32) * GP + 8 * hi, Vt + (32 * cj + r32) * GP + 8 * hi, 2 * (ti + 1), acc);
            const float* bs = A.in[I_GB] + (size_t)(l * NH + g) * 128;
#pragma unroll
            for (int r = 0; r < 16; ++r) { const int t = 32 * ti + crow(r, hi), c = 32 * cj + r32; const size_t m = m0 + t;
                const float z = acc[r] + bs[t], u = gelu_f(bf2f(proj[m * NP + PC_GU + g * 64 + c]));
                ycat[m * D + YC_C + g * 64 + c] = (bf16)f2bf(u * z); }
        }
        __syncthreads();
    }
}
constexpr size_t WS_QF = WS_RIN, WS_YF = WS_RIN + 32 * MiB, WS_PA = WS_RIN + 64 * MiB, WS_RT = WS_RIN + 80 * MiB, WS_GL = WS_RIN + 96 * MiB, WS_RBV = WS_RIN + 97 * MiB;
constexpr int TP = 72;
constexpr int R_AH = 0, R_RH = 9216, R_BT = 18432, R_KT = 27648, R_VT = 36864, R_BH = 46080, R_KH = 55296, R_RHS = 46080  ;
constexpr int R_LR = 64512  , R_NP = 64512  , R_NK = 80896, R_BR = 90112, R_KR = 99328, R_W1 = 108544, R_W2 = 117760, R_GT = 126976;
__device__ __forceinline__ float shifted(const bf16* proj, size_t m, int t, int col, float mu) {
    const float p = bf2f(proj[m * NP + col]); const float pp = (t > 0) ? bf2f(proj[(m - 1) * NP + col]) : 0.f; return p + (pp - p) * mu;
}
__device__ __forceinline__ float dpp_xor1(float v) { return __builtin_bit_cast(float, __builtin_amdgcn_update_dpp(0, __builtin_bit_cast(int, v), 0xB1, 0xF, 0xF, true)); }
__device__ __forceinline__ float dpp_xor2(float v) { return __builtin_bit_cast(float, __builtin_amdgcn_update_dpp(0, __builtin_bit_cast(int, v), 0x4E, 0xF, 0xF, true)); }
__device__ __forceinline__ void rwkv_chunk_unit(const Ctx& C, int l, int b, int c, int h) {
    KA_DECL; asm volatile("" : "+s"(l));
    const bf16* proj = (const bf16*)(A.ws + WS_PROJ);
    const int tid = C.tid, lane = C.lane, wave = C.wave, r32 = lane & 31, hi = lane >> 5;
    const size_t m0 = (size_t)b * T + 64 * c; const int t0 = 64 * c; const size_t pair = (size_t)(b * NH + h) * 64 + c;
    LAS unsigned char* L = C.lds;
    LAS bf16* tAH = (LAS bf16*)(L + R_AH); LAS bf16* tRH = (LAS bf16*)(L + R_RH); LAS bf16* tBT = (LAS bf16*)(L + R_BT); LAS bf16* tKT = (LAS bf16*)(L + R_KT); LAS bf16* tVT = (LAS bf16*)(L + R_VT);
    LAS bf16* tBH = (LAS bf16*)(L + R_BH); LAS bf16* tKH = (LAS bf16*)(L + R_KH); LAS float* RHS = (LAS float*)(L + R_RHS); LAS float* LR = (LAS float*)(L + R_LR); LAS float* NPm = (LAS float*)(L + R_NP);
    LAS bf16* tNK = (LAS bf16*)(L + R_NK); LAS bf16* tBR = (LAS bf16*)(L + R_BR); LAS bf16* tKR = (LAS bf16*)(L + R_KR); LAS bf16* tW1 = (LAS bf16*)(L + R_W1); LAS bf16* tW2 = (LAS bf16*)(L + R_W2);
    LAS float* GT = (LAS float*)(L + R_GT);
    const float* mu = A.in[I_RMU] + l * 1696;
    __syncthreads();
    for (int e = tid; e < 64 * 160; e += NTHREADS) { const int tok = e / 160, j = e % 160;
        const float x = shifted(proj, m0 + tok, t0 + tok, PC_RW + j, mu[1536 + j]);
        LR[e] = (j < 32) ? tanhf(x) : (j < 64 ? x : sigmoidf_(x)); }
    __syncthreads();
    const int cg = h * 64 + lane, tg = wave;
    float rr[8], kp[8], vv[8], na[8], bb[8], pg[8];
    {
        float aw[8], aa[8], ag[8];
#pragma unroll
        for (int k = 0; k < 8; ++k) { aw[k] = 0.f; aa[k] = 0.f; ag[k] = 0.f; }
        const float* w2 = A.in[I_RW2] + (size_t)l * 32 * GW + cg; const float* a2 = A.in[I_RA2] + (size_t)l * 32 * GW + cg; const float* g2 = A.in[I_RG2] + (size_t)l * 96 * GW + cg;
        const LAS float* lr = LR + tg * 8 * 160;
#pragma unroll 1
        for (int m4 = 0; m4 < 8; ++m4) {
            const float wv0 = w2[(4 * m4 + 0) * GW], wv1 = w2[(4 * m4 + 1) * GW], wv2 = w2[(4 * m4 + 2) * GW], wv3 = w2[(4 * m4 + 3) * GW];
            const float av0 = a2[(4 * m4 + 0) * GW], av1 = a2[(4 * m4 + 1) * GW], av2 = a2[(4 * m4 + 2) * GW], av3 = a2[(4 * m4 + 3) * GW];
#pragma unroll
            for (int k = 0; k < 8; ++k) { const f32x4 x = *(const LAS f32x4*)(lr + k * 160 + 4 * m4), y = *(const LAS f32x4*)(lr + k * 160 + 32 + 4 * m4);
                aw[k] += (x.x * wv0 + x.y * wv1) + (x.z * wv2 + x.w * wv3); aa[k] += (y.x * av0 + y.y * av1) + (y.z * av2 + y.w * av3); }
        }
#pragma unroll 1
        for (int m4 = 0; m4 < 24; ++m4) {
            const float gv0 = g2[(4 * m4 + 0) * GW], gv1 = g2[(4 * m4 + 1) * GW], gv2 = g2[(4 * m4 + 2) * GW], gv3 = g2[(4 * m4 + 3) * GW];
#pragma unroll
            for (int k = 0; k < 8; ++k) { const f32x4 x = *(const LAS f32x4*)(lr + k * 160 + 64 + 4 * m4); ag[k] += (x.x * gv0 + x.y * gv1) + (x.z * gv2 + x.w * gv3); }
        }
        const float w0 = A.in[I_RW0][l * GW + cg], a0 = A.in[I_RA0][l * GW + cg], kkc = A.in[I_RKK][l * GW + cg], kac = A.in[I_RKA][l * GW + cg], rkc = A.in[I_RRK][l * GW + cg];
        const float mur = mu[cg], muk = mu[512 + cg], muv = mu[1024 + cg];
        float* rg = (float*)(A.ws + WS_RG); float* rbv = (float*)(A.ws + WS_RBV);
        float run = 0.f;
#pragma unroll
        for (int k = 0; k < 8; ++k) { const size_t m = m0 + 8 * tg + k; const int t = t0 + 8 * tg + k;
            const float r = shifted(proj, m, t, PC_RR + cg, mur), kx = shifted(proj, m, t, PC_RK + cg, muk), v = shifted(proj, m, t, PC_RV + cg, muv);
            run += -0.6065306597126334f * sigmoidf_(w0 + aw[k]); pg[k] = run;
            const float ia = sigmoidf_(a0 + aa[k]);
            float kk = kx * kkc; const float n2 = wave_sum(kk * kk); kk = kk / fmaxf(sqrtf(n2), 1e-12f);
            const float kpv = kx * (1.0f + (ia - 1.0f) * kac);
            const float bonus = wave_sum(r * kpv * rkc);
            rg[m * GW + cg] = ag[k]; rbv[m * GW + cg] = bonus * v * ag[k];
            rr[k] = r; kp[k] = kpv; vv[k] = v; na[k] = -kk; bb[k] = kk * ia; }
        GT[tg * 64 + lane] = run;
    }
    __syncthreads();
    {
        float off = 0.f, gL = 0.f;
#pragma unroll
        for (int w = 0; w < 8; ++w) { const float x = GT[w * 64 + lane]; gL += x; off += (w < tg) ? x : 0.f; }
        float bt[8], kt[8];
#pragma unroll
        for (int k = 0; k < 8; ++k) { const int t = 8 * tg + k; const float g = off + pg[k], gp = off + (k > 0 ? pg[k - 1] : 0.f);
            const float eg = __expf(g), egp = __expf(gp), ei = __expf(-g), eL = __expf(gL - g);
            tAH[t * TP + lane] = (bf16)f2bf(na[k] * egp); tRH[t * TP + lane] = (bf16)f2bf(rr[k] * eg); tBH[t * TP + lane] = (bf16)f2bf(bb[k] * ei); tKH[t * TP + lane] = (bf16)f2bf(kp[k] * ei);
            bt[k] = bb[k] * eL; kt[k] = kp[k] * eL; }
        v4u o; o.x = pk2(bt[0], bt[1]); o.y = pk2(bt[2], bt[3]); o.z = pk2(bt[4], bt[5]); o.w = pk2(bt[6], bt[7]); *(LAS v4u*)(tBT + lane * TP + 8 * tg) = o;
        o.x = pk2(kt[0], kt[1]); o.y = pk2(kt[2], kt[3]); o.z = pk2(kt[4], kt[5]); o.w = pk2(kt[6], kt[7]); *(LAS v4u*)(tKT + lane * TP + 8 * tg) = o;
        o.x = pk2(vv[0], vv[1]); o.y = pk2(vv[2], vv[3]); o.z = pk2(vv[4], vv[5]); o.w = pk2(vv[6], vv[7]); *(LAS v4u*)(tVT + lane * TP + 8 * tg) = o;
        if (tg == 0) ((float*)(A.ws + WS_GL))[pair * 64 + lane] = __expf(gL);
    }
    __syncthreads();
    {
        const int mi = wave >> 1, rt = wave & 1;
        const LAS bf16* Am = (mi < 2) ? tAH : tRH; const LAS bf16* Bm = (mi & 1) ? tKH : tBH;
        for (int ct = 0; ct < 2; ++ct) {
            f32x16 acc;
#pragma unroll
            for (int r = 0; r < 16; ++r) acc[r] = 0.f;
            if (!(rt == 0 && ct == 1)) acc = mma32(Am + (32 * rt + r32) * TP + 8 * hi, Bm + (32 * ct + r32) * TP + 8 * hi, 4, acc);
#pragma unroll
            for (int r = 0; r < 16; ++r) { const int t = 32 * rt + crow(r, hi), s = 32 * ct + r32;
                const bool keep = (mi < 2) ? (s < t) : (s <= t); const float val = keep ? acc[r] : 0.f;
                if (mi == 0) NPm[t * 64 + (s & 3) * 16 + (s >> 2)] = val;
                else { LAS bf16* dst = (mi == 1) ? tNK : ((mi == 2) ? tBR : tKR); dst[t * TP + s] = (bf16)f2bf(val); } }
        }
    }
    __syncthreads();
    if (wave < 4) {
        const int rt = wave >> 1, ct = wave & 1;
        f32x16 acc;
#pragma unroll
        for (int r = 0; r < 16; ++r) acc[r] = 0.f;
        acc = mma32(tNK + (32 * rt + r32) * TP + 8 * hi, tVT + (32 * ct + r32) * TP + 8 * hi, 2 * (rt + 1), acc);
#pragma unroll
        for (int r = 0; r < 16; ++r) RHS[(32 * rt + crow(r, hi)) * 64 + 32 * ct + r32] = acc[r];
    }
    __syncthreads();
    {
        const int cl = lane >> 2, p = lane & 3, cidx = 16 * wave + cl;
        float xs[16];
#pragma unroll
        for (int q = 0; q < 16; ++q) xs[q] = 0.f;
        const LAS float* np_ = NPm + p * 16;
#pragma unroll
        for (int t = 0; t < 64; ++t) {
            float part = 0.f;
#pragma unroll
            for (int q4 = 0; q4 < (t + 15) / 16; ++q4) { const f32x4 nv = *(const LAS f32x4*)(np_ + t * 64 + 4 * q4);
                part += (nv.x * xs[4 * q4] + nv.y * xs[4 * q4 + 1]) + (nv.z * xs[4 * q4 + 2] + nv.w * xs[4 * q4 + 3]); }
            part += dpp_xor1(part); part += dpp_xor2(part);
            const float rhs = (wave < 4) ? RHS[t * 64 + cidx] : bf2f(tAH[t * TP + (cidx - 64)]);
            const float xt = rhs + part;
            xs[t >> 2] = (p == (t & 3)) ? xt : xs[t >> 2];
            asm volatile("" ::: "memory");
        }
        LAS bf16* wt = (wave < 4) ? (tW1 + cidx * TP) : (tW2 + (cidx - 64) * TP);
#pragma unroll
        for (int q = 0; q < 16; ++q) wt[4 * q + p] = (bf16)f2bf(xs[q]);
    }
    __syncthreads();
    {
        const int kind = wave >> 1, rt = wave & 1;
        bf16* RTg = (bf16*)(A.ws + WS_RT) + pair * 4096; bf16* PAg = (bf16*)(A.ws + WS_PA) + pair * 4096;
        float* YFg = (float*)(A.ws + WS_YF) + pair * 4096; float* QFg = (float*)(A.ws + WS_QF) + pair * 4096;
        for (int ct = 0; ct < 2; ++ct) {
            f32x16 acc;
            if (kind == 0) {
#pragma unroll
                for (int r = 0; r < 16; ++r) acc[r] = bf2f(tRH[(32 * rt + crow(r, hi)) * TP + 32 * ct + r32]);
                acc = mma32(tBR + (32 * rt + r32) * TP + 8 * hi, tW2 + (32 * ct + r32) * TP + 8 * hi, 2 * (rt + 1), acc);
#pragma unroll
                for (int r = 0; r < 16; ++r) RTg[(32 * rt + crow(r, hi)) * 64 + 32 * ct + r32] = (bf16)f2bf(acc[r]);
            } else if (kind == 1) {
#pragma unroll
                for (int r = 0; r < 16; ++r) acc[r] = 0.f;
                acc = mma32(tBR + (32 * rt + r32) * TP + 8 * hi, tW1 + (32 * ct + r32) * TP + 8 * hi, 2 * (rt + 1), acc);
                acc = mma32(tKR + (32 * rt + r32) * TP + 8 * hi, tVT + (32 * ct + r32) * TP + 8 * hi, 2 * (rt + 1), acc);
                f32x4* dst = (f32x4*)(YFg + (rt * 2 + ct) * 1024 + lane * 16);
#pragma unroll
                for (int q = 0; q < 4; ++q) dst[q] = (f32x4){acc[4 * q], acc[4 * q + 1], acc[4 * q + 2], acc[4 * q + 3]};
            } else if (kind == 2) {
#pragma unroll
                for (int r = 0; r < 16; ++r) acc[r] = 0.f;
                acc = mma32(tBT + (32 * rt + r32) * TP + 8 * hi, tW2 + (32 * ct + r32) * TP + 8 * hi, 4, acc);
#pragma unroll
                for (int r = 0; r < 16; ++r) PAg[(32 * rt + crow(r, hi)) * 64 + 32 * ct + r32] = (bf16)f2bf(acc[r]);
            } else {
#pragma unroll
                for (int r = 0; r < 16; ++r) acc[r] = 0.f;
                acc = mma32(tBT + (32 * rt + r32) * TP + 8 * hi, tW1 + (32 * ct + r32) * TP + 8 * hi, 4, acc);
                acc = mma32(tKT + (32 * rt + r32) * TP + 8 * hi, tVT + (32 * ct + r32) * TP + 8 * hi, 4, acc);
                f32x4* dst = (f32x4*)(QFg + (rt * 2 + ct) * 1024 + lane * 16);
#pragma unroll
                for (int q = 0; q < 4; ++q) dst[q] = (f32x4){acc[4 * q], acc[4 * q + 1], acc[4 * q + 2], acc[4 * q + 3]};
            }
        }
    }
}
__device__ __forceinline__ void rwkv_seq_unit(const Ctx& C, int bh) {
    KA_DECL;
    const int tid = C.tid, lane = C.lane, wave = C.wave, r32 = lane & 31, hi = lane >> 5;
    const bool zw = wave < 4; const int w4 = wave & 3, rt = w4 >> 1, ct = w4 & 1;
    LAS bf16* Zb = (LAS bf16*)C.lds;
    const bf16* Ag = (const bf16*)(A.ws + (zw ? WS_PA : WS_RT)) + (size_t)bh * 64 * 4096 + (32 * rt + r32) * 64 + 8 * hi;
    const float* Cg = (const float*)(A.ws + (zw ? WS_QF : WS_YF)) + (size_t)bh * 64 * 4096 + (rt * 2 + ct) * 1024 + lane * 16;
    const float* GLg = (const float*)(A.ws + WS_GL) + (size_t)bh * 64 * 64 + 32 * rt + 4 * hi;
    float* ry = (float*)(A.ws + WS_RY) + (size_t)(bh >> 3) * T * GW + (bh & 7) * 64;
    f32x16 Z;
#pragma unroll
    for (int r = 0; r < 16; ++r) Z[r] = 0.f;
    __syncthreads();
    for (int i = tid; i < 64 * TP; i += NTHREADS) Zb[i] = 0;
    __syncthreads();
    bf16x8 af[4]; f32x4 ci[4], gl[4];
#pragma unroll
    for (int k = 0; k < 4; ++k) { af[k] = *(const bf16x8*)(Ag + 16 * k); ci[k] = *(const f32x4*)(Cg + 4 * k); gl[k] = *(const f32x4*)(GLg + 8 * k); }
    for (int c = 0; c < 64; ++c) {
        bf16x8 afn[4]; f32x4 cin[4], gln[4];
        const int cn = (c + 1 < 64) ? c + 1 : c;
#pragma unroll
        for (int k = 0; k < 4; ++k) { afn[k] = *(const bf16x8*)(Ag + (size_t)cn * 4096 + 16 * k); cin[k] = *(const f32x4*)(Cg + (size_t)cn * 4096 + 4 * k); gln[k] = *(const f32x4*)(GLg + cn * 64 + 8 * k); }
        f32x16 acc;
#pragma unroll
        for (int q = 0; q < 4; ++q) { acc[4 * q] = ci[q].x; acc[4 * q + 1] = ci[q].y; acc[4 * q + 2] = ci[q].z; acc[4 * q + 3] = ci[q].w; }
        if (zw) {
#pragma unroll
            for (int q = 0; q < 4; ++q) { acc[4 * q] += gl[q].x * Z[4 * q]; acc[4 * q + 1] += gl[q].y * Z[4 * q + 1]; acc[4 * q + 2] += gl[q].z * Z[4 * q + 2]; acc[4 * q + 3] += gl[q].w * Z[4 * q + 3]; }
        }
        const LAS bf16* Bp = Zb + (c & 1) * 64 * TP + (32 * ct + r32) * TP + 8 * hi;
#pragma unroll
        for (int k = 0; k < 4; ++k) { const bf16x8 bfr = *(const LAS bf16x8*)(Bp + 16 * k); acc = __builtin_amdgcn_mfma_f32_32x32x16_bf16(af[k], bfr, acc, 0, 0, 0); }
        if (zw) {
            Z = acc;
            LAS bf16* Zn = Zb + ((c + 1) & 1) * 64 * TP + (32 * ct + r32) * TP + 32 * rt + 4 * hi;
#pragma unroll
            for (int q = 0; q < 4; ++q) { v2u w; w.x = pk2(acc[4 * q], acc[4 * q + 1]); w.y = pk2(acc[4 * q + 2], acc[4 * q + 3]); *(LAS v2u*)(Zn + 8 * q) = w; }
        } else {
#pragma unroll
            for (int r = 0; r < 16; ++r) ry[(size_t)(64 * c + 32 * rt + crow(r, hi)) * GW + 32 * ct + r32] = acc[r];
        }
#pragma unroll
        for (int k = 0; k < 4; ++k) { af[k] = afn[k]; ci[k] = cin[k]; gl[k] = gln[k]; }
        __syncthreads();
    }
}
__device__ __forceinline__ void ph_rwkv_post(const Ctx& C, int l) {
    KA_DECL;
    const int gw = C.bid * NWAVES + C.wave, NGW = C.G * NWAVES, lane = C.lane;
    const float* RY = (const float*)(A.ws + WS_RY); const float* RG = (const float*)(A.ws + WS_RG); const float* RBV = (const float*)(A.ws + WS_RBV); bf16* ycat = (bf16*)(A.ws + WS_YCAT);
    for (int it = gw; it < M * NH; it += NGW) {
        const int m = it >> 3, h = it & 7, ch = h * 64 + lane;
        const float y = RY[(size_t)m * GW + ch];
        const float mean = wave_sum(y) * (1.0f / 64.0f), d = y - mean, var = wave_sum(d * d) * (1.0f / 64.0f);
        const float yn = d * (1.0f / sqrtf(var + 64e-5f)) * A.in[I_RLG][l * GW + ch] + A.in[I_RLB][l * GW + ch];
        ycat[(size_t)m * D + YC_A + ch] = (bf16)f2bf(yn * RG[(size_t)m * GW + ch] + RBV[(size_t)m * GW + ch]);
    }
}
#ifndef REP_MIX1
#define REP_MIX1 1
#endif
#ifndef REP_SCAN
#define REP_SCAN 1
#endif
#ifndef REP_FOX
#define REP_FOX 1
#endif
__device__ __forceinline__ void ph_mix1(const Ctx& C, int l) {
    for (int rep = 0; rep < REP_MIX1; ++rep) {
        for (int u = C.bid; u < 2048; u += C.G) rwkv_chunk_unit(C, l, u >> 9, (u >> 3) & 63, u & 7);
        for (int v = C.bid; v < 1024; v += C.G) attn_unit<0>(C, l, v >> 8, (v >> 5) & 7, v & 31);
        for (int v = C.bid; v < 256; v += C.G) sgu_unit(C, l, v >> 6, (v >> 1) & 31, v & 1);
    }
}
__device__ __forceinline__ void ph_mix2(const Ctx& C, int l) {
    for (int rep = 0; rep < REP_SCAN; ++rep)
    for (int u = C.bid; u < 32; u += C.G) rwkv_seq_unit(C, u);
    for (int rep = 0; rep < REP_FOX; ++rep)
    for (int i = 0; i * C.G < 1024; ++i) { const int u = i * C.G + ((i & 1) ? (C.G - 1 - C.bid) : C.bid); if (u < 1024) { const int qb = 31 - (u >> 5), bh = u & 31; attn_unit<1>(C, l, bh >> 3, bh & 7, qb); } }
}
constexpr int N_PHASES = 2 + 9 * DEPTH;
#define IN(k) (lo <= (k) && (k) < hi)
#define SEAM(k) do { if (IN((k) + 1)) xcd_barrier(bar); } while (0)
template <int l>
__device__ __forceinline__ void layer_phases(const Args& A, const Ctx& C, const XcdBarrier& bar, const int lo, const int hi) {
    bf16* const H = (bf16*)(A.ws + WS_H); bf16* const PROJ = (bf16*)(A.ws + WS_PROJ); bf16* const YCAT = (bf16*)(A.ws + WS_YCAT); bf16* const FB = (bf16*)(A.ws + WS_F);
    constexpr int p0 = 2 + 9 * l;
    const float* xin = (l == 0) ? A.in[I_X] : A.out;
    const float* modl = (const float*)(A.ws + WS_MOD) + (size_t)l * NB * MODW;
    if (IN(p0 + 0)) { ph_norm(C, xin, A.in[I_N1G] + l * D, modl + 0 * D, modl + 1 * D, H); SEAM(p0 + 0); }
    if (IN(p0 + 1)) {
        pg8::Gemm g{H, (const bf16*)(A.ws + WS_WIN) + (size_t)l * NP * D, M, NP, D}; pg8::StaticOrder S; S.init(M, NP, C.G, C.bid);
        pg8::EpiStoreBf16 E{PROJ, NP};
        pg8::gemm_phase<pg8::EpiStoreBf16, pg8::StaticOrder, true, true>(C.lds, g, S, E);
        SEAM(p0 + 1); }
    if (IN(p0 + 2)) { ph_mix1(C, l); SEAM(p0 + 2); }
    if (IN(p0 + 3)) { ph_mix2(C, l); SEAM(p0 + 3); }
    if (IN(p0 + 4)) { ph_rwkv_post(C, l); SEAM(p0 + 4); }
    if (IN(p0 + 5)) {
        pg8::Gemm g{YCAT, (const bf16*)(A.ws + WS_WOUT) + (size_t)l * D * D, M, D, D}; pg8::StaticOrder S; S.init(M, D, C.G, C.bid);
        pg8::EpiResid E{xin, A.out, D, modl + 2 * D, MODW, T};
        pg8::gemm_phase<pg8::EpiResid, pg8::StaticOrder, true, true>(C.lds, g, S, E);
        SEAM(p0 + 5); }
    if (IN(p0 + 6)) { ph_norm(C, A.out, A.in[I_N2G] + l * D, modl + 3 * D, modl + 4 * D, H); SEAM(p0 + 6); }
    if (IN(p0 + 7)) {
        pg8::Gemm g{H, (const bf16*)(A.ws + WS_W13) + (size_t)l * 2 * FF * D, M, 2 * FF, D}; pg8::StaticOrder S; S.init(M, 2 * FF, C.G, C.bid);
        pg8::EpiSwiGLU E{FB, FF};
        pg8::gemm_phase<pg8::EpiSwiGLU, pg8::StaticOrder, true, true>(C.lds, g, S, E);
        SEAM(p0 + 7); }
    if (IN(p0 + 8)) {
        pg8::Gemm g{FB, (const bf16*)(A.ws + WS_W2) + (size_t)l * D * FF, M, D, FF}; pg8::StaticOrder S; S.init(M, D, C.G, C.bid);
        pg8::EpiResid E{A.out, A.out, D, modl + 5 * D, MODW, T};
        pg8::gemm_phase<pg8::EpiResid, pg8::StaticOrder, true, true>(C.lds, g, S, E);
        SEAM(p0 + 8); }
}
__global__ void __launch_bounds__(NTHREADS, 2) fwd_kernel(Args A) {
    extern __shared__ __attribute__((aligned(16))) unsigned char lds_raw[];
    Ctx C; C.lds = (LAS unsigned char*)lds_raw; C.tid = threadIdx.x; C.lane = C.tid & 63; C.wave = __builtin_amdgcn_readfirstlane(C.tid >> 6); C.G = gridDim.x; C.bid = blockIdx.x;
    volatile LAS unsigned* MISC = (volatile LAS unsigned*)(C.lds + MISC_OFF);
    for (int u = C.tid; u < (LDS_BYTES - LDSCTL_OFF) / 4; u += NTHREADS) ((LAS unsigned*)(C.lds + LDSCTL_OFF))[u] = 0u;
    __syncthreads();
    const int lo = A.ph_lo, hi = A.ph_hi;
    const bool multi = (hi - lo) > 1;
    XcdBarrier bar; bar.bar = (unsigned*)(A.ws + WS_CTL) + CW_BAR; bar.x = 0; bar.st = nullptr;
    if (multi) bar = xcd_barrier_post((unsigned*)(A.ws + WS_CTL) + CW_BAR, MISC + 8);
    if (IN(0)) { ph_prologue(C); SEAM(0); }
    if (IN(1)) { ph_modreduce(C); SEAM(1); }
    layer_phases<0>(A, C, bar, lo, hi);
    layer_phases<1>(A, C, bar, lo, hi);
    layer_phases<2>(A, C, bar, lo, hi);
    layer_phases<3>(A, C, bar, lo, hi);
}
#undef IN
#undef SEAM

extern "C" void kernel_launch(void* const* d_in, const int* in_sizes, int n_in, void* d_out, int out_size, void* d_ws, size_t ws_size, hipStream_t stream) {
    static int grid = 0;
    if (grid == 0) {
        if (n_in != N_INPUTS || out_size != M * D || ws_size < WS_END) { fprintf(stderr, "kernel_launch: unexpected problem (n_in %d, out %d, ws %zu; need %zu)\n", n_in, out_size, ws_size, (size_t)WS_END); grid = -1; return; }
        int dev = 0, cus = 0, per_cu = 0;
        if (hipGetDevice(&dev) != hipSuccess || hipDeviceGetAttribute(&cus, hipDeviceAttributeMultiprocessorCount, dev) != hipSuccess) { grid = -1; return; }
        if (hipFuncSetAttribute((const void*)fwd_kernel, hipFuncAttributeMaxDynamicSharedMemorySize, LDS_BYTES) != hipSuccess) { fprintf(stderr, "kernel_launch: hipFuncSetAttribute failed\n"); grid = -1; return; }
        if (hipOccupancyMaxActiveBlocksPerMultiprocessor(&per_cu, (const void*)fwd_kernel, NTHREADS, LDS_BYTES) != hipSuccess || per_cu < 1) fprintf(stderr, "kernel_launch: occupancy query reports %d\n", per_cu);
        (void)hipGetLastError();
        grid = cus;
    }
    if (grid < 0) return;
    (void)hipMemsetAsync((char*)d_ws + WS_CTL, 0, CTL_ZERO_BYTES, stream);
    Args a{};
    for (int i = 0; i < N_INPUTS; ++i) a.in[i] = (const float*)d_in[i];
    a.out = (float*)d_out; a.ws = (unsigned char*)d_ws;
#if MK_ONE_LAUNCH
    a.ph_lo = 0; a.ph_hi = N_PHASES;
    hipLaunchKernelGGL(fwd_kernel, dim3(grid), dim3(NTHREADS), LDS_BYTES, stream, a);
#else
    for (int p = 0; p < N_PHASES; ++p) { a.ph_lo = p; a.ph_hi = p + 1; hipLaunchKernelGGL(fwd_kernel, dim3(grid), dim3(NTHREADS), LDS_BYTES, stream, a); }
#endif
    const hipError_t le = hipPeekAtLastError();
    if (le != hipSuccess) fprintf(stderr, "kernel_launch: launch failed: %s\n", hipGetErrorName(le));
}
```

```cpp
#include <hip/hip_runtime.h>
#include <cstdio>
#include <cstdint>
#ifndef MK_ONE_LAUNCH
#define MK_ONE_LAUNCH 1
#endif
namespace pg8 {
#define PG8_LAS __attribute__((address_space(3)))
typedef unsigned short bf16_t;
typedef short bf16x8 __attribute__((ext_vector_type(8)));
typedef float f32x4 __attribute__((ext_vector_type(4)));
typedef unsigned u32x4 __attribute__((ext_vector_type(4)));
constexpr int BM = 256, BK = 64, HALF = 128, HTB = HALF * BK * 2  , STAGE_BYTES = 8 * HTB, NXCD = 8, WGM = 8;

__host__ __device__ __forceinline__ int lds_byte(int r, int c) { const int st = (r >> 4) * 2 + (c >> 5), rr = r & 15, cc = c & 31, ob = rr * 64 + cc * 2; return st * 1024 + (ob ^ (((ob >> 9) & 1) << 5)); }
__host__ __device__ __forceinline__ void stage_rc(int b, int& R, int& C) { const int st = b / 1024, sb = b % 1024, swz = sb ^ (((sb >> 9) & 1) << 5); R = (st >> 1) * 16 + swz / 64; C = (st & 1) * 32 + (swz % 64) / 2; }
__host__ __device__ __forceinline__ int perm32(int rho) { const int n = rho >> 4, i = rho & 15; return 8 * (i >> 2) + 4 * n + (i & 3); }

struct Unit { int pm, pn; };
struct Gemm { const bf16_t* A; const bf16_t* Bt; int M, N, K; };

struct StaticOrder {
    int nM, nN, nwg, G, c;
    __host__ __device__ void init(int M, int N, int G_, int c_) { nM = M / BM; nN = N / BM; nwg = nM * nN; G = G_; c = c_; }
    __host__ __device__ bool next(int i, Unit& u) const {
        const long L = (long)i * G + c; if (L >= nwg) return false;
        int wgid = (int)L; { const int q = nwg / NXCD, r = nwg % NXCD, xcd = wgid % NXCD, off = wgid / NXCD; wgid = (xcd < r ? xcd * (q + 1) : r * (q + 1) + (xcd - r) * q) + off; }
        const int nig = WGM * nN, gid = wgid / nig, fm = gid * WGM, gsz = (nM - fm) < WGM ? (nM - fm) : WGM;
        u.pm = fm + ((wgid % nig) % gsz); u.pn = (wgid % nig) / gsz; return true;
    }
    __device__ __forceinline__ void a_ready(const Unit&) const {}
    __device__ __forceinline__ void done(const Unit&) const {}
};

__device__ __forceinline__ unsigned cvt_pk_bf16(float lo, float hi) { unsigned r; asm volatile("v_cvt_pk_bf16_f32 %0, %1, %2" : "=v"(r) : "v"(lo), "v"(hi)); return r; }
typedef float f32x2 __attribute__((ext_vector_type(2)));
__device__ __forceinline__ f32x2 gelu_pk(f32x2 v) {
    const f32x2 av = __builtin_elementwise_abs(v), d = av * 0.2316418882f + 1.0f;
    f32x2 t; t.x = __builtin_amdgcn_rcpf(d.x); t.y = __builtin_amdgcn_rcpf(d.y);
    f32x2 q = t * 0.5307027145f + (-0.7265760135f); q = q * t + 0.7107068705f; q = q * t + (-0.142248368f); q = q * t + 0.127414796f; q = q * t;
    const f32x2 s = (v * v) * (-0.72134752044f);
    f32x2 e; e.x = __builtin_amdgcn_exp2f(s.x); e.y = __builtin_amdgcn_exp2f(s.y);
    const f32x2 m = v * (q * e), r = v - m;
    f32x2 o; o.x = v.x < 0.f ? m.x : r.x; o.y = v.y < 0.f ? m.y : r.y; return o;
}

struct EpiStoreBf16 {
    static constexpr bool PERM = true, AFTER_DRAIN = false;
    bf16_t* O; int ldc;
    __device__ __forceinline__ void operator()(const f32x4 (&acc)[2][2][4][2], const Unit& u, int wr, int wc, int fr, int fq) const {
        const int row0 = u.pm * BM + wr * 64 + fr, col0 = u.pn * BM + wc * 32 + 8 * fq;
#pragma unroll
        for (int ai = 0; ai < 2; ++ai)
#pragma unroll
            for (int m = 0; m < 4; ++m) { bf16_t* rowp = O + (size_t)(row0 + ai * HALF + m * 16) * ldc + col0;
#pragma unroll
                for (int bj = 0; bj < 2; ++bj) { const f32x4 v0 = acc[ai][bj][m][0], v1 = acc[ai][bj][m][1];
                    u32x4 w; w.x = cvt_pk_bf16(v0[0], v0[1]); w.y = cvt_pk_bf16(v0[2], v0[3]); w.z = cvt_pk_bf16(v1[0], v1[1]); w.w = cvt_pk_bf16(v1[2], v1[3]);
                    *(u32x4*)(rowp + bj * HALF) = w; } }
    }
};
struct EpiResid {
    static constexpr bool PERM = false, AFTER_DRAIN = false;
    const float* base; float* out; int ldc; const float* gate; int gate_stride; int rows_per_batch;
    __device__ __forceinline__ void operator()(const f32x4 (&acc)[2][2][4][2], const Unit& u, int wr, int wc, int fr, int fq) const {
        const int row0 = u.pm * BM + wr * 64 + fr, col0 = u.pn * BM + wc * 32 + 4 * fq;
        const float* gp = gate + (size_t)((u.pm * BM) / rows_per_batch) * gate_stride + col0;
        f32x4 gv[2][2];
#pragma unroll
        for (int bj = 0; bj < 2; ++bj)
#pragma unroll
            for (int n = 0; n < 2; ++n) gv[bj][n] = *(const f32x4*)(gp + bj * HALF + n * 16);
#pragma unroll
        for (int ai = 0; ai < 2; ++ai)
#pragma unroll
            for (int m = 0; m < 4; ++m) { const size_t off = (size_t)(row0 + ai * HALF + m * 16) * ldc + col0;
#pragma unroll
                for (int bj = 0; bj < 2; ++bj)
#pragma unroll
                    for (int n = 0; n < 2; ++n) { const f32x4 x = *(const f32x4*)(base + off + bj * HALF + n * 16);
                        *(f32x4*)(out + off + bj * HALF + n * 16) = x + gv[bj][n] * acc[ai][bj][m][n]; } }
    }
};
struct EpiSwiGLU {
    static constexpr bool PERM = true, AFTER_DRAIN = false;
    bf16_t* O; int ldc;
    __device__ __forceinline__ void operator()(const f32x4 (&acc)[2][2][4][2], const Unit& u, int wr, int wc, int fr, int fq) const {
        const int row0 = u.pm * BM + wr * 64 + fr, col0 = u.pn * HALF + wc * 32 + 8 * fq;
#pragma unroll
        for (int ai = 0; ai < 2; ++ai)
#pragma unroll
            for (int m = 0; m < 4; ++m) { bf16_t* rowp = O + (size_t)(row0 + ai * HALF + m * 16) * ldc + col0;
                float f[8];
#pragma unroll
                for (int n = 0; n < 2; ++n)
#pragma unroll
                    for (int e = 0; e < 4; ++e) { const float g = acc[ai][0][m][n][e], up = acc[ai][1][m][n][e];
                        f[n * 4 + e] = g * up * __builtin_amdgcn_rcpf(1.0f + __builtin_amdgcn_exp2f(-1.4426950408889634f * g)); }
                u32x4 w; w.x = cvt_pk_bf16(f[0], f[1]); w.y = cvt_pk_bf16(f[2], f[3]); w.z = cvt_pk_bf16(f[4], f[5]); w.w = cvt_pk_bf16(f[6], f[7]);
                *(u32x4*)rowp = w; }
    }
};

template <class Epi, class Sched, bool ALIGN_EPI = false, bool SP2 = false>
__device__ __forceinline__ void gemm_phase(PG8_LAS unsigned char* lds, const Gemm g, const Sched& S, const Epi& E) {
    const int tid = threadIdx.x, wid = __builtin_amdgcn_readfirstlane(tid >> 6), lane = tid & 63, wr = wid >> 2, wc = wid & 3, fr = lane & 15, fq = lane >> 4;
    const int K = g.K, nt = K / BK;
    unsigned voffA[2], voffB[2];
#pragma unroll
    for (int i = 0; i < 2; ++i) { int R, C; stage_rc(tid * 16 + i * 8192, R, C); const int Rb = Epi::PERM ? ((R & ~31) + perm32(R & 31)) : R;
        voffA[i] = (unsigned)(R * K + C) * 2u; voffB[i] = (unsigned)(Rb * K + C) * 2u; }
    const size_t kstep = (size_t)(BK * 2);
    const size_t hstep = (size_t)HALF * K * 2;
    const size_t tstep = 2 * hstep;
    const unsigned ldsw = (unsigned)wid * 1024u;
    const int aoff = lds_byte(wr * 64 + fr, fq * 8), boff = lds_byte(wc * 32 + fr, fq * 8);
#define PG8_SA(b, h) (((b) * 2 + (h)) * HTB)
#define PG8_SB(b, h) ((4 + (b) * 2 + (h)) * HTB)
#define PG8_STAGE(bufoff, gbase, voff) do { _Pragma("unroll") for (int _i = 0; _i < 2; ++_i) \
        __builtin_amdgcn_global_load_lds((const unsigned*)((const char*)(gbase) + (voff)[_i]), (PG8_LAS unsigned*)(lds + (bufoff) + ldsw + _i * 8192), 16, 0, 0); } while (0)
#define PG8_LDA(dst, b, h) do { _Pragma("unroll") for (int m = 0; m < 4; ++m) _Pragma("unroll") for (int k = 0; k < 2; ++k) dst[m][k] = *(const PG8_LAS bf16x8*)(lds + PG8_SA(b, h) + aoff + m * 2048 + k * 1024); } while (0)
#define PG8_LDB(dst, b, h) do { _Pragma("unroll") for (int n = 0; n < 2; ++n) _Pragma("unroll") for (int k = 0; k < 2; ++k) dst[n][k] = *(const PG8_LAS bf16x8*)(lds + PG8_SB(b, h) + boff + n * 2048 + k * 1024); } while (0)
#define PG8_MMA(ai, bj, At, Bt) do { __builtin_amdgcn_s_setprio(1); _Pragma("unroll") for (int m = 0; m < 4; ++m) _Pragma("unroll") for (int n = 0; n < 2; ++n) _Pragma("unroll") for (int k = 0; k < 2; ++k) \
        acc[ai][bj][m][n] = __builtin_amdgcn_mfma_f32_16x16x32_bf16(Bt[n][k], At[m][k], acc[ai][bj][m][n], 0, 0, 0); __builtin_amdgcn_s_setprio(0); } while (0)
#define PG8_WAIT_V(n) asm volatile("s_waitcnt vmcnt(" #n ")" ::: "memory")
#define PG8_WAIT_L(n) asm volatile("s_waitcnt lgkmcnt(" #n ")" ::: "memory")
#define PG8_BAR __builtin_amdgcn_s_barrier()
#define PG8_SCHED __builtin_amdgcn_sched_barrier(0)
    Unit cur, nxt; int ui = 0;
    if (!S.next(0, cur)) return;
    f32x4 acc[2][2][4][2];
#pragma unroll
    for (int a = 0; a < 2; ++a)
#pragma unroll
        for (int b = 0; b < 2; ++b)
#pragma unroll
            for (int m = 0; m < 4; ++m)
#pragma unroll
                for (int n = 0; n < 2; ++n) acc[a][b][m][n] = (f32x4){0.f, 0.f, 0.f, 0.f};
    bf16x8 At[4][2], B0[2][2], B1[2][2];
    const char* cA = (const char*)g.A + (size_t)cur.pm * tstep; const char* cB = (const char*)g.Bt + (size_t)cur.pn * tstep;
    S.a_ready(cur);
    if constexpr (SP2) {
        PG8_STAGE(PG8_SB(0, 0), cB, voffB); PG8_STAGE(PG8_SB(0, 1), cB + hstep, voffB); PG8_STAGE(PG8_SA(0, 0), cA, voffA); PG8_STAGE(PG8_SA(0, 1), cA + hstep, voffA);
        if (wr == 1) PG8_BAR;
        PG8_WAIT_V(2); PG8_BAR;
        PG8_STAGE(PG8_SB(1, 0), cB + kstep, voffB); PG8_STAGE(PG8_SA(1, 0), cA + kstep, voffA); PG8_STAGE(PG8_SB(1, 1), cB + hstep + kstep, voffB);
        PG8_WAIT_V(6); PG8_BAR;
    } else {
        PG8_STAGE(PG8_SB(0, 0), cB, voffB); PG8_STAGE(PG8_SA(0, 0), cA, voffA); PG8_STAGE(PG8_SB(0, 1), cB + hstep, voffB); PG8_STAGE(PG8_SA(0, 1), cA + hstep, voffA);
        if (wr == 1) PG8_BAR;
        PG8_WAIT_V(4); PG8_BAR;
        PG8_STAGE(PG8_SB(1, 0), cB + kstep, voffB); PG8_STAGE(PG8_SA(1, 0), cA + kstep, voffA); PG8_STAGE(PG8_SB(1, 1), cB + hstep + kstep, voffB);
        PG8_WAIT_V(6); PG8_BAR;
    }
    for (;;) {
        const bool has_next = S.next(ui + 1, nxt);
        const char* nA = has_next ? (const char*)g.A + (size_t)nxt.pm * tstep : cA; const char* nB = has_next ? (const char*)g.Bt + (size_t)nxt.pn * tstep : cB;
        for (int t = 0; t < nt; t += 2) {
            const bool last = (t == nt - 2);
            const char* a1 = cA + (size_t)(t + 1) * kstep;
            const char* a2 = last ? nA : cA + (size_t)(t + 2) * kstep; const char* b2 = last ? nB : cB + (size_t)(t + 2) * kstep;
            const char* a3 = a2 + kstep; const char* b3 = b2 + kstep;
            if (last && has_next) S.a_ready(nxt);
            if constexpr (SP2) {
            PG8_LDB(B0, 0, 0); PG8_LDB(B1, 0, 1); PG8_SCHED; PG8_LDA(At, 0, 0); PG8_STAGE(PG8_SA(1, 1), a1 + hstep, voffA);
            PG8_WAIT_V(8); PG8_WAIT_L(0); PG8_BAR; PG8_MMA(0, 0, At, B0); PG8_MMA(0, 1, At, B1); PG8_BAR; PG8_SCHED;
            PG8_LDA(At, 0, 1); PG8_STAGE(PG8_SB(0, 0), b2, voffB); PG8_STAGE(PG8_SB(0, 1), b2 + hstep, voffB); PG8_STAGE(PG8_SA(0, 0), a2, voffA);
            PG8_WAIT_V(8); PG8_WAIT_L(0); PG8_BAR; PG8_MMA(1, 0, At, B0); PG8_MMA(1, 1, At, B1); PG8_BAR; PG8_SCHED;
            PG8_LDB(B0, 1, 0); PG8_LDB(B1, 1, 1); PG8_SCHED; PG8_LDA(At, 1, 0); PG8_STAGE(PG8_SA(0, 1), a2 + hstep, voffA);
            PG8_WAIT_V(8); PG8_WAIT_L(0); PG8_BAR; PG8_MMA(0, 0, At, B0); PG8_MMA(0, 1, At, B1); PG8_BAR; PG8_SCHED;
            PG8_LDA(At, 1, 1); PG8_STAGE(PG8_SB(1, 0), b3, voffB); PG8_STAGE(PG8_SB(1, 1), b3 + hstep, voffB); PG8_STAGE(PG8_SA(1, 0), a3, voffA);
            PG8_WAIT_V(8); PG8_WAIT_L(0); PG8_BAR; PG8_MMA(1, 0, At, B0); PG8_MMA(1, 1, At, B1); PG8_BAR; PG8_SCHED;
            } else {
            PG8_LDB(B0, 0, 0); PG8_SCHED; PG8_LDA(At, 0, 0); PG8_STAGE(PG8_SA(1, 1), a1 + hstep, voffA);
            PG8_WAIT_L(8); PG8_BAR; PG8_WAIT_L(0); PG8_MMA(0, 0, At, B0); PG8_BAR; PG8_SCHED;
            PG8_LDB(B1, 0, 1); PG8_STAGE(PG8_SB(0, 0), b2, voffB);
            PG8_BAR; PG8_WAIT_L(0); PG8_MMA(0, 1, At, B1); PG8_BAR;
            PG8_LDA(At, 0, 1); PG8_STAGE(PG8_SA(0, 0), a2, voffA);
            PG8_BAR; PG8_WAIT_L(0); PG8_MMA(1, 0, At, B0); PG8_BAR; PG8_SCHED;
            PG8_STAGE(PG8_SB(0, 1), b2 + hstep, voffB);
            PG8_WAIT_V(6); PG8_BAR; PG8_MMA(1, 1, At, B1); PG8_BAR;
            PG8_LDB(B0, 1, 0); PG8_SCHED; PG8_LDA(At, 1, 0); PG8_STAGE(PG8_SA(0, 1), a2 + hstep, voffA);
            PG8_WAIT_L(8); PG8_BAR; PG8_WAIT_L(0); PG8_MMA(0, 0, At, B0); PG8_BAR; PG8_SCHED;
            PG8_LDB(B1, 1, 1); PG8_STAGE(PG8_SB(1, 0), b3, voffB);
            PG8_BAR; PG8_WAIT_L(0); PG8_MMA(0, 1, At, B1); PG8_BAR;
            PG8_LDA(At, 1, 1); PG8_STAGE(PG8_SA(1, 0), a3, voffA);
            PG8_BAR; PG8_WAIT_L(0); PG8_MMA(1, 0, At, B0); PG8_BAR; PG8_SCHED;
            PG8_STAGE(PG8_SB(1, 1), b3 + hstep, voffB);
            PG8_WAIT_V(6); PG8_BAR; PG8_MMA(1, 1, At, B1); PG8_BAR;
            }
        }
        if constexpr (ALIGN_EPI) { if (wr == 0) PG8_BAR; }
        if constexpr (!Epi::AFTER_DRAIN) { E(acc, cur, wr, wc, fr, fq); S.done(cur); }
        if (!has_next) break;
#pragma unroll
        for (int a = 0; a < 2; ++a)
#pragma unroll
            for (int b = 0; b < 2; ++b)
#pragma unroll
                for (int m = 0; m < 4; ++m)
#pragma unroll
                    for (int n = 0; n < 2; ++n) acc[a][b][m][n] = (f32x4){0.f, 0.f, 0.f, 0.f};
        cur = nxt; cA = nA; cB = nB; ++ui;
        if constexpr (ALIGN_EPI) { if (wr == 1) PG8_BAR; }
    }
    PG8_WAIT_V(0);
    if constexpr (!ALIGN_EPI) { if (wr == 0) PG8_BAR; }
    PG8_BAR;
    if constexpr (Epi::AFTER_DRAIN) { E.fused(acc, cur, wr, wc, fr, fq, lds, wid, lane); S.done(cur); }
#undef PG8_SA
#undef PG8_SB
#undef PG8_STAGE
#undef PG8_LDA
#undef PG8_LDB
#undef PG8_MMA
#undef PG8_WAIT_V
#undef PG8_WAIT_L
#undef PG8_BAR
#undef PG8_SCHED
}
}
constexpr int NWAVES = 8, NTHREADS = 512;
constexpr int D = 2048, NB = 4, T = 4096, M = NB * T, DEPTH = 4, GW = 512, NH = 8, HD = 64;
constexpr int NIN = 5544, NP = 5632, FF = 5632, MODW = 6 * D;
constexpr int PC_RR = 0, PC_RK = 512, PC_RV = 1024, PC_SQ = 1536, PC_SK = 2048, PC_SV = 2176, PC_GU = 2304, PC_GV = 2816;
constexpr int PC_FQ = 3328, PC_FK = 3840, PC_FV = 4352, PC_FG = 4864, PC_RW = 5376, PC_FL = 5536;
constexpr int YC_A = 0, YC_B = 512, YC_C = 1024, YC_D = 1536;
constexpr int SGU_TRI = 8256;
enum { I_X = 0, I_C, I_WMOD, I_BMOD, I_N1G, I_N2G, I_WIN, I_WOUT, I_RMU, I_RW0, I_RW2, I_RA0, I_RA2, I_RG2, I_RKK, I_RKA, I_RRK, I_RLG, I_RLB,
       I_SQG, I_SKG, I_SSINK, I_GLG, I_GLB, I_GWS, I_GB, I_FQG, I_FKG, I_FFB, I_W1, I_W3, I_W2, N_INPUTS };

constexpr size_t MiB = 1u << 20;
constexpr size_t WS_CTL = 0, CTL_ZERO_BYTES = 1 * MiB;
constexpr size_t WS_MOD = 1 * MiB;
constexpr size_t WS_MODP = 2 * MiB;
constexpr size_t WS_WIN = 8 * MiB;
constexpr size_t WS_WOUT = 96 * MiB;
constexpr size_t WS_W13 = 128 * MiB;
constexpr size_t WS_W2 = 304 * MiB;
constexpr size_t WS_H = 392 * MiB;
constexpr size_t WS_PROJ = 456 * MiB;
constexpr size_t WS_YCAT = 632 * MiB;
constexpr size_t WS_F = 696 * MiB;
constexpr size_t WS_RIN = 872 * MiB;
constexpr size_t WS_RG = 1064 * MiB;
constexpr size_t WS_RY = 1096 * MiB;
constexpr size_t WS_END = 1128 * MiB;
constexpr int CW_BAR = 4096;

constexpr int RING_BYTES = 131072;
constexpr int LDSCTL_OFF = RING_BYTES, MISC_OFF = LDSCTL_OFF + 320;
constexpr int LDS_BYTES = 147456;

#define GAS __attribute__((address_space(1)))
#define LAS __attribute__((address_space(3)))
typedef unsigned short bf16;
typedef short bf16x8 __attribute__((ext_vector_type(8)));
typedef float f32x4 __attribute__((ext_vector_type(4)));
typedef float f32x16 __attribute__((ext_vector_type(16)));
typedef unsigned v4u __attribute__((ext_vector_type(4)));
typedef unsigned v2u __attribute__((ext_vector_type(2)));
#define LDS_WAIT() asm volatile("s_waitcnt lgkmcnt(0)" ::: "memory")
__device__ __forceinline__ float bf2f(unsigned short b) { return __uint_as_float(((unsigned)b) << 16); }
__device__ __forceinline__ unsigned f2bf(float f) { unsigned u = __float_as_uint(f); return (u + 0x7fffu + ((u >> 16) & 1u)) >> 16; }
__device__ __forceinline__ unsigned pk2(float lo, float hi) { return f2bf(lo) | (f2bf(hi) << 16); }
__device__ __forceinline__ float bflo(unsigned w) { return __uint_as_float(w << 16); }
__device__ __forceinline__ float bfhi(unsigned w) { return __uint_as_float(w & 0xffff0000u); }
__device__ __forceinline__ float wave_sum(float v) {
#pragma unroll
    for (int o = 1; o < 64; o <<= 1) v += __shfl_xor(v, o);
    return v;
}
__device__ __forceinline__ float sigmoidf_(float x) { return 1.0f / (1.0f + __expf(-x)); }
__device__ __forceinline__ float gelu_f(float v) {
    const float av = fabsf(v), t = __builtin_amdgcn_rcpf(av * 0.2316418882f + 1.0f);
    float q = t * 0.5307027145f + (-0.7265760135f); q = q * t + 0.7107068705f; q = q * t + (-0.142248368f); q = q * t + 0.127414796f; q = q * t;
    const float e = __builtin_amdgcn_exp2f((v * v) * (-0.72134752044f));
    const float m = v * (q * e);
    return v < 0.f ? m : v - m;
}
__device__ __forceinline__ int crow(int r, int hi) { return (r & 3) + 8 * (r >> 2) + 4 * hi; }

#define XB_TMO      128
#define XB_XCNT(j)  (256  + 64 * (j))
#define XB_XSUB(j)  (1280 + 64 * (j))
#define XB_XGEN(j)  (2304 + 64 * (j))
#define XB_TOP      3328
#define XB_TOPGEN   3392
#define XCD_BAR_WORDS 3456
#define XB_SPIN_CAP (1u << 18)

__device__ __forceinline__ unsigned xb_ld(unsigned* p)              { return __hip_atomic_load(p, __ATOMIC_RELAXED, __HIP_MEMORY_SCOPE_AGENT); }
__device__ __forceinline__ unsigned xb_add(unsigned* p, unsigned v) { return __hip_atomic_fetch_add(p, v, __ATOMIC_RELAXED, __HIP_MEMORY_SCOPE_AGENT); }
__device__ __forceinline__ unsigned xb_xcc_id() { return (unsigned)__builtin_amdgcn_s_getreg((3 << 11) | 20) & 0xFu; }
#define XB_SPIN(cond, bar) do { unsigned _sp = 0; while (cond) { __builtin_amdgcn_s_sleep(1); \
    if ((++_sp & 255u) == 0u) { if (xb_ld(&(bar)[XB_TMO])) break; if (_sp > XB_SPIN_CAP) { atomicAdd(&(bar)[XB_TMO], 1u); break; } } } } while (0)

struct XcdBarrier {
    unsigned* bar; unsigned x;
    volatile LAS unsigned* st;
};

__device__ __forceinline__ XcdBarrier xcd_barrier_post(unsigned* bar, volatile LAS unsigned* st) {
    XcdBarrier b; b.bar = bar; b.x = xb_xcc_id(); b.st = st;
    if (threadIdx.x == 0) (void)xb_add(&bar[XB_XCNT(b.x)], 1u);
    return b;
}
__device__ __forceinline__ void xcd_barrier_complete(unsigned* bar, unsigned x, unsigned& nloc, unsigned& nx) {
    const unsigned G = gridDim.x * gridDim.y * gridDim.z;
    unsigned sum, cnt, mine, sp = 0u;
    for (;;) {
        sum = 0u; cnt = 0u; mine = 0u;
#pragma unroll
        for (unsigned j = 0; j < 16; ++j) { const unsigned c = xb_ld(&bar[XB_XCNT(j)]); sum += c; cnt += (c > 0u) ? 1u : 0u; mine = (j == x) ? c : mine; }
        if (sum == G) break;
        __builtin_amdgcn_s_sleep(1);
        if ((++sp & 255u) == 0u) { if (xb_ld(&bar[XB_TMO])) break; if (sp > XB_SPIN_CAP) { atomicAdd(&bar[XB_TMO], 1u); break; } }
    }
    nloc = mine > 0u ? mine : 1u; nx = cnt > 0u ? cnt : 1u;
}

__device__ __forceinline__ void xcd_barrier(const XcdBarrier& b) {
    asm volatile("s_waitcnt vmcnt(0)" ::: "memory");
    __syncthreads();
    if (threadIdx.x == 0) {
        unsigned* bar = b.bar;
        __builtin_amdgcn_s_waitcnt(0);
        unsigned nloc = b.st[0], nx = b.st[1];
        if (nloc == 0u) { xcd_barrier_complete(bar, b.x, nloc, nx); b.st[0] = nloc; b.st[1] = nx; }
        const unsigned old = xb_add(&bar[XB_XSUB(b.x)], 1u);
        const unsigned gen = old / nloc;
        if (old + 1u == (gen + 1u) * nloc) {
            __builtin_amdgcn_fence(__ATOMIC_RELEASE, "agent");
            asm volatile("s_waitcnt vmcnt(0)" ::: "memory");
            const unsigned og = xb_add(&bar[XB_TOP], 1u);
            const unsigned tg = og / nx;
            if (og + 1u == (tg + 1u) * nx) xb_add(&bar[XB_TOPGEN], 1u);
            else XB_SPIN(xb_ld(&bar[XB_TOPGEN]) == tg, bar);
            __builtin_amdgcn_fence(__ATOMIC_ACQUIRE, "agent");
            xb_add(&bar[XB_XGEN(b.x)], 1u);
            asm volatile("s_waitcnt vmcnt(0)" ::: "memory");
        } else {
            XB_SPIN(xb_ld(&bar[XB_XGEN(b.x)]) == gen, bar);
            __builtin_amdgcn_fence(__ATOMIC_ACQUIRE, "agent");
            asm volatile("s_waitcnt vmcnt(0)" ::: "memory");
        }
    }
    __syncthreads();
}

struct Args { const float* in[N_INPUTS]; float* out; unsigned char* ws; int ph_lo, ph_hi; };
static_assert(sizeof(Args) == (N_INPUTS + 2) * 8 + 8, "Args has no padding");

struct Ctx {
    LAS unsigned char* lds; int tid, lane, wave, G, bid;
};
typedef const Args __attribute__((address_space(4))) KArgs;
__device__ __forceinline__ KArgs* ka_ptr() { KArgs* p = (KArgs*)__builtin_amdgcn_kernarg_segment_ptr(); asm volatile("" : "+s"(p)); return p; }
#define KA_DECL KArgs& A = *ka_ptr()

__device__ __forceinline__ void tr_item(const float* __restrict__ W, int N, int col0, int nvalid, int k0, bf16* __restrict__ WT, int K, int n0, LAS float* scr, int lane) {
#pragma unroll 8
    for (int i = 0; i < 32; ++i) { const int kk = 2 * i + (lane >> 5), nn = lane & 31; float v = 0.f; if (nn < nvalid) v = W[(size_t)(k0 + kk) * N + col0 + nn]; scr[kk * 33 + nn] = v; }
    LDS_WAIT(); asm volatile("" ::: "memory");
    const int c = lane & 7;
#pragma unroll
    for (int j = 0; j < 4; ++j) { const int n = (lane >> 3) + 8 * j; const LAS float* s = scr + (8 * c) * 33 + n;
        v4u o; o.x = pk2(s[0 * 33], s[1 * 33]); o.y = pk2(s[2 * 33], s[3 * 33]); o.z = pk2(s[4 * 33], s[5 * 33]); o.w = pk2(s[6 * 33], s[7 * 33]);
        *(v4u*)(WT + (size_t)(n0 + n) * K + k0 + 8 * c) = o; }
    LDS_WAIT(); asm volatile("" ::: "memory");
}
__device__ __forceinline__ void ph_prologue(const Ctx& C) {
    KA_DECL;
    LAS float* csilu = (LAS float*)(C.lds + 73728);
    for (int i = C.tid; i < NB * D; i += NTHREADS) { const float c = A.in[I_C][i]; csilu[i] = c / (1.0f + __expf(-c)); }
    __syncthreads();
    LAS float* scr = (LAS float*)(C.lds + C.wave * 8704);
    const int gw = C.bid * NWAVES + C.wave, NGW = C.G * NWAVES;
    constexpr int I_IN = (D / 64) * (NP / 32), I_OUT = (D / 64) * (D / 32), I_13 = (D / 64) * (2 * FF / 32), I_2 = (FF / 64) * (D / 32), PER_L = I_IN + I_OUT + I_13 + I_2;
    for (int it = gw; it < DEPTH * PER_L; it += NGW) {
        const int l = it / PER_L; int r = it % PER_L;
        if (r < I_IN) { const int kb = r / (NP / 32), nb = r % (NP / 32), n0 = 32 * nb; int col0, nv = 32;
            if (n0 < 1536) col0 = n0; else if (n0 < 4864) col0 = n0 + 160; else if (n0 < 5376) col0 = n0 + 168; else if (n0 < 5536) col0 = n0 - 3840;
            else if (n0 == 5536) { col0 = 5024; nv = 8; } else { col0 = 0; nv = 0; }
            tr_item(A.in[I_WIN] + (size_t)l * D * NIN, NIN, col0, nv, 64 * kb, (bf16*)(A.ws + WS_WIN) + (size_t)l * NP * D, D, n0, scr, C.lane); continue; }
        r -= I_IN;
        if (r < I_OUT) { const int kb = r / (D / 32), nb = r % (D / 32);
            tr_item(A.in[I_WOUT] + (size_t)l * D * D, D, 32 * nb, 32, 64 * kb, (bf16*)(A.ws + WS_WOUT) + (size_t)l * D * D, D, 32 * nb, scr, C.lane); continue; }
        r -= I_OUT;
        if (r < I_13) { const int kb = r / (2 * FF / 32), nb = r % (2 * FF / 32), n0 = 32 * nb, pn = n0 >> 8, j = n0 & 255;
            const float* src = (j < 128 ? A.in[I_W1] : A.in[I_W3]) + (size_t)l * D * FF;
            tr_item(src, FF, 128 * pn + (j & 127), 32, 64 * kb, (bf16*)(A.ws + WS_W13) + (size_t)l * 2 * FF * D, D, n0, scr, C.lane); continue; }
        r -= I_13;
        { const int kb = r / (D / 32), nb = r % (D / 32);
            tr_item(A.in[I_W2] + (size_t)l * FF * D, D, 32 * nb, 32, 64 * kb, (bf16*)(A.ws + WS_W2) + (size_t)l * D * FF, FF, 32 * nb, scr, C.lane); }
    }
    for (int it = gw; it < 8 * DEPTH * (MODW / 256); it += NGW) {
        const int cg = it % (DEPTH * (MODW / 256)), ks = it / (DEPTH * (MODW / 256)), l = cg / (MODW / 256), n0 = (cg % (MODW / 256)) * 256, k0 = ks * 256;
        const float* wp = A.in[I_WMOD] + ((size_t)l * D + k0) * MODW + n0 + 4 * C.lane;
        f32x4 a0 = {0.f, 0.f, 0.f, 0.f}, a1 = a0, a2 = a0, a3 = a0;
#pragma unroll 8
        for (int k = 0; k < 256; ++k) { const f32x4 w = *(const f32x4*)(wp + (size_t)k * MODW);
            a0 += w * csilu[0 * D + k0 + k]; a1 += w * csilu[1 * D + k0 + k]; a2 += w * csilu[2 * D + k0 + k]; a3 += w * csilu[3 * D + k0 + k]; }
        float* mp = (float*)(A.ws + WS_MODP) + ((size_t)(ks * DEPTH + l) * NB) * MODW + n0 + 4 * C.lane;
        *(f32x4*)(mp + 0 * MODW) = a0; *(f32x4*)(mp + 1 * MODW) = a1; *(f32x4*)(mp + 2 * MODW) = a2; *(f32x4*)(mp + 3 * MODW) = a3;
    }
}
__device__ __forceinline__ void ph_modreduce(const Ctx& C) {
    KA_DECL;
    const float* mp = (const float*)(A.ws + WS_MODP); float* mod = (float*)(A.ws + WS_MOD);
    for (int i = C.bid * NTHREADS + C.tid; i < DEPTH * NB * MODW; i += C.G * NTHREADS) {
        const int l = i / (NB * MODW), n = i % MODW; float s = A.in[I_BMOD][l * MODW + n];
#pragma unroll
        for (int ks = 0; ks < 8; ++ks) s += mp[(size_t)ks * DEPTH * NB * MODW + i];
        mod[i] = s;
    }
}
__device__ __forceinline__ void ph_norm(const Ctx& C, const float* x, const float* g, const float* shift, const float* scale, bf16* H) {
    const int gw = C.bid * NWAVES + C.wave, NGW = C.G * NWAVES;
    for (int m = gw; m < M; m += NGW) {
        const int b = m / T; const f32x4* xr = (const f32x4*)(x + (size_t)m * D) + C.lane;
        f32x4 v[8]; float ss = 0.f;
#pragma unroll
        for (int j = 0; j < 8; ++j) { v[j] = xr[64 * j]; ss += (v[j].x * v[j].x + v[j].y * v[j].y) + (v[j].z * v[j].z + v[j].w * v[j].w); }
        const float rstd = 1.0f / sqrtf(wave_sum(ss) * (1.0f / D) + 1e-6f);
        unsigned long long* o8 = (unsigned long long*)(H + (size_t)m * D) + C.lane;
#pragma unroll
        for (int j = 0; j < 8; ++j) { const int c = 4 * (C.lane + 64 * j);
            const f32x4 gg = *(const f32x4*)(g + c), sc = *(const f32x4*)(scale + (size_t)b * MODW + c), sh = *(const f32x4*)(shift + (size_t)b * MODW + c);
            const f32x4 y = v[j] * rstd * gg * (sc + 1.0f) + sh;
            o8[64 * j] = (unsigned long long)pk2(y.x, y.y) | ((unsigned long long)pk2(y.z, y.w) << 32); }
    }
}

__device__ __forceinline__ float dpp_xor1(float v) { return __builtin_bit_cast(float, __builtin_amdgcn_update_dpp(0, __builtin_bit_cast(int, v), 0xB1, 0xF, 0xF, true)); }
__device__ __forceinline__ float dpp_xor2(float v) { return __builtin_bit_cast(float, __builtin_amdgcn_update_dpp(0, __builtin_bit_cast(int, v), 0x4E, 0xF, 0xF, true)); }
__device__ __forceinline__ float wave_sum_dpp(float v) {
    v += dpp_xor1(v); v += dpp_xor2(v);
    v += __builtin_bit_cast(float, __builtin_amdgcn_update_dpp(0, __builtin_bit_cast(int, v), 0x141, 0xF, 0xF, true));
    v += __builtin_bit_cast(float, __builtin_amdgcn_update_dpp(0, __builtin_bit_cast(int, v), 0x140, 0xF, 0xF, true));
    const int b = __builtin_bit_cast(int, v);
    return (__builtin_bit_cast(float, __builtin_amdgcn_readlane(b, 0)) + __builtin_bit_cast(float, __builtin_amdgcn_readlane(b, 16))) +
           (__builtin_bit_cast(float, __builtin_amdgcn_readlane(b, 32)) + __builtin_bit_cast(float, __builtin_amdgcn_readlane(b, 48)));
}

__device__ __forceinline__ f32x16 mma32(const LAS bf16* Ap, const LAS bf16* Bp, int ksteps, f32x16 acc) {
    for (int k = 0; k < ksteps; ++k) { const bf16x8 a = *(const LAS bf16x8*)(Ap + 16 * k), b = *(const LAS bf16x8*)(Bp + 16 * k);
        acc = __builtin_amdgcn_mfma_f32_32x32x16_bf16(a, b, acc, 0, 0, 0); }
    return acc;
}
constexpr int AP = 72;
constexpr int A_Q = 0, A_K = 18432, A_VT = 27648, A_S = 36864, A_P = 71680, A_AL = 90112, A_CUM = 90624, A_END = 107008;
constexpr int SP = 68;
template <int MODE>
__device__ __forceinline__ void attn_unit(const Ctx& C, int l, int b, int h, int qb) {
    KA_DECL; asm volatile("" : "+s"(l));
    const bf16* proj = (const bf16*)(A.ws + WS_PROJ); bf16* ycat = (bf16*)(A.ws + WS_YCAT);
    const int tid = C.tid, lane = C.lane, wave = C.wave, r32 = lane & 31, hi = lane >> 5;
    const int q0 = qb * 128; const size_t rowb = (size_t)b * T;
    const int qcol = (MODE == 0 ? PC_SQ : PC_FQ) + h * 64;
    const int kcol = (MODE == 0) ? PC_SK + (h >> 2) * 64 : PC_FK + h * 64;
    const int vcol = (MODE == 0) ? PC_SV + (h >> 2) * 64 : PC_FV + h * 64;
    const float* qg = A.in[MODE == 0 ? I_SQG : I_FQG] + l * 64; const float* kg = A.in[MODE == 0 ? I_SKG : I_FKG] + l * 64;
    LAS bf16* Qs = (LAS bf16*)(C.lds + A_Q); LAS bf16* Ks = (LAS bf16*)(C.lds + A_K); LAS bf16* Vt = (LAS bf16*)(C.lds + A_VT);
    LAS float* Ss = (LAS float*)(C.lds + A_S); LAS bf16* Ps = (LAS bf16*)(C.lds + A_P); LAS float* AL = (LAS float*)(C.lds + A_AL); LAS float* cum = (LAS float*)(C.lds + A_CUM);
    __syncthreads();
    if (MODE == 1) {
        const int n = q0 + 128; const float fb = A.in[I_FFB][l * NH + h];
        float loc[8]; float s = 0.f;
#pragma unroll
        for (int i = 0; i < 8; ++i) { const int pos = 8 * tid + i; float v = 0.f;
            if (pos < n) { const float x = bf2f(proj[(rowb + pos) * NP + PC_FL + h]) + fb; v = (x < 0.f) ? x - log1pf(expf(x)) : -log1pf(expf(-x)); }
            s += v; loc[i] = s; }
        float ws_ = s;
#pragma unroll
        for (int o = 1; o < 64; o <<= 1) { const float t_ = __shfl_up(ws_, o); if (lane >= o) ws_ += t_; }
        if (lane == 63) AL[wave] = ws_;
        __syncthreads();
        float base = ws_ - s;
        for (int w = 0; w < wave; ++w) base += AL[w];
#pragma unroll
        for (int i = 0; i < 8; ++i) { const int pos = 8 * tid + i; if (pos < n) cum[pos] = base + loc[i]; }
    }
    {
        const int row = tid >> 2, dq = (tid & 3) * 16;
        const v4u* src = (const v4u*)(proj + (rowb + q0 + row) * NP + qcol + dq);
        const v4u r0 = src[0], r1 = src[1];
        float f[16];
        f[0] = bflo(r0.x); f[1] = bfhi(r0.x); f[2] = bflo(r0.y); f[3] = bfhi(r0.y); f[4] = bflo(r0.z); f[5] = bfhi(r0.z); f[6] = bflo(r0.w); f[7] = bfhi(r0.w);
        f[8] = bflo(r1.x); f[9] = bfhi(r1.x); f[10] = bflo(r1.y); f[11] = bfhi(r1.y); f[12] = bflo(r1.z); f[13] = bfhi(r1.z); f[14] = bflo(r1.w); f[15] = bfhi(r1.w);
        float ss = 0.f;
#pragma unroll
        for (int i = 0; i < 16; ++i) ss += f[i] * f[i];
        ss += __shfl_xor(ss, 1); ss += __shfl_xor(ss, 2);
        const float rs = 0.125f / sqrtf(ss * (1.0f / 64.0f) + 1e-6f);
#pragma unroll
        for (int i = 0; i < 16; ++i) f[i] = f[i] * rs * qg[dq + i];
        v4u o0, o1; o0.x = pk2(f[0], f[1]); o0.y = pk2(f[2], f[3]); o0.z = pk2(f[4], f[5]); o0.w = pk2(f[6], f[7]);
        o1.x = pk2(f[8], f[9]); o1.y = pk2(f[10], f[11]); o1.z = pk2(f[12], f[13]); o1.w = pk2(f[14], f[15]);
        *(LAS v4u*)(Qs + row * AP + dq) = o0; *(LAS v4u*)(Qs + row * AP + dq + 8) = o1;
    }
    const int ks_begin = (MODE == 0) ? (q0 >= 128 ? q0 - 128 : 0) : 0, ks_end = q0 + 128;
    float m_run = -1e30f, l_run = 0.f;
    f32x16 o;
#pragma unroll
    for (int r = 0; r < 16; ++r) o[r] = 0.f;
    const int qi = wave >> 1, cj = wave & 1;
    for (int ks = ks_begin; ks < ks_end; ks += 64) {
        {
            const int row = tid >> 3, dc = (tid & 7) * 8;
            const v4u kr = *(const v4u*)(proj + (rowb + ks + row) * NP + kcol + dc);
            float f[8]; f[0] = bflo(kr.x); f[1] = bfhi(kr.x); f[2] = bflo(kr.y); f[3] = bfhi(kr.y); f[4] = bflo(kr.z); f[5] = bfhi(kr.z); f[6] = bflo(kr.w); f[7] = bfhi(kr.w);
            float ss = 0.f;
#pragma unroll
            for (int i = 0; i < 8; ++i) ss += f[i] * f[i];
            ss += __shfl_xor(ss, 1); ss += __shfl_xor(ss, 2); ss += __shfl_xor(ss, 4);
            const float rs = 1.0f / sqrtf(ss * (1.0f / 64.0f) + 1e-6f);
#pragma unroll
            for (int i = 0; i < 8; ++i) f[i] = f[i] * rs * kg[dc + i];
            v4u ko; ko.x = pk2(f[0], f[1]); ko.y = pk2(f[2], f[3]); ko.z = pk2(f[4], f[5]); ko.w = pk2(f[6], f[7]);
            *(LAS v4u*)(Ks + row * AP + dc) = ko;
            const v4u vr = *(const v4u*)(proj + (rowb + ks + row) * NP + vcol + dc);
            Vt[(dc + 0) * AP + row] = (bf16)(vr.x & 0xffffu); Vt[(dc + 1) * AP + row] = (bf16)(vr.x >> 16);
            Vt[(dc + 2) * AP + row] = (bf16)(vr.y & 0xffffu); Vt[(dc + 3) * AP + row] = (bf16)(vr.y >> 16);
            Vt[(dc + 4) * AP + row] = (bf16)(vr.z & 0xffffu); Vt[(dc + 5) * AP + row] = (bf16)(vr.z >> 16);
            Vt[(dc + 6) * AP + row] = (bf16)(vr.w & 0xffffu); Vt[(dc + 7) * AP + row] = (bf16)(vr.w >> 16);
        }
        __syncthreads();
        {
            f32x16 acc;
#pragma unroll
            for (int r = 0; r < 16; ++r) acc[r] = 0.f;
            acc = mma32(Qs + (32 * qi + r32) * AP + 8 * hi, Ks + (32 * cj + r32) * AP + 8 * hi, 4, acc);
#pragma unroll
            for (int r = 0; r < 16; ++r) Ss[(32 * qi + crow(r, hi)) * SP + 32 * cj + r32] = acc[r];
        }
        __syncthreads();
        {
            const int row = tid >> 2, c0 = (tid & 3) * 16, qp = q0 + row;
            float s[16];
#pragma unroll
            for (int i = 0; i < 4; ++i) { const f32x4 t4 = *(const LAS f32x4*)(Ss + row * SP + c0 + 4 * i); s[4 * i] = t4.x; s[4 * i + 1] = t4.y; s[4 * i + 2] = t4.z; s[4 * i + 3] = t4.w; }
            float cq = 0.f; if (MODE == 1) cq = cum[qp];
            float mx = -1e30f;
#pragma unroll
            for (int i = 0; i < 16; ++i) { const int kp = ks + c0 + i;
                if (MODE == 1) s[i] += cq - cum[kp];
                const bool ok = (MODE == 1) ? (kp <= qp) : (kp <= qp && kp > qp - 128);
                s[i] = ok ? s[i] : -1e30f; mx = fmaxf(mx, s[i]); }
            mx = fmaxf(mx, __shfl_xor(mx, 1)); mx = fmaxf(mx, __shfl_xor(mx, 2));
            const float m_new = fmaxf(m_run, mx), alpha = __expf(m_run - m_new);
            float p[16], rsum = 0.f;
#pragma unroll
            for (int i = 0; i < 16; ++i) { p[i] = (s[i] > -1e29f) ? __expf(s[i] - m_new) : 0.f; rsum += p[i]; }
            rsum += __shfl_xor(rsum, 1); rsum += __shfl_xor(rsum, 2);
            l_run = l_run * alpha + rsum; m_run = m_new;
            v4u o0, o1; o0.x = pk2(p[0], p[1]); o0.y = pk2(p[2], p[3]); o0.z = pk2(p[4], p[5]); o0.w = pk2(p[6], p[7]);
            o1.x = pk2(p[8], p[9]); o1.y = pk2(p[10], p[11]); o1.z = pk2(p[12], p[13]); o1.w = pk2(p[14], p[15]);
            *(LAS v4u*)(Ps + row * AP + c0) = o0; *(LAS v4u*)(Ps + row * AP + c0 + 8) = o1;
            if ((tid & 3) == 0) AL[row] = alpha;
        }
        __syncthreads();
        {
#pragma unroll
            for (int r = 0; r < 16; ++r) o[r] *= AL[32 * qi + crow(r, hi)];
            o = mma32(Ps + (32 * qi + r32) * AP + 8 * hi, Vt + (32 * cj + r32) * AP + 8 * hi, 4, o);
        }
        __syncthreads();
    }
    {
        if (MODE == 0) l_run += __expf(A.in[I_SSINK][l * NH + h] - m_run);
        if ((tid & 3) == 0) AL[tid >> 2] = 1.0f / l_run;
    }
    __syncthreads();
#pragma unroll
    for (int r = 0; r < 16; ++r) { const int row = 32 * qi + crow(r, hi), d = 32 * cj + r32; const size_t m = rowb + q0 + row;
        float val = o[r] * AL[row];
        if (MODE == 1) val *= sigmoidf_(bf2f(proj[m * NP + PC_FG + h * 64 + d]));
        ycat[m * D + (MODE == 0 ? YC_B : YC_D) + h * 64 + d] = (bf16)f2bf(val); }
}
constexpr int B_K = 0, B_VT = 18432, B_CUM = 36864, B_WT = 53248;
__device__ __forceinline__ float max_halves(float m) { auto rr = __builtin_amdgcn_permlane32_swap(__float_as_uint(m), __float_as_uint(m), false, false); return fmaxf(__uint_as_float(rr[0]), __uint_as_float(rr[1])); }
__device__ __forceinline__ float sum_halves(float m) { auto rr = __builtin_amdgcn_permlane32_swap(__float_as_uint(m), __float_as_uint(m), false, false); return __uint_as_float(rr[0]) + __uint_as_float(rr[1]); }
template <int MODE>
__device__ __forceinline__ void attn2_unit(const Ctx& C, int l, int b, int h, int qb) {
    KA_DECL; asm volatile("" : "+s"(l));
    const bf16* proj = (const bf16*)(A.ws + WS_PROJ); bf16* ycat = (bf16*)(A.ws + WS_YCAT);
    const int tid = C.tid, lane = C.lane, wave = C.wave, r32 = lane & 31, hi = lane >> 5;
    const int q0 = qb * 256; const size_t rowb = (size_t)b * T;
    const int qcol = (MODE == 0 ? PC_SQ : PC_FQ) + h * 64;
    const int kcol = (MODE == 0) ? PC_SK + (h >> 2) * 64 : PC_FK + h * 64;
    const int vcol = (MODE == 0) ? PC_SV + (h >> 2) * 64 : PC_FV + h * 64;
    const float* qg = A.in[MODE == 0 ? I_SQG : I_FQG] + l * 64; const float* kg = A.in[MODE == 0 ? I_SKG : I_FKG] + l * 64;
    LAS bf16* Ks = (LAS bf16*)(C.lds + B_K); LAS bf16* Vt = (LAS bf16*)(C.lds + B_VT); LAS float* cum = (LAS float*)(C.lds + B_CUM); LAS float* WT = (LAS float*)(C.lds + B_WT);
    constexpr float LOG2E = 1.4426950408889634f;
    __syncthreads();
    if (MODE == 1) {
        const int n = q0 + 256; const float fb = A.in[I_FFB][l * NH + h];
        float loc[8]; float s = 0.f;
#pragma unroll
        for (int i = 0; i < 8; ++i) { const int pos = 8 * tid + i; float v = 0.f;
            if (pos < n) { const float x = bf2f(proj[(rowb + pos) * NP + PC_FL + h]) + fb; v = (x < 0.f) ? x - log1pf(expf(x)) : -log1pf(expf(-x)); }
            s += v; loc[i] = s; }
        float ws_ = s;
#pragma unroll
        for (int o = 1; o < 64; o <<= 1) { const float t_ = __shfl_up(ws_, o); if (lane >= o) ws_ += t_; }
        if (lane == 63) WT[wave] = ws_;
        __syncthreads();
        float base = ws_ - s;
        for (int w = 0; w < wave; ++w) base += WT[w];
#pragma unroll
        for (int i = 0; i < 8; ++i) { const int pos = 8 * tid + i; if (pos < n) cum[pos] = (base + loc[i]) * LOG2E; }
    }
    const int qp = q0 + 32 * wave + r32;
    bf16x8 qf[4];
    {
        const bf16* src = proj + (rowb + qp) * NP + qcol + 8 * hi;
        v4u raw[4]; float ss = 0.f;
#pragma unroll
        for (int s4 = 0; s4 < 4; ++s4) { raw[s4] = *(const v4u*)(src + 16 * s4);
            const float f0 = bflo(raw[s4].x), f1 = bfhi(raw[s4].x), f2 = bflo(raw[s4].y), f3 = bfhi(raw[s4].y), f4 = bflo(raw[s4].z), f5 = bfhi(raw[s4].z), f6 = bflo(raw[s4].w), f7 = bfhi(raw[s4].w);
            ss += ((f0 * f0 + f1 * f1) + (f2 * f2 + f3 * f3)) + ((f4 * f4 + f5 * f5) + (f6 * f6 + f7 * f7)); }
        ss = sum_halves(ss);
        const float rs = (0.125f * LOG2E) / sqrtf(ss * (1.0f / 64.0f) + 1e-6f);
#pragma unroll
        for (int s4 = 0; s4 < 4; ++s4) { const float* g8 = qg + 16 * s4 + 8 * hi; v4u o;
            o.x = pk2(bflo(raw[s4].x) * rs * g8[0], bfhi(raw[s4].x) * rs * g8[1]); o.y = pk2(bflo(raw[s4].y) * rs * g8[2], bfhi(raw[s4].y) * rs * g8[3]);
            o.z = pk2(bflo(raw[s4].z) * rs * g8[4], bfhi(raw[s4].z) * rs * g8[5]); o.w = pk2(bflo(raw[s4].w) * rs * g8[6], bfhi(raw[s4].w) * rs * g8[7]);
            qf[s4] = __builtin_bit_cast(bf16x8, o); }
    }
    const int ks_begin = (MODE == 0) ? (q0 >= 128 ? q0 - 128 : 0) : 0, ks_end = q0 + 256;
    const int srow = tid >> 3, sdc = (tid & 7) * 8;
    float kgv[8];
#pragma unroll
    for (int i = 0; i < 8; ++i) kgv[i] = kg[sdc + i];
    v4u kreg, vreg;
#define A2_LOAD(ks_) do { const bf16* kp_ = proj + (rowb + (ks_) + srow) * NP; kreg = *(const v4u*)(kp_ + kcol + sdc); vreg = *(const v4u*)(kp_ + vcol + sdc); } while (0)
#define A2_STAGE(buf_) do { \
        float f[8]; f[0] = bflo(kreg.x); f[1] = bfhi(kreg.x); f[2] = bflo(kreg.y); f[3] = bfhi(kreg.y); f[4] = bflo(kreg.z); f[5] = bfhi(kreg.z); f[6] = bflo(kreg.w); f[7] = bfhi(kreg.w); \
        float ss = ((f[0] * f[0] + f[1] * f[1]) + (f[2] * f[2] + f[3] * f[3])) + ((f[4] * f[4] + f[5] * f[5]) + (f[6] * f[6] + f[7] * f[7])); \
        ss += dpp_xor1(ss); ss += dpp_xor2(ss); ss += __shfl_xor(ss, 4); \
        const float rs = 1.0f / sqrtf(ss * (1.0f / 64.0f) + 1e-6f); \
        v4u ko; ko.x = pk2(f[0] * rs * kgv[0], f[1] * rs * kgv[1]); ko.y = pk2(f[2] * rs * kgv[2], f[3] * rs * kgv[3]); ko.z = pk2(f[4] * rs * kgv[4], f[5] * rs * kgv[5]); ko.w = pk2(f[6] * rs * kgv[6], f[7] * rs * kgv[7]); \
        *(LAS v4u*)(Ks + (buf_) * 64 * AP + srow * AP + sdc) = ko; \
        LAS bf16* vt_ = Vt + (buf_) * 64 * AP + sdc * AP + srow; \
        vt_[0 * AP] = (bf16)(vreg.x & 0xffffu); vt_[1 * AP] = (bf16)(vreg.x >> 16); vt_[2 * AP] = (bf16)(vreg.y & 0xffffu); vt_[3 * AP] = (bf16)(vreg.y >> 16); \
        vt_[4 * AP] = (bf16)(vreg.z & 0xffffu); vt_[5 * AP] = (bf16)(vreg.z >> 16); vt_[6 * AP] = (bf16)(vreg.w & 0xffffu); vt_[7 * AP] = (bf16)(vreg.w >> 16); } while (0)
    A2_LOAD(ks_begin); A2_STAGE(0);
    if (ks_begin + 64 < ks_end) A2_LOAD(ks_begin + 64);
    float m_run = -1e30f, l_run = 0.f;
    float cq = 0.f;
    f32x16 o0, o1;
#pragma unroll
    for (int r = 0; r < 16; ++r) { o0[r] = 0.f; o1[r] = 0.f; }
    const int qmax = q0 + 32 * wave + 31, qmin = q0 + 32 * wave;
    int buf = 0;
    for (int ks = ks_begin; ks < ks_end; ks += 64, buf ^= 1) {
        __syncthreads();
        if (MODE == 1 && ks == ks_begin) cq = cum[qp];
        if (ks + 64 < ks_end) { A2_STAGE(buf ^ 1); if (ks + 128 < ks_end) A2_LOAD(ks + 128); }
        const bool live = (MODE == 1) ? (ks <= qmax) : (ks <= qmax && ks + 63 > qmin - 128);
        if (live) {
            const LAS bf16* kb = Ks + buf * 64 * AP + r32 * AP + 8 * hi;
            f32x16 p0, p1;
#pragma unroll
            for (int r = 0; r < 16; ++r) { p0[r] = 0.f; p1[r] = 0.f; }
#pragma unroll
            for (int s4 = 0; s4 < 4; ++s4) { const bf16x8 k0 = *(const LAS bf16x8*)(kb + 16 * s4), k1 = *(const LAS bf16x8*)(kb + 32 * AP + 16 * s4);
                p0 = __builtin_amdgcn_mfma_f32_32x32x16_bf16(k0, qf[s4], p0, 0, 0, 0); p1 = __builtin_amdgcn_mfma_f32_32x32x16_bf16(k1, qf[s4], p1, 0, 0, 0); }
            if (MODE == 1) {
#pragma unroll
                for (int q4 = 0; q4 < 4; ++q4) { const f32x4 c0 = *(const LAS f32x4*)(cum + ks + 8 * q4 + 4 * hi), c1 = *(const LAS f32x4*)(cum + ks + 32 + 8 * q4 + 4 * hi);
                    p0[4 * q4] += cq - c0.x; p0[4 * q4 + 1] += cq - c0.y; p0[4 * q4 + 2] += cq - c0.z; p0[4 * q4 + 3] += cq - c0.w;
                    p1[4 * q4] += cq - c1.x; p1[4 * q4 + 1] += cq - c1.y; p1[4 * q4 + 2] += cq - c1.z; p1[4 * q4 + 3] += cq - c1.w; }
            }
            const bool edge = (MODE == 1) ? (ks + 63 > qmin) : true;
            if (edge) {
#pragma unroll
                for (int r = 0; r < 16; ++r) { const int k0p = ks + crow(r, hi), k1p = k0p + 32;
                    const bool ok0 = (MODE == 1) ? (k0p <= qp) : (k0p <= qp && k0p > qp - 128), ok1 = (MODE == 1) ? (k1p <= qp) : (k1p <= qp && k1p > qp - 128);
                    p0[r] = ok0 ? p0[r] : -1e30f; p1[r] = ok1 ? p1[r] : -1e30f; }
            }
            float mx = fmaxf(p0[0], p1[0]);
#pragma unroll
            for (int r = 1; r < 16; ++r) mx = fmaxf(mx, fmaxf(p0[r], p1[r]));
            mx = max_halves(mx);
            const float m_new = fmaxf(m_run, mx), alpha = __builtin_amdgcn_exp2f(m_run - m_new);
            float rsum = 0.f;
#pragma unroll
            for (int r = 0; r < 16; ++r) { p0[r] = (p0[r] > -1e29f) ? __builtin_amdgcn_exp2f(p0[r] - m_new) : 0.f; p1[r] = (p1[r] > -1e29f) ? __builtin_amdgcn_exp2f(p1[r] - m_new) : 0.f; rsum += p0[r] + p1[r]; }
            l_run = l_run * alpha + rsum; m_run = m_new;
#pragma unroll
            for (int r = 0; r < 16; ++r) { o0[r] *= alpha; o1[r] *= alpha; }
            bf16x8 pf[4];
            { v4u w;
              w.x = pk2(p0[0], p0[1]); w.y = pk2(p0[2], p0[3]); w.z = pk2(p0[4], p0[5]); w.w = pk2(p0[6], p0[7]); pf[0] = __builtin_bit_cast(bf16x8, w);
              w.x = pk2(p0[8], p0[9]); w.y = pk2(p0[10], p0[11]); w.z = pk2(p0[12], p0[13]); w.w = pk2(p0[14], p0[15]); pf[1] = __builtin_bit_cast(bf16x8, w);
              w.x = pk2(p1[0], p1[1]); w.y = pk2(p1[2], p1[3]); w.z = pk2(p1[4], p1[5]); w.w = pk2(p1[6], p1[7]); pf[2] = __builtin_bit_cast(bf16x8, w);
              w.x = pk2(p1[8], p1[9]); w.y = pk2(p1[10], p1[11]); w.z = pk2(p1[12], p1[13]); w.w = pk2(p1[14], p1[15]); pf[3] = __builtin_bit_cast(bf16x8, w); }
            const LAS bf16* vb = Vt + buf * 64 * AP + r32 * AP + 4 * hi;
#pragma unroll
            for (int ks4 = 0; ks4 < 4; ++ks4) {
                const v2u a0 = *(const LAS v2u*)(vb + 16 * ks4), a1 = *(const LAS v2u*)(vb + 16 * ks4 + 8), b0 = *(const LAS v2u*)(vb + 32 * AP + 16 * ks4), b1 = *(const LAS v2u*)(vb + 32 * AP + 16 * ks4 + 8);
                const v4u fa = {a0.x, a0.y, a1.x, a1.y}, fb = {b0.x, b0.y, b1.x, b1.y};
                o0 = __builtin_amdgcn_mfma_f32_32x32x16_bf16(__builtin_bit_cast(bf16x8, fa), pf[ks4], o0, 0, 0, 0);
                o1 = __builtin_amdgcn_mfma_f32_32x32x16_bf16(__builtin_bit_cast(bf16x8, fb), pf[ks4], o1, 0, 0, 0); }
        }
    }
#undef A2_LOAD
#undef A2_STAGE
    float l_tot = sum_halves(l_run);
    if (MODE == 0) l_tot += __builtin_amdgcn_exp2f(A.in[I_SSINK][l * NH + h] * LOG2E - m_run);
    const float inv = 1.0f / l_tot;
    const size_t m = rowb + qp; bf16* orow = ycat + m * D + (MODE == 0 ? YC_B : YC_D) + h * 64;
#pragma unroll
    for (int q4 = 0; q4 < 4; ++q4) {
        float v0[4] = {o0[4 * q4] * inv, o0[4 * q4 + 1] * inv, o0[4 * q4 + 2] * inv, o0[4 * q4 + 3] * inv}, v1[4] = {o1[4 * q4] * inv, o1[4 * q4 + 1] * inv, o1[4 * q4 + 2] * inv, o1[4 * q4 + 3] * inv};
        const int d0 = 8 * q4 + 4 * hi;
        if (MODE == 1) { const bf16* gp = proj + m * NP + PC_FG + h * 64; const v2u g0 = *(const v2u*)(gp + d0), g1 = *(const v2u*)(gp + 32 + d0);
            v0[0] *= sigmoidf_(bflo(g0.x)); v0[1] *= sigmoidf_(bfhi(g0.x)); v0[2] *= sigmoidf_(bflo(g0.y)); v0[3] *= sigmoidf_(bfhi(g0.y));
            v1[0] *= sigmoidf_(bflo(g1.x)); v1[1] *= sigmoidf_(bfhi(g1.x)); v1[2] *= sigmoidf_(bflo(g1.y)); v1[3] *= sigmoidf_(bfhi(g1.y)); }
        v2u w0, w1; w0.x = pk2(v0[0], v0[1]); w0.y = pk2(v0[2], v0[3]); w1.x = pk2(v1[0], v1[1]); w1.y = pk2(v1[2], v1[3]);
        *(v2u*)(orow + d0) = w0; *(v2u*)(orow + 32 + d0) = w1; }
}
constexpr int GP = 136;
constexpr int G_W = 0, G_VT = 34816, G_ST = 52224;
__device__ __forceinline__ void sgu_unit(const Ctx& C, int l, int b, int chunk, int ghalf) {
    KA_DECL; asm volatile("" : "+s"(l));
    const bf16* proj = (const bf16*)(A.ws + WS_PROJ); bf16* ycat = (bf16*)(A.ws + WS_YCAT);
    const int tid = C.tid, lane = C.lane, wave = C.wave, r32 = lane & 31, hi = lane >> 5;
    const size_t m0 = (size_t)b * T + chunk * 128;
    LAS bf16* Wd = (LAS bf16*)(C.lds + G_W); LAS bf16* Vt = (LAS bf16*)(C.lds + G_VT); LAS float* ST = (LAS float*)(C.lds + G_ST);
    __syncthreads();
    {
        const int tok = tid >> 2, part = tid & 3; const v4u* src = (const v4u*)(proj + (m0 + tok) * NP + PC_GV + part * 128);
        float s1 = 0.f, s2 = 0.f;
#pragma unroll 4
        for (int i = 0; i < 16; ++i) { const v4u w = src[i];
            const float e0 = gelu_f(bflo(w.x)), e1 = gelu_f(bfhi(w.x)), e2 = gelu_f(bflo(w.y)), e3 = gelu_f(bfhi(w.y)), e4 = gelu_f(bflo(w.z)), e5 = gelu_f(bfhi(w.z)), e6 = gelu_f(bflo(w.w)), e7 = gelu_f(bfhi(w.w));
            s1 += ((e0 + e1) + (e2 + e3)) + ((e4 + e5) + (e6 + e7));
            s2 += ((e0 * e0 + e1 * e1) + (e2 * e2 + e3 * e3)) + ((e4 * e4 + e5 * e5) + (e6 * e6 + e7 * e7)); }
        s1 += __shfl_xor(s1, 1); s1 += __shfl_xor(s1, 2); s2 += __shfl_xor(s2, 1); s2 += __shfl_xor(s2, 2);
        const float mean = s1 * (1.0f / 512.0f), var = fmaxf(s2 * (1.0f / 512.0f) - mean * mean, 0.f);
        if (part == 0) { ST[2 * tok] = mean; ST[2 * tok + 1] = 1.0f / sqrtf(var + 1e-5f); }
    }
    __syncthreads();
    const int ti = wave >> 1, cj = wave & 1;
    for (int gi = 0; gi < 4; ++gi) {
        const int g = ghalf * 4 + gi;
        {
            const int row = tid >> 2, s0 = (tid & 3) * 32; const float* wsrc = A.in[I_GWS] + (size_t)(l * NH + g) * SGU_TRI + (row * (row + 1)) / 2;
#pragma unroll
            for (int i = 0; i < 32; i += 2) { const int s = s0 + i; const float w0 = (s <= row) ? wsrc[s] : 0.f, w1 = (s + 1 <= row) ? wsrc[s + 1] : 0.f;
                *(LAS unsigned*)(Wd + row * GP + s) = pk2(w0, w1); }
        }
        {
            const int tok = tid >> 2, c0 = (tid & 3) * 16; const v4u* src = (const v4u*)(proj + (m0 + tok) * NP + PC_GV + g * 64 + c0);
            const v4u r0 = src[0], r1 = src[1]; const float mean = ST[2 * tok], rstd = ST[2 * tok + 1];
            const float* lg = A.in[I_GLG] + l * GW + g * 64 + c0; const float* lb = A.in[I_GLB] + l * GW + g * 64 + c0;
            float f[16];
            f[0] = bflo(r0.x); f[1] = bfhi(r0.x); f[2] = bflo(r0.y); f[3] = bfhi(r0.y); f[4] = bflo(r0.z); f[5] = bfhi(r0.z); f[6] = bflo(r0.w); f[7] = bfhi(r0.w);
            f[8] = bflo(r1.x); f[9] = bfhi(r1.x); f[10] = bflo(r1.y); f[11] = bfhi(r1.y); f[12] = bflo(r1.z); f[13] = bfhi(r1.z); f[14] = bflo(r1.w); f[15] = bfhi(r1.w);
#pragma unroll
            for (int i = 0; i < 16; ++i) { const float y = (gelu_f(f[i]) - mean) * rstd * lg[i] + lb[i]; Vt[(c0 + i) * GP + tok] = (bf16)f2bf(y); }
        }
        __syncthreads();
        {
            f32x16 acc;
#pragma unroll
            for (int r = 0; r < 16; ++r) acc[r] = 0.f;
            acc = mma32(Wd + (32 * ti + r32) * GP + 8 * hi, Vt + (32 * cj + r32) * GP + 8 * hi, 2 * (ti + 1), acc);
            const float* bs = A.in[I_GB] + (size_t)(l * NH + g) * 128;
#pragma unroll
            for (int r = 0; r < 16; ++r) { const int t = 32 * ti + crow(r, hi), c = 32 * cj + r32; const size_t m = m0 + t;
                const float z = acc[r] + bs[t], u = gelu_f(bf2f(proj[m * NP + PC_GU + g * 64 + c]));
                ycat[m * D + YC_C + g * 64 + c] = (bf16)f2bf(u * z); }
        }
        __syncthreads();
    }
}
constexpr size_t WS_QF = WS_RIN, WS_YF = WS_RIN + 32 * MiB, WS_PA = WS_RIN + 64 * MiB, WS_RT = WS_RIN + 80 * MiB, WS_GL = WS_RIN + 96 * MiB, WS_RBV = WS_RIN + 97 * MiB;
constexpr int TP = 72;
constexpr int LP = 168;
constexpr int R_AH = 0, R_RH = 9216, R_BT = 18432, R_KT = 27648, R_VT = 36864, R_BH = 46080, R_KH = 55296, R_RHS = 46080  ;
constexpr int R_LR = 64512  , R_NP = 64512  , R_NK = 80896, R_BR = 90112, R_KR = 99328, R_W1 = 108544, R_W2 = 117760, R_GT = 126976;
__device__ __forceinline__ float shifted(const bf16* proj, size_t m, int t, int col, float mu) {
    const float p = bf2f(proj[m * NP + col]); const float pp = (t > 0) ? bf2f(proj[(m - 1) * NP + col]) : 0.f; return p + (pp - p) * mu;
}
__device__ __forceinline__ void rwkv_chunk_unit(const Ctx& C, int l, int b, int c, int h) {
    KA_DECL; asm volatile("" : "+s"(l));
    const bf16* proj = (const bf16*)(A.ws + WS_PROJ);
    const int tid = C.tid, lane = C.lane, wave = C.wave, r32 = lane & 31, hi = lane >> 5;
    const size_t m0 = (size_t)b * T + 64 * c; const int t0 = 64 * c; const size_t pair = (size_t)(b * NH + h) * 64 + c;
    LAS unsigned char* L = C.lds;
    LAS bf16* tAH = (LAS bf16*)(L + R_AH); LAS bf16* tRH = (LAS bf16*)(L + R_RH); LAS bf16* tBT = (LAS bf16*)(L + R_BT); LAS bf16* tKT = (LAS bf16*)(L + R_KT); LAS bf16* tVT = (LAS bf16*)(L + R_VT);
    LAS bf16* tBH = (LAS bf16*)(L + R_BH); LAS bf16* tKH = (LAS bf16*)(L + R_KH); LAS float* RHS = (LAS float*)(L + R_RHS); LAS float* LR = (LAS float*)(L + R_LR); LAS float* NPm = (LAS float*)(L + R_NP);
    LAS bf16* tNK = (LAS bf16*)(L + R_NK); LAS bf16* tBR = (LAS bf16*)(L + R_BR); LAS bf16* tKR = (LAS bf16*)(L + R_KR); LAS bf16* tW1 = (LAS bf16*)(L + R_W1); LAS bf16* tW2 = (LAS bf16*)(L + R_W2);
    LAS float* GT = (LAS float*)(L + R_GT);
    const float* mu = A.in[I_RMU] + l * 1696;
    LAS bf16* LRb = (LAS bf16*)(L + R_LR);
    LAS bf16* Wt = (LAS bf16*)(L + R_LR + 64 * LP * 2);
    LAS float* OUT = (LAS float*)L;
    __syncthreads();
    for (int e = tid; e < 64 * 160; e += NTHREADS) { const int tok = e / 160, j = e % 160;
        const float x = shifted(proj, m0 + tok, t0 + tok, PC_RW + j, mu[1536 + j]);
        LRb[tok * LP + j] = (bf16)f2bf((j < 32) ? tanhf(x) : (j < 64 ? x : sigmoidf_(x))); }
    for (int e = tid; e < 160 * 64; e += NTHREADS) { const int ch = e & 63, m = e >> 6;
        const float w = (m < 32) ? A.in[I_RW2][((size_t)l * 32 + m) * GW + h * 64 + ch] : ((m < 64) ? A.in[I_RA2][((size_t)l * 32 + (m - 32)) * GW + h * 64 + ch] : A.in[I_RG2][((size_t)l * 96 + (m - 64)) * GW + h * 64 + ch]);
        Wt[ch * LP + m] = (bf16)f2bf(w); }
    __syncthreads();
    {
        const int rt = (wave >> 1) & 1, ct = wave & 1;
        const LAS bf16* Ap = LRb + (32 * rt + r32) * LP + 8 * hi; const LAS bf16* Bp = Wt + (32 * ct + r32) * LP + 8 * hi;
        f32x16 acc, acc2;
#pragma unroll
        for (int r = 0; r < 16; ++r) { acc[r] = 0.f; acc2[r] = 0.f; }
        if (wave < 4) { acc = mma32(Ap, Bp, 2, acc); acc2 = mma32(Ap + 32, Bp + 32, 2, acc2); }
        else acc = mma32(Ap + 64, Bp + 64, 6, acc);
#pragma unroll
        for (int r = 0; r < 16; ++r) { const int o = (32 * rt + crow(r, hi)) * 64 + 32 * ct + r32;
            if (wave < 4) { OUT[o] = acc[r]; OUT[4096 + o] = acc2[r]; } else OUT[8192 + o] = acc[r]; }
    }
    __syncthreads();
    const int cg = h * 64 + lane, tg = wave;
    float rr[8], kp[8], vv[8], na[8], bb[8], pg[8];
    {
        float aw[8], aa[8], ag[8];
#pragma unroll
        for (int k = 0; k < 8; ++k) { const int o = (8 * tg + k) * 64 + lane; aw[k] = OUT[o]; aa[k] = OUT[4096 + o]; ag[k] = OUT[8192 + o]; }
        const float w0 = A.in[I_RW0][l * GW + cg], a0 = A.in[I_RA0][l * GW + cg], kkc = A.in[I_RKK][l * GW + cg], kac = A.in[I_RKA][l * GW + cg], rkc = A.in[I_RRK][l * GW + cg];
        const float mur = mu[cg], muk = mu[512 + cg], muv = mu[1024 + cg];
        float* rg = (float*)(A.ws + WS_RG); float* rbv = (float*)(A.ws + WS_RBV);
        float run = 0.f;
#pragma unroll
        for (int k = 0; k < 8; ++k) { const size_t m = m0 + 8 * tg + k; const int t = t0 + 8 * tg + k;
            const float r = shifted(proj, m, t, PC_RR + cg, mur), kx = shifted(proj, m, t, PC_RK + cg, muk), v = shifted(proj, m, t, PC_RV + cg, muv);
            run += -0.6065306597126334f * sigmoidf_(w0 + aw[k]); pg[k] = run;
            const float ia = sigmoidf_(a0 + aa[k]);
            float kk = kx * kkc; const float n2 = wave_sum_dpp(kk * kk); kk = kk / fmaxf(sqrtf(n2), 1e-12f);
            const float kpv = kx * (1.0f + (ia - 1.0f) * kac);
            const float bonus = wave_sum_dpp(r * kpv * rkc);
            rg[m * GW + cg] = ag[k]; rbv[m * GW + cg] = bonus * v * ag[k];
            rr[k] = r; kp[k] = kpv; vv[k] = v; na[k] = -kk; bb[k] = kk * ia; }
        GT[tg * 64 + lane] = run;
    }
    __syncthreads();
    {
        float off = 0.f, gL = 0.f;
#pragma unroll
        for (int w = 0; w < 8; ++w) { const float x = GT[w * 64 + lane]; gL += x; off += (w < tg) ? x : 0.f; }
        float bt[8], kt[8];
#pragma unroll
        for (int k = 0; k < 8; ++k) { const int t = 8 * tg + k; const float g = off + pg[k], gp = off + (k > 0 ? pg[k - 1] : 0.f);
            const float eg = __expf(g), egp = __expf(gp), ei = __expf(-g), eL = __expf(gL - g);
            tAH[t * TP + lane] = (bf16)f2bf(na[k] * egp); tRH[t * TP + lane] = (bf16)f2bf(rr[k] * eg); tBH[t * TP + lane] = (bf16)f2bf(bb[k] * ei); tKH[t * TP + lane] = (bf16)f2bf(kp[k] * ei);
            bt[k] = bb[k] * eL; kt[k] = kp[k] * eL; }
        v4u o; o.x = pk2(bt[0], bt[1]); o.y = pk2(bt[2], bt[3]); o.z = pk2(bt[4], bt[5]); o.w = pk2(bt[6], bt[7]); *(LAS v4u*)(tBT + lane * TP + 8 * tg) = o;
        o.x = pk2(kt[0], kt[1]); o.y = pk2(kt[2], kt[3]); o.z = pk2(kt[4], kt[5]); o.w = pk2(kt[6], kt[7]); *(LAS v4u*)(tKT + lane * TP + 8 * tg) = o;
        o.x = pk2(vv[0], vv[1]); o.y = pk2(vv[2], vv[3]); o.z = pk2(vv[4], vv[5]); o.w = pk2(vv[6], vv[7]); *(LAS v4u*)(tVT + lane * TP + 8 * tg) = o;
        if (tg == 0) ((float*)(A.ws + WS_GL))[pair * 64 + lane] = __expf(gL);
    }
    __syncthreads();
    {
        const int mi = wave >> 1, rt = wave & 1;
        const LAS bf16* Am = (mi < 2) ? tAH : tRH; const LAS bf16* Bm = (mi & 1) ? tKH : tBH;
        for (int ct = 0; ct < 2; ++ct) {
            f32x16 acc;
#pragma unroll
            for (int r = 0; r < 16; ++r) acc[r] = 0.f;
            if (!(rt == 0 && ct == 1)) acc = mma32(Am + (32 * rt + r32) * TP + 8 * hi, Bm + (32 * ct + r32) * TP + 8 * hi, 4, acc);
#pragma unroll
            for (int r = 0; r < 16; ++r) { const int t = 32 * rt + crow(r, hi), s = 32 * ct + r32;
                const bool keep = (mi < 2) ? (s < t) : (s <= t); const float val = keep ? acc[r] : 0.f;
                if (mi == 0) NPm[t * 64 + (s & 3) * 16 + (s >> 2)] = val;
                else { LAS bf16* dst = (mi == 1) ? tNK : ((mi == 2) ? tBR : tKR); dst[t * TP + s] = (bf16)f2bf(val); } }
        }
    }
    __syncthreads();
    if (wave < 4) {
        const int rt = wave >> 1, ct = wave & 1;
        f32x16 acc;
#pragma unroll
        for (int r = 0; r < 16; ++r) acc[r] = 0.f;
        acc = mma32(tNK + (32 * rt + r32) * TP + 8 * hi, tVT + (32 * ct + r32) * TP + 8 * hi, 2 * (rt + 1), acc);
#pragma unroll
        for (int r = 0; r < 16; ++r) RHS[(32 * rt + crow(r, hi)) * 64 + 32 * ct + r32] = acc[r];
    }
    __syncthreads();
    {
        const int cl = lane >> 2, p = lane & 3, cidx = 16 * wave + cl;
        float xs[16];
#pragma unroll
        for (int q = 0; q < 16; ++q) xs[q] = 0.f;
        const LAS float* np_ = NPm + p * 16;
#pragma unroll
        for (int t = 0; t < 64; ++t) {
            float part = 0.f;
#pragma unroll
            for (int q4 = 0; q4 < (t + 15) / 16; ++q4) { const f32x4 nv = *(const LAS f32x4*)(np_ + t * 64 + 4 * q4);
                part += (nv.x * xs[4 * q4] + nv.y * xs[4 * q4 + 1]) + (nv.z * xs[4 * q4 + 2] + nv.w * xs[4 * q4 + 3]); }
            part += dpp_xor1(part); part += dpp_xor2(part);
            const float rhs = (wave < 4) ? RHS[t * 64 + cidx] : bf2f(tAH[t * TP + (cidx - 64)]);
            const float xt = rhs + part;
            xs[t >> 2] = (p == (t & 3)) ? xt : xs[t >> 2];
            asm volatile("" ::: "memory");
        }
        LAS bf16* wt = (wave < 4) ? (tW1 + cidx * TP) : (tW2 + (cidx - 64) * TP);
#pragma unroll
        for (int q = 0; q < 16; ++q) wt[4 * q + p] = (bf16)f2bf(xs[q]);
    }
    __syncthreads();
    {
        const int kind = wave >> 1, rt = wave & 1;
        bf16* RTg = (bf16*)(A.ws + WS_RT) + pair * 4096; bf16* PAg = (bf16*)(A.ws + WS_PA) + pair * 4096;
        float* YFg = (float*)(A.ws + WS_YF) + pair * 4096; float* QFg = (float*)(A.ws + WS_QF) + pair * 4096;
        for (int ct = 0; ct < 2; ++ct) {
            f32x16 acc;
            if (kind == 0) {
#pragma unroll
                for (int r = 0; r < 16; ++r) acc[r] = bf2f(tRH[(32 * rt + crow(r, hi)) * TP + 32 * ct + r32]);
                acc = mma32(tBR + (32 * rt + r32) * TP + 8 * hi, tW2 + (32 * ct + r32) * TP + 8 * hi, 2 * (rt + 1), acc);
#pragma unroll
                for (int r = 0; r < 16; ++r) RTg[(32 * rt + crow(r, hi)) * 64 + 32 * ct + r32] = (bf16)f2bf(acc[r]);
            } else if (kind == 1) {
#pragma unroll
                for (int r = 0; r < 16; ++r) acc[r] = 0.f;
                acc = mma32(tBR + (32 * rt + r32) * TP + 8 * hi, tW1 + (32 * ct + r32) * TP + 8 * hi, 2 * (rt + 1), acc);
                acc = mma32(tKR + (32 * rt + r32) * TP + 8 * hi, tVT + (32 * ct + r32) * TP + 8 * hi, 2 * (rt + 1), acc);
                f32x4* dst = (f32x4*)(YFg + (rt * 2 + ct) * 1024 + lane * 16);
#pragma unroll
                for (int q = 0; q < 4; ++q) dst[q] = (f32x4){acc[4 * q], acc[4 * q + 1], acc[4 * q + 2], acc[4 * q + 3]};
            } else if (kind == 2) {
#pragma unroll
                for (int r = 0; r < 16; ++r) acc[r] = 0.f;
                acc = mma32(tBT + (32 * rt + r32) * TP + 8 * hi, tW2 + (32 * ct + r32) * TP + 8 * hi, 4, acc);
#pragma unroll
                for (int r = 0; r < 16; ++r) PAg[(32 * rt + crow(r, hi)) * 64 + 32 * ct + r32] = (bf16)f2bf(acc[r]);
            } else {
#pragma unroll
                for (int r = 0; r < 16; ++r) acc[r] = 0.f;
                acc = mma32(tBT + (32 * rt + r32) * TP + 8 * hi, tW1 + (32 * ct + r32) * TP + 8 * hi, 4, acc);
                acc = mma32(tKT + (32 * rt + r32) * TP + 8 * hi, tVT + (32 * ct + r32) * TP + 8 * hi, 4, acc);
                f32x4* dst = (f32x4*)(QFg + (rt * 2 + ct) * 1024 + lane * 16);
#pragma unroll
                for (int q = 0; q < 4; ++q) dst[q] = (f32x4){acc[4 * q], acc[4 * q + 1], acc[4 * q + 2], acc[4 * q + 3]};
            }
        }
    }
}
__device__ __forceinline__ void rwkv_seq_unit(const Ctx& C, int bh) {
    KA_DECL;
    const int tid = C.tid, lane = C.lane, wave = C.wave, r32 = lane & 31, hi = lane >> 5;
    const bool zw = wave < 4; const int w4 = wave & 3, rt = w4 >> 1, ct = w4 & 1;
    LAS bf16* Zb = (LAS bf16*)C.lds;
    const bf16* Ag = (const bf16*)(A.ws + (zw ? WS_PA : WS_RT)) + (size_t)bh * 64 * 4096 + (32 * rt + r32) * 64 + 8 * hi;
    const float* Cg = (const float*)(A.ws + (zw ? WS_QF : WS_YF)) + (size_t)bh * 64 * 4096 + (rt * 2 + ct) * 1024 + lane * 16;
    const float* GLg = (const float*)(A.ws + WS_GL) + (size_t)bh * 64 * 64 + 32 * rt + 4 * hi;
    float* ry = (float*)(A.ws + WS_RY) + (size_t)(bh >> 3) * T * GW + (bh & 7) * 64;
    f32x16 Z;
#pragma unroll
    for (int r = 0; r < 16; ++r) Z[r] = 0.f;
    __syncthreads();
    for (int i = tid; i < 64 * TP; i += NTHREADS) Zb[i] = 0;
    __syncthreads();
    bf16x8 af[3][4]; f32x4 ci[3][4], gl[3][4];
#define SEQ_LOAD(S, cc) do { const int c_ = (cc) < 64 ? (cc) : 63; _Pragma("unroll") for (int k = 0; k < 4; ++k) { af[S][k] = *(const bf16x8*)(Ag + (size_t)c_ * 4096 + 16 * k); \
        ci[S][k] = *(const f32x4*)(Cg + (size_t)c_ * 4096 + 4 * k); gl[S][k] = *(const f32x4*)(GLg + c_ * 64 + 8 * k); } } while (0)
#define SEQ_STEP(c, S, SN) do { if ((c) < 64) { \
        SEQ_LOAD(SN, (c) + 2); \
        f32x16 acc; \
        _Pragma("unroll") for (int q = 0; q < 4; ++q) { acc[4 * q] = ci[S][q].x; acc[4 * q + 1] = ci[S][q].y; acc[4 * q + 2] = ci[S][q].z; acc[4 * q + 3] = ci[S][q].w; } \
        if (zw) { _Pragma("unroll") for (int q = 0; q < 4; ++q) { acc[4 * q] += gl[S][q].x * Z[4 * q]; acc[4 * q + 1] += gl[S][q].y * Z[4 * q + 1]; acc[4 * q + 2] += gl[S][q].z * Z[4 * q + 2]; acc[4 * q + 3] += gl[S][q].w * Z[4 * q + 3]; } } \
        const LAS bf16* Bp = Zb + ((c) & 1) * 64 * TP + (32 * ct + r32) * TP + 8 * hi; \
        _Pragma("unroll") for (int k = 0; k < 4; ++k) { const bf16x8 bfr = *(const LAS bf16x8*)(Bp + 16 * k); acc = __builtin_amdgcn_mfma_f32_32x32x16_bf16(af[S][k], bfr, acc, 0, 0, 0); } \
        if (zw) { Z = acc; LAS bf16* Zn = Zb + (((c) + 1) & 1) * 64 * TP + (32 * ct + r32) * TP + 32 * rt + 4 * hi; \
            _Pragma("unroll") for (int q = 0; q < 4; ++q) { v2u w; w.x = pk2(acc[4 * q], acc[4 * q + 1]); w.y = pk2(acc[4 * q + 2], acc[4 * q + 3]); *(LAS v2u*)(Zn + 8 * q) = w; } } \
        else { _Pragma("unroll") for (int r = 0; r < 16; ++r) ry[(size_t)(64 * (c) + 32 * rt + crow(r, hi)) * GW + 32 * ct + r32] = acc[r]; } \
        __syncthreads(); } } while (0)
    SEQ_LOAD(0, 0); SEQ_LOAD(1, 1);
    for (int c0 = 0; c0 < 66; c0 += 3) { SEQ_STEP(c0, 0, 2); SEQ_STEP(c0 + 1, 1, 0); SEQ_STEP(c0 + 2, 2, 1); }
#undef SEQ_LOAD
#undef SEQ_STEP
}
__device__ __forceinline__ void ph_rwkv_post(const Ctx& C, int l) {
    KA_DECL;
    const int gw = C.bid * NWAVES + C.wave, NGW = C.G * NWAVES, lane = C.lane;
    const float* RY = (const float*)(A.ws + WS_RY); const float* RG = (const float*)(A.ws + WS_RG); const float* RBV = (const float*)(A.ws + WS_RBV); bf16* ycat = (bf16*)(A.ws + WS_YCAT);
    for (int it = gw; it < M * NH; it += NGW) {
        const int m = it >> 3, h = it & 7, ch = h * 64 + lane;
        const float y = RY[(size_t)m * GW + ch];
        const float mean = wave_sum(y) * (1.0f / 64.0f), d = y - mean, var = wave_sum(d * d) * (1.0f / 64.0f);
        const float yn = d * (1.0f / sqrtf(var + 64e-5f)) * A.in[I_RLG][l * GW + ch] + A.in[I_RLB][l * GW + ch];
        ycat[(size_t)m * D + YC_A + ch] = (bf16)f2bf(yn * RG[(size_t)m * GW + ch] + RBV[(size_t)m * GW + ch]);
    }
}
#ifndef REP_CHUNK
#define REP_CHUNK 1
#endif
#ifndef REP_SWA
#define REP_SWA 1
#endif
#ifndef REP_SGU
#define REP_SGU 1
#endif
#ifndef REP_GIN
#define REP_GIN 1
#endif
#ifndef REP_SCAN
#define REP_SCAN 1
#endif
#ifndef REP_FOX
#define REP_FOX 1
#endif
__device__ __forceinline__ void ph_mix1(const Ctx& C, int l) {
    for (int rep = 0; rep < REP_CHUNK; ++rep) for (int u = C.bid; u < 2048; u += C.G) rwkv_chunk_unit(C, l, u >> 9, (u >> 3) & 63, u & 7);
    for (int rep = 0; rep < REP_SWA; ++rep) for (int v = C.bid; v < 512; v += C.G) attn2_unit<0>(C, l, v >> 7, (v >> 4) & 7, v & 15);
    for (int rep = 0; rep < REP_SGU; ++rep) for (int v = C.bid; v < 256; v += C.G) sgu_unit(C, l, v >> 6, (v >> 1) & 31, v & 1);
}
__device__ __forceinline__ void ph_mix2(const Ctx& C, int l) {
    for (int rep = 0; rep < REP_SCAN; ++rep)
    for (int u = C.bid; u < 32; u += C.G) rwkv_seq_unit(C, u);
    for (int rep = 0; rep < REP_FOX; ++rep)
    for (int i = 0; i * C.G < 512; ++i) { const int u = i * C.G + ((i & 1) ? (C.G - 1 - C.bid) : C.bid); if (u < 512) { const int qb = 15 - (u >> 5), bh = u & 31; attn2_unit<1>(C, l, bh >> 3, bh & 7, qb); } }
}
constexpr int N_PHASES = 2 + 9 * DEPTH;
#define IN(k) (lo <= (k) && (k) < hi)
#define SEAM(k) do { if (IN((k) + 1)) xcd_barrier(bar); } while (0)
template <int l>
__device__ __forceinline__ void layer_phases(const Args& A, const Ctx& C, const XcdBarrier& bar, const int lo, const int hi) {
    bf16* const H = (bf16*)(A.ws + WS_H); bf16* const PROJ = (bf16*)(A.ws + WS_PROJ); bf16* const YCAT = (bf16*)(A.ws + WS_YCAT); bf16* const FB = (bf16*)(A.ws + WS_F);
    constexpr int p0 = 2 + 9 * l;
    const float* xin = (l == 0) ? A.in[I_X] : A.out;
    const float* modl = (const float*)(A.ws + WS_MOD) + (size_t)l * NB * MODW;
    if (IN(p0 + 0)) { ph_norm(C, xin, A.in[I_N1G] + l * D, modl + 0 * D, modl + 1 * D, H); SEAM(p0 + 0); }
    if (IN(p0 + 1)) {
        pg8::Gemm g{H, (const bf16*)(A.ws + WS_WIN) + (size_t)l * NP * D, M, NP, D}; pg8::StaticOrder S; S.init(M, NP, C.G, C.bid);
        pg8::EpiStoreBf16 E{PROJ, NP};
        for (int rep = 0; rep < REP_GIN; ++rep) pg8::gemm_phase<pg8::EpiStoreBf16, pg8::StaticOrder, true, true>(C.lds, g, S, E);
        SEAM(p0 + 1); }
    if (IN(p0 + 2)) { ph_mix1(C, l); SEAM(p0 + 2); }
    if (IN(p0 + 3)) { ph_mix2(C, l); SEAM(p0 + 3); }
    if (IN(p0 + 4)) { ph_rwkv_post(C, l); SEAM(p0 + 4); }
    if (IN(p0 + 5)) {
        pg8::Gemm g{YCAT, (const bf16*)(A.ws + WS_WOUT) + (size_t)l * D * D, M, D, D}; pg8::StaticOrder S; S.init(M, D, C.G, C.bid);
        pg8::EpiResid E{xin, A.out, D, modl + 2 * D, MODW, T};
        pg8::gemm_phase<pg8::EpiResid, pg8::StaticOrder, true, true>(C.lds, g, S, E);
        SEAM(p0 + 5); }
    if (IN(p0 + 6)) { ph_norm(C, A.out, A.in[I_N2G] + l * D, modl + 3 * D, modl + 4 * D, H); SEAM(p0 + 6); }
    if (IN(p0 + 7)) {
        pg8::Gemm g{H, (const bf16*)(A.ws + WS_W13) + (size_t)l * 2 * FF * D, M, 2 * FF, D}; pg8::StaticOrder S; S.init(M, 2 * FF, C.G, C.bid);
        pg8::EpiSwiGLU E{FB, FF};
        pg8::gemm_phase<pg8::EpiSwiGLU, pg8::StaticOrder, true, true>(C.lds, g, S, E);
        SEAM(p0 + 7); }
    if (IN(p0 + 8)) {
        pg8::Gemm g{FB, (const bf16*)(A.ws + WS_W2) + (size_t)l * D * FF, M, D, FF}; pg8::StaticOrder S; S.init(M, D, C.G, C.bid);
        pg8::EpiResid E{A.out, A.out, D, modl + 5 * D, MODW, T};
        pg8::gemm_phase<pg8::EpiResid, pg8::StaticOrder, true, true>(C.lds, g, S, E);
        SEAM(p0 + 8); }
}
__global__ void __launch_bounds__(NTHREADS, 2) fwd_kernel(Args A) {
    extern __shared__ __attribute__((aligned(16))) unsigned char lds_raw[];
    Ctx C; C.lds = (LAS unsigned char*)lds_raw; C.tid = threadIdx.x; C.lane = C.tid & 63; C.wave = __builtin_amdgcn_readfirstlane(C.tid >> 6); C.G = gridDim.x; C.bid = blockIdx.x;
    volatile LAS unsigned* MISC = (volatile LAS unsigned*)(C.lds + MISC_OFF);
    for (int u = C.tid; u < (LDS_BYTES - LDSCTL_OFF) / 4; u += NTHREADS) ((LAS unsigned*)(C.lds + LDSCTL_OFF))[u] = 0u;
    __syncthreads();
    const int lo = A.ph_lo, hi = A.ph_hi;
    const bool multi = (hi - lo) > 1;
    XcdBarrier bar; bar.bar = (unsigned*)(A.ws + WS_CTL) + CW_BAR; bar.x = 0; bar.st = nullptr;
    if (multi) bar = xcd_barrier_post((unsigned*)(A.ws + WS_CTL) + CW_BAR, MISC + 8);
    if (IN(0)) { ph_prologue(C); SEAM(0); }
    if (IN(1)) { ph_modreduce(C); SEAM(1); }
    layer_phases<0>(A, C, bar, lo, hi);
    layer_phases<1>(A, C, bar, lo, hi);
    layer_phases<2>(A, C, bar, lo, hi);
    layer_phases<3>(A, C, bar, lo, hi);
}
#undef IN
#undef SEAM

extern "C" void kernel_launch(void* const* d_in, const int* in_sizes, int n_in, void* d_out, int out_size, void* d_ws, size_t ws_size, hipStream_t stream) {
    static int grid = 0;
    if (grid == 0) {
        if (n_in != N_INPUTS || out_size != M * D || ws_size < WS_END) { fprintf(stderr, "kernel_launch: unexpected problem (n_in %d, out %d, ws %zu; need %zu)\n", n_in, out_size, ws_size, (size_t)WS_END); grid = -1; return; }
        int dev = 0, cus = 0, per_cu = 0;
        if (hipGetDevice(&dev) != hipSuccess || hipDeviceGetAttribute(&cus, hipDeviceAttributeMultiprocessorCount, dev) != hipSuccess) { grid = -1; return; }
        if (hipFuncSetAttribute((const void*)fwd_kernel, hipFuncAttributeMaxDynamicSharedMemorySize, LDS_BYTES) != hipSuccess) { fprintf(stderr, "kernel_launch: hipFuncSetAttribute failed\n"); grid = -1; return; }
        if (hipOccupancyMaxActiveBlocksPerMultiprocessor(&per_cu, (const void*)fwd_kernel, NTHREADS, LDS_BYTES) != hipSuccess || per_cu < 1) fprintf(stderr, "kernel_launch: occupancy query reports %d\n", per_cu);
        (void)hipGetLastError();
        grid = cus;
    }
    if (grid < 0) return;
    (void)hipMemsetAsync((char*)d_ws + WS_CTL, 0, CTL_ZERO_BYTES, stream);
    Args a{};
    for (int i = 0; i < N_INPUTS; ++i) a.in[i] = (const float*)d_in[i];
    a.out = (float*)d_out; a.ws = (unsigned char*)d_ws;
#if MK_ONE_LAUNCH
    a.ph_lo = 0; a.ph_hi = N_PHASES;
    hipLaunchKernelGGL(fwd_kernel, dim3(grid), dim3(NTHREADS), LDS_BYTES, stream, a);
#else
    for (int p = 0; p < N_PHASES; ++p) { a.ph_lo = p; a.ph_hi = p + 1; hipLaunchKernelGGL(fwd_kernel, dim3(grid), dim3(NTHREADS), LDS_BYTES, stream, a); }
#endif
    const hipError_t le = hipPeekAtLastError();
    if (le != hipSuccess) fprintf(stderr, "kernel_launch: launch failed: %s\n", hipGetErrorName(le));
}
```

```cpp
#include <hip/hip_runtime.h>
#include <cstdio>
#include <cstdint>
#ifndef MK_ONE_LAUNCH
#define MK_ONE_LAUNCH 1
#endif
namespace pg8 {
#define PG8_LAS __attribute__((address_space(3)))
typedef unsigned short bf16_t;
typedef short bf16x8 __attribute__((ext_vector_type(8)));
typedef float f32x4 __attribute__((ext_vector_type(4)));
typedef unsigned u32x4 __attribute__((ext_vector_type(4)));
constexpr int BM = 256, BK = 64, HALF = 128, HTB = HALF * BK * 2  , STAGE_BYTES = 8 * HTB, NXCD = 8, WGM = 8;

__host__ __device__ __forceinline__ int lds_byte(int r, int c) { const int st = (r >> 4) * 2 + (c >> 5), rr = r & 15, cc = c & 31, ob = rr * 64 + cc * 2; return st * 1024 + (ob ^ (((ob >> 9) & 1) << 5)); }
__host__ __device__ __forceinline__ void stage_rc(int b, int& R, int& C) { const int st = b / 1024, sb = b % 1024, swz = sb ^ (((sb >> 9) & 1) << 5); R = (st >> 1) * 16 + swz / 64; C = (st & 1) * 32 + (swz % 64) / 2; }
__host__ __device__ __forceinline__ int perm32(int rho) { const int n = rho >> 4, i = rho & 15; return 8 * (i >> 2) + 4 * n + (i & 3); }

struct Unit { int pm, pn; };
struct Gemm { const bf16_t* A; const bf16_t* Bt; int M, N, K; };

struct StaticOrder {
    int nM, nN, nwg, G, c;
    __host__ __device__ void init(int M, int N, int G_, int c_) { nM = M / BM; nN = N / BM; nwg = nM * nN; G = G_; c = c_; }
    __host__ __device__ bool next(int i, Unit& u) const {
        const long L = (long)i * G + c; if (L >= nwg) return false;
        int wgid = (int)L; { const int q = nwg / NXCD, r = nwg % NXCD, xcd = wgid % NXCD, off = wgid / NXCD; wgid = (xcd < r ? xcd * (q + 1) : r * (q + 1) + (xcd - r) * q) + off; }
        const int nig = WGM * nN, gid = wgid / nig, fm = gid * WGM, gsz = (nM - fm) < WGM ? (nM - fm) : WGM;
        u.pm = fm + ((wgid % nig) % gsz); u.pn = (wgid % nig) / gsz; return true;
    }
    __device__ __forceinline__ void a_ready(const Unit&) const {}
    __device__ __forceinline__ void done(const Unit&) const {}
};

__device__ __forceinline__ unsigned cvt_pk_bf16(float lo, float hi) { unsigned r; asm volatile("v_cvt_pk_bf16_f32 %0, %1, %2" : "=v"(r) : "v"(lo), "v"(hi)); return r; }
typedef float f32x2 __attribute__((ext_vector_type(2)));
__device__ __forceinline__ f32x2 gelu_pk(f32x2 v) {
    const f32x2 av = __builtin_elementwise_abs(v), d = av * 0.2316418882f + 1.0f;
    f32x2 t; t.x = __builtin_amdgcn_rcpf(d.x); t.y = __builtin_amdgcn_rcpf(d.y);
    f32x2 q = t * 0.5307027145f + (-0.7265760135f); q = q * t + 0.7107068705f; q = q * t + (-0.142248368f); q = q * t + 0.127414796f; q = q * t;
    const f32x2 s = (v * v) * (-0.72134752044f);
    f32x2 e; e.x = __builtin_amdgcn_exp2f(s.x); e.y = __builtin_amdgcn_exp2f(s.y);
    const f32x2 m = v * (q * e), r = v - m;
    f32x2 o; o.x = v.x < 0.f ? m.x : r.x; o.y = v.y < 0.f ? m.y : r.y; return o;
}

struct EpiStoreBf16 {
    static constexpr bool PERM = true, AFTER_DRAIN = false;
    bf16_t* O; int ldc;
    __device__ __forceinline__ void operator()(const f32x4 (&acc)[2][2][4][2], const Unit& u, int wr, int wc, int fr, int fq) const {
        const int row0 = u.pm * BM + wr * 64 + fr, col0 = u.pn * BM + wc * 32 + 8 * fq;
#pragma unroll
        for (int ai = 0; ai < 2; ++ai)
#pragma unroll
            for (int m = 0; m < 4; ++m) { bf16_t* rowp = O + (size_t)(row0 + ai * HALF + m * 16) * ldc + col0;
#pragma unroll
                for (int bj = 0; bj < 2; ++bj) { const f32x4 v0 = acc[ai][bj][m][0], v1 = acc[ai][bj][m][1];
                    u32x4 w; w.x = cvt_pk_bf16(v0[0], v0[1]); w.y = cvt_pk_bf16(v0[2], v0[3]); w.z = cvt_pk_bf16(v1[0], v1[1]); w.w = cvt_pk_bf16(v1[2], v1[3]);
                    *(u32x4*)(rowp + bj * HALF) = w; } }
    }
};
struct EpiResid {
    static constexpr bool PERM = false, AFTER_DRAIN = false;
    const float* base; float* out; int ldc; const float* gate; int gate_stride; int rows_per_batch;
    __device__ __forceinline__ void operator()(const f32x4 (&acc)[2][2][4][2], const Unit& u, int wr, int wc, int fr, int fq) const {
        const int row0 = u.pm * BM + wr * 64 + fr, col0 = u.pn * BM + wc * 32 + 4 * fq;
        const float* gp = gate + (size_t)((u.pm * BM) / rows_per_batch) * gate_stride + col0;
        f32x4 gv[2][2];
#pragma unroll
        for (int bj = 0; bj < 2; ++bj)
#pragma unroll
            for (int n = 0; n < 2; ++n) gv[bj][n] = *(const f32x4*)(gp + bj * HALF + n * 16);
        f32x4 xb[3][2][2];
#define ER_LOAD(g) do { const size_t off = (size_t)(row0 + ((g) >> 2) * HALF + ((g) & 3) * 16) * ldc + col0; \
            _Pragma("unroll") for (int bj = 0; bj < 2; ++bj) _Pragma("unroll") for (int n = 0; n < 2; ++n) xb[(g) % 3][bj][n] = *(const f32x4*)(base + off + bj * HALF + n * 16); } while (0)
#define ER_STORE(g) do { const size_t off = (size_t)(row0 + ((g) >> 2) * HALF + ((g) & 3) * 16) * ldc + col0; \
            _Pragma("unroll") for (int bj = 0; bj < 2; ++bj) _Pragma("unroll") for (int n = 0; n < 2; ++n) \
                *(f32x4*)(out + off + bj * HALF + n * 16) = xb[(g) % 3][bj][n] + gv[bj][n] * acc[(g) >> 2][bj][(g) & 3][n]; } while (0)
        ER_LOAD(0); ER_LOAD(1); ER_LOAD(2); ER_STORE(0); ER_LOAD(3); ER_STORE(1); ER_LOAD(4); ER_STORE(2); ER_LOAD(5); ER_STORE(3); ER_LOAD(6); ER_STORE(4); ER_LOAD(7); ER_STORE(5); ER_STORE(6); ER_STORE(7);
#undef ER_LOAD
#undef ER_STORE
    }
};
struct EpiSwiGLU {
    static constexpr bool PERM = true, AFTER_DRAIN = false;
    bf16_t* O; int ldc;
    __device__ __forceinline__ void operator()(const f32x4 (&acc)[2][2][4][2], const Unit& u, int wr, int wc, int fr, int fq) const {
        const int row0 = u.pm * BM + wr * 64 + fr, col0 = u.pn * HALF + wc * 32 + 8 * fq;
#pragma unroll
        for (int ai = 0; ai < 2; ++ai)
#pragma unroll
            for (int m = 0; m < 4; ++m) { bf16_t* rowp = O + (size_t)(row0 + ai * HALF + m * 16) * ldc + col0;
                float f[8];
#pragma unroll
                for (int n = 0; n < 2; ++n)
#pragma unroll
                    for (int e = 0; e < 4; ++e) { const float g = acc[ai][0][m][n][e], up = acc[ai][1][m][n][e];
                        f[n * 4 + e] = g * up * __builtin_amdgcn_rcpf(1.0f + __builtin_amdgcn_exp2f(-1.4426950408889634f * g)); }
                u32x4 w; w.x = cvt_pk_bf16(f[0], f[1]); w.y = cvt_pk_bf16(f[2], f[3]); w.z = cvt_pk_bf16(f[4], f[5]); w.w = cvt_pk_bf16(f[6], f[7]);
                *(u32x4*)rowp = w; }
    }
};

template <class Epi, class Sched, bool ALIGN_EPI = false, bool SP2 = false>
__device__ __forceinline__ void gemm_phase(PG8_LAS unsigned char* lds, const Gemm g, const Sched& S, const Epi& E) {
    const int tid = threadIdx.x, wid = __builtin_amdgcn_readfirstlane(tid >> 6), lane = tid & 63, wr = wid >> 2, wc = wid & 3, fr = lane & 15, fq = lane >> 4;
    const int K = g.K, nt = K / BK;
    unsigned voffA[2], voffB[2];
#pragma unroll
    for (int i = 0; i < 2; ++i) { int R, C; stage_rc(tid * 16 + i * 8192, R, C); const int Rb = Epi::PERM ? ((R & ~31) + perm32(R & 31)) : R;
        voffA[i] = (unsigned)(R * K + C) * 2u; voffB[i] = (unsigned)(Rb * K + C) * 2u; }
    const size_t kstep = (size_t)(BK * 2);
    const size_t hstep = (size_t)HALF * K * 2;
    const size_t tstep = 2 * hstep;
    const unsigned ldsw = (unsigned)wid * 1024u;
    const int aoff = lds_byte(wr * 64 + fr, fq * 8), boff = lds_byte(wc * 32 + fr, fq * 8);
#define PG8_SA(b, h) (((b) * 2 + (h)) * HTB)
#define PG8_SB(b, h) ((4 + (b) * 2 + (h)) * HTB)
#define PG8_STAGE(bufoff, gbase, voff) do { _Pragma("unroll") for (int _i = 0; _i < 2; ++_i) \
        __builtin_amdgcn_global_load_lds((const unsigned*)((const char*)(gbase) + (voff)[_i]), (PG8_LAS unsigned*)(lds + (bufoff) + ldsw + _i * 8192), 16, 0, 0); } while (0)
#define PG8_LDA(dst, b, h) do { _Pragma("unroll") for (int m = 0; m < 4; ++m) _Pragma("unroll") for (int k = 0; k < 2; ++k) dst[m][k] = *(const PG8_LAS bf16x8*)(lds + PG8_SA(b, h) + aoff + m * 2048 + k * 1024); } while (0)
#define PG8_LDB(dst, b, h) do { _Pragma("unroll") for (int n = 0; n < 2; ++n) _Pragma("unroll") for (int k = 0; k < 2; ++k) dst[n][k] = *(const PG8_LAS bf16x8*)(lds + PG8_SB(b, h) + boff + n * 2048 + k * 1024); } while (0)
#define PG8_MMA(ai, bj, At, Bt) do { __builtin_amdgcn_s_setprio(1); _Pragma("unroll") for (int m = 0; m < 4; ++m) _Pragma("unroll") for (int n = 0; n < 2; ++n) _Pragma("unroll") for (int k = 0; k < 2; ++k) \
        acc[ai][bj][m][n] = __builtin_amdgcn_mfma_f32_16x16x32_bf16(Bt[n][k], At[m][k], acc[ai][bj][m][n], 0, 0, 0); __builtin_amdgcn_s_setprio(0); } while (0)
#define PG8_WAIT_V(n) asm volatile("s_waitcnt vmcnt(" #n ")" ::: "memory")
#define PG8_WAIT_L(n) asm volatile("s_waitcnt lgkmcnt(" #n ")" ::: "memory")
#define PG8_BAR __builtin_amdgcn_s_barrier()
#define PG8_SCHED __builtin_amdgcn_sched_barrier(0)
    Unit cur, nxt; int ui = 0;
    if (!S.next(0, cur)) return;
    f32x4 acc[2][2][4][2];
#pragma unroll
    for (int a = 0; a < 2; ++a)
#pragma unroll
        for (int b = 0; b < 2; ++b)
#pragma unroll
            for (int m = 0; m < 4; ++m)
#pragma unroll
                for (int n = 0; n < 2; ++n) acc[a][b][m][n] = (f32x4){0.f, 0.f, 0.f, 0.f};
    bf16x8 At[4][2], B0[2][2], B1[2][2];
    const char* cA = (const char*)g.A + (size_t)cur.pm * tstep; const char* cB = (const char*)g.Bt + (size_t)cur.pn * tstep;
    S.a_ready(cur);
    if constexpr (SP2) {
        PG8_STAGE(PG8_SB(0, 0), cB, voffB); PG8_STAGE(PG8_SB(0, 1), cB + hstep, voffB); PG8_STAGE(PG8_SA(0, 0), cA, voffA); PG8_STAGE(PG8_SA(0, 1), cA + hstep, voffA);
        if (wr == 1) PG8_BAR;
        PG8_WAIT_V(2); PG8_BAR;
        PG8_STAGE(PG8_SB(1, 0), cB + kstep, voffB); PG8_STAGE(PG8_SA(1, 0), cA + kstep, voffA); PG8_STAGE(PG8_SB(1, 1), cB + hstep + kstep, voffB);
        PG8_WAIT_V(6); PG8_BAR;
    } else {
        PG8_STAGE(PG8_SB(0, 0), cB, voffB); PG8_STAGE(PG8_SA(0, 0), cA, voffA); PG8_STAGE(PG8_SB(0, 1), cB + hstep, voffB); PG8_STAGE(PG8_SA(0, 1), cA + hstep, voffA);
        if (wr == 1) PG8_BAR;
        PG8_WAIT_V(4); PG8_BAR;
        PG8_STAGE(PG8_SB(1, 0), cB + kstep, voffB); PG8_STAGE(PG8_SA(1, 0), cA + kstep, voffA); PG8_STAGE(PG8_SB(1, 1), cB + hstep + kstep, voffB);
        PG8_WAIT_V(6); PG8_BAR;
    }
    for (;;) {
        const bool has_next = S.next(ui + 1, nxt);
        const char* nA = has_next ? (const char*)g.A + (size_t)nxt.pm * tstep : cA; const char* nB = has_next ? (const char*)g.Bt + (size_t)nxt.pn * tstep : cB;
        for (int t = 0; t < nt; t += 2) {
            const bool last = (t == nt - 2);
            const char* a1 = cA + (size_t)(t + 1) * kstep;
            const char* a2 = last ? nA : cA + (size_t)(t + 2) * kstep; const char* b2 = last ? nB : cB + (size_t)(t + 2) * kstep;
            const char* a3 = a2 + kstep; const char* b3 = b2 + kstep;
            if (last && has_next) S.a_ready(nxt);
            if constexpr (SP2) {
            PG8_LDB(B0, 0, 0); PG8_LDB(B1, 0, 1); PG8_SCHED; PG8_LDA(At, 0, 0); PG8_STAGE(PG8_SA(1, 1), a1 + hstep, voffA);
            PG8_WAIT_V(8); PG8_WAIT_L(0); PG8_BAR; PG8_MMA(0, 0, At, B0); PG8_MMA(0, 1, At, B1); PG8_BAR; PG8_SCHED;
            PG8_LDA(At, 0, 1); PG8_STAGE(PG8_SB(0, 0), b2, voffB); PG8_STAGE(PG8_SB(0, 1), b2 + hstep, voffB); PG8_STAGE(PG8_SA(0, 0), a2, voffA);
            PG8_WAIT_V(8); PG8_WAIT_L(0); PG8_BAR; PG8_MMA(1, 0, At, B0); PG8_MMA(1, 1, At, B1); PG8_BAR; PG8_SCHED;
            PG8_LDB(B0, 1, 0); PG8_LDB(B1, 1, 1); PG8_SCHED; PG8_LDA(At, 1, 0); PG8_STAGE(PG8_SA(0, 1), a2 + hstep, voffA);
            PG8_WAIT_V(8); PG8_WAIT_L(0); PG8_BAR; PG8_MMA(0, 0, At, B0); PG8_MMA(0, 1, At, B1); PG8_BAR; PG8_SCHED;
            PG8_LDA(At, 1, 1); PG8_STAGE(PG8_SB(1, 0), b3, voffB); PG8_STAGE(PG8_SB(1, 1), b3 + hstep, voffB); PG8_STAGE(PG8_SA(1, 0), a3, voffA);
            PG8_WAIT_V(8); PG8_WAIT_L(0); PG8_BAR; PG8_MMA(1, 0, At, B0); PG8_MMA(1, 1, At, B1); PG8_BAR; PG8_SCHED;
            } else {
            PG8_LDB(B0, 0, 0); PG8_SCHED; PG8_LDA(At, 0, 0); PG8_STAGE(PG8_SA(1, 1), a1 + hstep, voffA);
            PG8_WAIT_L(8); PG8_BAR; PG8_WAIT_L(0); PG8_MMA(0, 0, At, B0); PG8_BAR; PG8_SCHED;
            PG8_LDB(B1, 0, 1); PG8_STAGE(PG8_SB(0, 0), b2, voffB);
            PG8_BAR; PG8_WAIT_L(0); PG8_MMA(0, 1, At, B1); PG8_BAR;
            PG8_LDA(At, 0, 1); PG8_STAGE(PG8_SA(0, 0), a2, voffA);
            PG8_BAR; PG8_WAIT_L(0); PG8_MMA(1, 0, At, B0); PG8_BAR; PG8_SCHED;
            PG8_STAGE(PG8_SB(0, 1), b2 + hstep, voffB);
            PG8_WAIT_V(6); PG8_BAR; PG8_MMA(1, 1, At, B1); PG8_BAR;
            PG8_LDB(B0, 1, 0); PG8_SCHED; PG8_LDA(At, 1, 0); PG8_STAGE(PG8_SA(0, 1), a2 + hstep, voffA);
            PG8_WAIT_L(8); PG8_BAR; PG8_WAIT_L(0); PG8_MMA(0, 0, At, B0); PG8_BAR; PG8_SCHED;
            PG8_LDB(B1, 1, 1); PG8_STAGE(PG8_SB(1, 0), b3, voffB);
            PG8_BAR; PG8_WAIT_L(0); PG8_MMA(0, 1, At, B1); PG8_BAR;
            PG8_LDA(At, 1, 1); PG8_STAGE(PG8_SA(1, 0), a3, voffA);
            PG8_BAR; PG8_WAIT_L(0); PG8_MMA(1, 0, At, B0); PG8_BAR; PG8_SCHED;
            PG8_STAGE(PG8_SB(1, 1), b3 + hstep, voffB);
            PG8_WAIT_V(6); PG8_BAR; PG8_MMA(1, 1, At, B1); PG8_BAR;
            }
        }
        if constexpr (ALIGN_EPI) { if (wr == 0) PG8_BAR; }
        if constexpr (!Epi::AFTER_DRAIN) { E(acc, cur, wr, wc, fr, fq); S.done(cur); }
        if (!has_next) break;
#pragma unroll
        for (int a = 0; a < 2; ++a)
#pragma unroll
            for (int b = 0; b < 2; ++b)
#pragma unroll
                for (int m = 0; m < 4; ++m)
#pragma unroll
                    for (int n = 0; n < 2; ++n) acc[a][b][m][n] = (f32x4){0.f, 0.f, 0.f, 0.f};
        cur = nxt; cA = nA; cB = nB; ++ui;
        if constexpr (ALIGN_EPI) { if (wr == 1) PG8_BAR; }
    }
    PG8_WAIT_V(0);
    if constexpr (!ALIGN_EPI) { if (wr == 0) PG8_BAR; }
    PG8_BAR;
    if constexpr (Epi::AFTER_DRAIN) { E.fused(acc, cur, wr, wc, fr, fq, lds, wid, lane); S.done(cur); }
#undef PG8_SA
#undef PG8_SB
#undef PG8_STAGE
#undef PG8_LDA
#undef PG8_LDB
#undef PG8_MMA
#undef PG8_WAIT_V
#undef PG8_WAIT_L
#undef PG8_BAR
#undef PG8_SCHED
}
}
constexpr int NWAVES = 8, NTHREADS = 512;
constexpr int D = 2048, NB = 4, T = 4096, M = NB * T, DEPTH = 4, GW = 512, NH = 8, HD = 64;
constexpr int NIN = 5544, NP = 5632, FF = 5632, MODW = 6 * D;
constexpr int PC_RR = 0, PC_RK = 512, PC_RV = 1024, PC_SQ = 1536, PC_SK = 2048, PC_SV = 2176, PC_GU = 2304, PC_GV = 2816;
constexpr int PC_FQ = 3328, PC_FK = 3840, PC_FV = 4352, PC_FG = 4864, PC_RW = 5376, PC_FL = 5536;
constexpr int YC_A = 0, YC_B = 512, YC_C = 1024, YC_D = 1536;
constexpr int SGU_TRI = 8256;
enum { I_X = 0, I_C, I_WMOD, I_BMOD, I_N1G, I_N2G, I_WIN, I_WOUT, I_RMU, I_RW0, I_RW2, I_RA0, I_RA2, I_RG2, I_RKK, I_RKA, I_RRK, I_RLG, I_RLB,
       I_SQG, I_SKG, I_SSINK, I_GLG, I_GLB, I_GWS, I_GB, I_FQG, I_FKG, I_FFB, I_W1, I_W3, I_W2, N_INPUTS };

constexpr size_t MiB = 1u << 20;
constexpr size_t WS_CTL = 0, CTL_ZERO_BYTES = 1 * MiB;
constexpr size_t WS_MOD = 1 * MiB;
constexpr size_t WS_MODP = 2 * MiB;
constexpr size_t WS_WIN = 8 * MiB;
constexpr size_t WS_WOUT = 96 * MiB;
constexpr size_t WS_W13 = 128 * MiB;
constexpr size_t WS_W2 = 304 * MiB;
constexpr size_t WS_H = 392 * MiB;
constexpr size_t WS_PROJ = 456 * MiB;
constexpr size_t WS_YCAT = 632 * MiB;
constexpr size_t WS_F = 696 * MiB;
constexpr size_t WS_RIN = 872 * MiB;
constexpr size_t WS_RG = 1064 * MiB;
constexpr size_t WS_RY = 1096 * MiB;
constexpr size_t WS_END = 1128 * MiB;
constexpr int CW_BAR = 4096;

constexpr int RING_BYTES = 131072;
constexpr int LDSCTL_OFF = RING_BYTES, MISC_OFF = LDSCTL_OFF + 320;
constexpr int LDS_BYTES = 147456;

#define GAS __attribute__((address_space(1)))
#define LAS __attribute__((address_space(3)))
typedef unsigned short bf16;
typedef short bf16x8 __attribute__((ext_vector_type(8)));
typedef float f32x4 __attribute__((ext_vector_type(4)));
typedef float f32x16 __attribute__((ext_vector_type(16)));
typedef unsigned v4u __attribute__((ext_vector_type(4)));
typedef unsigned v2u __attribute__((ext_vector_type(2)));
#define LDS_WAIT() asm volatile("s_waitcnt lgkmcnt(0)" ::: "memory")
__device__ __forceinline__ float bf2f(unsigned short b) { return __uint_as_float(((unsigned)b) << 16); }
__device__ __forceinline__ unsigned f2bf(float f) { unsigned u = __float_as_uint(f); return (u + 0x7fffu + ((u >> 16) & 1u)) >> 16; }
typedef float f32x2_t __attribute__((ext_vector_type(2))); typedef __bf16 bf16x2_t __attribute__((ext_vector_type(2)));
__device__ __forceinline__ unsigned pk2(float lo, float hi) { const f32x2_t v = {lo, hi}; const bf16x2_t b = __builtin_convertvector(v, bf16x2_t); return __builtin_bit_cast(unsigned, b); }
__device__ __forceinline__ float bflo(unsigned w) { return __uint_as_float(w << 16); }
__device__ __forceinline__ float bfhi(unsigned w) { return __uint_as_float(w & 0xffff0000u); }
__device__ __forceinline__ float wave_sum(float v) {
#pragma unroll
    for (int o = 1; o < 64; o <<= 1) v += __shfl_xor(v, o);
    return v;
}
__device__ __forceinline__ float sigmoidf_(float x) { return __builtin_amdgcn_rcpf(1.0f + __expf(-x)); }
__device__ __forceinline__ float gelu_f(float v) {
    const float av = fabsf(v), t = __builtin_amdgcn_rcpf(av * 0.2316418882f + 1.0f);
    float q = t * 0.5307027145f + (-0.7265760135f); q = q * t + 0.7107068705f; q = q * t + (-0.142248368f); q = q * t + 0.127414796f; q = q * t;
    const float e = __builtin_amdgcn_exp2f((v * v) * (-0.72134752044f));
    const float m = v * (q * e);
    return v < 0.f ? m : v - m;
}
__device__ __forceinline__ int crow(int r, int hi) { return (r & 3) + 8 * (r >> 2) + 4 * hi; }

#define XB_TMO      128
#define XB_XCNT(j)  (256  + 64 * (j))
#define XB_XSUB(j)  (1280 + 64 * (j))
#define XB_XGEN(j)  (2304 + 64 * (j))
#define XB_TOP      3328
#define XB_TOPGEN   3392
#define XCD_BAR_WORDS 3456
#define XB_SPIN_CAP (1u << 18)

__device__ __forceinline__ unsigned xb_ld(unsigned* p)              { return __hip_atomic_load(p, __ATOMIC_RELAXED, __HIP_MEMORY_SCOPE_AGENT); }
__device__ __forceinline__ unsigned xb_add(unsigned* p, unsigned v) { return __hip_atomic_fetch_add(p, v, __ATOMIC_RELAXED, __HIP_MEMORY_SCOPE_AGENT); }
__device__ __forceinline__ unsigned xb_xcc_id() { return (unsigned)__builtin_amdgcn_s_getreg((3 << 11) | 20) & 0xFu; }
#define XB_SPIN(cond, bar) do { unsigned _sp = 0; while (cond) { __builtin_amdgcn_s_sleep(1); \
    if ((++_sp & 255u) == 0u) { if (xb_ld(&(bar)[XB_TMO])) break; if (_sp > XB_SPIN_CAP) { atomicAdd(&(bar)[XB_TMO], 1u); break; } } } } while (0)

struct XcdBarrier {
    unsigned* bar; unsigned x;
    volatile LAS unsigned* st;
};

__device__ __forceinline__ XcdBarrier xcd_barrier_post(unsigned* bar, volatile LAS unsigned* st) {
    XcdBarrier b; b.bar = bar; b.x = xb_xcc_id(); b.st = st;
    if (threadIdx.x == 0) (void)xb_add(&bar[XB_XCNT(b.x)], 1u);
    return b;
}
__device__ __forceinline__ void xcd_barrier_complete(unsigned* bar, unsigned x, unsigned& nloc, unsigned& nx) {
    const unsigned G = gridDim.x * gridDim.y * gridDim.z;
    unsigned sum, cnt, mine, sp = 0u;
    for (;;) {
        sum = 0u; cnt = 0u; mine = 0u;
#pragma unroll
        for (unsigned j = 0; j < 16; ++j) { const unsigned c = xb_ld(&bar[XB_XCNT(j)]); sum += c; cnt += (c > 0u) ? 1u : 0u; mine = (j == x) ? c : mine; }
        if (sum == G) break;
        __builtin_amdgcn_s_sleep(1);
        if ((++sp & 255u) == 0u) { if (xb_ld(&bar[XB_TMO])) break; if (sp > XB_SPIN_CAP) { atomicAdd(&bar[XB_TMO], 1u); break; } }
    }
    nloc = mine > 0u ? mine : 1u; nx = cnt > 0u ? cnt : 1u;
}

__device__ __forceinline__ void xcd_barrier(const XcdBarrier& b) {
    asm volatile("s_waitcnt vmcnt(0)" ::: "memory");
    __syncthreads();
    if (threadIdx.x == 0) {
        unsigned* bar = b.bar;
        __builtin_amdgcn_s_waitcnt(0);
        unsigned nloc = b.st[0], nx = b.st[1];
        if (nloc == 0u) { xcd_barrier_complete(bar, b.x, nloc, nx); b.st[0] = nloc; b.st[1] = nx; }
        const unsigned old = xb_add(&bar[XB_XSUB(b.x)], 1u);
        const unsigned gen = old / nloc;
        if (old + 1u == (gen + 1u) * nloc) {
            __builtin_amdgcn_fence(__ATOMIC_RELEASE, "agent");
            asm volatile("s_waitcnt vmcnt(0)" ::: "memory");
            const unsigned og = xb_add(&bar[XB_TOP], 1u);
            const unsigned tg = og / nx;
            if (og + 1u == (tg + 1u) * nx) xb_add(&bar[XB_TOPGEN], 1u);
            else XB_SPIN(xb_ld(&bar[XB_TOPGEN]) == tg, bar);
            __builtin_amdgcn_fence(__ATOMIC_ACQUIRE, "agent");
            xb_add(&bar[XB_XGEN(b.x)], 1u);
            asm volatile("s_waitcnt vmcnt(0)" ::: "memory");
        } else {
            XB_SPIN(xb_ld(&bar[XB_XGEN(b.x)]) == gen, bar);
            __builtin_amdgcn_fence(__ATOMIC_ACQUIRE, "agent");
            asm volatile("s_waitcnt vmcnt(0)" ::: "memory");
        }
    }
    __syncthreads();
}

struct Args { const float* in[N_INPUTS]; float* out; unsigned char* ws; int ph_lo, ph_hi; };
static_assert(sizeof(Args) == (N_INPUTS + 2) * 8 + 8, "Args has no padding");

struct Ctx {
    LAS unsigned char* lds; int tid, lane, wave, G, bid;
};
typedef const Args __attribute__((address_space(4))) KArgs;
__device__ __forceinline__ KArgs* ka_ptr() { KArgs* p = (KArgs*)__builtin_amdgcn_kernarg_segment_ptr(); asm volatile("" : "+s"(p)); return p; }
#define KA_DECL KArgs& A = *ka_ptr()
#define LBAR() do { asm volatile("s_waitcnt lgkmcnt(0)" ::: "memory"); __builtin_amdgcn_s_barrier(); asm volatile("" ::: "memory"); } while (0)

__device__ __forceinline__ void tr_item(const float* __restrict__ W, int N, int col0, int nvalid, int k0, bf16* __restrict__ WT, int K, int n0, LAS float* scr, int lane) {
    float wv[32];
    const int nn = lane & 31; const bool okc = nn < nvalid; const float* wp = W + (size_t)(k0 + (lane >> 5)) * N + col0 + (okc ? nn : 0);
#pragma unroll
    for (int i = 0; i < 32; ++i) wv[i] = wp[(size_t)(2 * i) * N];
#pragma unroll
    for (int i = 0; i < 32; ++i) scr[(2 * i + (lane >> 5)) * 33 + nn] = okc ? wv[i] : 0.f;
    LDS_WAIT(); asm volatile("" ::: "memory");
    const int c = lane & 7;
#pragma unroll
    for (int j = 0; j < 4; ++j) { const int n = (lane >> 3) + 8 * j; const LAS float* s = scr + (8 * c) * 33 + n;
        v4u o; o.x = pk2(s[0 * 33], s[1 * 33]); o.y = pk2(s[2 * 33], s[3 * 33]); o.z = pk2(s[4 * 33], s[5 * 33]); o.w = pk2(s[6 * 33], s[7 * 33]);
        *(v4u*)(WT + (size_t)(n0 + n) * K + k0 + 8 * c) = o; }
    LDS_WAIT(); asm volatile("" ::: "memory");
}
__device__ __forceinline__ void ph_prologue(const Ctx& C) {
    KA_DECL;
    LAS float* csilu = (LAS float*)(C.lds + 73728);
    for (int i = C.tid; i < NB * D; i += NTHREADS) { const float c = A.in[I_C][i]; csilu[i] = c / (1.0f + __expf(-c)); }
    __syncthreads();
    LAS float* scr = (LAS float*)(C.lds + C.wave * 8704);
    const int gw = C.bid * NWAVES + C.wave, NGW = C.G * NWAVES;
    constexpr int I_IN = (D / 64) * (NP / 32), I_OUT = (D / 64) * (D / 32), I_13 = (D / 64) * (2 * FF / 32), I_2 = (FF / 64) * (D / 32), PER_L = I_IN + I_OUT + I_13 + I_2;
    for (int it = gw; it < DEPTH * PER_L; it += NGW) {
        const int l = it / PER_L; int r = it % PER_L;
        if (r < I_IN) { const int kb = r / (NP / 32), nb = r % (NP / 32), n0 = 32 * nb; int col0, nv = 32;
            if (n0 < 1536) col0 = n0; else if (n0 < 4864) col0 = n0 + 160; else if (n0 < 5376) col0 = n0 + 168; else if (n0 < 5536) col0 = n0 - 3840;
            else if (n0 == 5536) { col0 = 5024; nv = 8; } else { col0 = 0; nv = 0; }
            tr_item(A.in[I_WIN] + (size_t)l * D * NIN, NIN, col0, nv, 64 * kb, (bf16*)(A.ws + WS_WIN) + (size_t)l * NP * D, D, n0, scr, C.lane); continue; }
        r -= I_IN;
        if (r < I_OUT) { const int kb = r / (D / 32), nb = r % (D / 32);
            tr_item(A.in[I_WOUT] + (size_t)l * D * D, D, 32 * nb, 32, 64 * kb, (bf16*)(A.ws + WS_WOUT) + (size_t)l * D * D, D, 32 * nb, scr, C.lane); continue; }
        r -= I_OUT;
        if (r < I_13) { const int kb = r / (2 * FF / 32), nb = r % (2 * FF / 32), n0 = 32 * nb, pn = n0 >> 8, j = n0 & 255;
            const float* src = (j < 128 ? A.in[I_W1] : A.in[I_W3]) + (size_t)l * D * FF;
            tr_item(src, FF, 128 * pn + (j & 127), 32, 64 * kb, (bf16*)(A.ws + WS_W13) + (size_t)l * 2 * FF * D, D, n0, scr, C.lane); continue; }
        r -= I_13;
        { const int kb = r / (D / 32), nb = r % (D / 32);
            tr_item(A.in[I_W2] + (size_t)l * FF * D, D, 32 * nb, 32, 64 * kb, (bf16*)(A.ws + WS_W2) + (size_t)l * D * FF, FF, 32 * nb, scr, C.lane); }
    }
    for (int it = gw; it < 8 * DEPTH * (MODW / 256); it += NGW) {
        const int cg = it % (DEPTH * (MODW / 256)), ks = it / (DEPTH * (MODW / 256)), l = cg / (MODW / 256), n0 = (cg % (MODW / 256)) * 256, k0 = ks * 256;
        const float* wp = A.in[I_WMOD] + ((size_t)l * D + k0) * MODW + n0 + 4 * C.lane;
        f32x4 a0 = {0.f, 0.f, 0.f, 0.f}, a1 = a0, a2 = a0, a3 = a0;
#pragma unroll 16
        for (int k = 0; k < 256; ++k) { const f32x4 w = *(const f32x4*)(wp + (size_t)k * MODW);
            a0 += w * csilu[0 * D + k0 + k]; a1 += w * csilu[1 * D + k0 + k]; a2 += w * csilu[2 * D + k0 + k]; a3 += w * csilu[3 * D + k0 + k]; }
        float* mp = (float*)(A.ws + WS_MODP) + ((size_t)(ks * DEPTH + l) * NB) * MODW + n0 + 4 * C.lane;
        *(f32x4*)(mp + 0 * MODW) = a0; *(f32x4*)(mp + 1 * MODW) = a1; *(f32x4*)(mp + 2 * MODW) = a2; *(f32x4*)(mp + 3 * MODW) = a3;
    }
}
__device__ __forceinline__ void ph_modreduce(const Ctx& C) {
    KA_DECL;
    const float* mp = (const float*)(A.ws + WS_MODP); float* mod = (float*)(A.ws + WS_MOD);
    for (int i = C.bid * NTHREADS + C.tid; i < DEPTH * NB * MODW; i += C.G * NTHREADS) {
        const int l = i / (NB * MODW), n = i % MODW; float s = A.in[I_BMOD][l * MODW + n];
#pragma unroll
        for (int ks = 0; ks < 8; ++ks) s += mp[(size_t)ks * DEPTH * NB * MODW + i];
        mod[i] = s;
    }
}
__device__ __forceinline__ void ph_norm(const Ctx& C, const float* x, const float* g, const float* shift, const float* scale, bf16* H) {
    const int gw = C.bid * NWAVES + C.wave, NGW = C.G * NWAVES;
    for (int m = gw; m < M; m += NGW) {
        const int b = m / T; const f32x4* xr = (const f32x4*)(x + (size_t)m * D) + C.lane;
        f32x4 v[8]; float ss = 0.f;
#pragma unroll
        for (int j = 0; j < 8; ++j) { v[j] = xr[64 * j]; ss += (v[j].x * v[j].x + v[j].y * v[j].y) + (v[j].z * v[j].z + v[j].w * v[j].w); }
        const float rstd = 1.0f / sqrtf(wave_sum(ss) * (1.0f / D) + 1e-6f);
        unsigned long long* o8 = (unsigned long long*)(H + (size_t)m * D) + C.lane;
        f32x4 cv[8], sh[8];
#pragma unroll
        for (int j = 0; j < 8; ++j) { const int c = 4 * (C.lane + 64 * j);
            const f32x4 gg = *(const f32x4*)(g + c), sc = *(const f32x4*)(scale + (size_t)b * MODW + c); sh[j] = *(const f32x4*)(shift + (size_t)b * MODW + c); cv[j] = gg * (sc + 1.0f); }
#pragma unroll
        for (int j = 0; j < 8; ++j) { const f32x4 y = v[j] * rstd * cv[j] + sh[j];
            o8[64 * j] = (unsigned long long)pk2(y.x, y.y) | ((unsigned long long)pk2(y.z, y.w) << 32); }
    }
}

__device__ __forceinline__ float dpp_xor1(float v) { return __builtin_bit_cast(float, __builtin_amdgcn_update_dpp(0, __builtin_bit_cast(int, v), 0xB1, 0xF, 0xF, true)); }
__device__ __forceinline__ float dpp_xor2(float v) { return __builtin_bit_cast(float, __builtin_amdgcn_update_dpp(0, __builtin_bit_cast(int, v), 0x4E, 0xF, 0xF, true)); }
__device__ __forceinline__ float wave_sum_dpp(float v) {
    v += dpp_xor1(v); v += dpp_xor2(v);
    v += __builtin_bit_cast(float, __builtin_amdgcn_update_dpp(0, __builtin_bit_cast(int, v), 0x141, 0xF, 0xF, true));
    v += __builtin_bit_cast(float, __builtin_amdgcn_update_dpp(0, __builtin_bit_cast(int, v), 0x140, 0xF, 0xF, true));
    const int b = __builtin_bit_cast(int, v);
    return (__builtin_bit_cast(float, __builtin_amdgcn_readlane(b, 0)) + __builtin_bit_cast(float, __builtin_amdgcn_readlane(b, 16))) +
           (__builtin_bit_cast(float, __builtin_amdgcn_readlane(b, 32)) + __builtin_bit_cast(float, __builtin_amdgcn_readlane(b, 48)));
}

__device__ __forceinline__ f32x16 mma32(const LAS bf16* Ap, const LAS bf16* Bp, int ksteps, f32x16 acc) {
    for (int k = 0; k < ksteps; ++k) { const bf16x8 a = *(const LAS bf16x8*)(Ap + 16 * k), b = *(const LAS bf16x8*)(Bp + 16 * k);
        acc = __builtin_amdgcn_mfma_f32_32x32x16_bf16(a, b, acc, 0, 0, 0); }
    return acc;
}
constexpr int AP = 72;
constexpr size_t WS_QF = WS_RIN, WS_YF = WS_RIN + 32 * MiB, WS_PA = WS_RIN + 64 * MiB, WS_RT = WS_RIN + 80 * MiB, WS_GL = WS_RIN + 96 * MiB, WS_RBV = WS_RIN + 97 * MiB;
constexpr size_t WS_CUM = WS_RIN + 170 * MiB;
constexpr size_t WS_KNF = WS_RIN + 130 * MiB, WS_KNS = WS_RIN + 146 * MiB, WS_VTF = WS_RIN + 150 * MiB, WS_VTS = WS_RIN + 166 * MiB;
__device__ __forceinline__ void kvprep_unit(const Ctx& C, int l, int u) {
    KA_DECL; asm volatile("" : "+s"(l));
    const bf16* proj = (const bf16*)(A.ws + WS_PROJ);
    int tid = C.tid; asm volatile("" : "+v"(tid));
    const size_t m0 = (size_t)u * 64; const int b = (int)(m0 / T), t0 = (int)(m0 % T);
    bf16* KNF = (bf16*)(A.ws + WS_KNF); bf16* KNS = (bf16*)(A.ws + WS_KNS); bf16* VTF = (bf16*)(A.ws + WS_VTF); bf16* VTS = (bf16*)(A.ws + WS_VTS);
    LAS bf16* Vl = (LAS bf16*)C.lds;
    LBAR();
    float gF[8], gS[8];
#pragma unroll
    for (int i = 0; i < 8; ++i) { gF[i] = A.in[I_FKG][l * 64 + 8 * (tid & 7) + i]; gS[i] = A.in[I_SKG][l * 64 + 8 * (tid & 7) + i]; }
    for (int half = 0; half < 2; ++half) {
        v4u krr[5];
#pragma unroll
        for (int it = 0; it < 5; ++it) { const int i = tid + NTHREADS * (5 * half + it), tok = i / 80, ch = i % 80;
            krr[it] = *(const v4u*)(proj + (m0 + tok) * NP + ((ch < 64) ? PC_FK + 8 * ch : PC_SK + 8 * (ch - 64))); }
#pragma unroll
        for (int it = 0; it < 5; ++it) { const int i = tid + NTHREADS * (5 * half + it), tok = i / 80, ch = i % 80; const size_t m = m0 + tok;
            const bool fox = ch < 64;
            float g[8];
#pragma unroll
            for (int q = 0; q < 8; ++q) g[q] = fox ? gF[q] : gS[q];
            const v4u kr = krr[it];
            float f[8]; f[0] = bflo(kr.x); f[1] = bfhi(kr.x); f[2] = bflo(kr.y); f[3] = bfhi(kr.y); f[4] = bflo(kr.z); f[5] = bfhi(kr.z); f[6] = bflo(kr.w); f[7] = bfhi(kr.w);
            float ss = ((f[0] * f[0] + f[1] * f[1]) + (f[2] * f[2] + f[3] * f[3])) + ((f[4] * f[4] + f[5] * f[5]) + (f[6] * f[6] + f[7] * f[7]));
            ss += dpp_xor1(ss); ss += dpp_xor2(ss); ss += __shfl_xor(ss, 4);
            const float rs = __builtin_amdgcn_rsqf(ss * (1.0f / 64.0f) + 1e-6f);
            v4u ko; ko.x = pk2(f[0] * rs * g[0], f[1] * rs * g[1]); ko.y = pk2(f[2] * rs * g[2], f[3] * rs * g[3]); ko.z = pk2(f[4] * rs * g[4], f[5] * rs * g[5]); ko.w = pk2(f[6] * rs * g[6], f[7] * rs * g[7]);
            if (fox) *(v4u*)(KNF + m * 512 + 8 * ch) = ko; else *(v4u*)(KNS + m * 128 + 8 * (ch - 64)) = ko; }
    }
#pragma unroll
    for (int it = 0; it < 10; ++it) { const int i = tid + NTHREADS * it, head = i >> 9, rem = i & 511, tok = rem >> 3, dc = rem & 7;
        const int scol = (head < 8) ? PC_FV + head * 64 + 8 * dc : PC_SV + (head - 8) * 64 + 8 * dc;
        *(LAS v4u*)(Vl + (head * 64 + tok) * AP + 8 * dc) = *(const v4u*)(proj + (m0 + tok) * NP + scol); }
    LBAR();
    for (int it = 0; it < 10; ++it) { const int i = tid + NTHREADS * it, head = i >> 9, rem = i & 511, d = rem >> 3, tc = rem & 7;
        const LAS bf16* src = Vl + (head * 64 + 8 * tc) * AP + d;
        v4u o; o.x = (unsigned)src[0] | ((unsigned)src[AP] << 16); o.y = (unsigned)src[2 * AP] | ((unsigned)src[3 * AP] << 16); o.z = (unsigned)src[4 * AP] | ((unsigned)src[5 * AP] << 16); o.w = (unsigned)src[6 * AP] | ((unsigned)src[7 * AP] << 16);
        bf16* dst = (head < 8) ? VTF + ((size_t)(b * 8 + head) * 64 + d) * T : VTS + ((size_t)(b * 2 + head - 8) * 64 + d) * T;
        *(v4u*)(dst + t0 + 8 * tc) = o; }
}
__device__ __forceinline__ void cumprep_unit(const Ctx& C, int l, int bh) {
    KA_DECL; asm volatile("" : "+s"(l));
    const bf16* proj = (const bf16*)(A.ws + WS_PROJ); float* cumg = (float*)(A.ws + WS_CUM) + (size_t)bh * T;
    const int tid = C.tid, lane = C.lane, wave = C.wave, b = bh >> 3, h = bh & 7; const size_t rowb = (size_t)b * T;
    LAS float* WT = (LAS float*)C.lds;
    const float fb = A.in[I_FFB][l * NH + h];
    LBAR();
    float loc[8]; float s = 0.f;
    bf16 xr[8];
#pragma unroll
    for (int i = 0; i < 8; ++i) xr[i] = proj[(rowb + 8 * tid + i) * NP + PC_FL + h];
#pragma unroll
    for (int i = 0; i < 8; ++i) { const float x = bf2f(xr[i]) + fb;
        const float e_ = __expf(-fabsf(x)); const float v = fminf(x, 0.f) - __logf(1.0f + e_); s += v; loc[i] = s; }
    float ws_ = s;
#pragma unroll
    for (int o = 1; o < 64; o <<= 1) { const float t_ = __shfl_up(ws_, o); if (lane >= o) ws_ += t_; }
    if (lane == 63) WT[wave] = ws_;
    LBAR();
    float base = ws_ - s;
    for (int w = 0; w < wave; ++w) base += WT[w];
    f32x4 o0 = {(base + loc[0]) * 1.4426950408889634f, (base + loc[1]) * 1.4426950408889634f, (base + loc[2]) * 1.4426950408889634f, (base + loc[3]) * 1.4426950408889634f};
    f32x4 o1 = {(base + loc[4]) * 1.4426950408889634f, (base + loc[5]) * 1.4426950408889634f, (base + loc[6]) * 1.4426950408889634f, (base + loc[7]) * 1.4426950408889634f};
    *(f32x4*)(cumg + 8 * tid) = o0; *(f32x4*)(cumg + 8 * tid + 4) = o1;
}
constexpr int B_K = 0, B_VT = 18432, B_CUM = 36864, B_WT = 53248;
__device__ __forceinline__ float max3f(float a, float b, float c) { float r; asm("v_max3_f32 %0, %1, %2, %3" : "=v"(r) : "v"(a), "v"(b), "v"(c)); return r; }
__device__ __forceinline__ float max_halves(float m) { auto rr = __builtin_amdgcn_permlane32_swap(__float_as_uint(m), __float_as_uint(m), false, false); return fmaxf(__uint_as_float(rr[0]), __uint_as_float(rr[1])); }
__device__ __forceinline__ float sum_halves(float m) { auto rr = __builtin_amdgcn_permlane32_swap(__float_as_uint(m), __float_as_uint(m), false, false); return __uint_as_float(rr[0]) + __uint_as_float(rr[1]); }
template <int MODE>
__device__ __forceinline__ void attn2_unit(const Ctx& C, int l, int b, int h, int qb) {
    KA_DECL; asm volatile("" : "+s"(l));
    const bf16* proj = (const bf16*)(A.ws + WS_PROJ); bf16* ycat = (bf16*)(A.ws + WS_YCAT);
    int tid = C.tid; asm volatile("" : "+v"(tid));
    const int lane = tid & 63, wave = C.wave, r32 = lane & 31, hi = lane >> 5;
    const int q0 = qb * 256; const size_t rowb = (size_t)b * T;
    const int qcol = (MODE == 0 ? PC_SQ : PC_FQ) + h * 64;
    const bf16* KN = (MODE == 0) ? (const bf16*)(A.ws + WS_KNS) + (h >> 2) * 64 : (const bf16*)(A.ws + WS_KNF) + h * 64;
    constexpr int KPI = (MODE == 0) ? 128 : 512;
    const bf16* VT = (MODE == 0) ? (const bf16*)(A.ws + WS_VTS) + (size_t)(b * 2 + (h >> 2)) * 64 * T : (const bf16*)(A.ws + WS_VTF) + (size_t)(b * 8 + h) * 64 * T;
    const float* qg = A.in[MODE == 0 ? I_SQG : I_FQG] + l * 64;
    LAS bf16* Ks = (LAS bf16*)(C.lds + B_K); LAS bf16* Vt = (LAS bf16*)(C.lds + B_VT); LAS float* cum = (LAS float*)(C.lds + B_CUM); LAS float* WT = (LAS float*)(C.lds + B_WT);
    constexpr float LOG2E = 1.4426950408889634f;
    LBAR();
    if (MODE == 1) {
        const float* cumg = (const float*)(A.ws + WS_CUM) + (size_t)(b * NH + h) * T;
        for (int i = tid; i < (q0 + 256) / 4; i += NTHREADS) *(LAS f32x4*)(cum + 4 * i) = *(const f32x4*)(cumg + 4 * i);
    }
    const int qp = q0 + 32 * wave + r32;
    bf16x8 qf[4];
    {
        const bf16* src = proj + (rowb + qp) * NP + qcol + 8 * hi;
        v4u raw[4]; float ss = 0.f;
#pragma unroll
        for (int s4 = 0; s4 < 4; ++s4) { raw[s4] = *(const v4u*)(src + 16 * s4);
            const float f0 = bflo(raw[s4].x), f1 = bfhi(raw[s4].x), f2 = bflo(raw[s4].y), f3 = bfhi(raw[s4].y), f4 = bflo(raw[s4].z), f5 = bfhi(raw[s4].z), f6 = bflo(raw[s4].w), f7 = bfhi(raw[s4].w);
            ss += ((f0 * f0 + f1 * f1) + (f2 * f2 + f3 * f3)) + ((f4 * f4 + f5 * f5) + (f6 * f6 + f7 * f7)); }
        ss = sum_halves(ss);
        const float rs = (0.125f * LOG2E) / sqrtf(ss * (1.0f / 64.0f) + 1e-6f);
#pragma unroll
        for (int s4 = 0; s4 < 4; ++s4) { const float* g8 = qg + 16 * s4 + 8 * hi; v4u o;
            o.x = pk2(bflo(raw[s4].x) * rs * g8[0], bfhi(raw[s4].x) * rs * g8[1]); o.y = pk2(bflo(raw[s4].y) * rs * g8[2], bfhi(raw[s4].y) * rs * g8[3]);
            o.z = pk2(bflo(raw[s4].z) * rs * g8[4], bfhi(raw[s4].z) * rs * g8[5]); o.w = pk2(bflo(raw[s4].w) * rs * g8[6], bfhi(raw[s4].w) * rs * g8[7]);
            qf[s4] = __builtin_bit_cast(bf16x8, o); }
    }
    int ks_begin = (MODE == 0) ? (q0 >= 128 ? q0 - 128 : 0) : 0; const int ks_end = q0 + 256;
    if (MODE == 1) {
        const float* cumg = (const float*)(A.ws + WS_CUM) + (size_t)(b * NH + h) * T;
        float gq = fabsf(qg[lane]), gk = fabsf(A.in[I_FKG][l * 64 + lane]);
#pragma unroll
        for (int o = 1; o < 64; o <<= 1) { gq = fmaxf(gq, __shfl_xor(gq, o)); gk = fmaxf(gk, __shfl_xor(gk, o)); }
        const float B2 = 8.0f * LOG2E * gq * gk * 1.05f;
        const int ntile = q0 >> 6;
        const bool skip = (lane < ntile) && (cumg[q0] - cumg[64 * lane + 63] + 2.0f * B2 < -172.0f);
        ks_begin = 64 * __builtin_popcountll(__ballot(skip));
    }
    const int srow = tid >> 3, sdc = (tid & 7) * 8;
    v4u kreg[2], vreg[2];
#define A2_LOAD(S_, ks_) do { kreg[S_] = *(const v4u*)(KN + (rowb + (ks_) + srow) * KPI + sdc); vreg[S_] = *(const v4u*)(VT + (size_t)srow * T + (ks_) + sdc); } while (0)
#define A2_STAGE(S_, buf_) do { *(LAS v4u*)(Ks + (buf_) * 64 * AP + srow * AP + sdc) = kreg[S_]; *(LAS v4u*)(Vt + (buf_) * 64 * AP + srow * AP + sdc) = vreg[S_]; } while (0)
    A2_LOAD(0, ks_begin); A2_LOAD(1, ks_begin + 64);
    A2_STAGE(0, 0);
    if (ks_begin + 128 < ks_end) A2_LOAD(0, ks_begin + 128);
    float m_run = -1e30f, l_run = 0.f;
    f32x16 o0, o1, cqv;
#pragma unroll
    for (int r = 0; r < 16; ++r) { o0[r] = 0.f; o1[r] = 0.f; cqv[r] = 0.f; }
    const int qmax = q0 + 32 * wave + 31, qmin = q0 + 32 * wave;
    int buf = 0;
    for (int ks = ks_begin; ks < ks_end; ks += 64, buf ^= 1) {
        LBAR();
        if (MODE == 1 && ks == ks_begin) { const float cq = cum[qp];
#pragma unroll
            for (int r = 0; r < 16; ++r) cqv[r] = cq; }
        if (ks + 64 < ks_end) { if (buf == 0) { A2_STAGE(1, 1); if (ks + 192 < ks_end) A2_LOAD(1, ks + 192); } else { A2_STAGE(0, 0); if (ks + 192 < ks_end) A2_LOAD(0, ks + 192); } }
        const bool live = (MODE == 1) ? (ks <= qmax) : (ks <= qmax && ks + 63 > qmin - 128);
        if (live) {
            const LAS bf16* kb = Ks + buf * 64 * AP + r32 * AP + 8 * hi;
            f32x16 p0, p1;
#pragma unroll
            for (int s4 = 0; s4 < 4; ++s4) { const bf16x8 k0 = *(const LAS bf16x8*)(kb + 16 * s4), k1 = *(const LAS bf16x8*)(kb + 32 * AP + 16 * s4);
                if (s4 == 0) { p0 = __builtin_amdgcn_mfma_f32_32x32x16_bf16(k0, qf[0], cqv, 0, 0, 0); p1 = __builtin_amdgcn_mfma_f32_32x32x16_bf16(k1, qf[0], cqv, 0, 0, 0); }
                else { p0 = __builtin_amdgcn_mfma_f32_32x32x16_bf16(k0, qf[s4], p0, 0, 0, 0); p1 = __builtin_amdgcn_mfma_f32_32x32x16_bf16(k1, qf[s4], p1, 0, 0, 0); } }
            if (MODE == 1) {
#pragma unroll
                for (int q4 = 0; q4 < 4; ++q4) { const f32x4 c0 = *(const LAS f32x4*)(cum + ks + 8 * q4 + 4 * hi), c1 = *(const LAS f32x4*)(cum + ks + 32 + 8 * q4 + 4 * hi);
                    p0[4 * q4] -= c0.x; p0[4 * q4 + 1] -= c0.y; p0[4 * q4 + 2] -= c0.z; p0[4 * q4 + 3] -= c0.w;
                    p1[4 * q4] -= c1.x; p1[4 * q4 + 1] -= c1.y; p1[4 * q4 + 2] -= c1.z; p1[4 * q4 + 3] -= c1.w; }
            }
            const bool edge = (MODE == 1) ? (ks + 63 > qmin) : true;
            if (edge) {
#pragma unroll
                for (int r = 0; r < 16; ++r) { const int k0p = ks + crow(r, hi), k1p = k0p + 32;
                    const bool ok0 = (MODE == 1) ? (k0p <= qp) : (k0p <= qp && k0p > qp - 128), ok1 = (MODE == 1) ? (k1p <= qp) : (k1p <= qp && k1p > qp - 128);
                    p0[r] = ok0 ? p0[r] : -1e30f; p1[r] = ok1 ? p1[r] : -1e30f; }
            }
            float mx = max3f(p0[0], p1[0], p0[1]);
#pragma unroll
            for (int r = 1; r < 15; r += 2) mx = max3f(mx, p1[r], p0[r + 1]), mx = max3f(mx, p1[r + 1], (r + 2 < 16) ? p0[r + 2] : p1[r + 1]);
            mx = max3f(mx, p1[15], p1[15]);
            mx = max_halves(mx);
            const float m_new = (mx > m_run + 8.0f) ? mx : m_run;
            float rsum = 0.f;
            if (MODE == 1) {
#pragma unroll
                for (int r = 0; r < 16; ++r) { p0[r] = __builtin_amdgcn_exp2f(p0[r] - m_new); p1[r] = __builtin_amdgcn_exp2f(p1[r] - m_new); }
                float ra = 0.f, rb = 0.f, rc = 0.f, rd = 0.f;
#pragma unroll
                for (int r = 0; r < 16; r += 2) { ra += p0[r]; rb += p1[r]; rc += p0[r + 1]; rd += p1[r + 1]; }
                rsum = (ra + rb) + (rc + rd);
            } else {
#pragma unroll
                for (int r = 0; r < 16; ++r) { p0[r] = (p0[r] > -1e29f) ? __builtin_amdgcn_exp2f(p0[r] - m_new) : 0.f; p1[r] = (p1[r] > -1e29f) ? __builtin_amdgcn_exp2f(p1[r] - m_new) : 0.f; rsum += p0[r] + p1[r]; }
            }
            if (__any(m_new != m_run)) {
                const float alpha = __builtin_amdgcn_exp2f(m_run - m_new);
                l_run *= alpha;
#pragma unroll
                for (int r = 0; r < 16; ++r) { o0[r] *= alpha; o1[r] *= alpha; }
                m_run = m_new;
            }
            l_run += rsum;
            bf16x8 pf[4];
            { v4u w;
              w.x = pk2(p0[0], p0[1]); w.y = pk2(p0[2], p0[3]); w.z = pk2(p0[4], p0[5]); w.w = pk2(p0[6], p0[7]); pf[0] = __builtin_bit_cast(bf16x8, w);
              w.x = pk2(p0[8], p0[9]); w.y = pk2(p0[10], p0[11]); w.z = pk2(p0[12], p0[13]); w.w = pk2(p0[14], p0[15]); pf[1] = __builtin_bit_cast(bf16x8, w);
              w.x = pk2(p1[0], p1[1]); w.y = pk2(p1[2], p1[3]); w.z = pk2(p1[4], p1[5]); w.w = pk2(p1[6], p1[7]); pf[2] = __builtin_bit_cast(bf16x8, w);
              w.x = pk2(p1[8], p1[9]); w.y = pk2(p1[10], p1[11]); w.z = pk2(p1[12], p1[13]); w.w = pk2(p1[14], p1[15]); pf[3] = __builtin_bit_cast(bf16x8, w); }
            const LAS bf16* vb = Vt + buf * 64 * AP + r32 * AP + 4 * hi;
#pragma unroll
            for (int ks4 = 0; ks4 < 4; ++ks4) {
                const v2u a0 = *(const LAS v2u*)(vb + 16 * ks4), a1 = *(const LAS v2u*)(vb + 16 * ks4 + 8), b0 = *(const LAS v2u*)(vb + 32 * AP + 16 * ks4), b1 = *(const LAS v2u*)(vb + 32 * AP + 16 * ks4 + 8);
                const v4u fa = {a0.x, a0.y, a1.x, a1.y}, fb = {b0.x, b0.y, b1.x, b1.y};
                o0 = __builtin_amdgcn_mfma_f32_32x32x16_bf16(__builtin_bit_cast(bf16x8, fa), pf[ks4], o0, 0, 0, 0);
                o1 = __builtin_amdgcn_mfma_f32_32x32x16_bf16(__builtin_bit_cast(bf16x8, fb), pf[ks4], o1, 0, 0, 0); }
        }
    }
#undef A2_LOAD
#undef A2_STAGE
    float l_tot = sum_halves(l_run);
    if (MODE == 0) l_tot += __builtin_amdgcn_exp2f(A.in[I_SSINK][l * NH + h] * LOG2E - m_run);
    const float inv = 1.0f / l_tot;
    const size_t m = rowb + qp; bf16* orow = ycat + m * D + (MODE == 0 ? YC_B : YC_D) + h * 64;
    v2u gq0[4], gq1[4];
    if (MODE == 1) { const bf16* gp = proj + m * NP + PC_FG + h * 64;
#pragma unroll
        for (int q4 = 0; q4 < 4; ++q4) { gq0[q4] = *(const v2u*)(gp + 8 * q4 + 4 * hi); gq1[q4] = *(const v2u*)(gp + 32 + 8 * q4 + 4 * hi); } }
#pragma unroll
    for (int q4 = 0; q4 < 4; ++q4) {
        float v0[4] = {o0[4 * q4] * inv, o0[4 * q4 + 1] * inv, o0[4 * q4 + 2] * inv, o0[4 * q4 + 3] * inv}, v1[4] = {o1[4 * q4] * inv, o1[4 * q4 + 1] * inv, o1[4 * q4 + 2] * inv, o1[4 * q4 + 3] * inv};
        const int d0 = 8 * q4 + 4 * hi;
        if (MODE == 1) { const v2u g0 = gq0[q4], g1 = gq1[q4];
            v0[0] *= sigmoidf_(bflo(g0.x)); v0[1] *= sigmoidf_(bfhi(g0.x)); v0[2] *= sigmoidf_(bflo(g0.y)); v0[3] *= sigmoidf_(bfhi(g0.y));
            v1[0] *= sigmoidf_(bflo(g1.x)); v1[1] *= sigmoidf_(bfhi(g1.x)); v1[2] *= sigmoidf_(bflo(g1.y)); v1[3] *= sigmoidf_(bfhi(g1.y)); }
        v2u w0, w1; w0.x = pk2(v0[0], v0[1]); w0.y = pk2(v0[2], v0[3]); w1.x = pk2(v1[0], v1[1]); w1.y = pk2(v1[2], v1[3]);
        *(v2u*)(orow + d0) = w0; *(v2u*)(orow + 32 + d0) = w1; }
}
constexpr int GP = 136;
constexpr int G_W = 0, G_VT = 34816, G_ST = 52224;
__device__ __forceinline__ void sgu_unit(const Ctx& C, int l, int b, int chunk, int ghalf) {
    KA_DECL; asm volatile("" : "+s"(l));
    const bf16* proj = (const bf16*)(A.ws + WS_PROJ); bf16* ycat = (bf16*)(A.ws + WS_YCAT);
    int tid = C.tid; asm volatile("" : "+v"(tid));
    const int lane = tid & 63, wave = C.wave, r32 = lane & 31, hi = lane >> 5;
    const size_t m0 = (size_t)b * T + chunk * 128;
    LAS bf16* Wd = (LAS bf16*)(C.lds + G_W); LAS bf16* Vt = (LAS bf16*)(C.lds + G_VT); LAS float* ST = (LAS float*)(C.lds + G_ST);
    LBAR();
    {
        const int tok = tid >> 2, part = tid & 3; const v4u* src = (const v4u*)(proj + (m0 + tok) * NP + PC_GV + part * 128);
        float s1 = 0.f, s2 = 0.f;
#pragma unroll 4
        for (int i = 0; i < 16; ++i) { const v4u w = src[i];
            const float e0 = gelu_f(bflo(w.x)), e1 = gelu_f(bfhi(w.x)), e2 = gelu_f(bflo(w.y)), e3 = gelu_f(bfhi(w.y)), e4 = gelu_f(bflo(w.z)), e5 = gelu_f(bfhi(w.z)), e6 = gelu_f(bflo(w.w)), e7 = gelu_f(bfhi(w.w));
            s1 += ((e0 + e1) + (e2 + e3)) + ((e4 + e5) + (e6 + e7));
            s2 += ((e0 * e0 + e1 * e1) + (e2 * e2 + e3 * e3)) + ((e4 * e4 + e5 * e5) + (e6 * e6 + e7 * e7)); }
        s1 += __shfl_xor(s1, 1); s1 += __shfl_xor(s1, 2); s2 += __shfl_xor(s2, 1); s2 += __shfl_xor(s2, 2);
        const float mean = s1 * (1.0f / 512.0f), var = fmaxf(s2 * (1.0f / 512.0f) - mean * mean, 0.f);
        if (part == 0) { ST[2 * tok] = mean; ST[2 * tok + 1] = 1.0f / sqrtf(var + 1e-5f); }
    }
    LBAR();
    const int ti = wave >> 1, cj = wave & 1;
    for (int gi = 0; gi < 4; ++gi) {
        const int g = ghalf * 4 + gi;
        {
            const int row = tid >> 2, s0 = (tid & 3) * 32; const float* wsrc = A.in[I_GWS] + (size_t)(l * NH + g) * SGU_TRI + (row * (row + 1)) / 2;
            float wv[32];
#pragma unroll
            for (int i = 0; i < 32; ++i) { const int s_ = s0 + i; wv[i] = wsrc[s_ <= row ? s_ : row]; }
#pragma unroll
            for (int i = 0; i < 32; i += 2) { const int s_ = s0 + i; *(LAS unsigned*)(Wd + row * GP + s_) = pk2((s_ <= row) ? wv[i] : 0.f, (s_ + 1 <= row) ? wv[i + 1] : 0.f); }
        }
        {
            const int tok = tid >> 2, c0 = (tid & 3) * 16; const v4u* src = (const v4u*)(proj + (m0 + tok) * NP + PC_GV + g * 64 + c0);
            const v4u r0 = src[0], r1 = src[1]; const float mean = ST[2 * tok], rstd = ST[2 * tok + 1];
            const float* lg = A.in[I_GLG] + l * GW + g * 64 + c0; const float* lb = A.in[I_GLB] + l * GW + g * 64 + c0;
            float f[16];
            f[0] = bflo(r0.x); f[1] = bfhi(r0.x); f[2] = bflo(r0.y); f[3] = bfhi(r0.y); f[4] = bflo(r0.z); f[5] = bfhi(r0.z); f[6] = bflo(r0.w); f[7] = bfhi(r0.w);
            f[8] = bflo(r1.x); f[9] = bfhi(r1.x); f[10] = bflo(r1.y); f[11] = bfhi(r1.y); f[12] = bflo(r1.z); f[13] = bfhi(r1.z); f[14] = bflo(r1.w); f[15] = bfhi(r1.w);
#pragma unroll
            for (int i = 0; i < 16; ++i) { const float y = (gelu_f(f[i]) - mean) * rstd * lg[i] + lb[i]; Vt[(c0 + i) * GP + tok] = (bf16)f2bf(y); }
        }
        bf16 ur[16]; float bsv[16];
        {
            const float* bs = A.in[I_GB] + (size_t)(l * NH + g) * 128;
#pragma unroll
            for (int r = 0; r < 16; ++r) { ur[r] = proj[(m0 + 32 * ti + crow(r, hi)) * NP + PC_GU + g * 64 + 32 * cj + r32]; bsv[r] = bs[32 * ti + crow(r, hi)]; }
        }
        LBAR();
        {
            f32x16 acc;
#pragma unroll
            for (int r = 0; r < 16; ++r) acc[r] = 0.f;
            acc = mma32(Wd + (32 * ti + r32) * GP + 8 * hi, Vt + (32 * cj + r32) * GP + 8 * hi, 2 * (ti + 1), acc);
#pragma unroll
            for (int r = 0; r < 16; ++r) { const int t = 32 * ti + crow(r, hi), c = 32 * cj + r32; const size_t m = m0 + t;
                const float z = acc[r] + bsv[r], u = gelu_f(bf2f(ur[r]));
                ycat[m * D + YC_C + g * 64 + c] = (bf16)f2bf(u * z); }
        }
        LBAR();
    }
}
constexpr int TP = 72;
constexpr int LP = 168;
constexpr int R_AH = 0, R_RH = 9216, R_BT = 18432, R_KT = 27648, R_VT = 36864, R_BH = 46080, R_KH = 55296, R_RHS = 46080  ;
constexpr int R_LR = 64512  , R_NP = 64512  , R_NK = 80896, R_BR = 90112, R_KR = 99328, R_W1 = 108544, R_W2 = 117760, R_GT = 126976;
__device__ __forceinline__ float shifted(const bf16* proj, size_t m, int t, int col, float mu) {
    const float p = bf2f(proj[m * NP + col]); const float pp = (t > 0) ? bf2f(proj[(m - 1) * NP + col]) : 0.f; return p + (pp - p) * mu;
}
__device__ __forceinline__ void subst_cols(const bool FROM_RHS, const LAS float* NPm, const LAS float* RHS, const LAS bf16* tAH, LAS bf16* tW, int wave, int lane) {
    const int cl = lane >> 2, p = lane & 3, col = (16 * wave + cl) & 63;
    float xs[16], rh[16];
#pragma unroll
    for (int q = 0; q < 16; ++q) xs[q] = 0.f;
    if (FROM_RHS) {
#pragma unroll
        for (int q = 0; q < 16; ++q) rh[q] = RHS[(4 * q + p) * 64 + col];
    } else {
#pragma unroll
        for (int q = 0; q < 16; ++q) rh[q] = bf2f(tAH[(4 * q + p) * TP + col]);
    }
    const LAS float* np_ = NPm + p * 16;
    f32x4 nv[4], nn[4];
#pragma unroll
    for (int q4 = 0; q4 < 4; ++q4) nv[q4] = (f32x4){0.f, 0.f, 0.f, 0.f};
#pragma unroll
    for (int t = 0; t < 64; ++t) {
        if (t + 1 < 64) {
#pragma unroll
            for (int q4 = 0; q4 < (t + 16) / 16; ++q4) nn[q4] = *(const LAS f32x4*)(np_ + (t + 1) * 64 + 4 * q4);
        }
        float part = 0.f, part2 = 0.f;
#pragma unroll
        for (int q4 = 0; q4 < (t + 15) / 16; ++q4) {
            if (q4 & 1) part2 += (nv[q4].x * xs[4 * q4] + nv[q4].y * xs[4 * q4 + 1]) + (nv[q4].z * xs[4 * q4 + 2] + nv[q4].w * xs[4 * q4 + 3]);
            else part += (nv[q4].x * xs[4 * q4] + nv[q4].y * xs[4 * q4 + 1]) + (nv[q4].z * xs[4 * q4 + 2] + nv[q4].w * xs[4 * q4 + 3]); }
        part += part2;
        part += dpp_xor1(part); part += dpp_xor2(part);
        xs[t >> 2] = (p == (t & 3)) ? rh[t >> 2] + part : xs[t >> 2];
#pragma unroll
        for (int q4 = 0; q4 < 4; ++q4) nv[q4] = nn[q4];
        asm volatile("" ::: "memory");
    }
    LAS bf16* wt = tW + col * TP;
#pragma unroll
    for (int q = 0; q < 16; ++q) wt[4 * q + p] = (bf16)f2bf(xs[q]);
}
__device__ __forceinline__ void rwkv_chunk_unit(const Ctx& C, int l, int b, int c, int h) {
    KA_DECL; asm volatile("" : "+s"(l));
    const bf16* proj = (const bf16*)(A.ws + WS_PROJ);
    int tid = C.tid; asm volatile("" : "+v"(tid));
    const int lane = tid & 63, wave = C.wave, r32 = lane & 31, hi = lane >> 5;
    const size_t m0 = (size_t)b * T + 64 * c; const int t0 = 64 * c; const size_t pair = (size_t)(b * NH + h) * 64 + c;
    LAS unsigned char* L = C.lds;
    LAS bf16* tAH = (LAS bf16*)(L + R_AH); LAS bf16* tRH = (LAS bf16*)(L + R_RH); LAS bf16* tBT = (LAS bf16*)(L + R_BT); LAS bf16* tKT = (LAS bf16*)(L + R_KT); LAS bf16* tVT = (LAS bf16*)(L + R_VT);
    LAS bf16* tBH = (LAS bf16*)(L + R_BH); LAS bf16* tKH = (LAS bf16*)(L + R_KH); LAS float* RHS = (LAS float*)(L + R_RHS); LAS float* LR = (LAS float*)(L + R_LR); LAS float* NPm = (LAS float*)(L + R_NP);
    LAS bf16* tNK = (LAS bf16*)(L + R_NK); LAS bf16* tBR = (LAS bf16*)(L + R_BR); LAS bf16* tKR = (LAS bf16*)(L + R_KR); LAS bf16* tW1 = (LAS bf16*)(L + R_W1); LAS bf16* tW2 = (LAS bf16*)(L + R_W2);
    LAS float* GT = (LAS float*)(L + R_GT);
    const float* mu = A.in[I_RMU] + l * 1696;
    LAS bf16* LRb = (LAS bf16*)(L + R_LR);
    LAS bf16* Wt = (LAS bf16*)(L + R_LR + 64 * LP * 2);
    LAS float* OUT = (LAS float*)L;
    LBAR();
    {
        float xv[12];
#pragma unroll
        for (int i = 0; i < 4; ++i) { const int e = tid + NTHREADS * i, tok = e >> 5, j = e & 31; xv[i] = shifted(proj, m0 + tok, t0 + tok, PC_RW + j, mu[1536 + j]); }
#pragma unroll
        for (int i = 0; i < 4; ++i) { const int e = tid + NTHREADS * i, tok = e >> 5, j = e & 31;
            LRb[tok * LP + j] = (bf16)f2bf(1.0f - 2.0f * __builtin_amdgcn_rcpf(__expf(2.0f * xv[i]) + 1.0f)); }
#pragma unroll
        for (int i = 0; i < 4; ++i) { const int e = tid + NTHREADS * i, tok = e >> 5, j = 32 + (e & 31); xv[i] = shifted(proj, m0 + tok, t0 + tok, PC_RW + j, mu[1536 + j]); }
#pragma unroll
        for (int i = 0; i < 4; ++i) { const int e = tid + NTHREADS * i, tok = e >> 5, j = 32 + (e & 31); LRb[tok * LP + j] = (bf16)f2bf(xv[i]); }
#pragma unroll
        for (int i = 0; i < 12; ++i) { const int e = tid + NTHREADS * i, tok = e / 96, j = 64 + e % 96; xv[i] = shifted(proj, m0 + tok, t0 + tok, PC_RW + j, mu[1536 + j]); }
#pragma unroll
        for (int i = 0; i < 12; ++i) { const int e = tid + NTHREADS * i, tok = e / 96, j = 64 + e % 96; LRb[tok * LP + j] = (bf16)f2bf(sigmoidf_(xv[i])); }
        float wv[20];
#pragma unroll
        for (int i = 0; i < 20; ++i) { const int e = tid + NTHREADS * i, ch = e & 63, m = e >> 6;
            wv[i] = (m < 32) ? A.in[I_RW2][((size_t)l * 32 + m) * GW + h * 64 + ch] : ((m < 64) ? A.in[I_RA2][((size_t)l * 32 + (m - 32)) * GW + h * 64 + ch] : A.in[I_RG2][((size_t)l * 96 + (m - 64)) * GW + h * 64 + ch]); }
#pragma unroll
        for (int i = 0; i < 20; ++i) { const int e = tid + NTHREADS * i, ch = e & 63, m = e >> 6; Wt[ch * LP + m] = (bf16)f2bf(wv[i]); }
    }
    LBAR();
    {
        const int rt = (wave >> 1) & 1, ct = wave & 1;
        const LAS bf16* Ap = LRb + (32 * rt + r32) * LP + 8 * hi; const LAS bf16* Bp = Wt + (32 * ct + r32) * LP + 8 * hi;
        f32x16 acc, acc2;
#pragma unroll
        for (int r = 0; r < 16; ++r) { acc[r] = 0.f; acc2[r] = 0.f; }
        if (wave < 4) { acc = mma32(Ap, Bp, 2, acc); acc2 = mma32(Ap + 32, Bp + 32, 2, acc2); }
        else acc = mma32(Ap + 64, Bp + 64, 6, acc);
#pragma unroll
        for (int r = 0; r < 16; ++r) { const int o = (32 * rt + crow(r, hi)) * 64 + 32 * ct + r32;
            if (wave < 4) { OUT[o] = acc[r]; OUT[4096 + o] = acc2[r]; } else OUT[8192 + o] = acc[r]; }
    }
    LBAR();
    const int cg = h * 64 + lane, tg = wave;
    float rr[8], kp[8], vv[8], na[8], bb[8], pg[8];
    {
        float aw[8], aa[8], ag[8];
#pragma unroll
        for (int k = 0; k < 8; ++k) { const int o = (8 * tg + k) * 64 + lane; aw[k] = OUT[o]; aa[k] = OUT[4096 + o]; ag[k] = OUT[8192 + o]; }
        const float w0 = A.in[I_RW0][l * GW + cg], a0 = A.in[I_RA0][l * GW + cg], kkc = A.in[I_RKK][l * GW + cg], kac = A.in[I_RKA][l * GW + cg], rkc = A.in[I_RRK][l * GW + cg];
        const float mur = mu[cg], muk = mu[512 + cg], muv = mu[1024 + cg];
        float* rg = (float*)(A.ws + WS_RG); float* rbv = (float*)(A.ws + WS_RBV);
        float run = 0.f;
#pragma unroll
        for (int k = 0; k < 8; ++k) { const size_t m = m0 + 8 * tg + k; const int t = t0 + 8 * tg + k;
            const float r = shifted(proj, m, t, PC_RR + cg, mur), kx = shifted(proj, m, t, PC_RK + cg, muk), v = shifted(proj, m, t, PC_RV + cg, muv);
            run += -0.6065306597126334f * sigmoidf_(w0 + aw[k]); pg[k] = run;
            const float ia = sigmoidf_(a0 + aa[k]);
            float kk = kx * kkc; const float n2 = wave_sum_dpp(kk * kk); kk = kk * __builtin_amdgcn_rsqf(fmaxf(n2, 1e-24f));
            const float kpv = kx * (1.0f + (ia - 1.0f) * kac);
            const float bonus = wave_sum_dpp(r * kpv * rkc);
            rg[m * GW + cg] = ag[k]; rbv[m * GW + cg] = bonus * v * ag[k];
            rr[k] = r; kp[k] = kpv; vv[k] = v; na[k] = -kk; bb[k] = kk * ia; }
        GT[tg * 64 + lane] = run;
    }
    LBAR();
    {
        float off = 0.f, gL = 0.f;
#pragma unroll
        for (int w = 0; w < 8; ++w) { const float x = GT[w * 64 + lane]; gL += x; off += (w < tg) ? x : 0.f; }
        float bt[8], kt[8];
#pragma unroll
        for (int k = 0; k < 8; ++k) { const int t = 8 * tg + k; const float g = off + pg[k], gp = off + (k > 0 ? pg[k - 1] : 0.f);
            const float eg = __expf(g), egp = __expf(gp), ei = __expf(-g), eL = __expf(gL - g);
            tAH[t * TP + lane] = (bf16)f2bf(na[k] * egp); tRH[t * TP + lane] = (bf16)f2bf(rr[k] * eg); tBH[t * TP + lane] = (bf16)f2bf(bb[k] * ei); tKH[t * TP + lane] = (bf16)f2bf(kp[k] * ei);
            bt[k] = bb[k] * eL; kt[k] = kp[k] * eL; }
        v4u o; o.x = pk2(bt[0], bt[1]); o.y = pk2(bt[2], bt[3]); o.z = pk2(bt[4], bt[5]); o.w = pk2(bt[6], bt[7]); *(LAS v4u*)(tBT + lane * TP + 8 * tg) = o;
        o.x = pk2(kt[0], kt[1]); o.y = pk2(kt[2], kt[3]); o.z = pk2(kt[4], kt[5]); o.w = pk2(kt[6], kt[7]); *(LAS v4u*)(tKT + lane * TP + 8 * tg) = o;
        o.x = pk2(vv[0], vv[1]); o.y = pk2(vv[2], vv[3]); o.z = pk2(vv[4], vv[5]); o.w = pk2(vv[6], vv[7]); *(LAS v4u*)(tVT + lane * TP + 8 * tg) = o;
        if (tg == 0) ((float*)(A.ws + WS_GL))[pair * 64 + lane] = __expf(gL);
    }
    LBAR();
    {
        const int mi = wave >> 1, rt = wave & 1;
        const LAS bf16* Am = (mi < 2) ? tAH : tRH; const LAS bf16* Bm = (mi & 1) ? tKH : tBH;
        for (int ct = 0; ct < 2; ++ct) {
            f32x16 acc;
#pragma unroll
            for (int r = 0; r < 16; ++r) acc[r] = 0.f;
            if (!(rt == 0 && ct == 1)) acc = mma32(Am + (32 * rt + r32) * TP + 8 * hi, Bm + (32 * ct + r32) * TP + 8 * hi, 4, acc);
#pragma unroll
            for (int r = 0; r < 16; ++r) { const int t = 32 * rt + crow(r, hi), s = 32 * ct + r32;
                const bool keep = (mi < 2) ? (s < t) : (s <= t); const float val = keep ? acc[r] : 0.f;
                if (mi == 0) NPm[t * 64 + (s & 3) * 16 + (s >> 2)] = val;
                else { LAS bf16* dst = (mi == 1) ? tNK : ((mi == 2) ? tBR : tKR); dst[t * TP + s] = (bf16)f2bf(val); } }
        }
    }
    LBAR();
    if (wave < 4) {
        const int rt = wave >> 1, ct = wave & 1;
        f32x16 acc;
#pragma unroll
        for (int r = 0; r < 16; ++r) acc[r] = 0.f;
        acc = mma32(tNK + (32 * rt + r32) * TP + 8 * hi, tVT + (32 * ct + r32) * TP + 8 * hi, 2 * (rt + 1), acc);
#pragma unroll
        for (int r = 0; r < 16; ++r) RHS[(32 * rt + crow(r, hi)) * 64 + 32 * ct + r32] = acc[r];
    }
    LBAR();
    subst_cols(wave < 4, NPm, RHS, tAH, (wave < 4) ? tW1 : tW2, wave, lane);
    LBAR();
    {
        const int kind = wave >> 1, rt = wave & 1;
        bf16* RTg = (bf16*)(A.ws + WS_RT) + pair * 4096; bf16* PAg = (bf16*)(A.ws + WS_PA) + pair * 4096;
        float* YFg = (float*)(A.ws + WS_YF) + pair * 4096; float* QFg = (float*)(A.ws + WS_QF) + pair * 4096;
        for (int ct = 0; ct < 2; ++ct) {
            f32x16 acc;
            if (kind == 0) {
#pragma unroll
                for (int r = 0; r < 16; ++r) acc[r] = bf2f(tRH[(32 * rt + crow(r, hi)) * TP + 32 * ct + r32]);
                acc = mma32(tBR + (32 * rt + r32) * TP + 8 * hi, tW2 + (32 * ct + r32) * TP + 8 * hi, 2 * (rt + 1), acc);
#pragma unroll
                for (int r = 0; r < 16; ++r) RTg[(32 * rt + crow(r, hi)) * 64 + 32 * ct + r32] = (bf16)f2bf(acc[r]);
            } else if (kind == 1) {
#pragma unroll
                for (int r = 0; r < 16; ++r) acc[r] = 0.f;
                acc = mma32(tBR + (32 * rt + r32) * TP + 8 * hi, tW1 + (32 * ct + r32) * TP + 8 * hi, 2 * (rt + 1), acc);
                acc = mma32(tKR + (32 * rt + r32) * TP + 8 * hi, tVT + (32 * ct + r32) * TP + 8 * hi, 2 * (rt + 1), acc);
                f32x4* dst = (f32x4*)(YFg + (rt * 2 + ct) * 1024 + lane * 16);
#pragma unroll
                for (int q = 0; q < 4; ++q) dst[q] = (f32x4){acc[4 * q], acc[4 * q + 1], acc[4 * q + 2], acc[4 * q + 3]};
            } else if (kind == 2) {
#pragma unroll
                for (int r = 0; r < 16; ++r) acc[r] = 0.f;
                acc = mma32(tBT + (32 * rt + r32) * TP + 8 * hi, tW2 + (32 * ct + r32) * TP + 8 * hi, 4, acc);
#pragma unroll
                for (int r = 0; r < 16; ++r) PAg[(32 * rt + crow(r, hi)) * 64 + 32 * ct + r32] = (bf16)f2bf(acc[r]);
            } else {
#pragma unroll
                for (int r = 0; r < 16; ++r) acc[r] = 0.f;
                acc = mma32(tBT + (32 * rt + r32) * TP + 8 * hi, tW1 + (32 * ct + r32) * TP + 8 * hi, 4, acc);
                acc = mma32(tKT + (32 * rt + r32) * TP + 8 * hi, tVT + (32 * ct + r32) * TP + 8 * hi, 4, acc);
                f32x4* dst = (f32x4*)(QFg + (rt * 2 + ct) * 1024 + lane * 16);
#pragma unroll
                for (int q = 0; q < 4; ++q) dst[q] = (f32x4){acc[4 * q], acc[4 * q + 1], acc[4 * q + 2], acc[4 * q + 3]};
            }
        }
    }
}
__device__ __forceinline__ void rwkv_seq_unit(const Ctx& C, int bh) {
    KA_DECL;
    const int tid = C.tid, lane = C.lane, wave = C.wave, r32 = lane & 31, hi = lane >> 5;
    const bool zw = wave < 4; const int w4 = wave & 3, rt = w4 >> 1, ct = w4 & 1;
    LAS bf16* Zb = (LAS bf16*)C.lds;
    const bf16* Ag = (const bf16*)(A.ws + (zw ? WS_PA : WS_RT)) + (size_t)bh * 64 * 4096 + (32 * rt + r32) * 64 + 8 * hi;
    const float* Cg = (const float*)(A.ws + (zw ? WS_QF : WS_YF)) + (size_t)bh * 64 * 4096 + (rt * 2 + ct) * 1024 + lane * 16;
    const float* GLg = (const float*)(A.ws + WS_GL) + (size_t)bh * 64 * 64 + 32 * rt + 4 * hi;
    float* ry = (float*)(A.ws + WS_RY) + (size_t)(bh >> 3) * T * GW + (bh & 7) * 64;
    f32x16 Z;
#pragma unroll
    for (int r = 0; r < 16; ++r) Z[r] = 0.f;
    LBAR();
    for (int i = tid; i < 64 * TP; i += NTHREADS) Zb[i] = 0;
    LBAR();
    LAS float* GLs = (LAS float*)(C.lds + 2 * 64 * TP * 2);
    { const float* gsrc = (const float*)(A.ws + WS_GL) + (size_t)bh * 64 * 64; for (int i = tid; i < 64 * 64 / 4; i += NTHREADS) *(LAS f32x4*)(GLs + 4 * i) = *(const f32x4*)(gsrc + 4 * i); }
    LBAR();
    const LAS float* glp = GLs + 32 * rt + 4 * hi;
    LAS float* ypatch = (LAS float*)(C.lds + 2 * 64 * TP * 2 + 64 * 64 * 4) + (wave & 3) * (32 * 36);
    float* ryl = ry + (size_t)(32 * rt + (lane >> 3)) * GW + 32 * ct + 4 * (lane & 7); const LAS float* ypl = ypatch + (lane >> 3) * 36 + 4 * (lane & 7);
    bf16x8 af[4][4]; f32x4 ci[4][4];
#define SEQ_LOAD(S, cc) do { const int c_ = (cc) < 64 ? (cc) : 63; _Pragma("unroll") for (int k = 0; k < 4; ++k) { af[S][k] = *(const bf16x8*)(Ag + (size_t)c_ * 4096 + 16 * k); \
        ci[S][k] = *(const f32x4*)(Cg + (size_t)c_ * 4096 + 4 * k); } } while (0)
#define SEQ_STEP(c, S, SN) do { \
        if ((c) + 3 < 64) SEQ_LOAD(SN, (c) + 3); \
        f32x16 acc; \
        _Pragma("unroll") for (int q = 0; q < 4; ++q) { acc[4 * q] = ci[S][q].x; acc[4 * q + 1] = ci[S][q].y; acc[4 * q + 2] = ci[S][q].z; acc[4 * q + 3] = ci[S][q].w; } \
        if (zw) { _Pragma("unroll") for (int q = 0; q < 4; ++q) { const f32x4 g4 = *(const LAS f32x4*)(glp + (c) * 64 + 8 * q); \
            acc[4 * q] += g4.x * Z[4 * q]; acc[4 * q + 1] += g4.y * Z[4 * q + 1]; acc[4 * q + 2] += g4.z * Z[4 * q + 2]; acc[4 * q + 3] += g4.w * Z[4 * q + 3]; } } \
        const LAS bf16* Bp = Zb + ((c) & 1) * 64 * TP + (32 * ct + r32) * TP + 8 * hi; \
        _Pragma("unroll") for (int k = 0; k < 4; ++k) { const bf16x8 bfr = *(const LAS bf16x8*)(Bp + 16 * k); acc = __builtin_amdgcn_mfma_f32_32x32x16_bf16(af[S][k], bfr, acc, 0, 0, 0); } \
        if (zw) { Z = acc; LAS bf16* Zn = Zb + (((c) + 1) & 1) * 64 * TP + (32 * ct + r32) * TP + 32 * rt + 4 * hi; \
            _Pragma("unroll") for (int q = 0; q < 4; ++q) { v2u w; w.x = pk2(acc[4 * q], acc[4 * q + 1]); w.y = pk2(acc[4 * q + 2], acc[4 * q + 3]); *(LAS v2u*)(Zn + 8 * q) = w; } } \
        else {   \
            _Pragma("unroll") for (int r = 0; r < 16; ++r) ypatch[crow(r, hi) * 36 + r32] = acc[r]; \
            asm volatile("s_waitcnt lgkmcnt(0)" ::: "memory"); \
            GAS float* ryc = (GAS float*)(ryl + (size_t)(64 * (c)) * GW); asm volatile("" : "+v"(ryc));     \
            _Pragma("unroll") for (int j = 0; j < 4; ++j) *(GAS f32x4*)(ryc + (size_t)(8 * j) * GW) = *(const LAS f32x4*)(ypl + 8 * j * 36); \
            asm volatile("s_waitcnt lgkmcnt(0)" ::: "memory"); } \
        asm volatile("s_waitcnt lgkmcnt(0)" ::: "memory"); __builtin_amdgcn_s_barrier(); asm volatile("" ::: "memory"); } while (0)
    SEQ_LOAD(0, 0); SEQ_LOAD(1, 1); SEQ_LOAD(2, 2);
#define SEQ_4(c) SEQ_STEP(c, 0, 3); SEQ_STEP((c) + 1, 1, 0); SEQ_STEP((c) + 2, 2, 1); SEQ_STEP((c) + 3, 3, 2);
    SEQ_4(0) SEQ_4(4) SEQ_4(8) SEQ_4(12) SEQ_4(16) SEQ_4(20) SEQ_4(24) SEQ_4(28) SEQ_4(32) SEQ_4(36) SEQ_4(40) SEQ_4(44) SEQ_4(48) SEQ_4(52) SEQ_4(56) SEQ_4(60)
#undef SEQ_4
#undef SEQ_LOAD
#undef SEQ_STEP
}
__device__ __forceinline__ void rwkv_post_bh(const Ctx& C, int l, int bh, int tbeg, int tend) {
    KA_DECL;
    const int lane = C.lane, wave = C.wave, b = bh >> 3, h = bh & 7, ch = h * 64 + lane;
    const float* RY = (const float*)(A.ws + WS_RY) + (size_t)b * T * GW + ch; const float* RG = (const float*)(A.ws + WS_RG) + (size_t)b * T * GW + ch; const float* RBV = (const float*)(A.ws + WS_RBV) + (size_t)b * T * GW + ch;
    bf16* yc = (bf16*)(A.ws + WS_YCAT) + (size_t)b * T * D + YC_A + ch;
    const float lg = A.in[I_RLG][l * GW + ch], lb = A.in[I_RLB][l * GW + ch];
    for (int t0 = tbeg + 16 * wave; t0 < tend; t0 += 16 * NWAVES) {
        float y[16], g[16], bv[16];
#pragma unroll
        for (int k = 0; k < 16; ++k) { y[k] = RY[(size_t)(t0 + k) * GW]; g[k] = RG[(size_t)(t0 + k) * GW]; bv[k] = RBV[(size_t)(t0 + k) * GW]; }
#pragma unroll
        for (int k = 0; k < 16; ++k) {
            const float mean = wave_sum_dpp(y[k]) * (1.0f / 64.0f), d = y[k] - mean, var = wave_sum_dpp(d * d) * (1.0f / 64.0f);
            const float yn = d * __builtin_amdgcn_rsqf(var + 64e-5f) * lg + lb;
            yc[(size_t)(t0 + k) * D] = (bf16)f2bf(yn * g[k] + bv[k]); }
    }
}
#ifndef REP_CHUNK
#define REP_CHUNK 1
#endif
#ifndef REP_SWA
#define REP_SWA 1
#endif
#ifndef REP_SGU
#define REP_SGU 1
#endif
#ifndef REP_GIN
#define REP_GIN 1
#endif
#ifndef REP_SCAN
#define REP_SCAN 1
#endif
#ifndef REP_FOX
#define REP_FOX 1
#endif
__device__ __forceinline__ void ph_mix1(const Ctx& C, int l) {
    for (int rep = 0; rep < REP_CHUNK; ++rep) for (int u = C.bid; u < 2048; u += C.G) rwkv_chunk_unit(C, l, u >> 9, (u >> 3) & 63, u & 7);
    for (int v = C.bid; v < 256; v += C.G) kvprep_unit(C, l, v);
    for (int v = C.bid; v < 32; v += C.G) cumprep_unit(C, l, v);
}
constexpr int CW_Q = 8192;
constexpr int CW_SEQF = 9216;
__device__ __forceinline__ void ph_mix2(const Ctx& C, int l) {
    KA_DECL;
    unsigned* ctl = (unsigned*)(A.ws + WS_CTL);
    for (int rep = 0; rep < REP_SCAN; ++rep)
    for (int u = C.bid; u < 32; u += C.G) {
        rwkv_seq_unit(C, u);
        asm volatile("s_waitcnt vmcnt(0)" ::: "memory"); __syncthreads();
        if (C.tid == 0) { __builtin_amdgcn_fence(__ATOMIC_RELEASE, "agent"); asm volatile("s_waitcnt vmcnt(0)" ::: "memory");
            __hip_atomic_store(ctl + CW_SEQF + (l * 32 + u) * 64, 1u, __ATOMIC_RELAXED, __HIP_MEMORY_SCOPE_AGENT); }
    }
    unsigned* head = ctl + CW_Q + 64 * l;
    volatile LAS unsigned* slot = (volatile LAS unsigned*)(C.lds + LDSCTL_OFF + 64);
    for (;;) {
        if (C.tid == 0) *slot = __hip_atomic_fetch_add(head, 1u, __ATOMIC_RELAXED, __HIP_MEMORY_SCOPE_AGENT);
        LBAR();
        const unsigned u = *slot;
        if (u >= 1024u * REP_FOX + 512u) break;
        if (u < 1024u * REP_FOX) {
            const unsigned w = u % 1024u;
            if (w < 512u) { const int qb = 15 - (int)(w >> 5), bh = (int)(w & 31u); attn2_unit<1>(C, l, bh >> 3, bh & 7, qb); }
            else { const int v = (int)w - 512; attn2_unit<0>(C, l, v >> 7, (v >> 4) & 7, v & 15); }
        } else if (u < 1024u * REP_FOX + 256u) { const int v = (int)(u - 1024u * REP_FOX); sgu_unit(C, l, v >> 6, (v >> 1) & 31, v & 1);
        } else {
            const int v = (int)(u - 1024u * REP_FOX - 256u), bh = v >> 3, part = v & 7;
            if (C.tid == 0) {
                unsigned spins = 0;
                while (__hip_atomic_load(ctl + CW_SEQF + (l * 32 + bh) * 64, __ATOMIC_RELAXED, __HIP_MEMORY_SCOPE_AGENT) == 0u && ++spins < (1u << 22)) __builtin_amdgcn_s_sleep(2);
                __builtin_amdgcn_fence(__ATOMIC_ACQUIRE, "agent"); asm volatile("s_waitcnt vmcnt(0)" ::: "memory");
            }
            __syncthreads();
            rwkv_post_bh(C, l, bh, part * 512, part * 512 + 512);
        }
    }
    LBAR();
}
constexpr int N_PHASES = 2 + 9 * DEPTH;
#define IN(k) (lo <= (k) && (k) < hi)
#ifndef REP_PRO
#define REP_PRO 1
#endif
#ifndef REP_NORM
#define REP_NORM 1
#endif
#ifndef REP_MIX1
#define REP_MIX1 1
#endif
#ifndef REP_POST
#define REP_POST 1
#endif
#ifndef REP_GUP
#define REP_GUP 1
#endif
#ifndef PROBE_STAMP
#define PROBE_STAMP (-100)
#endif
#define STAMP(k) do { if (PROBE_STAMP > -100 && C.bid == 0 && C.tid == 0) ((volatile LAS unsigned long long*)(C.lds + LDSCTL_OFF + 1024))[(k) + 1] = __builtin_amdgcn_s_memrealtime(); } while (0)
#define SEAM(k) do { if (IN((k) + 1) || PROBE_STAMP > -100) xcd_barrier(bar); STAMP(k); } while (0)
template <int l>
__device__ __forceinline__ void layer_phases(const Args& A, const Ctx& C, const XcdBarrier& bar, const int lo, const int hi) {
    bf16* const H = (bf16*)(A.ws + WS_H); bf16* const PROJ = (bf16*)(A.ws + WS_PROJ); bf16* const YCAT = (bf16*)(A.ws + WS_YCAT); bf16* const FB = (bf16*)(A.ws + WS_F);
    constexpr int p0 = 2 + 9 * l;
    const float* xin = (l == 0) ? A.in[I_X] : A.out;
    const float* modl = (const float*)(A.ws + WS_MOD) + (size_t)l * NB * MODW;
    if (IN(p0 + 0)) { for (int rep = 0; rep < REP_NORM; ++rep) ph_norm(C, xin, A.in[I_N1G] + l * D, modl + 0 * D, modl + 1 * D, H); SEAM(p0 + 0); }
    if (IN(p0 + 1)) {
        pg8::Gemm g{H, (const bf16*)(A.ws + WS_WIN) + (size_t)l * NP * D, M, NP, D}; pg8::StaticOrder S; S.init(M, NP, C.G, C.bid);
        pg8::EpiStoreBf16 E{PROJ, NP};
        for (int rep = 0; rep < REP_GIN; ++rep) { if (rep) __syncthreads(); pg8::gemm_phase<pg8::EpiStoreBf16, pg8::StaticOrder, true, true>(C.lds, g, S, E); }
        SEAM(p0 + 1); }
    if (IN(p0 + 2)) { for (int rep = 0; rep < REP_MIX1; ++rep) ph_mix1(C, l); SEAM(p0 + 2); }
    if (IN(p0 + 3)) { ph_mix2(C, l); SEAM(p0 + 3); }
    if (IN(p0 + 5)) {
        pg8::Gemm g{YCAT, (const bf16*)(A.ws + WS_WOUT) + (size_t)l * D * D, M, D, D}; pg8::StaticOrder S; S.init(M, D, C.G, C.bid);
        pg8::EpiResid E{xin, A.out, D, modl + 2 * D, MODW, T};
        pg8::gemm_phase<pg8::EpiResid, pg8::StaticOrder, true, true>(C.lds, g, S, E);
        SEAM(p0 + 5); }
    if (IN(p0 + 6)) { for (int rep = 0; rep < REP_NORM; ++rep) ph_norm(C, A.out, A.in[I_N2G] + l * D, modl + 3 * D, modl + 4 * D, H); SEAM(p0 + 6); }
    if (IN(p0 + 7)) {
        pg8::Gemm g{H, (const bf16*)(A.ws + WS_W13) + (size_t)l * 2 * FF * D, M, 2 * FF, D}; pg8::StaticOrder S; S.init(M, 2 * FF, C.G, C.bid);
        pg8::EpiSwiGLU E{FB, FF};
        for (int rep = 0; rep < REP_GUP; ++rep) { if (rep) __syncthreads(); pg8::gemm_phase<pg8::EpiSwiGLU, pg8::StaticOrder, true, true>(C.lds, g, S, E); }
        SEAM(p0 + 7); }
    if (IN(p0 + 8)) {
        pg8::Gemm g{FB, (const bf16*)(A.ws + WS_W2) + (size_t)l * D * FF, M, D, FF}; pg8::StaticOrder S; S.init(M, D, C.G, C.bid);
        pg8::EpiResid E{A.out, A.out, D, modl + 5 * D, MODW, T};
        pg8::gemm_phase<pg8::EpiResid, pg8::StaticOrder, true, true>(C.lds, g, S, E);
        SEAM(p0 + 8); }
}
__global__ void __launch_bounds__(NTHREADS, 2) fwd_kernel(Args A) {
    extern __shared__ __attribute__((aligned(16))) unsigned char lds_raw[];
    Ctx C; C.lds = (LAS unsigned char*)lds_raw; C.tid = threadIdx.x; C.lane = C.tid & 63; C.wave = __builtin_amdgcn_readfirstlane(C.tid >> 6); C.G = gridDim.x; C.bid = blockIdx.x;
    volatile LAS unsigned* MISC = (volatile LAS unsigned*)(C.lds + MISC_OFF);
    for (int u = C.tid; u < (LDS_BYTES - LDSCTL_OFF) / 4; u += NTHREADS) ((LAS unsigned*)(C.lds + LDSCTL_OFF))[u] = 0u;
    __syncthreads();
    const int lo = A.ph_lo, hi = A.ph_hi;
    const bool multi = (hi - lo) > 1;
    XcdBarrier bar; bar.bar = (unsigned*)(A.ws + WS_CTL) + CW_BAR; bar.x = 0; bar.st = nullptr;
    if (multi) bar = xcd_barrier_post((unsigned*)(A.ws + WS_CTL) + CW_BAR, MISC + 8);
    if (PROBE_STAMP > -100 && C.bid == 0 && C.tid == 0) ((volatile LAS unsigned long long*)(C.lds + LDSCTL_OFF + 1024))[0] = __builtin_amdgcn_s_memrealtime();
    if (IN(0)) { for (int rep = 0; rep < REP_PRO; ++rep) { if (rep) __syncthreads(); ph_prologue(C); } SEAM(0); }
    if (IN(1)) { ph_modreduce(C); SEAM(1); }
    layer_phases<0>(A, C, bar, lo, hi);
    layer_phases<1>(A, C, bar, lo, hi);
    layer_phases<2>(A, C, bar, lo, hi);
    layer_phases<3>(A, C, bar, lo, hi);
    if (PROBE_STAMP > -100 && C.bid == 0 && C.tid == 0) {
        volatile LAS unsigned long long* st = (volatile LAS unsigned long long*)(C.lds + LDSCTL_OFF + 1024);
        unsigned long long tot = 0;
        if (PROBE_STAMP < 0) tot = st[2] - st[0];
        else for (int l = 0; l < DEPTH; ++l) tot += st[2 + 9 * l + PROBE_STAMP + 1] - st[2 + 9 * l + PROBE_STAMP];
        A.out[0] = (float)tot * 0.01f;
    }
}
#undef IN
#undef SEAM

extern "C" void kernel_launch(void* const* d_in, const int* in_sizes, int n_in, void* d_out, int out_size, void* d_ws, size_t ws_size, hipStream_t stream) {
    static int grid = 0;
    if (grid == 0) {
        if (n_in != N_INPUTS || out_size != M * D || ws_size < WS_END) { fprintf(stderr, "kernel_launch: unexpected problem (n_in %d, out %d, ws %zu; need %zu)\n", n_in, out_size, ws_size, (size_t)WS_END); grid = -1; return; }
        int dev = 0, cus = 0, per_cu = 0;
        if (hipGetDevice(&dev) != hipSuccess || hipDeviceGetAttribute(&cus, hipDeviceAttributeMultiprocessorCount, dev) != hipSuccess) { grid = -1; return; }
        if (hipFuncSetAttribute((const void*)fwd_kernel, hipFuncAttributeMaxDynamicSharedMemorySize, LDS_BYTES) != hipSuccess) { fprintf(stderr, "kernel_launch: hipFuncSetAttribute failed\n"); grid = -1; return; }
        if (hipOccupancyMaxActiveBlocksPerMultiprocessor(&per_cu, (const void*)fwd_kernel, NTHREADS, LDS_BYTES) != hipSuccess || per_cu < 1) fprintf(stderr, "kernel_launch: occupancy query reports %d\n", per_cu);
        (void)hipGetLastError();
        grid = cus;
    }
    if (grid < 0) return;
    (void)hipMemsetAsync((char*)d_ws + WS_CTL, 0, CTL_ZERO_BYTES, stream);
    Args a{};
    for (int i = 0; i < N_INPUTS; ++i) a.in[i] = (const float*)d_in[i];
    a.out = (float*)d_out; a.ws = (unsigned char*)d_ws;
#if MK_ONE_LAUNCH
    a.ph_lo = 0; a.ph_hi = N_PHASES;
    hipLaunchKernelGGL(fwd_kernel, dim3(grid), dim3(NTHREADS), LDS_BYTES, stream, a);
#else
    for (int p = 0; p < N_PHASES; ++p) { a.ph_lo = p; a.ph_hi = p + 1; hipLaunchKernelGGL(fwd_kernel, dim3(grid), dim3(NTHREADS), LDS_BYTES, stream, a); }
#endif
    const hipError_t le = hipPeekAtLastError();
    if (le != hipSuccess) fprintf(stderr, "kernel_launch: launch failed: %s\n", hipGetErrorName(le));
}
```

```cpp
#include <hip/hip_runtime.h>
#include <cstdio>
#include <cstdint>
#ifndef MK_ONE_LAUNCH
#define MK_ONE_LAUNCH 1
#endif
namespace pg8 {
#define PG8_LAS __attribute__((address_space(3)))
typedef unsigned short bf16_t;
typedef short bf16x8 __attribute__((ext_vector_type(8)));
typedef float f32x4 __attribute__((ext_vector_type(4)));
typedef unsigned u32x4 __attribute__((ext_vector_type(4)));
constexpr int BM = 256, BK = 64, HALF = 128, HTB = HALF * BK * 2  , STAGE_BYTES = 8 * HTB, NXCD = 8, WGM = 8;

__host__ __device__ __forceinline__ int lds_byte(int r, int c) { const int st = (r >> 4) * 2 + (c >> 5), rr = r & 15, cc = c & 31, ob = rr * 64 + cc * 2; return st * 1024 + (ob ^ (((ob >> 9) & 1) << 5)); }
__host__ __device__ __forceinline__ void stage_rc(int b, int& R, int& C) { const int st = b / 1024, sb = b % 1024, swz = sb ^ (((sb >> 9) & 1) << 5); R = (st >> 1) * 16 + swz / 64; C = (st & 1) * 32 + (swz % 64) / 2; }
__host__ __device__ __forceinline__ int perm32(int rho) { const int n = rho >> 4, i = rho & 15; return 8 * (i >> 2) + 4 * n + (i & 3); }

struct Unit { int pm, pn; };
struct Gemm { const bf16_t* A; const bf16_t* Bt; int M, N, K; };

struct StaticOrder {
    int nM, nN, nwg, G, c;
    __host__ __device__ void init(int M, int N, int G_, int c_) { nM = M / BM; nN = N / BM; nwg = nM * nN; G = G_; c = c_; }
    __host__ __device__ bool next(int i, Unit& u) const {
        const long L = (long)i * G + c; if (L >= nwg) return false;
        int wgid = (int)L; { const int q = nwg / NXCD, r = nwg % NXCD, xcd = wgid % NXCD, off = wgid / NXCD; wgid = (xcd < r ? xcd * (q + 1) : r * (q + 1) + (xcd - r) * q) + off; }
        const int nig = WGM * nN, gid = wgid / nig, fm = gid * WGM, gsz = (nM - fm) < WGM ? (nM - fm) : WGM;
        u.pm = fm + ((wgid % nig) % gsz); u.pn = (wgid % nig) / gsz; return true;
    }
    __device__ __forceinline__ void a_ready(const Unit&) const {}
    __device__ __forceinline__ void done(const Unit&) const {}
};

__device__ __forceinline__ unsigned cvt_pk_bf16(float lo, float hi) { unsigned r; asm volatile("v_cvt_pk_bf16_f32 %0, %1, %2" : "=v"(r) : "v"(lo), "v"(hi)); return r; }
typedef float f32x2 __attribute__((ext_vector_type(2)));
__device__ __forceinline__ f32x2 gelu_pk(f32x2 v) {
    const f32x2 av = __builtin_elementwise_abs(v), d = av * 0.2316418882f + 1.0f;
    f32x2 t; t.x = __builtin_amdgcn_rcpf(d.x); t.y = __builtin_amdgcn_rcpf(d.y);
    f32x2 q = t * 0.5307027145f + (-0.7265760135f); q = q * t + 0.7107068705f; q = q * t + (-0.142248368f); q = q * t + 0.127414796f; q = q * t;
    const f32x2 s = (v * v) * (-0.72134752044f);
    f32x2 e; e.x = __builtin_amdgcn_exp2f(s.x); e.y = __builtin_amdgcn_exp2f(s.y);
    const f32x2 m = v * (q * e), r = v - m;
    f32x2 o; o.x = v.x < 0.f ? m.x : r.x; o.y = v.y < 0.f ? m.y : r.y; return o;
}

struct EpiStoreBf16 {
    static constexpr bool PERM = true, AFTER_DRAIN = false;
    bf16_t* O; int ldc;
    __device__ __forceinline__ void operator()(const f32x4 (&acc)[2][2][4][2], const Unit& u, int wr, int wc, int fr, int fq) const {
        const int row0 = u.pm * BM + wr * 64 + fr, col0 = u.pn * BM + wc * 32 + 8 * fq;
#pragma unroll
        for (int ai = 0; ai < 2; ++ai)
#pragma unroll
            for (int m = 0; m < 4; ++m) { bf16_t* rowp = O + (size_t)(row0 + ai * HALF + m * 16) * ldc + col0;
#pragma unroll
                for (int bj = 0; bj < 2; ++bj) { const f32x4 v0 = acc[ai][bj][m][0], v1 = acc[ai][bj][m][1];
                    u32x4 w; w.x = cvt_pk_bf16(v0[0], v0[1]); w.y = cvt_pk_bf16(v0[2], v0[3]); w.z = cvt_pk_bf16(v1[0], v1[1]); w.w = cvt_pk_bf16(v1[2], v1[3]);
                    *(u32x4*)(rowp + bj * HALF) = w; } }
    }
};
struct EpiResid {
    static constexpr bool PERM = false, AFTER_DRAIN = false;
    const float* base; float* out; int ldc; const float* gate; int gate_stride; int rows_per_batch;
    __device__ __forceinline__ void operator()(const f32x4 (&acc)[2][2][4][2], const Unit& u, int wr, int wc, int fr, int fq) const {
        const int row0 = u.pm * BM + wr * 64 + fr, col0 = u.pn * BM + wc * 32 + 4 * fq;
        const float* gp = gate + (size_t)((u.pm * BM) / rows_per_batch) * gate_stride + col0;
        f32x4 gv[2][2];
#pragma unroll
        for (int bj = 0; bj < 2; ++bj)
#pragma unroll
            for (int n = 0; n < 2; ++n) gv[bj][n] = *(const f32x4*)(gp + bj * HALF + n * 16);
        f32x4 xb[3][2][2];
#define ER_LOAD(g) do { const size_t off = (size_t)(row0 + ((g) >> 2) * HALF + ((g) & 3) * 16) * ldc + col0; \
            _Pragma("unroll") for (int bj = 0; bj < 2; ++bj) _Pragma("unroll") for (int n = 0; n < 2; ++n) xb[(g) % 3][bj][n] = *(const f32x4*)(base + off + bj * HALF + n * 16); } while (0)
#define ER_STORE(g) do { const size_t off = (size_t)(row0 + ((g) >> 2) * HALF + ((g) & 3) * 16) * ldc + col0; \
            _Pragma("unroll") for (int bj = 0; bj < 2; ++bj) _Pragma("unroll") for (int n = 0; n < 2; ++n) \
                *(f32x4*)(out + off + bj * HALF + n * 16) = xb[(g) % 3][bj][n] + gv[bj][n] * acc[(g) >> 2][bj][(g) & 3][n]; } while (0)
        ER_LOAD(0); ER_LOAD(1); ER_LOAD(2); ER_STORE(0); ER_LOAD(3); ER_STORE(1); ER_LOAD(4); ER_STORE(2); ER_LOAD(5); ER_STORE(3); ER_LOAD(6); ER_STORE(4); ER_LOAD(7); ER_STORE(5); ER_STORE(6); ER_STORE(7);
#undef ER_LOAD
#undef ER_STORE
    }
};
struct EpiSwiGLU {
    static constexpr bool PERM = true, AFTER_DRAIN = false;
    bf16_t* O; int ldc;
    __device__ __forceinline__ void operator()(const f32x4 (&acc)[2][2][4][2], const Unit& u, int wr, int wc, int fr, int fq) const {
        const int row0 = u.pm * BM + wr * 64 + fr, col0 = u.pn * HALF + wc * 32 + 8 * fq;
#pragma unroll
        for (int ai = 0; ai < 2; ++ai)
#pragma unroll
            for (int m = 0; m < 4; ++m) { bf16_t* rowp = O + (size_t)(row0 + ai * HALF + m * 16) * ldc + col0;
                float f[8];
#pragma unroll
                for (int n = 0; n < 2; ++n)
#pragma unroll
                    for (int e = 0; e < 4; ++e) { const float g = acc[ai][0][m][n][e], up = acc[ai][1][m][n][e];
                        f[n * 4 + e] = g * up * __builtin_amdgcn_rcpf(1.0f + __builtin_amdgcn_exp2f(-1.4426950408889634f * g)); }
                u32x4 w; w.x = cvt_pk_bf16(f[0], f[1]); w.y = cvt_pk_bf16(f[2], f[3]); w.z = cvt_pk_bf16(f[4], f[5]); w.w = cvt_pk_bf16(f[6], f[7]);
                *(u32x4*)rowp = w; }
    }
};

template <class Epi, class Sched, bool ALIGN_EPI = false, bool SP2 = false>
__device__ __forceinline__ void gemm_phase(PG8_LAS unsigned char* lds, const Gemm g, const Sched& S, const Epi& E) {
    const int tid = threadIdx.x, wid = __builtin_amdgcn_readfirstlane(tid >> 6), lane = tid & 63, wr = wid >> 2, wc = wid & 3, fr = lane & 15, fq = lane >> 4;
    const int K = g.K, nt = K / BK;
    unsigned voffA[2], voffB[2];
#pragma unroll
    for (int i = 0; i < 2; ++i) { int R, C; stage_rc(tid * 16 + i * 8192, R, C); const int Rb = Epi::PERM ? ((R & ~31) + perm32(R & 31)) : R;
        voffA[i] = (unsigned)(R * K + C) * 2u; voffB[i] = (unsigned)(Rb * K + C) * 2u; }
    const size_t kstep = (size_t)(BK * 2);
    const size_t hstep = (size_t)HALF * K * 2;
    const size_t tstep = 2 * hstep;
    const unsigned ldsw = (unsigned)wid * 1024u;
    const int aoff = lds_byte(wr * 64 + fr, fq * 8), boff = lds_byte(wc * 32 + fr, fq * 8);
#define PG8_SA(b, h) (((b) * 2 + (h)) * HTB)
#define PG8_SB(b, h) ((4 + (b) * 2 + (h)) * HTB)
#define PG8_STAGE(bufoff, gbase, voff) do { _Pragma("unroll") for (int _i = 0; _i < 2; ++_i) \
        __builtin_amdgcn_global_load_lds((const unsigned*)((const char*)(gbase) + (voff)[_i]), (PG8_LAS unsigned*)(lds + (bufoff) + ldsw + _i * 8192), 16, 0, 0); } while (0)
#define PG8_LDA(dst, b, h) do { _Pragma("unroll") for (int m = 0; m < 4; ++m) _Pragma("unroll") for (int k = 0; k < 2; ++k) dst[m][k] = *(const PG8_LAS bf16x8*)(lds + PG8_SA(b, h) + aoff + m * 2048 + k * 1024); } while (0)
#define PG8_LDB(dst, b, h) do { _Pragma("unroll") for (int n = 0; n < 2; ++n) _Pragma("unroll") for (int k = 0; k < 2; ++k) dst[n][k] = *(const PG8_LAS bf16x8*)(lds + PG8_SB(b, h) + boff + n * 2048 + k * 1024); } while (0)
#define PG8_MMA(ai, bj, At, Bt) do { __builtin_amdgcn_s_setprio(1); _Pragma("unroll") for (int m = 0; m < 4; ++m) _Pragma("unroll") for (int n = 0; n < 2; ++n) _Pragma("unroll") for (int k = 0; k < 2; ++k) \
        acc[ai][bj][m][n] = __builtin_amdgcn_mfma_f32_16x16x32_bf16(Bt[n][k], At[m][k], acc[ai][bj][m][n], 0, 0, 0); __builtin_amdgcn_s_setprio(0); } while (0)
#define PG8_WAIT_V(n) asm volatile("s_waitcnt vmcnt(" #n ")" ::: "memory")
#define PG8_WAIT_L(n) asm volatile("s_waitcnt lgkmcnt(" #n ")" ::: "memory")
#define PG8_BAR __builtin_amdgcn_s_barrier()
#define PG8_SCHED __builtin_amdgcn_sched_barrier(0)
    Unit cur, nxt; int ui = 0;
    if (!S.next(0, cur)) return;
    f32x4 acc[2][2][4][2];
#pragma unroll
    for (int a = 0; a < 2; ++a)
#pragma unroll
        for (int b = 0; b < 2; ++b)
#pragma unroll
            for (int m = 0; m < 4; ++m)
#pragma unroll
                for (int n = 0; n < 2; ++n) acc[a][b][m][n] = (f32x4){0.f, 0.f, 0.f, 0.f};
    bf16x8 At[4][2], B0[2][2], B1[2][2];
    const char* cA = (const char*)g.A + (size_t)cur.pm * tstep; const char* cB = (const char*)g.Bt + (size_t)cur.pn * tstep;
    S.a_ready(cur);
    if constexpr (SP2) {
        PG8_STAGE(PG8_SB(0, 0), cB, voffB); PG8_STAGE(PG8_SB(0, 1), cB + hstep, voffB); PG8_STAGE(PG8_SA(0, 0), cA, voffA); PG8_STAGE(PG8_SA(0, 1), cA + hstep, voffA);
        if (wr == 1) PG8_BAR;
        PG8_WAIT_V(2); PG8_BAR;
        PG8_STAGE(PG8_SB(1, 0), cB + kstep, voffB); PG8_STAGE(PG8_SA(1, 0), cA + kstep, voffA); PG8_STAGE(PG8_SB(1, 1), cB + hstep + kstep, voffB);
        PG8_WAIT_V(6); PG8_BAR;
    } else {
        PG8_STAGE(PG8_SB(0, 0), cB, voffB); PG8_STAGE(PG8_SA(0, 0), cA, voffA); PG8_STAGE(PG8_SB(0, 1), cB + hstep, voffB); PG8_STAGE(PG8_SA(0, 1), cA + hstep, voffA);
        if (wr == 1) PG8_BAR;
        PG8_WAIT_V(4); PG8_BAR;
        PG8_STAGE(PG8_SB(1, 0), cB + kstep, voffB); PG8_STAGE(PG8_SA(1, 0), cA + kstep, voffA); PG8_STAGE(PG8_SB(1, 1), cB + hstep + kstep, voffB);
        PG8_WAIT_V(6); PG8_BAR;
    }
    for (;;) {
        const bool has_next = S.next(ui + 1, nxt);
        const char* nA = has_next ? (const char*)g.A + (size_t)nxt.pm * tstep : cA; const char* nB = has_next ? (const char*)g.Bt + (size_t)nxt.pn * tstep : cB;
        for (int t = 0; t < nt; t += 2) {
            const bool last = (t == nt - 2);
            const char* a1 = cA + (size_t)(t + 1) * kstep;
            const char* a2 = last ? nA : cA + (size_t)(t + 2) * kstep; const char* b2 = last ? nB : cB + (size_t)(t + 2) * kstep;
            const char* a3 = a2 + kstep; const char* b3 = b2 + kstep;
            if (last && has_next) S.a_ready(nxt);
            if constexpr (SP2) {
            PG8_LDB(B0, 0, 0); PG8_LDB(B1, 0, 1); PG8_SCHED; PG8_LDA(At, 0, 0); PG8_STAGE(PG8_SA(1, 1), a1 + hstep, voffA);
            PG8_WAIT_V(8); PG8_WAIT_L(0); PG8_BAR; PG8_MMA(0, 0, At, B0); PG8_MMA(0, 1, At, B1); PG8_BAR; PG8_SCHED;
            PG8_LDA(At, 0, 1); PG8_STAGE(PG8_SB(0, 0), b2, voffB); PG8_STAGE(PG8_SB(0, 1), b2 + hstep, voffB); PG8_STAGE(PG8_SA(0, 0), a2, voffA);
            PG8_WAIT_V(8); PG8_WAIT_L(0); PG8_BAR; PG8_MMA(1, 0, At, B0); PG8_MMA(1, 1, At, B1); PG8_BAR; PG8_SCHED;
            PG8_LDB(B0, 1, 0); PG8_LDB(B1, 1, 1); PG8_SCHED; PG8_LDA(At, 1, 0); PG8_STAGE(PG8_SA(0, 1), a2 + hstep, voffA);
            PG8_WAIT_V(8); PG8_WAIT_L(0); PG8_BAR; PG8_MMA(0, 0, At, B0); PG8_MMA(0, 1, At, B1); PG8_BAR; PG8_SCHED;
            PG8_LDA(At, 1, 1); PG8_STAGE(PG8_SB(1, 0), b3, voffB); PG8_STAGE(PG8_SB(1, 1), b3 + hstep, voffB); PG8_STAGE(PG8_SA(1, 0), a3, voffA);
            PG8_WAIT_V(8); PG8_WAIT_L(0); PG8_BAR; PG8_MMA(1, 0, At, B0); PG8_MMA(1, 1, At, B1); PG8_BAR; PG8_SCHED;
            } else {
            PG8_LDB(B0, 0, 0); PG8_SCHED; PG8_LDA(At, 0, 0); PG8_STAGE(PG8_SA(1, 1), a1 + hstep, voffA);
            PG8_WAIT_L(8); PG8_BAR; PG8_WAIT_L(0); PG8_MMA(0, 0, At, B0); PG8_BAR; PG8_SCHED;
            PG8_LDB(B1, 0, 1); PG8_STAGE(PG8_SB(0, 0), b2, voffB);
            PG8_BAR; PG8_WAIT_L(0); PG8_MMA(0, 1, At, B1); PG8_BAR;
            PG8_LDA(At, 0, 1); PG8_STAGE(PG8_SA(0, 0), a2, voffA);
            PG8_BAR; PG8_WAIT_L(0); PG8_MMA(1, 0, At, B0); PG8_BAR; PG8_SCHED;
            PG8_STAGE(PG8_SB(0, 1), b2 + hstep, voffB);
            PG8_WAIT_V(6); PG8_BAR; PG8_MMA(1, 1, At, B1); PG8_BAR;
            PG8_LDB(B0, 1, 0); PG8_SCHED; PG8_LDA(At, 1, 0); PG8_STAGE(PG8_SA(0, 1), a2 + hstep, voffA);
            PG8_WAIT_L(8); PG8_BAR; PG8_WAIT_L(0); PG8_MMA(0, 0, At, B0); PG8_BAR; PG8_SCHED;
            PG8_LDB(B1, 1, 1); PG8_STAGE(PG8_SB(1, 0), b3, voffB);
            PG8_BAR; PG8_WAIT_L(0); PG8_MMA(0, 1, At, B1); PG8_BAR;
            PG8_LDA(At, 1, 1); PG8_STAGE(PG8_SA(1, 0), a3, voffA);
            PG8_BAR; PG8_WAIT_L(0); PG8_MMA(1, 0, At, B0); PG8_BAR; PG8_SCHED;
            PG8_STAGE(PG8_SB(1, 1), b3 + hstep, voffB);
            PG8_WAIT_V(6); PG8_BAR; PG8_MMA(1, 1, At, B1); PG8_BAR;
            }
        }
        if constexpr (ALIGN_EPI) { if (wr == 0) PG8_BAR; }
        if constexpr (!Epi::AFTER_DRAIN) { E(acc, cur, wr, wc, fr, fq); S.done(cur); }
        if (!has_next) break;
#pragma unroll
        for (int a = 0; a < 2; ++a)
#pragma unroll
            for (int b = 0; b < 2; ++b)
#pragma unroll
                for (int m = 0; m < 4; ++m)
#pragma unroll
                    for (int n = 0; n < 2; ++n) acc[a][b][m][n] = (f32x4){0.f, 0.f, 0.f, 0.f};
        cur = nxt; cA = nA; cB = nB; ++ui;
        if constexpr (ALIGN_EPI) { if (wr == 1) PG8_BAR; }
    }
    PG8_WAIT_V(0);
    if constexpr (!ALIGN_EPI) { if (wr == 0) PG8_BAR; }
    PG8_BAR;
    if constexpr (Epi::AFTER_DRAIN) { E.fused(acc, cur, wr, wc, fr, fq, lds, wid, lane); S.done(cur); }
#undef PG8_SA
#undef PG8_SB
#undef PG8_STAGE
#undef PG8_LDA
#undef PG8_LDB
#undef PG8_MMA
#undef PG8_WAIT_V
#undef PG8_WAIT_L
#undef PG8_BAR
#undef PG8_SCHED
}
}
constexpr int NWAVES = 8, NTHREADS = 512;
constexpr int D = 2048, NB = 4, T = 4096, M = NB * T, DEPTH = 4, GW = 512, NH = 8, HD = 64;
constexpr int NIN = 5544, NP = 5632, FF = 5632, MODW = 6 * D;
constexpr int PC_RR = 0, PC_RK = 512, PC_RV = 1024, PC_SQ = 1536, PC_SK = 2048, PC_SV = 2176, PC_GU = 2304, PC_GV = 2816;
constexpr int PC_FQ = 3328, PC_FK = 3840, PC_FV = 4352, PC_FG = 4864, PC_RW = 5376, PC_FL = 5536;
constexpr int YC_A = 0, YC_B = 512, YC_C = 1024, YC_D = 1536;
constexpr int SGU_TRI = 8256;
enum { I_X = 0, I_C, I_WMOD, I_BMOD, I_N1G, I_N2G, I_WIN, I_WOUT, I_RMU, I_RW0, I_RW2, I_RA0, I_RA2, I_RG2, I_RKK, I_RKA, I_RRK, I_RLG, I_RLB,
       I_SQG, I_SKG, I_SSINK, I_GLG, I_GLB, I_GWS, I_GB, I_FQG, I_FKG, I_FFB, I_W1, I_W3, I_W2, N_INPUTS };

constexpr size_t MiB = 1u << 20;
constexpr size_t WS_CTL = 0, CTL_ZERO_BYTES = 1 * MiB;
constexpr size_t WS_MOD = 1 * MiB;
constexpr size_t WS_MODP = 2 * MiB;
constexpr size_t WS_WIN = 8 * MiB;
constexpr size_t WS_WOUT = 96 * MiB;
constexpr size_t WS_W13 = 128 * MiB;
constexpr size_t WS_W2 = 304 * MiB;
constexpr size_t WS_H = 392 * MiB;
constexpr size_t WS_PROJ = 456 * MiB;
constexpr size_t WS_YCAT = 632 * MiB;
constexpr size_t WS_F = 696 * MiB;
constexpr size_t WS_RIN = 872 * MiB;
constexpr size_t WS_RG = 1064 * MiB;
constexpr size_t WS_RY = 1096 * MiB;
constexpr size_t WS_END = 1128 * MiB;
constexpr int CW_BAR = 4096;

constexpr int RING_BYTES = 131072;
constexpr int LDSCTL_OFF = RING_BYTES, MISC_OFF = LDSCTL_OFF + 320;
constexpr int LDS_BYTES = 147456;

#define GAS __attribute__((address_space(1)))
#define LAS __attribute__((address_space(3)))
typedef unsigned short bf16;
typedef short bf16x8 __attribute__((ext_vector_type(8)));
typedef float f32x4 __attribute__((ext_vector_type(4)));
typedef float f32x16 __attribute__((ext_vector_type(16)));
typedef unsigned v4u __attribute__((ext_vector_type(4)));
typedef unsigned v2u __attribute__((ext_vector_type(2)));
#define LDS_WAIT() asm volatile("s_waitcnt lgkmcnt(0)" ::: "memory")
__device__ __forceinline__ float bf2f(unsigned short b) { return __uint_as_float(((unsigned)b) << 16); }
__device__ __forceinline__ unsigned f2bf(float f) { unsigned u = __float_as_uint(f); return (u + 0x7fffu + ((u >> 16) & 1u)) >> 16; }
typedef float f32x2_t __attribute__((ext_vector_type(2))); typedef __bf16 bf16x2_t __attribute__((ext_vector_type(2)));
__device__ __forceinline__ unsigned pk2(float lo, float hi) { const f32x2_t v = {lo, hi}; const bf16x2_t b = __builtin_convertvector(v, bf16x2_t); return __builtin_bit_cast(unsigned, b); }
__device__ __forceinline__ float bflo(unsigned w) { return __uint_as_float(w << 16); }
__device__ __forceinline__ float bfhi(unsigned w) { return __uint_as_float(w & 0xffff0000u); }
__device__ __forceinline__ float wave_sum(float v) {
#pragma unroll
    for (int o = 1; o < 64; o <<= 1) v += __shfl_xor(v, o);
    return v;
}
__device__ __forceinline__ float sigmoidf_(float x) { return __builtin_amdgcn_rcpf(1.0f + __expf(-x)); }
__device__ __forceinline__ float gelu_f(float v) {
    const float av = fabsf(v), t = __builtin_amdgcn_rcpf(av * 0.2316418882f + 1.0f);
    float q = t * 0.5307027145f + (-0.7265760135f); q = q * t + 0.7107068705f; q = q * t + (-0.142248368f); q = q * t + 0.127414796f; q = q * t;
    const float e = __builtin_amdgcn_exp2f((v * v) * (-0.72134752044f));
    const float m = v * (q * e);
    return v < 0.f ? m : v - m;
}
__device__ __forceinline__ int crow(int r, int hi) { return (r & 3) + 8 * (r >> 2) + 4 * hi; }

#define XB_TMO      128
#define XB_XCNT(j)  (256  + 64 * (j))
#define XB_XSUB(j)  (1280 + 64 * (j))
#define XB_XGEN(j)  (2304 + 64 * (j))
#define XB_TOP      3328
#define XB_TOPGEN   3392
#define XCD_BAR_WORDS 3456
#define XB_SPIN_CAP (1u << 18)

__device__ __forceinline__ unsigned xb_ld(unsigned* p)              { return __hip_atomic_load(p, __ATOMIC_RELAXED, __HIP_MEMORY_SCOPE_AGENT); }
__device__ __forceinline__ unsigned xb_add(unsigned* p, unsigned v) { return __hip_atomic_fetch_add(p, v, __ATOMIC_RELAXED, __HIP_MEMORY_SCOPE_AGENT); }
__device__ __forceinline__ unsigned xb_xcc_id() { return (unsigned)__builtin_amdgcn_s_getreg((3 << 11) | 20) & 0xFu; }
#define XB_SPIN(cond, bar) do { unsigned _sp = 0; while (cond) { __builtin_amdgcn_s_sleep(1); \
    if ((++_sp & 255u) == 0u) { if (xb_ld(&(bar)[XB_TMO])) break; if (_sp > XB_SPIN_CAP) { atomicAdd(&(bar)[XB_TMO], 1u); break; } } } } while (0)

struct XcdBarrier {
    unsigned* bar; unsigned x;
    volatile LAS unsigned* st;
};

__device__ __forceinline__ XcdBarrier xcd_barrier_post(unsigned* bar, volatile LAS unsigned* st) {
    XcdBarrier b; b.bar = bar; b.x = xb_xcc_id(); b.st = st;
    if (threadIdx.x == 0) (void)xb_add(&bar[XB_XCNT(b.x)], 1u);
    return b;
}
__device__ __forceinline__ void xcd_barrier_complete(unsigned* bar, unsigned x, unsigned& nloc, unsigned& nx) {
    const unsigned G = gridDim.x * gridDim.y * gridDim.z;
    unsigned sum, cnt, mine, sp = 0u;
    for (;;) {
        sum = 0u; cnt = 0u; mine = 0u;
#pragma unroll
        for (unsigned j = 0; j < 16; ++j) { const unsigned c = xb_ld(&bar[XB_XCNT(j)]); sum += c; cnt += (c > 0u) ? 1u : 0u; mine = (j == x) ? c : mine; }
        if (sum == G) break;
        __builtin_amdgcn_s_sleep(1);
        if ((++sp & 255u) == 0u) { if (xb_ld(&bar[XB_TMO])) break; if (sp > XB_SPIN_CAP) { atomicAdd(&bar[XB_TMO], 1u); break; } }
    }
    nloc = mine > 0u ? mine : 1u; nx = cnt > 0u ? cnt : 1u;
}

__device__ __forceinline__ void xcd_barrier(const XcdBarrier& b) {
    asm volatile("s_waitcnt vmcnt(0)" ::: "memory");
    __syncthreads();
    if (threadIdx.x == 0) {
        unsigned* bar = b.bar;
        __builtin_amdgcn_s_waitcnt(0);
        unsigned nloc = b.st[0], nx = b.st[1];
        if (nloc == 0u) { xcd_barrier_complete(bar, b.x, nloc, nx); b.st[0] = nloc; b.st[1] = nx; }
        const unsigned old = xb_add(&bar[XB_XSUB(b.x)], 1u);
        const unsigned gen = old / nloc;
        if (old + 1u == (gen + 1u) * nloc) {
            __builtin_amdgcn_fence(__ATOMIC_RELEASE, "agent");
            asm volatile("s_waitcnt vmcnt(0)" ::: "memory");
            const unsigned og = xb_add(&bar[XB_TOP], 1u);
            const unsigned tg = og / nx;
            if (og + 1u == (tg + 1u) * nx) xb_add(&bar[XB_TOPGEN], 1u);
            else XB_SPIN(xb_ld(&bar[XB_TOPGEN]) == tg, bar);
            __builtin_amdgcn_fence(__ATOMIC_ACQUIRE, "agent");
            xb_add(&bar[XB_XGEN(b.x)], 1u);
            asm volatile("s_waitcnt vmcnt(0)" ::: "memory");
        } else {
            XB_SPIN(xb_ld(&bar[XB_XGEN(b.x)]) == gen, bar);
            __builtin_amdgcn_fence(__ATOMIC_ACQUIRE, "agent");
            asm volatile("s_waitcnt vmcnt(0)" ::: "memory");
        }
    }
    __syncthreads();
}

struct Args { const float* in[N_INPUTS]; float* out; unsigned char* ws; int ph_lo, ph_hi; };
static_assert(sizeof(Args) == (N_INPUTS + 2) * 8 + 8, "Args has no padding");

struct Ctx {
    LAS unsigned char* lds; int tid, lane, wave, G, bid;
};
typedef const Args __attribute__((address_space(4))) KArgs;
__device__ __forceinline__ KArgs* ka_ptr() { KArgs* p = (KArgs*)__builtin_amdgcn_kernarg_segment_ptr(); asm volatile("" : "+s"(p)); return p; }
#define KA_DECL KArgs& A = *ka_ptr()
#define LBAR() do { asm volatile("s_waitcnt lgkmcnt(0)" ::: "memory"); __builtin_amdgcn_s_barrier(); asm volatile("" ::: "memory"); } while (0)

__device__ __forceinline__ void tr_item(const float* __restrict__ W, int N, int col0, int nvalid, int k0, bf16* __restrict__ WT, int K, int n0, LAS float* scr, int lane) {
    float wv[32];
    const int nn = lane & 31; const bool okc = nn < nvalid; const float* wp = W + (size_t)(k0 + (lane >> 5)) * N + col0 + (okc ? nn : 0);
#pragma unroll
    for (int i = 0; i < 32; ++i) wv[i] = wp[(size_t)(2 * i) * N];
#pragma unroll
    for (int i = 0; i < 32; ++i) scr[(2 * i + (lane >> 5)) * 33 + nn] = okc ? wv[i] : 0.f;
    LDS_WAIT(); asm volatile("" ::: "memory");
    const int c = lane & 7;
#pragma unroll
    for (int j = 0; j < 4; ++j) { const int n = (lane >> 3) + 8 * j; const LAS float* s = scr + (8 * c) * 33 + n;
        v4u o; o.x = pk2(s[0 * 33], s[1 * 33]); o.y = pk2(s[2 * 33], s[3 * 33]); o.z = pk2(s[4 * 33], s[5 * 33]); o.w = pk2(s[6 * 33], s[7 * 33]);
        *(v4u*)(WT + (size_t)(n0 + n) * K + k0 + 8 * c) = o; }
    LDS_WAIT(); asm volatile("" ::: "memory");
}
__device__ __forceinline__ void ph_prologue(const Ctx& C) {
    KA_DECL;
    LAS float* csilu = (LAS float*)(C.lds + 73728);
    for (int i = C.tid; i < NB * D; i += NTHREADS) { const float c = A.in[I_C][i]; csilu[i] = c / (1.0f + __expf(-c)); }
    __syncthreads();
    LAS float* scr = (LAS float*)(C.lds + C.wave * 8704);
    const int gw = C.bid * NWAVES + C.wave, NGW = C.G * NWAVES;
    constexpr int I_IN = (D / 64) * (NP / 32), I_OUT = (D / 64) * (D / 32), I_13 = (D / 64) * (2 * FF / 32), I_2 = (FF / 64) * (D / 32), PER_L = I_IN + I_OUT + I_13 + I_2;
    for (int it = gw; it < DEPTH * PER_L; it += NGW) {
        const int l = it / PER_L; int r = it % PER_L;
        if (r < I_IN) { const int kb = r / (NP / 32), nb = r % (NP / 32), n0 = 32 * nb; int col0, nv = 32;
            if (n0 < 1536) col0 = n0; else if (n0 < 4864) col0 = n0 + 160; else if (n0 < 5376) col0 = n0 + 168; else if (n0 < 5536) col0 = n0 - 3840;
            else if (n0 == 5536) { col0 = 5024; nv = 8; } else { col0 = 0; nv = 0; }
            tr_item(A.in[I_WIN] + (size_t)l * D * NIN, NIN, col0, nv, 64 * kb, (bf16*)(A.ws + WS_WIN) + (size_t)l * NP * D, D, n0, scr, C.lane); continue; }
        r -= I_IN;
        if (r < I_OUT) { const int kb = r / (D / 32), nb = r % (D / 32);
            tr_item(A.in[I_WOUT] + (size_t)l * D * D, D, 32 * nb, 32, 64 * kb, (bf16*)(A.ws + WS_WOUT) + (size_t)l * D * D, D, 32 * nb, scr, C.lane); continue; }
        r -= I_OUT;
        if (r < I_13) { const int kb = r / (2 * FF / 32), nb = r % (2 * FF / 32), n0 = 32 * nb, pn = n0 >> 8, j = n0 & 255;
            const float* src = (j < 128 ? A.in[I_W1] : A.in[I_W3]) + (size_t)l * D * FF;
            tr_item(src, FF, 128 * pn + (j & 127), 32, 64 * kb, (bf16*)(A.ws + WS_W13) + (size_t)l * 2 * FF * D, D, n0, scr, C.lane); continue; }
        r -= I_13;
        { const int kb = r / (D / 32), nb = r % (D / 32);
            tr_item(A.in[I_W2] + (size_t)l * FF * D, D, 32 * nb, 32, 64 * kb, (bf16*)(A.ws + WS_W2) + (size_t)l * D * FF, FF, 32 * nb, scr, C.lane); }
    }
    for (int it = gw; it < 8 * DEPTH * (MODW / 256); it += NGW) {
        const int cg = it % (DEPTH * (MODW / 256)), ks = it / (DEPTH * (MODW / 256)), l = cg / (MODW / 256), n0 = (cg % (MODW / 256)) * 256, k0 = ks * 256;
        const float* wp = A.in[I_WMOD] + ((size_t)l * D + k0) * MODW + n0 + 4 * C.lane;
        f32x4 a0 = {0.f, 0.f, 0.f, 0.f}, a1 = a0, a2 = a0, a3 = a0;
#pragma unroll 16
        for (int k = 0; k < 256; ++k) { const f32x4 w = *(const f32x4*)(wp + (size_t)k * MODW);
            a0 += w * csilu[0 * D + k0 + k]; a1 += w * csilu[1 * D + k0 + k]; a2 += w * csilu[2 * D + k0 + k]; a3 += w * csilu[3 * D + k0 + k]; }
        float* mp = (float*)(A.ws + WS_MODP) + ((size_t)(ks * DEPTH + l) * NB) * MODW + n0 + 4 * C.lane;
        *(f32x4*)(mp + 0 * MODW) = a0; *(f32x4*)(mp + 1 * MODW) = a1; *(f32x4*)(mp + 2 * MODW) = a2; *(f32x4*)(mp + 3 * MODW) = a3;
    }
}
__device__ __forceinline__ void ph_modreduce(const Ctx& C) {
    KA_DECL;
    const float* mp = (const float*)(A.ws + WS_MODP); float* mod = (float*)(A.ws + WS_MOD);
    for (int i = C.bid * NTHREADS + C.tid; i < DEPTH * NB * MODW; i += C.G * NTHREADS) {
        const int l = i / (NB * MODW), n = i % MODW; float s = A.in[I_BMOD][l * MODW + n];
#pragma unroll
        for (int ks = 0; ks < 8; ++ks) s += mp[(size_t)ks * DEPTH * NB * MODW + i];
        mod[i] = s;
    }
}
__device__ __forceinline__ void ph_norm(const Ctx& C, const float* x, const float* g, const float* shift, const float* scale, bf16* H) {
    const int gw = C.bid * NWAVES + C.wave, NGW = C.G * NWAVES;
    for (int m = gw; m < M; m += NGW) {
        const int b = m / T; const f32x4* xr = (const f32x4*)(x + (size_t)m * D) + C.lane;
        f32x4 v[8]; float ss = 0.f;
#pragma unroll
        for (int j = 0; j < 8; ++j) { v[j] = xr[64 * j]; ss += (v[j].x * v[j].x + v[j].y * v[j].y) + (v[j].z * v[j].z + v[j].w * v[j].w); }
        const float rstd = 1.0f / sqrtf(wave_sum(ss) * (1.0f / D) + 1e-6f);
        unsigned long long* o8 = (unsigned long long*)(H + (size_t)m * D) + C.lane;
        f32x4 cv[8], sh[8];
#pragma unroll
        for (int j = 0; j < 8; ++j) { const int c = 4 * (C.lane + 64 * j);
            const f32x4 gg = *(const f32x4*)(g + c), sc = *(const f32x4*)(scale + (size_t)b * MODW + c); sh[j] = *(const f32x4*)(shift + (size_t)b * MODW + c); cv[j] = gg * (sc + 1.0f); }
#pragma unroll
        for (int j = 0; j < 8; ++j) { const f32x4 y = v[j] * rstd * cv[j] + sh[j];
            o8[64 * j] = (unsigned long long)pk2(y.x, y.y) | ((unsigned long long)pk2(y.z, y.w) << 32); }
    }
}

__device__ __forceinline__ float dpp_xor1(float v) { return __builtin_bit_cast(float, __builtin_amdgcn_update_dpp(0, __builtin_bit_cast(int, v), 0xB1, 0xF, 0xF, true)); }
__device__ __forceinline__ float dpp_xor2(float v) { return __builtin_bit_cast(float, __builtin_amdgcn_update_dpp(0, __builtin_bit_cast(int, v), 0x4E, 0xF, 0xF, true)); }
__device__ __forceinline__ float wave_sum_dpp(float v) {
    v += dpp_xor1(v); v += dpp_xor2(v);
    v += __builtin_bit_cast(float, __builtin_amdgcn_update_dpp(0, __builtin_bit_cast(int, v), 0x141, 0xF, 0xF, true));
    v += __builtin_bit_cast(float, __builtin_amdgcn_update_dpp(0, __builtin_bit_cast(int, v), 0x140, 0xF, 0xF, true));
    const int b = __builtin_bit_cast(int, v);
    return (__builtin_bit_cast(float, __builtin_amdgcn_readlane(b, 0)) + __builtin_bit_cast(float, __builtin_amdgcn_readlane(b, 16))) +
           (__builtin_bit_cast(float, __builtin_amdgcn_readlane(b, 32)) + __builtin_bit_cast(float, __builtin_amdgcn_readlane(b, 48)));
}

__device__ __forceinline__ f32x16 mma32(const LAS bf16* Ap, const LAS bf16* Bp, int ksteps, f32x16 acc) {
    for (int k = 0; k < ksteps; ++k) { const bf16x8 a = *(const LAS bf16x8*)(Ap + 16 * k), b = *(const LAS bf16x8*)(Bp + 16 * k);
        acc = __builtin_amdgcn_mfma_f32_32x32x16_bf16(a, b, acc, 0, 0, 0); }
    return acc;
}
constexpr int AP = 72;
constexpr size_t WS_QF = WS_RIN, WS_YF = WS_RIN + 32 * MiB, WS_PA = WS_RIN + 64 * MiB, WS_RT = WS_RIN + 80 * MiB, WS_GL = WS_RIN + 96 * MiB, WS_RBV = WS_RIN + 97 * MiB;
constexpr size_t WS_CUM = WS_RIN + 170 * MiB;
constexpr size_t WS_KNF = WS_RIN + 130 * MiB, WS_KNS = WS_RIN + 146 * MiB, WS_VTF = WS_RIN + 150 * MiB, WS_VTS = WS_RIN + 166 * MiB;
__device__ __forceinline__ void kvprep_unit(const Ctx& C, int l, int u) {
    KA_DECL; asm volatile("" : "+s"(l));
    const bf16* proj = (const bf16*)(A.ws + WS_PROJ);
    int tid = C.tid; asm volatile("" : "+v"(tid));
    const size_t m0 = (size_t)u * 64; const int b = (int)(m0 / T), t0 = (int)(m0 % T);
    bf16* KNF = (bf16*)(A.ws + WS_KNF); bf16* KNS = (bf16*)(A.ws + WS_KNS); bf16* VTF = (bf16*)(A.ws + WS_VTF); bf16* VTS = (bf16*)(A.ws + WS_VTS);
    LAS bf16* Vl = (LAS bf16*)C.lds;
    LBAR();
    float gF[8], gS[8];
#pragma unroll
    for (int i = 0; i < 8; ++i) { gF[i] = A.in[I_FKG][l * 64 + 8 * (tid & 7) + i]; gS[i] = A.in[I_SKG][l * 64 + 8 * (tid & 7) + i]; }
    for (int half = 0; half < 2; ++half) {
        v4u krr[5];
#pragma unroll
        for (int it = 0; it < 5; ++it) { const int i = tid + NTHREADS * (5 * half + it), tok = i / 80, ch = i % 80;
            krr[it] = *(const v4u*)(proj + (m0 + tok) * NP + ((ch < 64) ? PC_FK + 8 * ch : PC_SK + 8 * (ch - 64))); }
#pragma unroll
        for (int it = 0; it < 5; ++it) { const int i = tid + NTHREADS * (5 * half + it), tok = i / 80, ch = i % 80; const size_t m = m0 + tok;
            const bool fox = ch < 64;
            float g[8];
#pragma unroll
            for (int q = 0; q < 8; ++q) g[q] = fox ? gF[q] : gS[q];
            const v4u kr = krr[it];
            float f[8]; f[0] = bflo(kr.x); f[1] = bfhi(kr.x); f[2] = bflo(kr.y); f[3] = bfhi(kr.y); f[4] = bflo(kr.z); f[5] = bfhi(kr.z); f[6] = bflo(kr.w); f[7] = bfhi(kr.w);
            float ss = ((f[0] * f[0] + f[1] * f[1]) + (f[2] * f[2] + f[3] * f[3])) + ((f[4] * f[4] + f[5] * f[5]) + (f[6] * f[6] + f[7] * f[7]));
            ss += dpp_xor1(ss); ss += dpp_xor2(ss); ss += __shfl_xor(ss, 4);
            const float rs = __builtin_amdgcn_rsqf(ss * (1.0f / 64.0f) + 1e-6f);
            v4u ko; ko.x = pk2(f[0] * rs * g[0], f[1] * rs * g[1]); ko.y = pk2(f[2] * rs * g[2], f[3] * rs * g[3]); ko.z = pk2(f[4] * rs * g[4], f[5] * rs * g[5]); ko.w = pk2(f[6] * rs * g[6], f[7] * rs * g[7]);
            if (fox) *(v4u*)(KNF + m * 512 + 8 * ch) = ko; else *(v4u*)(KNS + m * 128 + 8 * (ch - 64)) = ko; }
    }
#pragma unroll
    for (int it = 0; it < 10; ++it) { const int i = tid + NTHREADS * it, head = i >> 9, rem = i & 511, tok = rem >> 3, dc = rem & 7;
        const int scol = (head < 8) ? PC_FV + head * 64 + 8 * dc : PC_SV + (head - 8) * 64 + 8 * dc;
        *(LAS v4u*)(Vl + (head * 64 + tok) * AP + 8 * dc) = *(const v4u*)(proj + (m0 + tok) * NP + scol); }
    LBAR();
    for (int it = 0; it < 10; ++it) { const int i = tid + NTHREADS * it, head = i >> 9, rem = i & 511, d = rem >> 3, tc = rem & 7;
        const LAS bf16* src = Vl + (head * 64 + 8 * tc) * AP + d;
        v4u o; o.x = (unsigned)src[0] | ((unsigned)src[AP] << 16); o.y = (unsigned)src[2 * AP] | ((unsigned)src[3 * AP] << 16); o.z = (unsigned)src[4 * AP] | ((unsigned)src[5 * AP] << 16); o.w = (unsigned)src[6 * AP] | ((unsigned)src[7 * AP] << 16);
        bf16* dst = (head < 8) ? VTF + ((size_t)(b * 8 + head) * 64 + d) * T : VTS + ((size_t)(b * 2 + head - 8) * 64 + d) * T;
        *(v4u*)(dst + t0 + 8 * tc) = o; }
}
__device__ __forceinline__ void cumprep_unit(const Ctx& C, int l, int bh) {
    KA_DECL; asm volatile("" : "+s"(l));
    const bf16* proj = (const bf16*)(A.ws + WS_PROJ); float* cumg = (float*)(A.ws + WS_CUM) + (size_t)bh * T;
    const int tid = C.tid, lane = C.lane, wave = C.wave, b = bh >> 3, h = bh & 7; const size_t rowb = (size_t)b * T;
    LAS float* WT = (LAS float*)C.lds;
    const float fb = A.in[I_FFB][l * NH + h];
    LBAR();
    float loc[8]; float s = 0.f;
    bf16 xr[8];
#pragma unroll
    for (int i = 0; i < 8; ++i) xr[i] = proj[(rowb + 8 * tid + i) * NP + PC_FL + h];
#pragma unroll
    for (int i = 0; i < 8; ++i) { const float x = bf2f(xr[i]) + fb;
        const float e_ = __expf(-fabsf(x)); const float v = fminf(x, 0.f) - __logf(1.0f + e_); s += v; loc[i] = s; }
    float ws_ = s;
#pragma unroll
    for (int o = 1; o < 64; o <<= 1) { const float t_ = __shfl_up(ws_, o); if (lane >= o) ws_ += t_; }
    if (lane == 63) WT[wave] = ws_;
    LBAR();
    float base = ws_ - s;
    for (int w = 0; w < wave; ++w) base += WT[w];
    f32x4 o0 = {(base + loc[0]) * 1.4426950408889634f, (base + loc[1]) * 1.4426950408889634f, (base + loc[2]) * 1.4426950408889634f, (base + loc[3]) * 1.4426950408889634f};
    f32x4 o1 = {(base + loc[4]) * 1.4426950408889634f, (base + loc[5]) * 1.4426950408889634f, (base + loc[6]) * 1.4426950408889634f, (base + loc[7]) * 1.4426950408889634f};
    *(f32x4*)(cumg + 8 * tid) = o0; *(f32x4*)(cumg + 8 * tid + 4) = o1;
}
constexpr int B_K = 0, B_VT = 18432, B_CUM = 36864, B_WT = 53248;
__device__ __forceinline__ float max3f(float a, float b, float c) { float r; asm("v_max3_f32 %0, %1, %2, %3" : "=v"(r) : "v"(a), "v"(b), "v"(c)); return r; }
__device__ __forceinline__ float max_halves(float m) { auto rr = __builtin_amdgcn_permlane32_swap(__float_as_uint(m), __float_as_uint(m), false, false); return fmaxf(__uint_as_float(rr[0]), __uint_as_float(rr[1])); }
__device__ __forceinline__ float sum_halves(float m) { auto rr = __builtin_amdgcn_permlane32_swap(__float_as_uint(m), __float_as_uint(m), false, false); return __uint_as_float(rr[0]) + __uint_as_float(rr[1]); }
template <int MODE>
__device__ __forceinline__ void attn2_unit(const Ctx& C, int l, int b, int h, int qb) {
    KA_DECL; asm volatile("" : "+s"(l));
    const bf16* proj = (const bf16*)(A.ws + WS_PROJ); bf16* ycat = (bf16*)(A.ws + WS_YCAT);
    int tid = C.tid; asm volatile("" : "+v"(tid));
    const int lane = tid & 63, wave = C.wave, r32 = lane & 31, hi = lane >> 5;
    const int q0 = qb * 256; const size_t rowb = (size_t)b * T;
    const int qcol = (MODE == 0 ? PC_SQ : PC_FQ) + h * 64;
    const bf16* KN = (MODE == 0) ? (const bf16*)(A.ws + WS_KNS) + (h >> 2) * 64 : (const bf16*)(A.ws + WS_KNF) + h * 64;
    constexpr int KPI = (MODE == 0) ? 128 : 512;
    const bf16* VT = (MODE == 0) ? (const bf16*)(A.ws + WS_VTS) + (size_t)(b * 2 + (h >> 2)) * 64 * T : (const bf16*)(A.ws + WS_VTF) + (size_t)(b * 8 + h) * 64 * T;
    const float* qg = A.in[MODE == 0 ? I_SQG : I_FQG] + l * 64;
    LAS bf16* Ks = (LAS bf16*)(C.lds + B_K); LAS bf16* Vt = (LAS bf16*)(C.lds + B_VT); LAS float* cum = (LAS float*)(C.lds + B_CUM); LAS float* WT = (LAS float*)(C.lds + B_WT);
    constexpr float LOG2E = 1.4426950408889634f;
    LBAR();
    if (MODE == 1) {
        const float* cumg = (const float*)(A.ws + WS_CUM) + (size_t)(b * NH + h) * T;
        for (int i = tid; i < (q0 + 256) / 4; i += NTHREADS) *(LAS f32x4*)(cum + 4 * i) = *(const f32x4*)(cumg + 4 * i);
    }
    const int qp = q0 + 32 * wave + r32;
    bf16x8 qf[4];
    {
        const bf16* src = proj + (rowb + qp) * NP + qcol + 8 * hi;
        v4u raw[4]; float ss = 0.f;
#pragma unroll
        for (int s4 = 0; s4 < 4; ++s4) { raw[s4] = *(const v4u*)(src + 16 * s4);
            const float f0 = bflo(raw[s4].x), f1 = bfhi(raw[s4].x), f2 = bflo(raw[s4].y), f3 = bfhi(raw[s4].y), f4 = bflo(raw[s4].z), f5 = bfhi(raw[s4].z), f6 = bflo(raw[s4].w), f7 = bfhi(raw[s4].w);
            ss += ((f0 * f0 + f1 * f1) + (f2 * f2 + f3 * f3)) + ((f4 * f4 + f5 * f5) + (f6 * f6 + f7 * f7)); }
        ss = sum_halves(ss);
        const float rs = (0.125f * LOG2E) / sqrtf(ss * (1.0f / 64.0f) + 1e-6f);
#pragma unroll
        for (int s4 = 0; s4 < 4; ++s4) { const float* g8 = qg + 16 * s4 + 8 * hi; v4u o;
            o.x = pk2(bflo(raw[s4].x) * rs * g8[0], bfhi(raw[s4].x) * rs * g8[1]); o.y = pk2(bflo(raw[s4].y) * rs * g8[2], bfhi(raw[s4].y) * rs * g8[3]);
            o.z = pk2(bflo(raw[s4].z) * rs * g8[4], bfhi(raw[s4].z) * rs * g8[5]); o.w = pk2(bflo(raw[s4].w) * rs * g8[6], bfhi(raw[s4].w) * rs * g8[7]);
            qf[s4] = __builtin_bit_cast(bf16x8, o); }
    }
    int ks_begin = (MODE == 0) ? (q0 >= 128 ? q0 - 128 : 0) : 0; const int ks_end = q0 + 256;
    if (MODE == 1) {
        const float* cumg = (const float*)(A.ws + WS_CUM) + (size_t)(b * NH + h) * T;
        float gq = fabsf(qg[lane]), gk = fabsf(A.in[I_FKG][l * 64 + lane]);
#pragma unroll
        for (int o = 1; o < 64; o <<= 1) { gq = fmaxf(gq, __shfl_xor(gq, o)); gk = fmaxf(gk, __shfl_xor(gk, o)); }
        const float B2 = 8.0f * LOG2E * gq * gk * 1.05f;
        const int ntile = q0 >> 6;
        const bool skip = (lane < ntile) && (cumg[q0] - cumg[64 * lane + 63] + 2.0f * B2 < -172.0f);
        ks_begin = 64 * __builtin_popcountll(__ballot(skip));
    }
    const int srow = tid >> 3, sdc = (tid & 7) * 8;
    v4u kreg[2], vreg[2];
#define A2_LOAD(S_, ks_) do { kreg[S_] = *(const v4u*)(KN + (rowb + (ks_) + srow) * KPI + sdc); vreg[S_] = *(const v4u*)(VT + (size_t)srow * T + (ks_) + sdc); } while (0)
#define A2_STAGE(S_, buf_) do { *(LAS v4u*)(Ks + (buf_) * 64 * AP + srow * AP + sdc) = kreg[S_]; *(LAS v4u*)(Vt + (buf_) * 64 * AP + srow * AP + sdc) = vreg[S_]; } while (0)
    A2_LOAD(0, ks_begin); A2_LOAD(1, ks_begin + 64);
    A2_STAGE(0, 0);
    if (ks_begin + 128 < ks_end) A2_LOAD(0, ks_begin + 128);
    float m_run = -1e30f, l_run = 0.f;
    f32x16 o0, o1, cqv;
#pragma unroll
    for (int r = 0; r < 16; ++r) { o0[r] = 0.f; o1[r] = 0.f; cqv[r] = 0.f; }
    const int qmax = q0 + 32 * wave + 31, qmin = q0 + 32 * wave;
    int buf = 0;
    for (int ks = ks_begin; ks < ks_end; ks += 64, buf ^= 1) {
        LBAR();
        if (MODE == 1 && ks == ks_begin) { const float cq = cum[qp];
#pragma unroll
            for (int r = 0; r < 16; ++r) cqv[r] = cq; }
        if (ks + 64 < ks_end) { if (buf == 0) { A2_STAGE(1, 1); if (ks + 192 < ks_end) A2_LOAD(1, ks + 192); } else { A2_STAGE(0, 0); if (ks + 192 < ks_end) A2_LOAD(0, ks + 192); } }
        const bool live = (MODE == 1) ? (ks <= qmax) : (ks <= qmax && ks + 63 > qmin - 128);
        if (live) {
            const LAS bf16* kb = Ks + buf * 64 * AP + r32 * AP + 8 * hi;
            f32x16 p0, p1;
#pragma unroll
            for (int s4 = 0; s4 < 4; ++s4) { const bf16x8 k0 = *(const LAS bf16x8*)(kb + 16 * s4), k1 = *(const LAS bf16x8*)(kb + 32 * AP + 16 * s4);
                if (s4 == 0) { p0 = __builtin_amdgcn_mfma_f32_32x32x16_bf16(k0, qf[0], cqv, 0, 0, 0); p1 = __builtin_amdgcn_mfma_f32_32x32x16_bf16(k1, qf[0], cqv, 0, 0, 0); }
                else { p0 = __builtin_amdgcn_mfma_f32_32x32x16_bf16(k0, qf[s4], p0, 0, 0, 0); p1 = __builtin_amdgcn_mfma_f32_32x32x16_bf16(k1, qf[s4], p1, 0, 0, 0); } }
            if (MODE == 1) {
#pragma unroll
                for (int q4 = 0; q4 < 4; ++q4) { const f32x4 c0 = *(const LAS f32x4*)(cum + ks + 8 * q4 + 4 * hi), c1 = *(const LAS f32x4*)(cum + ks + 32 + 8 * q4 + 4 * hi);
                    p0[4 * q4] -= c0.x; p0[4 * q4 + 1] -= c0.y; p0[4 * q4 + 2] -= c0.z; p0[4 * q4 + 3] -= c0.w;
                    p1[4 * q4] -= c1.x; p1[4 * q4 + 1] -= c1.y; p1[4 * q4 + 2] -= c1.z; p1[4 * q4 + 3] -= c1.w; }
            }
            const bool edge = (MODE == 1) ? (ks + 63 > qmin) : true;
            if (edge) {
#pragma unroll
                for (int r = 0; r < 16; ++r) { const int k0p = ks + crow(r, hi), k1p = k0p + 32;
                    const bool ok0 = (MODE == 1) ? (k0p <= qp) : (k0p <= qp && k0p > qp - 128), ok1 = (MODE == 1) ? (k1p <= qp) : (k1p <= qp && k1p > qp - 128);
                    p0[r] = ok0 ? p0[r] : -1e30f; p1[r] = ok1 ? p1[r] : -1e30f; }
            }
            float mx = max3f(p0[0], p1[0], p0[1]);
#pragma unroll
            for (int r = 1; r < 15; r += 2) mx = max3f(mx, p1[r], p0[r + 1]), mx = max3f(mx, p1[r + 1], (r + 2 < 16) ? p0[r + 2] : p1[r + 1]);
            mx = max3f(mx, p1[15], p1[15]);
            mx = max_halves(mx);
            const float m_new = (mx > m_run + 8.0f) ? mx : m_run;
            float rsum = 0.f;
            if (MODE == 1) {
#pragma unroll
                for (int r = 0; r < 16; ++r) { p0[r] = __builtin_amdgcn_exp2f(p0[r] - m_new); p1[r] = __builtin_amdgcn_exp2f(p1[r] - m_new); }
                float ra = 0.f, rb = 0.f, rc = 0.f, rd = 0.f;
#pragma unroll
                for (int r = 0; r < 16; r += 2) { ra += p0[r]; rb += p1[r]; rc += p0[r + 1]; rd += p1[r + 1]; }
                rsum = (ra + rb) + (rc + rd);
            } else {
#pragma unroll
                for (int r = 0; r < 16; ++r) { p0[r] = (p0[r] > -1e29f) ? __builtin_amdgcn_exp2f(p0[r] - m_new) : 0.f; p1[r] = (p1[r] > -1e29f) ? __builtin_amdgcn_exp2f(p1[r] - m_new) : 0.f; rsum += p0[r] + p1[r]; }
            }
            if (__any(m_new != m_run)) {
                const float alpha = __builtin_amdgcn_exp2f(m_run - m_new);
                l_run *= alpha;
#pragma unroll
                for (int r = 0; r < 16; ++r) { o0[r] *= alpha; o1[r] *= alpha; }
                m_run = m_new;
            }
            l_run += rsum;
            bf16x8 pf[4];
            { v4u w;
              w.x = pk2(p0[0], p0[1]); w.y = pk2(p0[2], p0[3]); w.z = pk2(p0[4], p0[5]); w.w = pk2(p0[6], p0[7]); pf[0] = __builtin_bit_cast(bf16x8, w);
              w.x = pk2(p0[8], p0[9]); w.y = pk2(p0[10], p0[11]); w.z = pk2(p0[12], p0[13]); w.w = pk2(p0[14], p0[15]); pf[1] = __builtin_bit_cast(bf16x8, w);
              w.x = pk2(p1[0], p1[1]); w.y = pk2(p1[2], p1[3]); w.z = pk2(p1[4], p1[5]); w.w = pk2(p1[6], p1[7]); pf[2] = __builtin_bit_cast(bf16x8, w);
              w.x = pk2(p1[8], p1[9]); w.y = pk2(p1[10], p1[11]); w.z = pk2(p1[12], p1[13]); w.w = pk2(p1[14], p1[15]); pf[3] = __builtin_bit_cast(bf16x8, w); }
            const LAS bf16* vb = Vt + buf * 64 * AP + r32 * AP + 4 * hi;
#pragma unroll
            for (int ks4 = 0; ks4 < 4; ++ks4) {
                const v2u a0 = *(const LAS v2u*)(vb + 16 * ks4), a1 = *(const LAS v2u*)(vb + 16 * ks4 + 8), b0 = *(const LAS v2u*)(vb + 32 * AP + 16 * ks4), b1 = *(const LAS v2u*)(vb + 32 * AP + 16 * ks4 + 8);
                const v4u fa = {a0.x, a0.y, a1.x, a1.y}, fb = {b0.x, b0.y, b1.x, b1.y};
                o0 = __builtin_amdgcn_mfma_f32_32x32x16_bf16(__builtin_bit_cast(bf16x8, fa), pf[ks4], o0, 0, 0, 0);
                o1 = __builtin_amdgcn_mfma_f32_32x32x16_bf16(__builtin_bit_cast(bf16x8, fb), pf[ks4], o1, 0, 0, 0); }
        }
    }
#undef A2_LOAD
#undef A2_STAGE
    float l_tot = sum_halves(l_run);
    if (MODE == 0) l_tot += __builtin_amdgcn_exp2f(A.in[I_SSINK][l * NH + h] * LOG2E - m_run);
    const float inv = 1.0f / l_tot;
    const size_t m = rowb + qp; bf16* orow = ycat + m * D + (MODE == 0 ? YC_B : YC_D) + h * 64;
    v2u gq0[4], gq1[4];
    if (MODE == 1) { const bf16* gp = proj + m * NP + PC_FG + h * 64;
#pragma unroll
        for (int q4 = 0; q4 < 4; ++q4) { gq0[q4] = *(const v2u*)(gp + 8 * q4 + 4 * hi); gq1[q4] = *(const v2u*)(gp + 32 + 8 * q4 + 4 * hi); } }
#pragma unroll
    for (int q4 = 0; q4 < 4; ++q4) {
        float v0[4] = {o0[4 * q4] * inv, o0[4 * q4 + 1] * inv, o0[4 * q4 + 2] * inv, o0[4 * q4 + 3] * inv}, v1[4] = {o1[4 * q4] * inv, o1[4 * q4 + 1] * inv, o1[4 * q4 + 2] * inv, o1[4 * q4 + 3] * inv};
        const int d0 = 8 * q4 + 4 * hi;
        if (MODE == 1) { const v2u g0 = gq0[q4], g1 = gq1[q4];
            v0[0] *= sigmoidf_(bflo(g0.x)); v0[1] *= sigmoidf_(bfhi(g0.x)); v0[2] *= sigmoidf_(bflo(g0.y)); v0[3] *= sigmoidf_(bfhi(g0.y));
            v1[0] *= sigmoidf_(bflo(g1.x)); v1[1] *= sigmoidf_(bfhi(g1.x)); v1[2] *= sigmoidf_(bflo(g1.y)); v1[3] *= sigmoidf_(bfhi(g1.y)); }
        v2u w0, w1; w0.x = pk2(v0[0], v0[1]); w0.y = pk2(v0[2], v0[3]); w1.x = pk2(v1[0], v1[1]); w1.y = pk2(v1[2], v1[3]);
        *(v2u*)(orow + d0) = w0; *(v2u*)(orow + 32 + d0) = w1; }
}
constexpr int GP = 136;
constexpr int G_W = 0, G_VT = 34816, G_ST = 52224;
__device__ __forceinline__ void sgu_unit(const Ctx& C, int l, int b, int chunk, int ghalf) {
    KA_DECL; asm volatile("" : "+s"(l));
    const bf16* proj = (const bf16*)(A.ws + WS_PROJ); bf16* ycat = (bf16*)(A.ws + WS_YCAT);
    int tid = C.tid; asm volatile("" : "+v"(tid));
    const int lane = tid & 63, wave = C.wave, r32 = lane & 31, hi = lane >> 5;
    const size_t m0 = (size_t)b * T + chunk * 128;
    LAS bf16* Wd = (LAS bf16*)(C.lds + G_W); LAS bf16* Vt = (LAS bf16*)(C.lds + G_VT); LAS float* ST = (LAS float*)(C.lds + G_ST);
    LBAR();
    {
        const int tok = tid >> 2, part = tid & 3; const v4u* src = (const v4u*)(proj + (m0 + tok) * NP + PC_GV + part * 128);
        float s1 = 0.f, s2 = 0.f;
#pragma unroll 4
        for (int i = 0; i < 16; ++i) { const v4u w = src[i];
            const float e0 = gelu_f(bflo(w.x)), e1 = gelu_f(bfhi(w.x)), e2 = gelu_f(bflo(w.y)), e3 = gelu_f(bfhi(w.y)), e4 = gelu_f(bflo(w.z)), e5 = gelu_f(bfhi(w.z)), e6 = gelu_f(bflo(w.w)), e7 = gelu_f(bfhi(w.w));
            s1 += ((e0 + e1) + (e2 + e3)) + ((e4 + e5) + (e6 + e7));
            s2 += ((e0 * e0 + e1 * e1) + (e2 * e2 + e3 * e3)) + ((e4 * e4 + e5 * e5) + (e6 * e6 + e7 * e7)); }
        s1 += __shfl_xor(s1, 1); s1 += __shfl_xor(s1, 2); s2 += __shfl_xor(s2, 1); s2 += __shfl_xor(s2, 2);
        const float mean = s1 * (1.0f / 512.0f), var = fmaxf(s2 * (1.0f / 512.0f) - mean * mean, 0.f);
        if (part == 0) { ST[2 * tok] = mean; ST[2 * tok + 1] = 1.0f / sqrtf(var + 1e-5f); }
    }
    LBAR();
    const int ti = wave >> 1, cj = wave & 1;
    for (int gi = 0; gi < 4; ++gi) {
        const int g = ghalf * 4 + gi;
        {
            const int row = tid >> 2, s0 = (tid & 3) * 32; const float* wsrc = A.in[I_GWS] + (size_t)(l * NH + g) * SGU_TRI + (row * (row + 1)) / 2;
            float wv[32];
#pragma unroll
            for (int i = 0; i < 32; ++i) { const int s_ = s0 + i; wv[i] = wsrc[s_ <= row ? s_ : row]; }
#pragma unroll
            for (int i = 0; i < 32; i += 2) { const int s_ = s0 + i; *(LAS unsigned*)(Wd + row * GP + s_) = pk2((s_ <= row) ? wv[i] : 0.f, (s_ + 1 <= row) ? wv[i + 1] : 0.f); }
        }
        {
            const int tok = tid >> 2, c0 = (tid & 3) * 16; const v4u* src = (const v4u*)(proj + (m0 + tok) * NP + PC_GV + g * 64 + c0);
            const v4u r0 = src[0], r1 = src[1]; const float mean = ST[2 * tok], rstd = ST[2 * tok + 1];
            const float* lg = A.in[I_GLG] + l * GW + g * 64 + c0; const float* lb = A.in[I_GLB] + l * GW + g * 64 + c0;
            float f[16];
            f[0] = bflo(r0.x); f[1] = bfhi(r0.x); f[2] = bflo(r0.y); f[3] = bfhi(r0.y); f[4] = bflo(r0.z); f[5] = bfhi(r0.z); f[6] = bflo(r0.w); f[7] = bfhi(r0.w);
            f[8] = bflo(r1.x); f[9] = bfhi(r1.x); f[10] = bflo(r1.y); f[11] = bfhi(r1.y); f[12] = bflo(r1.z); f[13] = bfhi(r1.z); f[14] = bflo(r1.w); f[15] = bfhi(r1.w);
#pragma unroll
            for (int i = 0; i < 16; ++i) { const float y = (gelu_f(f[i]) - mean) * rstd * lg[i] + lb[i]; Vt[(c0 + i) * GP + tok] = (bf16)f2bf(y); }
        }
        bf16 ur[16]; float bsv[16];
        {
            const float* bs = A.in[I_GB] + (size_t)(l * NH + g) * 128;
#pragma unroll
            for (int r = 0; r < 16; ++r) { ur[r] = proj[(m0 + 32 * ti + crow(r, hi)) * NP + PC_GU + g * 64 + 32 * cj + r32]; bsv[r] = bs[32 * ti + crow(r, hi)]; }
        }
        LBAR();
        {
            f32x16 acc;
#pragma unroll
            for (int r = 0; r < 16; ++r) acc[r] = 0.f;
            acc = mma32(Wd + (32 * ti + r32) * GP + 8 * hi, Vt + (32 * cj + r32) * GP + 8 * hi, 2 * (ti + 1), acc);
#pragma unroll
            for (int r = 0; r < 16; ++r) { const int t = 32 * ti + crow(r, hi), c = 32 * cj + r32; const size_t m = m0 + t;
                const float z = acc[r] + bsv[r], u = gelu_f(bf2f(ur[r]));
                ycat[m * D + YC_C + g * 64 + c] = (bf16)f2bf(u * z); }
        }
        LBAR();
    }
}
constexpr int TP = 72;
constexpr int LP = 168;
constexpr int R_AH = 0, R_RH = 9216, R_BT = 18432, R_KT = 27648, R_VT = 36864, R_BH = 46080, R_KH = 55296, R_RHS = 46080  ;
constexpr int R_LR = 64512  , R_NP = 64512  , R_NK = 80896, R_BR = 90112, R_KR = 99328, R_W1 = 108544, R_W2 = 117760, R_GT = 126976;
__device__ __forceinline__ float shifted(const bf16* proj, size_t m, int t, int col, float mu) {
    const float p = bf2f(proj[m * NP + col]); const float pp = (t > 0) ? bf2f(proj[(m - 1) * NP + col]) : 0.f; return p + (pp - p) * mu;
}
__device__ __forceinline__ void subst_cols(const bool FROM_RHS, const LAS float* NPm, const LAS float* RHS, const LAS bf16* tAH, LAS bf16* tW, int wave, int lane) {
    const int cl = lane >> 2, p = lane & 3, col = (16 * wave + cl) & 63;
    float xs[16], rh[16];
#pragma unroll
    for (int q = 0; q < 16; ++q) xs[q] = 0.f;
    if (FROM_RHS) {
#pragma unroll
        for (int q = 0; q < 16; ++q) rh[q] = RHS[(4 * q + p) * 64 + col];
    } else {
#pragma unroll
        for (int q = 0; q < 16; ++q) rh[q] = bf2f(tAH[(4 * q + p) * TP + col]);
    }
    const LAS float* np_ = NPm + p * 16;
    f32x4 nv[4], nn[4];
#pragma unroll
    for (int q4 = 0; q4 < 4; ++q4) nv[q4] = (f32x4){0.f, 0.f, 0.f, 0.f};
#pragma unroll
    for (int t = 0; t < 64; ++t) {
        if (t + 1 < 64) {
#pragma unroll
            for (int q4 = 0; q4 < (t + 16) / 16; ++q4) nn[q4] = *(const LAS f32x4*)(np_ + (t + 1) * 64 + 4 * q4);
        }
        float part = 0.f, part2 = 0.f;
#pragma unroll
        for (int q4 = 0; q4 < (t + 15) / 16; ++q4) {
            if (q4 & 1) part2 += (nv[q4].x * xs[4 * q4] + nv[q4].y * xs[4 * q4 + 1]) + (nv[q4].z * xs[4 * q4 + 2] + nv[q4].w * xs[4 * q4 + 3]);
            else part += (nv[q4].x * xs[4 * q4] + nv[q4].y * xs[4 * q4 + 1]) + (nv[q4].z * xs[4 * q4 + 2] + nv[q4].w * xs[4 * q4 + 3]); }
        part += part2;
        part += dpp_xor1(part); part += dpp_xor2(part);
        xs[t >> 2] = (p == (t & 3)) ? rh[t >> 2] + part : xs[t >> 2];
#pragma unroll
        for (int q4 = 0; q4 < 4; ++q4) nv[q4] = nn[q4];
        asm volatile("" ::: "memory");
    }
    LAS bf16* wt = tW + col * TP;
#pragma unroll
    for (int q = 0; q < 16; ++q) wt[4 * q + p] = (bf16)f2bf(xs[q]);
}
__device__ __forceinline__ void rwkv_chunk_unit(const Ctx& C, int l, int b, int c, int h) {
    KA_DECL; asm volatile("" : "+s"(l));
    const bf16* proj = (const bf16*)(A.ws + WS_PROJ);
    int tid = C.tid; asm volatile("" : "+v"(tid));
    const int lane = tid & 63, wave = C.wave, r32 = lane & 31, hi = lane >> 5;
    const size_t m0 = (size_t)b * T + 64 * c; const int t0 = 64 * c; const size_t pair = (size_t)(b * NH + h) * 64 + c;
    LAS unsigned char* L = C.lds;
    LAS bf16* tAH = (LAS bf16*)(L + R_AH); LAS bf16* tRH = (LAS bf16*)(L + R_RH); LAS bf16* tBT = (LAS bf16*)(L + R_BT); LAS bf16* tKT = (LAS bf16*)(L + R_KT); LAS bf16* tVT = (LAS bf16*)(L + R_VT);
    LAS bf16* tBH = (LAS bf16*)(L + R_BH); LAS bf16* tKH = (LAS bf16*)(L + R_KH); LAS float* RHS = (LAS float*)(L + R_RHS); LAS float* LR = (LAS float*)(L + R_LR); LAS float* NPm = (LAS float*)(L + R_NP);
    LAS bf16* tNK = (LAS bf16*)(L + R_NK); LAS bf16* tBR = (LAS bf16*)(L + R_BR); LAS bf16* tKR = (LAS bf16*)(L + R_KR); LAS bf16* tW1 = (LAS bf16*)(L + R_W1); LAS bf16* tW2 = (LAS bf16*)(L + R_W2);
    LAS float* GT = (LAS float*)(L + R_GT);
    const float* mu = A.in[I_RMU] + l * 1696;
    bf16 rraw[9], kraw[9], vraw[9];
    { const int tfirst = t0 + 8 * wave; const size_t mfirst = m0 + 8 * wave; const int cgl = h * 64 + lane;
#pragma unroll
        for (int k = 0; k < 9; ++k) { const size_t mr = (k == 0 && tfirst == 0) ? mfirst : mfirst + k - 1;
            rraw[k] = proj[mr * NP + PC_RR + cgl]; kraw[k] = proj[mr * NP + PC_RK + cgl]; vraw[k] = proj[mr * NP + PC_RV + cgl]; } }
    LAS bf16* LRb = (LAS bf16*)(L + R_LR);
    LAS bf16* Wt = (LAS bf16*)(L + R_LR + 64 * LP * 2);
    LAS float* OUT = (LAS float*)L;
    LBAR();
    {
        float xv[12];
#pragma unroll
        for (int i = 0; i < 4; ++i) { const int e = tid + NTHREADS * i, tok = e >> 5, j = e & 31; xv[i] = shifted(proj, m0 + tok, t0 + tok, PC_RW + j, mu[1536 + j]); }
#pragma unroll
        for (int i = 0; i < 4; ++i) { const int e = tid + NTHREADS * i, tok = e >> 5, j = e & 31;
            LRb[tok * LP + j] = (bf16)f2bf(1.0f - 2.0f * __builtin_amdgcn_rcpf(__expf(2.0f * xv[i]) + 1.0f)); }
#pragma unroll
        for (int i = 0; i < 4; ++i) { const int e = tid + NTHREADS * i, tok = e >> 5, j = 32 + (e & 31); xv[i] = shifted(proj, m0 + tok, t0 + tok, PC_RW + j, mu[1536 + j]); }
#pragma unroll
        for (int i = 0; i < 4; ++i) { const int e = tid + NTHREADS * i, tok = e >> 5, j = 32 + (e & 31); LRb[tok * LP + j] = (bf16)f2bf(xv[i]); }
#pragma unroll
        for (int i = 0; i < 12; ++i) { const int e = tid + NTHREADS * i, tok = e / 96, j = 64 + e % 96; xv[i] = shifted(proj, m0 + tok, t0 + tok, PC_RW + j, mu[1536 + j]); }
#pragma unroll
        for (int i = 0; i < 12; ++i) { const int e = tid + NTHREADS * i, tok = e / 96, j = 64 + e % 96; LRb[tok * LP + j] = (bf16)f2bf(sigmoidf_(xv[i])); }
        float wv[20];
#pragma unroll
        for (int i = 0; i < 20; ++i) { const int e = tid + NTHREADS * i, ch = e & 63, m = e >> 6;
            wv[i] = (m < 32) ? A.in[I_RW2][((size_t)l * 32 + m) * GW + h * 64 + ch] : ((m < 64) ? A.in[I_RA2][((size_t)l * 32 + (m - 32)) * GW + h * 64 + ch] : A.in[I_RG2][((size_t)l * 96 + (m - 64)) * GW + h * 64 + ch]); }
#pragma unroll
        for (int i = 0; i < 20; ++i) { const int e = tid + NTHREADS * i, ch = e & 63, m = e >> 6; Wt[ch * LP + m] = (bf16)f2bf(wv[i]); }
    }
    LBAR();
    {
        const int rt = (wave >> 1) & 1, ct = wave & 1;
        const LAS bf16* Ap = LRb + (32 * rt + r32) * LP + 8 * hi; const LAS bf16* Bp = Wt + (32 * ct + r32) * LP + 8 * hi;
        f32x16 acc, acc2;
#pragma unroll
        for (int r = 0; r < 16; ++r) { acc[r] = 0.f; acc2[r] = 0.f; }
        if (wave < 4) { acc = mma32(Ap, Bp, 2, acc); acc2 = mma32(Ap + 32, Bp + 32, 2, acc2); }
        else acc = mma32(Ap + 64, Bp + 64, 6, acc);
#pragma unroll
        for (int r = 0; r < 16; ++r) { const int o = (32 * rt + crow(r, hi)) * 64 + 32 * ct + r32;
            if (wave < 4) { OUT[o] = acc[r]; OUT[4096 + o] = acc2[r]; } else OUT[8192 + o] = acc[r]; }
    }
    LBAR();
    const int cg = h * 64 + lane, tg = wave;
    float rr[8], kp[8], vv[8], na[8], bb[8], pg[8];
    {
        float aw[8], aa[8], ag[8];
#pragma unroll
        for (int k = 0; k < 8; ++k) { const int o = (8 * tg + k) * 64 + lane; aw[k] = OUT[o]; aa[k] = OUT[4096 + o]; ag[k] = OUT[8192 + o]; }
        const float w0 = A.in[I_RW0][l * GW + cg], a0 = A.in[I_RA0][l * GW + cg], kkc = A.in[I_RKK][l * GW + cg], kac = A.in[I_RKA][l * GW + cg], rkc = A.in[I_RRK][l * GW + cg];
        const float mur = mu[cg], muk = mu[512 + cg], muv = mu[1024 + cg];
        float* rg = (float*)(A.ws + WS_RG); float* rbv = (float*)(A.ws + WS_RBV);
        float run = 0.f;
#pragma unroll
        for (int k = 0; k < 8; ++k) { const size_t m = m0 + 8 * tg + k; const int t = t0 + 8 * tg + k;
            const float hasp = (t > 0) ? 1.0f : 0.0f;
            const float rp_ = bf2f(rraw[k + 1]), kp_ = bf2f(kraw[k + 1]), vp_ = bf2f(vraw[k + 1]);
            const float r = rp_ + (bf2f(rraw[k]) * hasp - rp_) * mur, kx = kp_ + (bf2f(kraw[k]) * hasp - kp_) * muk, v = vp_ + (bf2f(vraw[k]) * hasp - vp_) * muv;
            run += -0.6065306597126334f * sigmoidf_(w0 + aw[k]); pg[k] = run;
            const float ia = sigmoidf_(a0 + aa[k]);
            float kk = kx * kkc; const float n2 = wave_sum_dpp(kk * kk); kk = kk * __builtin_amdgcn_rsqf(fmaxf(n2, 1e-24f));
            const float kpv = kx * (1.0f + (ia - 1.0f) * kac);
            const float bonus = wave_sum_dpp(r * kpv * rkc);
            rg[m * GW + cg] = ag[k]; rbv[m * GW + cg] = bonus * v * ag[k];
            rr[k] = r; kp[k] = kpv; vv[k] = v; na[k] = -kk; bb[k] = kk * ia; }
        GT[tg * 64 + lane] = run;
    }
    LBAR();
    {
        float off = 0.f, gL = 0.f;
#pragma unroll
        for (int w = 0; w < 8; ++w) { const float x = GT[w * 64 + lane]; gL += x; off += (w < tg) ? x : 0.f; }
        float bt[8], kt[8];
#pragma unroll
        for (int k = 0; k < 8; ++k) { const int t = 8 * tg + k; const float g = off + pg[k], gp = off + (k > 0 ? pg[k - 1] : 0.f);
            const float eg = __expf(g), egp = __expf(gp), ei = __expf(-g), eL = __expf(gL - g);
            tAH[t * TP + lane] = (bf16)f2bf(na[k] * egp); tRH[t * TP + lane] = (bf16)f2bf(rr[k] * eg); tBH[t * TP + lane] = (bf16)f2bf(bb[k] * ei); tKH[t * TP + lane] = (bf16)f2bf(kp[k] * ei);
            bt[k] = bb[k] * eL; kt[k] = kp[k] * eL; }
        v4u o; o.x = pk2(bt[0], bt[1]); o.y = pk2(bt[2], bt[3]); o.z = pk2(bt[4], bt[5]); o.w = pk2(bt[6], bt[7]); *(LAS v4u*)(tBT + lane * TP + 8 * tg) = o;
        o.x = pk2(kt[0], kt[1]); o.y = pk2(kt[2], kt[3]); o.z = pk2(kt[4], kt[5]); o.w = pk2(kt[6], kt[7]); *(LAS v4u*)(tKT + lane * TP + 8 * tg) = o;
        o.x = pk2(vv[0], vv[1]); o.y = pk2(vv[2], vv[3]); o.z = pk2(vv[4], vv[5]); o.w = pk2(vv[6], vv[7]); *(LAS v4u*)(tVT + lane * TP + 8 * tg) = o;
        if (tg == 0) ((float*)(A.ws + WS_GL))[pair * 64 + lane] = __expf(gL);
    }
    LBAR();
    {
        const int mi = wave >> 1, rt = wave & 1;
        const LAS bf16* Am = (mi < 2) ? tAH : tRH; const LAS bf16* Bm = (mi & 1) ? tKH : tBH;
        for (int ct = 0; ct < 2; ++ct) {
            f32x16 acc;
#pragma unroll
            for (int r = 0; r < 16; ++r) acc[r] = 0.f;
            if (!(rt == 0 && ct == 1)) acc = mma32(Am + (32 * rt + r32) * TP + 8 * hi, Bm + (32 * ct + r32) * TP + 8 * hi, 4, acc);
#pragma unroll
            for (int r = 0; r < 16; ++r) { const int t = 32 * rt + crow(r, hi), s = 32 * ct + r32;
                const bool keep = (mi < 2) ? (s < t) : (s <= t); const float val = keep ? acc[r] : 0.f;
                if (mi == 0) NPm[t * 64 + (s & 3) * 16 + (s >> 2)] = val;
                else { LAS bf16* dst = (mi == 1) ? tNK : ((mi == 2) ? tBR : tKR); dst[t * TP + s] = (bf16)f2bf(val); } }
        }
    }
    LBAR();
    if (wave < 4) {
        const int rt = wave >> 1, ct = wave & 1;
        f32x16 acc;
#pragma unroll
        for (int r = 0; r < 16; ++r) acc[r] = 0.f;
        acc = mma32(tNK + (32 * rt + r32) * TP + 8 * hi, tVT + (32 * ct + r32) * TP + 8 * hi, 2 * (rt + 1), acc);
#pragma unroll
        for (int r = 0; r < 16; ++r) RHS[(32 * rt + crow(r, hi)) * 64 + 32 * ct + r32] = acc[r];
    }
    LBAR();
    subst_cols(wave < 4, NPm, RHS, tAH, (wave < 4) ? tW1 : tW2, wave, lane);
    LBAR();
    {
        const int kind = wave >> 1, rt = wave & 1;
        bf16* RTg = (bf16*)(A.ws + WS_RT) + pair * 4096; bf16* PAg = (bf16*)(A.ws + WS_PA) + pair * 4096;
        float* YFg = (float*)(A.ws + WS_YF) + pair * 4096; float* QFg = (float*)(A.ws + WS_QF) + pair * 4096;
        for (int ct = 0; ct < 2; ++ct) {
            f32x16 acc;
            if (kind == 0) {
#pragma unroll
                for (int r = 0; r < 16; ++r) acc[r] = bf2f(tRH[(32 * rt + crow(r, hi)) * TP + 32 * ct + r32]);
                acc = mma32(tBR + (32 * rt + r32) * TP + 8 * hi, tW2 + (32 * ct + r32) * TP + 8 * hi, 2 * (rt + 1), acc);
#pragma unroll
                for (int r = 0; r < 16; ++r) RTg[(32 * rt + crow(r, hi)) * 64 + 32 * ct + r32] = (bf16)f2bf(acc[r]);
            } else if (kind == 1) {
#pragma unroll
                for (int r = 0; r < 16; ++r) acc[r] = 0.f;
                acc = mma32(tBR + (32 * rt + r32) * TP + 8 * hi, tW1 + (32 * ct + r32) * TP + 8 * hi, 2 * (rt + 1), acc);
                acc = mma32(tKR + (32 * rt + r32) * TP + 8 * hi, tVT + (32 * ct + r32) * TP + 8 * hi, 2 * (rt + 1), acc);
                f32x4* dst = (f32x4*)(YFg + (rt * 2 + ct) * 1024 + lane * 16);
#pragma unroll
                for (int q = 0; q < 4; ++q) dst[q] = (f32x4){acc[4 * q], acc[4 * q + 1], acc[4 * q + 2], acc[4 * q + 3]};
            } else if (kind == 2) {
#pragma unroll
                for (int r = 0; r < 16; ++r) acc[r] = 0.f;
                acc = mma32(tBT + (32 * rt + r32) * TP + 8 * hi, tW2 + (32 * ct + r32) * TP + 8 * hi, 4, acc);
#pragma unroll
                for (int r = 0; r < 16; ++r) PAg[(32 * rt + crow(r, hi)) * 64 + 32 * ct + r32] = (bf16)f2bf(acc[r]);
            } else {
#pragma unroll
                for (int r = 0; r < 16; ++r) acc[r] = 0.f;
                acc = mma32(tBT + (32 * rt + r32) * TP + 8 * hi, tW1 + (32 * ct + r32) * TP + 8 * hi, 4, acc);
                acc = mma32(tKT + (32 * rt + r32) * TP + 8 * hi, tVT + (32 * ct + r32) * TP + 8 * hi, 4, acc);
                f32x4* dst = (f32x4*)(QFg + (rt * 2 + ct) * 1024 + lane * 16);
#pragma unroll
                for (int q = 0; q < 4; ++q) dst[q] = (f32x4){acc[4 * q], acc[4 * q + 1], acc[4 * q + 2], acc[4 * q + 3]};
            }
        }
    }
}
__device__ __forceinline__ void rwkv_seq_unit(const Ctx& C, int bh) {
    KA_DECL;
    const int tid = C.tid, lane = C.lane, wave = C.wave, r32 = lane & 31, hi = lane >> 5;
    const bool zw = wave < 4; const int w4 = wave & 3, rt = w4 >> 1, ct = w4 & 1;
    LAS bf16* Zb = (LAS bf16*)C.lds;
    const bf16* Ag = (const bf16*)(A.ws + (zw ? WS_PA : WS_RT)) + (size_t)bh * 64 * 4096 + (32 * rt + r32) * 64 + 8 * hi;
    const float* Cg = (const float*)(A.ws + (zw ? WS_QF : WS_YF)) + (size_t)bh * 64 * 4096 + (rt * 2 + ct) * 1024 + lane * 16;
    const float* GLg = (const float*)(A.ws + WS_GL) + (size_t)bh * 64 * 64 + 32 * rt + 4 * hi;
    float* ry = (float*)(A.ws + WS_RY) + (size_t)(bh >> 3) * T * GW + (bh & 7) * 64;
    f32x16 Z;
#pragma unroll
    for (int r = 0; r < 16; ++r) Z[r] = 0.f;
    LBAR();
    for (int i = tid; i < 64 * TP; i += NTHREADS) Zb[i] = 0;
    LBAR();
    LAS float* GLs = (LAS float*)(C.lds + 2 * 64 * TP * 2);
    { const float* gsrc = (const float*)(A.ws + WS_GL) + (size_t)bh * 64 * 64; for (int i = tid; i < 64 * 64 / 4; i += NTHREADS) *(LAS f32x4*)(GLs + 4 * i) = *(const f32x4*)(gsrc + 4 * i); }
    LBAR();
    const LAS float* glp = GLs + 32 * rt + 4 * hi;
    LAS float* ypatch = (LAS float*)(C.lds + 2 * 64 * TP * 2 + 64 * 64 * 4) + (wave & 3) * (32 * 36);
    float* ryl = ry + (size_t)(32 * rt + (lane >> 3)) * GW + 32 * ct + 4 * (lane & 7); const LAS float* ypl = ypatch + (lane >> 3) * 36 + 4 * (lane & 7);
    bf16x8 af[4][4]; f32x4 ci[4][4];
#define SEQ_LOAD(S, cc) do { const int c_ = (cc) < 64 ? (cc) : 63; _Pragma("unroll") for (int k = 0; k < 4; ++k) { af[S][k] = *(const bf16x8*)(Ag + (size_t)c_ * 4096 + 16 * k); \
        ci[S][k] = *(const f32x4*)(Cg + (size_t)c_ * 4096 + 4 * k); } } while (0)
#define SEQ_STEP(c, S, SN) do { \
        if ((c) + 3 < 64) SEQ_LOAD(SN, (c) + 3); \
        f32x16 acc; \
        _Pragma("unroll") for (int q = 0; q < 4; ++q) { acc[4 * q] = ci[S][q].x; acc[4 * q + 1] = ci[S][q].y; acc[4 * q + 2] = ci[S][q].z; acc[4 * q + 3] = ci[S][q].w; } \
        if (zw) { _Pragma("unroll") for (int q = 0; q < 4; ++q) { const f32x4 g4 = *(const LAS f32x4*)(glp + (c) * 64 + 8 * q); \
            acc[4 * q] += g4.x * Z[4 * q]; acc[4 * q + 1] += g4.y * Z[4 * q + 1]; acc[4 * q + 2] += g4.z * Z[4 * q + 2]; acc[4 * q + 3] += g4.w * Z[4 * q + 3]; } } \
        const LAS bf16* Bp = Zb + ((c) & 1) * 64 * TP + (32 * ct + r32) * TP + 8 * hi; \
        _Pragma("unroll") for (int k = 0; k < 4; ++k) { const bf16x8 bfr = *(const LAS bf16x8*)(Bp + 16 * k); acc = __builtin_amdgcn_mfma_f32_32x32x16_bf16(af[S][k], bfr, acc, 0, 0, 0); } \
        if (zw) { Z = acc; LAS bf16* Zn = Zb + (((c) + 1) & 1) * 64 * TP + (32 * ct + r32) * TP + 32 * rt + 4 * hi; \
            _Pragma("unroll") for (int q = 0; q < 4; ++q) { v2u w; w.x = pk2(acc[4 * q], acc[4 * q + 1]); w.y = pk2(acc[4 * q + 2], acc[4 * q + 3]); *(LAS v2u*)(Zn + 8 * q) = w; } } \
        else {   \
            _Pragma("unroll") for (int r = 0; r < 16; ++r) ypatch[crow(r, hi) * 36 + r32] = acc[r]; \
            asm volatile("s_waitcnt lgkmcnt(0)" ::: "memory"); \
            GAS float* ryc = (GAS float*)(ryl + (size_t)(64 * (c)) * GW); asm volatile("" : "+v"(ryc));     \
            _Pragma("unroll") for (int j = 0; j < 4; ++j) *(GAS f32x4*)(ryc + (size_t)(8 * j) * GW) = *(const LAS f32x4*)(ypl + 8 * j * 36); \
            asm volatile("s_waitcnt lgkmcnt(0)" ::: "memory"); } \
        asm volatile("s_waitcnt lgkmcnt(0)" ::: "memory"); __builtin_amdgcn_s_barrier(); asm volatile("" ::: "memory"); } while (0)
    SEQ_LOAD(0, 0); SEQ_LOAD(1, 1); SEQ_LOAD(2, 2);
#define SEQ_4(c) SEQ_STEP(c, 0, 3); SEQ_STEP((c) + 1, 1, 0); SEQ_STEP((c) + 2, 2, 1); SEQ_STEP((c) + 3, 3, 2);
    SEQ_4(0) SEQ_4(4) SEQ_4(8) SEQ_4(12) SEQ_4(16) SEQ_4(20) SEQ_4(24) SEQ_4(28) SEQ_4(32) SEQ_4(36) SEQ_4(40) SEQ_4(44) SEQ_4(48) SEQ_4(52) SEQ_4(56) SEQ_4(60)
#undef SEQ_4
#undef SEQ_LOAD
#undef SEQ_STEP
}
__device__ __forceinline__ void rwkv_post_bh(const Ctx& C, int l, int bh, int tbeg, int tend) {
    KA_DECL;
    const int lane = C.lane, wave = C.wave, b = bh >> 3, h = bh & 7, ch = h * 64 + lane;
    const float* RY = (const float*)(A.ws + WS_RY) + (size_t)b * T * GW + ch; const float* RG = (const float*)(A.ws + WS_RG) + (size_t)b * T * GW + ch; const float* RBV = (const float*)(A.ws + WS_RBV) + (size_t)b * T * GW + ch;
    bf16* yc = (bf16*)(A.ws + WS_YCAT) + (size_t)b * T * D + YC_A + ch;
    const float lg = A.in[I_RLG][l * GW + ch], lb = A.in[I_RLB][l * GW + ch];
    for (int t0 = tbeg + 16 * wave; t0 < tend; t0 += 16 * NWAVES) {
        float y[16], g[16], bv[16];
#pragma unroll
        for (int k = 0; k < 16; ++k) { y[k] = RY[(size_t)(t0 + k) * GW]; g[k] = RG[(size_t)(t0 + k) * GW]; bv[k] = RBV[(size_t)(t0 + k) * GW]; }
#pragma unroll
        for (int k = 0; k < 16; ++k) {
            const float mean = wave_sum_dpp(y[k]) * (1.0f / 64.0f), d = y[k] - mean, var = wave_sum_dpp(d * d) * (1.0f / 64.0f);
            const float yn = d * __builtin_amdgcn_rsqf(var + 64e-5f) * lg + lb;
            yc[(size_t)(t0 + k) * D] = (bf16)f2bf(yn * g[k] + bv[k]); }
    }
}
#ifndef REP_CHUNK
#define REP_CHUNK 1
#endif
#ifndef REP_SWA
#define REP_SWA 1
#endif
#ifndef REP_SGU
#define REP_SGU 1
#endif
#ifndef REP_GIN
#define REP_GIN 1
#endif
#ifndef REP_SCAN
#define REP_SCAN 1
#endif
#ifndef REP_FOX
#define REP_FOX 1
#endif
__device__ __forceinline__ void ph_mix1(const Ctx& C, int l) {
    for (int rep = 0; rep < REP_CHUNK; ++rep) for (int u = C.bid; u < 2048; u += C.G) rwkv_chunk_unit(C, l, u >> 9, (u >> 3) & 63, u & 7);
    for (int v = C.bid; v < 256; v += C.G) kvprep_unit(C, l, v);
    for (int v = C.bid; v < 32; v += C.G) cumprep_unit(C, l, v);
}
constexpr int CW_Q = 8192;
constexpr int CW_SEQF = 9216;
__device__ __forceinline__ void ph_mix2(const Ctx& C, int l) {
    KA_DECL;
    unsigned* ctl = (unsigned*)(A.ws + WS_CTL);
    for (int rep = 0; rep < REP_SCAN; ++rep)
    for (int u = C.bid; u < 32; u += C.G) {
        rwkv_seq_unit(C, u);
        asm volatile("s_waitcnt vmcnt(0)" ::: "memory"); __syncthreads();
        if (C.tid == 0) { __builtin_amdgcn_fence(__ATOMIC_RELEASE, "agent"); asm volatile("s_waitcnt vmcnt(0)" ::: "memory");
            __hip_atomic_store(ctl + CW_SEQF + (l * 32 + u) * 64, 1u, __ATOMIC_RELAXED, __HIP_MEMORY_SCOPE_AGENT); }
    }
    unsigned* head = ctl + CW_Q + 64 * l;
    volatile LAS unsigned* slot = (volatile LAS unsigned*)(C.lds + LDSCTL_OFF + 64);
    for (;;) {
        if (C.tid == 0) *slot = __hip_atomic_fetch_add(head, 1u, __ATOMIC_RELAXED, __HIP_MEMORY_SCOPE_AGENT);
        LBAR();
        const unsigned u = *slot;
        if (u >= 1024u * REP_FOX + 512u) break;
        if (u < 1024u * REP_FOX) {
            const unsigned w = u % 1024u;
            if (w < 512u) { const int qb = 15 - (int)(w >> 5), bh = (int)(w & 31u); attn2_unit<1>(C, l, bh >> 3, bh & 7, qb); }
            else { const int v = (int)w - 512; attn2_unit<0>(C, l, v >> 7, (v >> 4) & 7, v & 15); }
        } else if (u < 1024u * REP_FOX + 256u) { const int v = (int)(u - 1024u * REP_FOX); sgu_unit(C, l, v >> 6, (v >> 1) & 31, v & 1);
        } else {
            const int v = (int)(u - 1024u * REP_FOX - 256u), bh = v >> 3, part = v & 7;
            if (C.tid == 0) {
                unsigned spins = 0;
                while (__hip_atomic_load(ctl + CW_SEQF + (l * 32 + bh) * 64, __ATOMIC_RELAXED, __HIP_MEMORY_SCOPE_AGENT) == 0u && ++spins < (1u << 22)) __builtin_amdgcn_s_sleep(2);
                __builtin_amdgcn_fence(__ATOMIC_ACQUIRE, "agent"); asm volatile("s_waitcnt vmcnt(0)" ::: "memory");
            }
            __syncthreads();
            rwkv_post_bh(C, l, bh, part * 512, part * 512 + 512);
        }
    }
    LBAR();
}
constexpr int N_PHASES = 2 + 9 * DEPTH;
#define IN(k) (lo <= (k) && (k) < hi)
#ifndef REP_PRO
#define REP_PRO 1
#endif
#ifndef REP_NORM
#define REP_NORM 1
#endif
#ifndef REP_MIX1
#define REP_MIX1 1
#endif
#ifndef REP_POST
#define REP_POST 1
#endif
#ifndef REP_GUP
#define REP_GUP 1
#endif
#ifndef PROBE_STAMP
#define PROBE_STAMP (-100)
#endif
#define STAMP(k) do { if (PROBE_STAMP > -100 && C.bid == 0 && C.tid == 0) ((volatile LAS unsigned long long*)(C.lds + LDSCTL_OFF + 1024))[(k) + 1] = __builtin_amdgcn_s_memrealtime(); } while (0)
#define SEAM(k) do { if (IN((k) + 1) || PROBE_STAMP > -100) xcd_barrier(bar); STAMP(k); } while (0)
template <int l>
__device__ __forceinline__ void layer_phases(const Args& A, const Ctx& C, const XcdBarrier& bar, const int lo, const int hi) {
    bf16* const H = (bf16*)(A.ws + WS_H); bf16* const PROJ = (bf16*)(A.ws + WS_PROJ); bf16* const YCAT = (bf16*)(A.ws + WS_YCAT); bf16* const FB = (bf16*)(A.ws + WS_F);
    constexpr int p0 = 2 + 9 * l;
    const float* xin = (l == 0) ? A.in[I_X] : A.out;
    const float* modl = (const float*)(A.ws + WS_MOD) + (size_t)l * NB * MODW;
    if (IN(p0 + 0)) { for (int rep = 0; rep < REP_NORM; ++rep) ph_norm(C, xin, A.in[I_N1G] + l * D, modl + 0 * D, modl + 1 * D, H); SEAM(p0 + 0); }
    if (IN(p0 + 1)) {
        pg8::Gemm g{H, (const bf16*)(A.ws + WS_WIN) + (size_t)l * NP * D, M, NP, D}; pg8::StaticOrder S; S.init(M, NP, C.G, C.bid);
        pg8::EpiStoreBf16 E{PROJ, NP};
        for (int rep = 0; rep < REP_GIN; ++rep) { if (rep) __syncthreads(); pg8::gemm_phase<pg8::EpiStoreBf16, pg8::StaticOrder, true, true>(C.lds, g, S, E); }
        SEAM(p0 + 1); }
    if (IN(p0 + 2)) { for (int rep = 0; rep < REP_MIX1; ++rep) ph_mix1(C, l); SEAM(p0 + 2); }
    if (IN(p0 + 3)) { ph_mix2(C, l); SEAM(p0 + 3); }
    if (IN(p0 + 5)) {
        pg8::Gemm g{YCAT, (const bf16*)(A.ws + WS_WOUT) + (size_t)l * D * D, M, D, D}; pg8::StaticOrder S; S.init(M, D, C.G, C.bid);
        pg8::EpiResid E{xin, A.out, D, modl + 2 * D, MODW, T};
        pg8::gemm_phase<pg8::EpiResid, pg8::StaticOrder, true, true>(C.lds, g, S, E);
        SEAM(p0 + 5); }
    if (IN(p0 + 6)) { for (int rep = 0; rep < REP_NORM; ++rep) ph_norm(C, A.out, A.in[I_N2G] + l * D, modl + 3 * D, modl + 4 * D, H); SEAM(p0 + 6); }
    if (IN(p0 + 7)) {
        pg8::Gemm g{H, (const bf16*)(A.ws + WS_W13) + (size_t)l * 2 * FF * D, M, 2 * FF, D}; pg8::StaticOrder S; S.init(M, 2 * FF, C.G, C.bid);
        pg8::EpiSwiGLU E{FB, FF};
        for (int rep = 0; rep < REP_GUP; ++rep) { if (rep) __syncthreads(); pg8::gemm_phase<pg8::EpiSwiGLU, pg8::StaticOrder, true, true>(C.lds, g, S, E); }
        SEAM(p0 + 7); }
    if (IN(p0 + 8)) {
        pg8::Gemm g{FB, (const bf16*)(A.ws + WS_W2) + (size_t)l * D * FF, M, D, FF}; pg8::StaticOrder S; S.init(M, D, C.G, C.bid);
        pg8::EpiResid E{A.out, A.out, D, modl + 5 * D, MODW, T};
        pg8::gemm_phase<pg8::EpiResid, pg8::StaticOrder, true, true>(C.lds, g, S, E);
        SEAM(p0 + 8); }
}
__global__ void __launch_bounds__(NTHREADS, 2) fwd_kernel(Args A) {
    extern __shared__ __attribute__((aligned(16))) unsigned char lds_raw[];
    Ctx C; C.lds = (LAS unsigned char*)lds_raw; C.tid = threadIdx.x; C.lane = C.tid & 63; C.wave = __builtin_amdgcn_readfirstlane(C.tid >> 6); C.G = gridDim.x; C.bid = blockIdx.x;
    volatile LAS unsigned* MISC = (volatile LAS unsigned*)(C.lds + MISC_OFF);
    for (int u = C.tid; u < (LDS_BYTES - LDSCTL_OFF) / 4; u += NTHREADS) ((LAS unsigned*)(C.lds + LDSCTL_OFF))[u] = 0u;
    __syncthreads();
    const int lo = A.ph_lo, hi = A.ph_hi;
    const bool multi = (hi - lo) > 1;
    XcdBarrier bar; bar.bar = (unsigned*)(A.ws + WS_CTL) + CW_BAR; bar.x = 0; bar.st = nullptr;
    if (multi) bar = xcd_barrier_post((unsigned*)(A.ws + WS_CTL) + CW_BAR, MISC + 8);
    if (PROBE_STAMP > -100 && C.bid == 0 && C.tid == 0) ((volatile LAS unsigned long long*)(C.lds + LDSCTL_OFF + 1024))[0] = __builtin_amdgcn_s_memrealtime();
    if (IN(0)) { for (int rep = 0; rep < REP_PRO; ++rep) { if (rep) __syncthreads(); ph_prologue(C); } SEAM(0); }
    if (IN(1)) { ph_modreduce(C); SEAM(1); }
    layer_phases<0>(A, C, bar, lo, hi);
    layer_phases<1>(A, C, bar, lo, hi);
    layer_phases<2>(A, C, bar, lo, hi);
    layer_phases<3>(A, C, bar, lo, hi);
    if (PROBE_STAMP > -100 && C.bid == 0 && C.tid == 0) {
        volatile LAS unsigned long long* st = (volatile LAS unsigned long long*)(C.lds + LDSCTL_OFF + 1024);
        unsigned long long tot = 0;
        if (PROBE_STAMP < 0) tot = st[2] - st[0];
        else for (int l = 0; l < DEPTH; ++l) tot += st[2 + 9 * l + PROBE_STAMP + 1] - st[2 + 9 * l + PROBE_STAMP];
        A.out[0] = (float)tot * 0.01f;
    }
}
#undef IN
#undef SEAM

extern "C" void kernel_launch(void* const* d_in, const int* in_sizes, int n_in, void* d_out, int out_size, void* d_ws, size_t ws_size, hipStream_t stream) {
    static int grid = 0;
    if (grid == 0) {
        if (n_in != N_INPUTS || out_size != M * D || ws_size < WS_END) { fprintf(stderr, "kernel_launch: unexpected problem (n_in %d, out %d, ws %zu; need %zu)\n", n_in, out_size, ws_size, (size_t)WS_END); grid = -1; return; }
        int dev = 0, cus = 0, per_cu = 0;
        if (hipGetDevice(&dev) != hipSuccess || hipDeviceGetAttribute(&cus, hipDeviceAttributeMultiprocessorCount, dev) != hipSuccess) { grid = -1; return; }
        if (hipFuncSetAttribute((const void*)fwd_kernel, hipFuncAttributeMaxDynamicSharedMemorySize, LDS_BYTES) != hipSuccess) { fprintf(stderr, "kernel_launch: hipFuncSetAttribute failed\n"); grid = -1; return; }
        if (hipOccupancyMaxActiveBlocksPerMultiprocessor(&per_cu, (const void*)fwd_kernel, NTHREADS, LDS_BYTES) != hipSuccess || per_cu < 1) fprintf(stderr, "kernel_launch: occupancy query reports %d\n", per_cu);
        (void)hipGetLastError();
        grid = cus;
    }
    if (grid < 0) return;
    (void)hipMemsetAsync((char*)d_ws + WS_CTL, 0, CTL_ZERO_BYTES, stream);
    Args a{};
    for (int i = 0; i < N_INPUTS; ++i) a.in[i] = (const float*)d_in[i];
    a.out = (float*)d_out; a.ws = (unsigned char*)d_ws;
#if MK_ONE_LAUNCH
    a.ph_lo = 0; a.ph_hi = N_PHASES;
    hipLaunchKernelGGL(fwd_kernel, dim3(grid), dim3(NTHREADS), LDS_BYTES, stream, a);
#else
    for (int p = 0; p < N_PHASES; ++p) { a.ph_lo = p; a.ph_hi = p + 1; hipLaunchKernelGGL(fwd_kernel, dim3(grid), dim3(NTHREADS), LDS_BYTES, stream, a); }
#endif
    const hipError_t le = hipPeekAtLastError();
    if (le != hipSuccess) fprintf(stderr, "kernel_launch: launch failed: %s\n", hipGetErrorName(le));
}
```

```cpp
#include <hip/hip_runtime.h>
#include <cstdio>
#include <cstdint>
#ifndef MK_ONE_LAUNCH
#define MK_ONE_LAUNCH 1
#endif
namespace pg8 {
#define PG8_LAS __attribute__((address_space(3)))
typedef unsigned short bf16_t;
typedef short bf16x8 __attribute__((ext_vector_type(8)));
typedef float f32x4 __attribute__((ext_vector_type(4)));
typedef unsigned u32x4 __attribute__((ext_vector_type(4)));
constexpr int BM = 256, BK = 64, HALF = 128, HTB = HALF * BK * 2  , STAGE_BYTES = 8 * HTB, NXCD = 8, WGM = 8;

__host__ __device__ __forceinline__ int lds_byte(int r, int c) { const int st = (r >> 4) * 2 + (c >> 5), rr = r & 15, cc = c & 31, ob = rr * 64 + cc * 2; return st * 1024 + (ob ^ (((ob >> 9) & 1) << 5)); }
__host__ __device__ __forceinline__ void stage_rc(int b, int& R, int& C) { const int st = b / 1024, sb = b % 1024, swz = sb ^ (((sb >> 9) & 1) << 5); R = (st >> 1) * 16 + swz / 64; C = (st & 1) * 32 + (swz % 64) / 2; }
__host__ __device__ __forceinline__ int perm32(int rho) { const int n = rho >> 4, i = rho & 15; return 8 * (i >> 2) + 4 * n + (i & 3); }

struct Unit { int pm, pn; };
struct Gemm { const bf16_t* A; const bf16_t* Bt; int M, N, K; };

struct StaticOrder {
    int nM, nN, nwg, G, c;
    __host__ __device__ void init(int M, int N, int G_, int c_) { nM = M / BM; nN = N / BM; nwg = nM * nN; G = G_; c = c_; }
    __host__ __device__ bool next(int i, Unit& u) const {
        const long L = (long)i * G + c; if (L >= nwg) return false;
        int wgid = (int)L; { const int q = nwg / NXCD, r = nwg % NXCD, xcd = wgid % NXCD, off = wgid / NXCD; wgid = (xcd < r ? xcd * (q + 1) : r * (q + 1) + (xcd - r) * q) + off; }
        const int nig = WGM * nN, gid = wgid / nig, fm = gid * WGM, gsz = (nM - fm) < WGM ? (nM - fm) : WGM;
        u.pm = fm + ((wgid % nig) % gsz); u.pn = (wgid % nig) / gsz; return true;
    }
    __device__ __forceinline__ void a_ready(const Unit&) const {}
    __device__ __forceinline__ void done(const Unit&) const {}
};

__device__ __forceinline__ unsigned cvt_pk_bf16(float lo, float hi) { unsigned r; asm volatile("v_cvt_pk_bf16_f32 %0, %1, %2" : "=v"(r) : "v"(lo), "v"(hi)); return r; }
typedef float f32x2 __attribute__((ext_vector_type(2)));
__device__ __forceinline__ f32x2 gelu_pk(f32x2 v) {
    const f32x2 av = __builtin_elementwise_abs(v), d = av * 0.2316418882f + 1.0f;
    f32x2 t; t.x = __builtin_amdgcn_rcpf(d.x); t.y = __builtin_amdgcn_rcpf(d.y);
    f32x2 q = t * 0.5307027145f + (-0.7265760135f); q = q * t + 0.7107068705f; q = q * t + (-0.142248368f); q = q * t + 0.127414796f; q = q * t;
    const f32x2 s = (v * v) * (-0.72134752044f);
    f32x2 e; e.x = __builtin_amdgcn_exp2f(s.x); e.y = __builtin_amdgcn_exp2f(s.y);
    const f32x2 m = v * (q * e), r = v - m;
    f32x2 o; o.x = v.x < 0.f ? m.x : r.x; o.y = v.y < 0.f ? m.y : r.y; return o;
}

struct EpiStoreBf16 {
    static constexpr bool PERM = true, AFTER_DRAIN = false;
    bf16_t* O; int ldc;
    __device__ __forceinline__ void operator()(const f32x4 (&acc)[2][2][4][2], const Unit& u, int wr, int wc, int fr, int fq) const {
        const int row0 = u.pm * BM + wr * 64 + fr, col0 = u.pn * BM + wc * 32 + 8 * fq;
#pragma unroll
        for (int ai = 0; ai < 2; ++ai)
#pragma unroll
            for (int m = 0; m < 4; ++m) { bf16_t* rowp = O + (size_t)(row0 + ai * HALF + m * 16) * ldc + col0;
#pragma unroll
                for (int bj = 0; bj < 2; ++bj) { const f32x4 v0 = acc[ai][bj][m][0], v1 = acc[ai][bj][m][1];
                    u32x4 w; w.x = cvt_pk_bf16(v0[0], v0[1]); w.y = cvt_pk_bf16(v0[2], v0[3]); w.z = cvt_pk_bf16(v1[0], v1[1]); w.w = cvt_pk_bf16(v1[2], v1[3]);
                    *(u32x4*)(rowp + bj * HALF) = w; } }
    }
};
struct EpiResid {
    static constexpr bool PERM = false, AFTER_DRAIN = false;
    const float* base; float* out; int ldc; const float* gate; int gate_stride; int rows_per_batch;
    __device__ __forceinline__ void operator()(const f32x4 (&acc)[2][2][4][2], const Unit& u, int wr, int wc, int fr, int fq) const {
        const int row0 = u.pm * BM + wr * 64 + fr, col0 = u.pn * BM + wc * 32 + 4 * fq;
        const float* gp = gate + (size_t)((u.pm * BM) / rows_per_batch) * gate_stride + col0;
        f32x4 gv[2][2];
#pragma unroll
        for (int bj = 0; bj < 2; ++bj)
#pragma unroll
            for (int n = 0; n < 2; ++n) gv[bj][n] = *(const f32x4*)(gp + bj * HALF + n * 16);
        f32x4 xb[3][2][2];
#define ER_LOAD(g) do { const size_t off = (size_t)(row0 + ((g) >> 2) * HALF + ((g) & 3) * 16) * ldc + col0; \
            _Pragma("unroll") for (int bj = 0; bj < 2; ++bj) _Pragma("unroll") for (int n = 0; n < 2; ++n) xb[(g) % 3][bj][n] = *(const f32x4*)(base + off + bj * HALF + n * 16); } while (0)
#define ER_STORE(g) do { const size_t off = (size_t)(row0 + ((g) >> 2) * HALF + ((g) & 3) * 16) * ldc + col0; \
            _Pragma("unroll") for (int bj = 0; bj < 2; ++bj) _Pragma("unroll") for (int n = 0; n < 2; ++n) \
                *(f32x4*)(out + off + bj * HALF + n * 16) = xb[(g) % 3][bj][n] + gv[bj][n] * acc[(g) >> 2][bj][(g) & 3][n]; } while (0)
        ER_LOAD(0); ER_LOAD(1); ER_LOAD(2); ER_STORE(0); ER_LOAD(3); ER_STORE(1); ER_LOAD(4); ER_STORE(2); ER_LOAD(5); ER_STORE(3); ER_LOAD(6); ER_STORE(4); ER_LOAD(7); ER_STORE(5); ER_STORE(6); ER_STORE(7);
#undef ER_LOAD
#undef ER_STORE
    }
};
struct EpiSwiGLU {
    static constexpr bool PERM = true, AFTER_DRAIN = false;
    bf16_t* O; int ldc;
    __device__ __forceinline__ void operator()(const f32x4 (&acc)[2][2][4][2], const Unit& u, int wr, int wc, int fr, int fq) const {
        const int row0 = u.pm * BM + wr * 64 + fr, col0 = u.pn * HALF + wc * 32 + 8 * fq;
#pragma unroll
        for (int ai = 0; ai < 2; ++ai)
#pragma unroll
            for (int m = 0; m < 4; ++m) { bf16_t* rowp = O + (size_t)(row0 + ai * HALF + m * 16) * ldc + col0;
                float f[8];
#pragma unroll
                for (int n = 0; n < 2; ++n)
#pragma unroll
                    for (int e = 0; e < 4; ++e) { const float g = acc[ai][0][m][n][e], up = acc[ai][1][m][n][e];
                        f[n * 4 + e] = g * up * __builtin_amdgcn_rcpf(1.0f + __builtin_amdgcn_exp2f(-1.4426950408889634f * g)); }
                u32x4 w; w.x = cvt_pk_bf16(f[0], f[1]); w.y = cvt_pk_bf16(f[2], f[3]); w.z = cvt_pk_bf16(f[4], f[5]); w.w = cvt_pk_bf16(f[6], f[7]);
                *(u32x4*)rowp = w; }
    }
};

template <class Epi, class Sched, bool ALIGN_EPI = false, bool SP2 = false>
__device__ __forceinline__ void gemm_phase(PG8_LAS unsigned char* lds, const Gemm g, const Sched& S, const Epi& E) {
    const int tid = threadIdx.x, wid = __builtin_amdgcn_readfirstlane(tid >> 6), lane = tid & 63, wr = wid >> 2, wc = wid & 3, fr = lane & 15, fq = lane >> 4;
    const int K = g.K, nt = K / BK;
    unsigned voffA[2], voffB[2];
#pragma unroll
    for (int i = 0; i < 2; ++i) { int R, C; stage_rc(tid * 16 + i * 8192, R, C); const int Rb = Epi::PERM ? ((R & ~31) + perm32(R & 31)) : R;
        voffA[i] = (unsigned)(R * K + C) * 2u; voffB[i] = (unsigned)(Rb * K + C) * 2u; }
    const size_t kstep = (size_t)(BK * 2);
    const size_t hstep = (size_t)HALF * K * 2;
    const size_t tstep = 2 * hstep;
    const unsigned ldsw = (unsigned)wid * 1024u;
    const int aoff = lds_byte(wr * 64 + fr, fq * 8), boff = lds_byte(wc * 32 + fr, fq * 8);
#define PG8_SA(b, h) (((b) * 2 + (h)) * HTB)
#define PG8_SB(b, h) ((4 + (b) * 2 + (h)) * HTB)
#define PG8_STAGE(bufoff, gbase, voff) do { _Pragma("unroll") for (int _i = 0; _i < 2; ++_i) \
        __builtin_amdgcn_global_load_lds((const unsigned*)((const char*)(gbase) + (voff)[_i]), (PG8_LAS unsigned*)(lds + (bufoff) + ldsw + _i * 8192), 16, 0, 0); } while (0)
#define PG8_LDA(dst, b, h) do { _Pragma("unroll") for (int m = 0; m < 4; ++m) _Pragma("unroll") for (int k = 0; k < 2; ++k) dst[m][k] = *(const PG8_LAS bf16x8*)(lds + PG8_SA(b, h) + aoff + m * 2048 + k * 1024); } while (0)
#define PG8_LDB(dst, b, h) do { _Pragma("unroll") for (int n = 0; n < 2; ++n) _Pragma("unroll") for (int k = 0; k < 2; ++k) dst[n][k] = *(const PG8_LAS bf16x8*)(lds + PG8_SB(b, h) + boff + n * 2048 + k * 1024); } while (0)
#define PG8_MMA(ai, bj, At, Bt) do { __builtin_amdgcn_s_setprio(1); _Pragma("unroll") for (int m = 0; m < 4; ++m) _Pragma("unroll") for (int n = 0; n < 2; ++n) _Pragma("unroll") for (int k = 0; k < 2; ++k) \
        acc[ai][bj][m][n] = __builtin_amdgcn_mfma_f32_16x16x32_bf16(Bt[n][k], At[m][k], acc[ai][bj][m][n], 0, 0, 0); __builtin_amdgcn_s_setprio(0); } while (0)
#define PG8_WAIT_V(n) asm volatile("s_waitcnt vmcnt(" #n ")" ::: "memory")
#define PG8_WAIT_L(n) asm volatile("s_waitcnt lgkmcnt(" #n ")" ::: "memory")
#define PG8_BAR __builtin_amdgcn_s_barrier()
#define PG8_SCHED __builtin_amdgcn_sched_barrier(0)
    Unit cur, nxt; int ui = 0;
    if (!S.next(0, cur)) return;
    f32x4 acc[2][2][4][2];
#pragma unroll
    for (int a = 0; a < 2; ++a)
#pragma unroll
        for (int b = 0; b < 2; ++b)
#pragma unroll
            for (int m = 0; m < 4; ++m)
#pragma unroll
                for (int n = 0; n < 2; ++n) acc[a][b][m][n] = (f32x4){0.f, 0.f, 0.f, 0.f};
    bf16x8 At[4][2], B0[2][2], B1[2][2];
    const char* cA = (const char*)g.A + (size_t)cur.pm * tstep; const char* cB = (const char*)g.Bt + (size_t)cur.pn * tstep;
    S.a_ready(cur);
    if constexpr (SP2) {
        PG8_STAGE(PG8_SB(0, 0), cB, voffB); PG8_STAGE(PG8_SB(0, 1), cB + hstep, voffB); PG8_STAGE(PG8_SA(0, 0), cA, voffA); PG8_STAGE(PG8_SA(0, 1), cA + hstep, voffA);
        if (wr == 1) PG8_BAR;
        PG8_WAIT_V(2); PG8_BAR;
        PG8_STAGE(PG8_SB(1, 0), cB + kstep, voffB); PG8_STAGE(PG8_SA(1, 0), cA + kstep, voffA); PG8_STAGE(PG8_SB(1, 1), cB + hstep + kstep, voffB);
        PG8_WAIT_V(6); PG8_BAR;
    } else {
        PG8_STAGE(PG8_SB(0, 0), cB, voffB); PG8_STAGE(PG8_SA(0, 0), cA, voffA); PG8_STAGE(PG8_SB(0, 1), cB + hstep, voffB); PG8_STAGE(PG8_SA(0, 1), cA + hstep, voffA);
        if (wr == 1) PG8_BAR;
        PG8_WAIT_V(4); PG8_BAR;
        PG8_STAGE(PG8_SB(1, 0), cB + kstep, voffB); PG8_STAGE(PG8_SA(1, 0), cA + kstep, voffA); PG8_STAGE(PG8_SB(1, 1), cB + hstep + kstep, voffB);
        PG8_WAIT_V(6); PG8_BAR;
    }
    for (;;) {
        const bool has_next = S.next(ui + 1, nxt);
        const char* nA = has_next ? (const char*)g.A + (size_t)nxt.pm * tstep : cA; const char* nB = has_next ? (const char*)g.Bt + (size_t)nxt.pn * tstep : cB;
        for (int t = 0; t < nt; t += 2) {
            const bool last = (t == nt - 2);
            const char* a1 = cA + (size_t)(t + 1) * kstep;
            const char* a2 = last ? nA : cA + (size_t)(t + 2) * kstep; const char* b2 = last ? nB : cB + (size_t)(t + 2) * kstep;
            const char* a3 = a2 + kstep; const char* b3 = b2 + kstep;
            if (last && has_next) S.a_ready(nxt);
            if constexpr (SP2) {
            PG8_LDB(B0, 0, 0); PG8_LDB(B1, 0, 1); PG8_SCHED; PG8_LDA(At, 0, 0); PG8_STAGE(PG8_SA(1, 1), a1 + hstep, voffA);
            PG8_WAIT_V(8); PG8_WAIT_L(0); PG8_BAR; PG8_MMA(0, 0, At, B0); PG8_MMA(0, 1, At, B1); PG8_BAR; PG8_SCHED;
            PG8_LDA(At, 0, 1); PG8_STAGE(PG8_SB(0, 0), b2, voffB); PG8_STAGE(PG8_SB(0, 1), b2 + hstep, voffB); PG8_STAGE(PG8_SA(0, 0), a2, voffA);
            PG8_WAIT_V(8); PG8_WAIT_L(0); PG8_BAR; PG8_MMA(1, 0, At, B0); PG8_MMA(1, 1, At, B1); PG8_BAR; PG8_SCHED;
            PG8_LDB(B0, 1, 0); PG8_LDB(B1, 1, 1); PG8_SCHED; PG8_LDA(At, 1, 0); PG8_STAGE(PG8_SA(0, 1), a2 + hstep, voffA);
            PG8_WAIT_V(8); PG8_WAIT_L(0); PG8_BAR; PG8_MMA(0, 0, At, B0); PG8_MMA(0, 1, At, B1); PG8_BAR; PG8_SCHED;
            PG8_LDA(At, 1, 1); PG8_STAGE(PG8_SB(1, 0), b3, voffB); PG8_STAGE(PG8_SB(1, 1), b3 + hstep, voffB); PG8_STAGE(PG8_SA(1, 0), a3, voffA);
            PG8_WAIT_V(8); PG8_WAIT_L(0); PG8_BAR; PG8_MMA(1, 0, At, B0); PG8_MMA(1, 1, At, B1); PG8_BAR; PG8_SCHED;
            } else {
            PG8_LDB(B0, 0, 0); PG8_SCHED; PG8_LDA(At, 0, 0); PG8_STAGE(PG8_SA(1, 1), a1 + hstep, voffA);
            PG8_WAIT_L(8); PG8_BAR; PG8_WAIT_L(0); PG8_MMA(0, 0, At, B0); PG8_BAR; PG8_SCHED;
            PG8_LDB(B1, 0, 1); PG8_STAGE(PG8_SB(0, 0), b2, voffB);
            PG8_BAR; PG8_WAIT_L(0); PG8_MMA(0, 1, At, B1); PG8_BAR;
            PG8_LDA(At, 0, 1); PG8_STAGE(PG8_SA(0, 0), a2, voffA);
            PG8_BAR; PG8_WAIT_L(0); PG8_MMA(1, 0, At, B0); PG8_BAR; PG8_SCHED;
            PG8_STAGE(PG8_SB(0, 1), b2 + hstep, voffB);
            PG8_WAIT_V(6); PG8_BAR; PG8_MMA(1, 1, At, B1); PG8_BAR;
            PG8_LDB(B0, 1, 0); PG8_SCHED; PG8_LDA(At, 1, 0); PG8_STAGE(PG8_SA(0, 1), a2 + hstep, voffA);
            PG8_WAIT_L(8); PG8_BAR; PG8_WAIT_L(0); PG8_MMA(0, 0, At, B0); PG8_BAR; PG8_SCHED;
            PG8_LDB(B1, 1, 1); PG8_STAGE(PG8_SB(1, 0), b3, voffB);
            PG8_BAR; PG8_WAIT_L(0); PG8_MMA(0, 1, At, B1); PG8_BAR;
            PG8_LDA(At, 1, 1); PG8_STAGE(PG8_SA(1, 0), a3, voffA);
            PG8_BAR; PG8_WAIT_L(0); PG8_MMA(1, 0, At, B0); PG8_BAR; PG8_SCHED;
            PG8_STAGE(PG8_SB(1, 1), b3 + hstep, voffB);
            PG8_WAIT_V(6); PG8_BAR; PG8_MMA(1, 1, At, B1); PG8_BAR;
            }
        }
        if constexpr (ALIGN_EPI) { if (wr == 0) PG8_BAR; }
        if constexpr (!Epi::AFTER_DRAIN) { E(acc, cur, wr, wc, fr, fq); S.done(cur); }
        if (!has_next) break;
#pragma unroll
        for (int a = 0; a < 2; ++a)
#pragma unroll
            for (int b = 0; b < 2; ++b)
#pragma unroll
                for (int m = 0; m < 4; ++m)
#pragma unroll
                    for (int n = 0; n < 2; ++n) acc[a][b][m][n] = (f32x4){0.f, 0.f, 0.f, 0.f};
        cur = nxt; cA = nA; cB = nB; ++ui;
        if constexpr (ALIGN_EPI) { if (wr == 1) PG8_BAR; }
    }
    PG8_WAIT_V(0);
    if constexpr (!ALIGN_EPI) { if (wr == 0) PG8_BAR; }
    PG8_BAR;
    if constexpr (Epi::AFTER_DRAIN) { E.fused(acc, cur, wr, wc, fr, fq, lds, wid, lane); S.done(cur); }
#undef PG8_SA
#undef PG8_SB
#undef PG8_STAGE
#undef PG8_LDA
#undef PG8_LDB
#undef PG8_MMA
#undef PG8_WAIT_V
#undef PG8_WAIT_L
#undef PG8_BAR
#undef PG8_SCHED
}
}
constexpr int NWAVES = 8, NTHREADS = 512;
constexpr int D = 2048, NB = 4, T = 4096, M = NB * T, DEPTH = 4, GW = 512, NH = 8, HD = 64;
constexpr int NIN = 5544, NP = 5632, FF = 5632, MODW = 6 * D;
constexpr int PC_RR = 0, PC_RK = 512, PC_RV = 1024, PC_SQ = 1536, PC_SK = 2048, PC_SV = 2176, PC_GU = 2304, PC_GV = 2816;
constexpr int PC_FQ = 3328, PC_FK = 3840, PC_FV = 4352, PC_FG = 4864, PC_RW = 5376, PC_FL = 5536;
constexpr int YC_A = 0, YC_B = 512, YC_C = 1024, YC_D = 1536;
constexpr int SGU_TRI = 8256;
enum { I_X = 0, I_C, I_WMOD, I_BMOD, I_N1G, I_N2G, I_WIN, I_WOUT, I_RMU, I_RW0, I_RW2, I_RA0, I_RA2, I_RG2, I_RKK, I_RKA, I_RRK, I_RLG, I_RLB,
       I_SQG, I_SKG, I_SSINK, I_GLG, I_GLB, I_GWS, I_GB, I_FQG, I_FKG, I_FFB, I_W1, I_W3, I_W2, N_INPUTS };

constexpr size_t MiB = 1u << 20;
constexpr size_t WS_CTL = 0, CTL_ZERO_BYTES = 1 * MiB;
constexpr size_t WS_MOD = 1 * MiB;
constexpr size_t WS_MODP = 2 * MiB;
constexpr size_t WS_WIN = 8 * MiB;
constexpr size_t WS_WOUT = 96 * MiB;
constexpr size_t WS_W13 = 128 * MiB;
constexpr size_t WS_W2 = 304 * MiB;
constexpr size_t WS_H = 392 * MiB;
constexpr size_t WS_PROJ = 456 * MiB;
constexpr size_t WS_YCAT = 632 * MiB;
constexpr size_t WS_F = 696 * MiB;
constexpr size_t WS_RIN = 872 * MiB;
constexpr size_t WS_RG = 1064 * MiB;
constexpr size_t WS_RY = 1096 * MiB;
constexpr size_t WS_END = 1128 * MiB;
constexpr int CW_BAR = 4096;

constexpr int RING_BYTES = 131072;
constexpr int LDSCTL_OFF = RING_BYTES, MISC_OFF = LDSCTL_OFF + 320;
constexpr int LDS_BYTES = 147456;

#define GAS __attribute__((address_space(1)))
#define LAS __attribute__((address_space(3)))
typedef unsigned short bf16;
typedef short bf16x8 __attribute__((ext_vector_type(8)));
typedef float f32x4 __attribute__((ext_vector_type(4)));
typedef float f32x16 __attribute__((ext_vector_type(16)));
typedef unsigned v4u __attribute__((ext_vector_type(4)));
typedef unsigned v2u __attribute__((ext_vector_type(2)));
#define LDS_WAIT() asm volatile("s_waitcnt lgkmcnt(0)" ::: "memory")
__device__ __forceinline__ float bf2f(unsigned short b) { return __uint_as_float(((unsigned)b) << 16); }
__device__ __forceinline__ unsigned f2bf(float f) { unsigned u = __float_as_uint(f); return (u + 0x7fffu + ((u >> 16) & 1u)) >> 16; }
typedef float f32x2_t __attribute__((ext_vector_type(2))); typedef __bf16 bf16x2_t __attribute__((ext_vector_type(2)));
__device__ __forceinline__ unsigned pk2(float lo, float hi) { const f32x2_t v = {lo, hi}; const bf16x2_t b = __builtin_convertvector(v, bf16x2_t); return __builtin_bit_cast(unsigned, b); }
__device__ __forceinline__ float bflo(unsigned w) { return __uint_as_float(w << 16); }
__device__ __forceinline__ float bfhi(unsigned w) { return __uint_as_float(w & 0xffff0000u); }
__device__ __forceinline__ float wave_sum(float v) {
#pragma unroll
    for (int o = 1; o < 64; o <<= 1) v += __shfl_xor(v, o);
    return v;
}
__device__ __forceinline__ float sigmoidf_(float x) { return __builtin_amdgcn_rcpf(1.0f + __expf(-x)); }
__device__ __forceinline__ float gelu_f(float v) {
    const float av = fabsf(v), t = __builtin_amdgcn_rcpf(av * 0.2316418882f + 1.0f);
    float q = t * 0.5307027145f + (-0.7265760135f); q = q * t + 0.7107068705f; q = q * t + (-0.142248368f); q = q * t + 0.127414796f; q = q * t;
    const float e = __builtin_amdgcn_exp2f((v * v) * (-0.72134752044f));
    const float m = v * (q * e);
    return v < 0.f ? m : v - m;
}
__device__ __forceinline__ int crow(int r, int hi) { return (r & 3) + 8 * (r >> 2) + 4 * hi; }

#define XB_TMO      128
#define XB_XCNT(j)  (256  + 64 * (j))
#define XB_XSUB(j)  (1280 + 64 * (j))
#define XB_XGEN(j)  (2304 + 64 * (j))
#define XB_TOP      3328
#define XB_TOPGEN   3392
#define XCD_BAR_WORDS 3456
#define XB_SPIN_CAP (1u << 18)

__device__ __forceinline__ unsigned xb_ld(unsigned* p)              { return __hip_atomic_load(p, __ATOMIC_RELAXED, __HIP_MEMORY_SCOPE_AGENT); }
__device__ __forceinline__ unsigned xb_add(unsigned* p, unsigned v) { return __hip_atomic_fetch_add(p, v, __ATOMIC_RELAXED, __HIP_MEMORY_SCOPE_AGENT); }
__device__ __forceinline__ unsigned xb_xcc_id() { return (unsigned)__builtin_amdgcn_s_getreg((3 << 11) | 20) & 0xFu; }
#define XB_SPIN(cond, bar) do { unsigned _sp = 0; while (cond) { __builtin_amdgcn_s_sleep(1); \
    if ((++_sp & 255u) == 0u) { if (xb_ld(&(bar)[XB_TMO])) break; if (_sp > XB_SPIN_CAP) { atomicAdd(&(bar)[XB_TMO], 1u); break; } } } } while (0)

struct XcdBarrier {
    unsigned* bar; unsigned x;
    volatile LAS unsigned* st;
};

__device__ __forceinline__ XcdBarrier xcd_barrier_post(unsigned* bar, volatile LAS unsigned* st) {
    XcdBarrier b; b.bar = bar; b.x = xb_xcc_id(); b.st = st;
    if (threadIdx.x == 0) (void)xb_add(&bar[XB_XCNT(b.x)], 1u);
    return b;
}
__device__ __forceinline__ void xcd_barrier_complete(unsigned* bar, unsigned x, unsigned& nloc, unsigned& nx) {
    const unsigned G = gridDim.x * gridDim.y * gridDim.z;
    unsigned sum, cnt, mine, sp = 0u;
    for (;;) {
        sum = 0u; cnt = 0u; mine = 0u;
#pragma unroll
        for (unsigned j = 0; j < 16; ++j) { const unsigned c = xb_ld(&bar[XB_XCNT(j)]); sum += c; cnt += (c > 0u) ? 1u : 0u; mine = (j == x) ? c : mine; }
        if (sum == G) break;
        __builtin_amdgcn_s_sleep(1);
        if ((++sp & 255u) == 0u) { if (xb_ld(&bar[XB_TMO])) break; if (sp > XB_SPIN_CAP) { atomicAdd(&bar[XB_TMO], 1u); break; } }
    }
    nloc = mine > 0u ? mine : 1u; nx = cnt > 0u ? cnt : 1u;
}

__device__ __forceinline__ void xcd_barrier(const XcdBarrier& b) {
    asm volatile("s_waitcnt vmcnt(0)" ::: "memory");
    __syncthreads();
    if (threadIdx.x == 0) {
        unsigned* bar = b.bar;
        __builtin_amdgcn_s_waitcnt(0);
        unsigned nloc = b.st[0], nx = b.st[1];
        if (nloc == 0u) { xcd_barrier_complete(bar, b.x, nloc, nx); b.st[0] = nloc; b.st[1] = nx; }
        const unsigned old = xb_add(&bar[XB_XSUB(b.x)], 1u);
        const unsigned gen = old / nloc;
        if (old + 1u == (gen + 1u) * nloc) {
            __builtin_amdgcn_fence(__ATOMIC_RELEASE, "agent");
            asm volatile("s_waitcnt vmcnt(0)" ::: "memory");
            const unsigned og = xb_add(&bar[XB_TOP], 1u);
            const unsigned tg = og / nx;
            if (og + 1u == (tg + 1u) * nx) xb_add(&bar[XB_TOPGEN], 1u);
            else XB_SPIN(xb_ld(&bar[XB_TOPGEN]) == tg, bar);
            __builtin_amdgcn_fence(__ATOMIC_ACQUIRE, "agent");
            xb_add(&bar[XB_XGEN(b.x)], 1u);
            asm volatile("s_waitcnt vmcnt(0)" ::: "memory");
        } else {
            XB_SPIN(xb_ld(&bar[XB_XGEN(b.x)]) == gen, bar);
            __builtin_amdgcn_fence(__ATOMIC_ACQUIRE, "agent");
            asm volatile("s_waitcnt vmcnt(0)" ::: "memory");
        }
    }
    __syncthreads();
}

struct Args { const float* in[N_INPUTS]; float* out; unsigned char* ws; int ph_lo, ph_hi; };
static_assert(sizeof(Args) == (N_INPUTS + 2) * 8 + 8, "Args has no padding");

struct Ctx {
    LAS unsigned char* lds; int tid, lane, wave, G, bid;
};
typedef const Args __attribute__((address_space(4))) KArgs;
__device__ __forceinline__ KArgs* ka_ptr() { KArgs* p = (KArgs*)__builtin_amdgcn_kernarg_segment_ptr(); asm volatile("" : "+s"(p)); return p; }
#define KA_DECL KArgs& A = *ka_ptr()
#define LBAR() do { asm volatile("s_waitcnt lgkmcnt(0)" ::: "memory"); __builtin_amdgcn_s_barrier(); asm volatile("" ::: "memory"); } while (0)

__device__ __forceinline__ void tr_item(const float* __restrict__ W, int N, int col0, int nvalid, int k0, bf16* __restrict__ WT, int K, int n0, LAS float* scr, int lane) {
    float wv[32];
    const int nn = lane & 31; const bool okc = nn < nvalid; const float* wp = W + (size_t)(k0 + (lane >> 5)) * N + col0 + (okc ? nn : 0);
#pragma unroll
    for (int i = 0; i < 32; ++i) wv[i] = wp[(size_t)(2 * i) * N];
#pragma unroll
    for (int i = 0; i < 32; ++i) scr[(2 * i + (lane >> 5)) * 33 + nn] = okc ? wv[i] : 0.f;
    LDS_WAIT(); asm volatile("" ::: "memory");
    const int c = lane & 7;
#pragma unroll
    for (int j = 0; j < 4; ++j) { const int n = (lane >> 3) + 8 * j; const LAS float* s = scr + (8 * c) * 33 + n;
        v4u o; o.x = pk2(s[0 * 33], s[1 * 33]); o.y = pk2(s[2 * 33], s[3 * 33]); o.z = pk2(s[4 * 33], s[5 * 33]); o.w = pk2(s[6 * 33], s[7 * 33]);
        *(v4u*)(WT + (size_t)(n0 + n) * K + k0 + 8 * c) = o; }
    LDS_WAIT(); asm volatile("" ::: "memory");
}
__device__ __forceinline__ void ph_prologue(const Ctx& C) {
    KA_DECL;
    LAS float* csilu = (LAS float*)(C.lds + 73728);
    for (int i = C.tid; i < NB * D; i += NTHREADS) { const float c = A.in[I_C][i]; csilu[i] = c / (1.0f + __expf(-c)); }
    __syncthreads();
    LAS float* scr = (LAS float*)(C.lds + C.wave * 8704);
    const int gw = C.bid * NWAVES + C.wave, NGW = C.G * NWAVES;
    constexpr int I_IN = (D / 64) * (NP / 32), I_OUT = (D / 64) * (D / 32), I_13 = (D / 64) * (2 * FF / 32), I_2 = (FF / 64) * (D / 32), PER_L = I_IN + I_OUT + I_13 + I_2;
    for (int it = gw; it < DEPTH * PER_L; it += NGW) {
        const int l = it / PER_L; int r = it % PER_L;
        if (r < I_IN) { const int kb = r / (NP / 32), nb = r % (NP / 32), n0 = 32 * nb; int col0, nv = 32;
            if (n0 < 1536) col0 = n0; else if (n0 < 4864) col0 = n0 + 160; else if (n0 < 5376) col0 = n0 + 168; else if (n0 < 5536) col0 = n0 - 3840;
            else if (n0 == 5536) { col0 = 5024; nv = 8; } else { col0 = 0; nv = 0; }
            tr_item(A.in[I_WIN] + (size_t)l * D * NIN, NIN, col0, nv, 64 * kb, (bf16*)(A.ws + WS_WIN) + (size_t)l * NP * D, D, n0, scr, C.lane); continue; }
        r -= I_IN;
        if (r < I_OUT) { const int kb = r / (D / 32), nb = r % (D / 32);
            tr_item(A.in[I_WOUT] + (size_t)l * D * D, D, 32 * nb, 32, 64 * kb, (bf16*)(A.ws + WS_WOUT) + (size_t)l * D * D, D, 32 * nb, scr, C.lane); continue; }
        r -= I_OUT;
        if (r < I_13) { const int kb = r / (2 * FF / 32), nb = r % (2 * FF / 32), n0 = 32 * nb, pn = n0 >> 8, j = n0 & 255;
            const float* src = (j < 128 ? A.in[I_W1] : A.in[I_W3]) + (size_t)l * D * FF;
            tr_item(src, FF, 128 * pn + (j & 127), 32, 64 * kb, (bf16*)(A.ws + WS_W13) + (size_t)l * 2 * FF * D, D, n0, scr, C.lane); continue; }
        r -= I_13;
        { const int kb = r / (D / 32), nb = r % (D / 32);
            tr_item(A.in[I_W2] + (size_t)l * FF * D, D, 32 * nb, 32, 64 * kb, (bf16*)(A.ws + WS_W2) + (size_t)l * D * FF, FF, 32 * nb, scr, C.lane); }
    }
    for (int it = gw; it < 8 * DEPTH * (MODW / 256); it += NGW) {
        const int cg = it % (DEPTH * (MODW / 256)), ks = it / (DEPTH * (MODW / 256)), l = cg / (MODW / 256), n0 = (cg % (MODW / 256)) * 256, k0 = ks * 256;
        const float* wp = A.in[I_WMOD] + ((size_t)l * D + k0) * MODW + n0 + 4 * C.lane;
        f32x4 a0 = {0.f, 0.f, 0.f, 0.f}, a1 = a0, a2 = a0, a3 = a0;
#pragma unroll 16
        for (int k = 0; k < 256; ++k) { const f32x4 w = *(const f32x4*)(wp + (size_t)k * MODW);
            a0 += w * csilu[0 * D + k0 + k]; a1 += w * csilu[1 * D + k0 + k]; a2 += w * csilu[2 * D + k0 + k]; a3 += w * csilu[3 * D + k0 + k]; }
        float* mp = (float*)(A.ws + WS_MODP) + ((size_t)(ks * DEPTH + l) * NB) * MODW + n0 + 4 * C.lane;
        *(f32x4*)(mp + 0 * MODW) = a0; *(f32x4*)(mp + 1 * MODW) = a1; *(f32x4*)(mp + 2 * MODW) = a2; *(f32x4*)(mp + 3 * MODW) = a3;
    }
}
__device__ __forceinline__ void ph_modreduce(const Ctx& C) {
    KA_DECL;
    const float* mp = (const float*)(A.ws + WS_MODP); float* mod = (float*)(A.ws + WS_MOD);
    for (int i = C.bid * NTHREADS + C.tid; i < DEPTH * NB * MODW; i += C.G * NTHREADS) {
        const int l = i / (NB * MODW), n = i % MODW; float s = A.in[I_BMOD][l * MODW + n];
#pragma unroll
        for (int ks = 0; ks < 8; ++ks) s += mp[(size_t)ks * DEPTH * NB * MODW + i];
        mod[i] = s;
    }
}
__device__ __forceinline__ void ph_norm(const Ctx& C, const float* x, const float* g, const float* shift, const float* scale, bf16* H) {
    const int gw = C.bid * NWAVES + C.wave, NGW = C.G * NWAVES;
    for (int m = gw; m < M; m += NGW) {
        const int b = m / T; const f32x4* xr = (const f32x4*)(x + (size_t)m * D) + C.lane;
        f32x4 v[8]; float ss = 0.f;
#pragma unroll
        for (int j = 0; j < 8; ++j) { v[j] = xr[64 * j]; ss += (v[j].x * v[j].x + v[j].y * v[j].y) + (v[j].z * v[j].z + v[j].w * v[j].w); }
        const float rstd = 1.0f / sqrtf(wave_sum(ss) * (1.0f / D) + 1e-6f);
        unsigned long long* o8 = (unsigned long long*)(H + (size_t)m * D) + C.lane;
        f32x4 cv[8], sh[8];
#pragma unroll
        for (int j = 0; j < 8; ++j) { const int c = 4 * (C.lane + 64 * j);
            const f32x4 gg = *(const f32x4*)(g + c), sc = *(const f32x4*)(scale + (size_t)b * MODW + c); sh[j] = *(const f32x4*)(shift + (size_t)b * MODW + c); cv[j] = gg * (sc + 1.0f); }
#pragma unroll
        for (int j = 0; j < 8; ++j) { const f32x4 y = v[j] * rstd * cv[j] + sh[j];
            o8[64 * j] = (unsigned long long)pk2(y.x, y.y) | ((unsigned long long)pk2(y.z, y.w) << 32); }
    }
}

__device__ __forceinline__ float dpp_xor1(float v) { return __builtin_bit_cast(float, __builtin_amdgcn_update_dpp(0, __builtin_bit_cast(int, v), 0xB1, 0xF, 0xF, true)); }
__device__ __forceinline__ float dpp_xor2(float v) { return __builtin_bit_cast(float, __builtin_amdgcn_update_dpp(0, __builtin_bit_cast(int, v), 0x4E, 0xF, 0xF, true)); }
__device__ __forceinline__ float wave_sum_dpp(float v) {
    v += dpp_xor1(v); v += dpp_xor2(v);
    v += __builtin_bit_cast(float, __builtin_amdgcn_update_dpp(0, __builtin_bit_cast(int, v), 0x141, 0xF, 0xF, true));
    v += __builtin_bit_cast(float, __builtin_amdgcn_update_dpp(0, __builtin_bit_cast(int, v), 0x140, 0xF, 0xF, true));
    const int b = __builtin_bit_cast(int, v);
    return (__builtin_bit_cast(float, __builtin_amdgcn_readlane(b, 0)) + __builtin_bit_cast(float, __builtin_amdgcn_readlane(b, 16))) +
           (__builtin_bit_cast(float, __builtin_amdgcn_readlane(b, 32)) + __builtin_bit_cast(float, __builtin_amdgcn_readlane(b, 48)));
}

__device__ __forceinline__ f32x16 mma32(const LAS bf16* Ap, const LAS bf16* Bp, int ksteps, f32x16 acc) {
    for (int k = 0; k < ksteps; ++k) { const bf16x8 a = *(const LAS bf16x8*)(Ap + 16 * k), b = *(const LAS bf16x8*)(Bp + 16 * k);
        acc = __builtin_amdgcn_mfma_f32_32x32x16_bf16(a, b, acc, 0, 0, 0); }
    return acc;
}
constexpr int AP = 72;
constexpr size_t WS_QF = WS_RIN, WS_YF = WS_RIN + 32 * MiB, WS_PA = WS_RIN + 64 * MiB, WS_RT = WS_RIN + 80 * MiB, WS_GL = WS_RIN + 96 * MiB, WS_RBV = WS_RIN + 97 * MiB;
constexpr size_t WS_CUM = WS_RIN + 170 * MiB;
constexpr size_t WS_KNF = WS_RIN + 130 * MiB, WS_KNS = WS_RIN + 146 * MiB, WS_VTF = WS_RIN + 150 * MiB, WS_VTS = WS_RIN + 166 * MiB;
__device__ __forceinline__ void kvprep_unit(const Ctx& C, int l, int u) {
    KA_DECL; asm volatile("" : "+s"(l));
    const bf16* proj = (const bf16*)(A.ws + WS_PROJ);
    int tid = C.tid; asm volatile("" : "+v"(tid));
    const size_t m0 = (size_t)u * 64; const int b = (int)(m0 / T), t0 = (int)(m0 % T);
    bf16* KNF = (bf16*)(A.ws + WS_KNF); bf16* KNS = (bf16*)(A.ws + WS_KNS); bf16* VTF = (bf16*)(A.ws + WS_VTF); bf16* VTS = (bf16*)(A.ws + WS_VTS);
    LAS bf16* Vl = (LAS bf16*)C.lds;
    LBAR();
    float gF[8], gS[8];
#pragma unroll
    for (int i = 0; i < 8; ++i) { gF[i] = A.in[I_FKG][l * 64 + 8 * (tid & 7) + i]; gS[i] = A.in[I_SKG][l * 64 + 8 * (tid & 7) + i]; }
    for (int half = 0; half < 2; ++half) {
        v4u krr[5];
#pragma unroll
        for (int it = 0; it < 5; ++it) { const int i = tid + NTHREADS * (5 * half + it), tok = i / 80, ch = i % 80;
            krr[it] = *(const v4u*)(proj + (m0 + tok) * NP + ((ch < 64) ? PC_FK + 8 * ch : PC_SK + 8 * (ch - 64))); }
#pragma unroll
        for (int it = 0; it < 5; ++it) { const int i = tid + NTHREADS * (5 * half + it), tok = i / 80, ch = i % 80; const size_t m = m0 + tok;
            const bool fox = ch < 64;
            float g[8];
#pragma unroll
            for (int q = 0; q < 8; ++q) g[q] = fox ? gF[q] : gS[q];
            const v4u kr = krr[it];
            float f[8]; f[0] = bflo(kr.x); f[1] = bfhi(kr.x); f[2] = bflo(kr.y); f[3] = bfhi(kr.y); f[4] = bflo(kr.z); f[5] = bfhi(kr.z); f[6] = bflo(kr.w); f[7] = bfhi(kr.w);
            float ss = ((f[0] * f[0] + f[1] * f[1]) + (f[2] * f[2] + f[3] * f[3])) + ((f[4] * f[4] + f[5] * f[5]) + (f[6] * f[6] + f[7] * f[7]));
            ss += dpp_xor1(ss); ss += dpp_xor2(ss); ss += __shfl_xor(ss, 4);
            const float rs = __builtin_amdgcn_rsqf(ss * (1.0f / 64.0f) + 1e-6f);
            v4u ko; ko.x = pk2(f[0] * rs * g[0], f[1] * rs * g[1]); ko.y = pk2(f[2] * rs * g[2], f[3] * rs * g[3]); ko.z = pk2(f[4] * rs * g[4], f[5] * rs * g[5]); ko.w = pk2(f[6] * rs * g[6], f[7] * rs * g[7]);
            if (fox) *(v4u*)(KNF + m * 512 + 8 * ch) = ko; else *(v4u*)(KNS + m * 128 + 8 * (ch - 64)) = ko; }
    }
#pragma unroll
    for (int it = 0; it < 10; ++it) { const int i = tid + NTHREADS * it, head = i >> 9, rem = i & 511, tok = rem >> 3, dc = rem & 7;
        const int scol = (head < 8) ? PC_FV + head * 64 + 8 * dc : PC_SV + (head - 8) * 64 + 8 * dc;
        *(LAS v4u*)(Vl + (head * 64 + tok) * AP + 8 * dc) = *(const v4u*)(proj + (m0 + tok) * NP + scol); }
    LBAR();
    for (int it = 0; it < 10; ++it) { const int i = tid + NTHREADS * it, head = i >> 9, rem = i & 511, d = rem >> 3, tc = rem & 7;
        const LAS bf16* src = Vl + (head * 64 + 8 * tc) * AP + d;
        v4u o; o.x = (unsigned)src[0] | ((unsigned)src[AP] << 16); o.y = (unsigned)src[2 * AP] | ((unsigned)src[3 * AP] << 16); o.z = (unsigned)src[4 * AP] | ((unsigned)src[5 * AP] << 16); o.w = (unsigned)src[6 * AP] | ((unsigned)src[7 * AP] << 16);
        bf16* dst = (head < 8) ? VTF + ((size_t)(b * 8 + head) * 64 + d) * T : VTS + ((size_t)(b * 2 + head - 8) * 64 + d) * T;
        *(v4u*)(dst + t0 + 8 * tc) = o; }
}
__device__ __forceinline__ void cumprep_unit(const Ctx& C, int l, int bh) {
    KA_DECL; asm volatile("" : "+s"(l));
    const bf16* proj = (const bf16*)(A.ws + WS_PROJ); float* cumg = (float*)(A.ws + WS_CUM) + (size_t)bh * T;
    const int tid = C.tid, lane = C.lane, wave = C.wave, b = bh >> 3, h = bh & 7; const size_t rowb = (size_t)b * T;
    LAS float* WT = (LAS float*)C.lds;
    const float fb = A.in[I_FFB][l * NH + h];
    LBAR();
    float loc[8]; float s = 0.f;
    bf16 xr[8];
#pragma unroll
    for (int i = 0; i < 8; ++i) xr[i] = proj[(rowb + 8 * tid + i) * NP + PC_FL + h];
#pragma unroll
    for (int i = 0; i < 8; ++i) { const float x = bf2f(xr[i]) + fb;
        const float e_ = __expf(-fabsf(x)); const float v = fminf(x, 0.f) - __logf(1.0f + e_); s += v; loc[i] = s; }
    float ws_ = s;
#pragma unroll
    for (int o = 1; o < 64; o <<= 1) { const float t_ = __shfl_up(ws_, o); if (lane >= o) ws_ += t_; }
    if (lane == 63) WT[wave] = ws_;
    LBAR();
    float base = ws_ - s;
    for (int w = 0; w < wave; ++w) base += WT[w];
    f32x4 o0 = {(base + loc[0]) * 1.4426950408889634f, (base + loc[1]) * 1.4426950408889634f, (base + loc[2]) * 1.4426950408889634f, (base + loc[3]) * 1.4426950408889634f};
    f32x4 o1 = {(base + loc[4]) * 1.4426950408889634f, (base + loc[5]) * 1.4426950408889634f, (base + loc[6]) * 1.4426950408889634f, (base + loc[7]) * 1.4426950408889634f};
    *(f32x4*)(cumg + 8 * tid) = o0; *(f32x4*)(cumg + 8 * tid + 4) = o1;
}
constexpr int B_K = 0, B_VT = 18432, B_CUM = 36864, B_WT = 53248;
__device__ __forceinline__ float max3f(float a, float b, float c) { float r; asm("v_max3_f32 %0, %1, %2, %3" : "=v"(r) : "v"(a), "v"(b), "v"(c)); return r; }
__device__ __forceinline__ float max_halves(float m) { auto rr = __builtin_amdgcn_permlane32_swap(__float_as_uint(m), __float_as_uint(m), false, false); return fmaxf(__uint_as_float(rr[0]), __uint_as_float(rr[1])); }
__device__ __forceinline__ float sum_halves(float m) { auto rr = __builtin_amdgcn_permlane32_swap(__float_as_uint(m), __float_as_uint(m), false, false); return __uint_as_float(rr[0]) + __uint_as_float(rr[1]); }
template <int MODE>
__device__ __forceinline__ void attn2_unit(const Ctx& C, int l, int b, int h, int qb) {
    KA_DECL; asm volatile("" : "+s"(l));
    const bf16* proj = (const bf16*)(A.ws + WS_PROJ); bf16* ycat = (bf16*)(A.ws + WS_YCAT);
    int tid = C.tid; asm volatile("" : "+v"(tid));
    const int lane = tid & 63, wave = C.wave, r32 = lane & 31, hi = lane >> 5;
    const int q0 = qb * 256; const size_t rowb = (size_t)b * T;
    const int qcol = (MODE == 0 ? PC_SQ : PC_FQ) + h * 64;
    const bf16* KN = (MODE == 0) ? (const bf16*)(A.ws + WS_KNS) + (h >> 2) * 64 : (const bf16*)(A.ws + WS_KNF) + h * 64;
    constexpr int KPI = (MODE == 0) ? 128 : 512;
    const bf16* VT = (MODE == 0) ? (const bf16*)(A.ws + WS_VTS) + (size_t)(b * 2 + (h >> 2)) * 64 * T : (const bf16*)(A.ws + WS_VTF) + (size_t)(b * 8 + h) * 64 * T;
    const float* qg = A.in[MODE == 0 ? I_SQG : I_FQG] + l * 64;
    LAS bf16* Ks = (LAS bf16*)(C.lds + B_K); LAS bf16* Vt = (LAS bf16*)(C.lds + B_VT); LAS float* cum = (LAS float*)(C.lds + B_CUM); LAS float* WT = (LAS float*)(C.lds + B_WT);
    constexpr float LOG2E = 1.4426950408889634f;
    LBAR();
    if (MODE == 1) {
        const float* cumg = (const float*)(A.ws + WS_CUM) + (size_t)(b * NH + h) * T;
        for (int i = tid; i < (q0 + 256) / 4; i += NTHREADS) *(LAS f32x4*)(cum + 4 * i) = *(const f32x4*)(cumg + 4 * i);
    }
    const int qp = q0 + 32 * wave + r32;
    bf16x8 qf[4];
    {
        const bf16* src = proj + (rowb + qp) * NP + qcol + 8 * hi;
        v4u raw[4]; float ss = 0.f;
#pragma unroll
        for (int s4 = 0; s4 < 4; ++s4) { raw[s4] = *(const v4u*)(src + 16 * s4);
            const float f0 = bflo(raw[s4].x), f1 = bfhi(raw[s4].x), f2 = bflo(raw[s4].y), f3 = bfhi(raw[s4].y), f4 = bflo(raw[s4].z), f5 = bfhi(raw[s4].z), f6 = bflo(raw[s4].w), f7 = bfhi(raw[s4].w);
            ss += ((f0 * f0 + f1 * f1) + (f2 * f2 + f3 * f3)) + ((f4 * f4 + f5 * f5) + (f6 * f6 + f7 * f7)); }
        ss = sum_halves(ss);
        const float rs = (0.125f * LOG2E) / sqrtf(ss * (1.0f / 64.0f) + 1e-6f);
#pragma unroll
        for (int s4 = 0; s4 < 4; ++s4) { const float* g8 = qg + 16 * s4 + 8 * hi; v4u o;
            o.x = pk2(bflo(raw[s4].x) * rs * g8[0], bfhi(raw[s4].x) * rs * g8[1]); o.y = pk2(bflo(raw[s4].y) * rs * g8[2], bfhi(raw[s4].y) * rs * g8[3]);
            o.z = pk2(bflo(raw[s4].z) * rs * g8[4], bfhi(raw[s4].z) * rs * g8[5]); o.w = pk2(bflo(raw[s4].w) * rs * g8[6], bfhi(raw[s4].w) * rs * g8[7]);
            qf[s4] = __builtin_bit_cast(bf16x8, o); }
    }
    int ks_begin = (MODE == 0) ? (q0 >= 128 ? q0 - 128 : 0) : 0; const int ks_end = q0 + 256;
    if (MODE == 1) {
        const float* cumg = (const float*)(A.ws + WS_CUM) + (size_t)(b * NH + h) * T;
        float gq = fabsf(qg[lane]), gk = fabsf(A.in[I_FKG][l * 64 + lane]);
#pragma unroll
        for (int o = 1; o < 64; o <<= 1) { gq = fmaxf(gq, __shfl_xor(gq, o)); gk = fmaxf(gk, __shfl_xor(gk, o)); }
        const float B2 = 8.0f * LOG2E * gq * gk * 1.05f;
        const int ntile = q0 >> 6;
        const bool skip = (lane < ntile) && (cumg[q0] - cumg[64 * lane + 63] + 2.0f * B2 < -172.0f);
        ks_begin = 64 * __builtin_popcountll(__ballot(skip));
    }
    const int srow = tid >> 3, sdc = (tid & 7) * 8;
    v4u kreg[2], vreg[2];
#define A2_LOAD(S_, ks_) do { kreg[S_] = *(const v4u*)(KN + (rowb + (ks_) + srow) * KPI + sdc); vreg[S_] = *(const v4u*)(VT + (size_t)srow * T + (ks_) + sdc); } while (0)
#define A2_STAGE(S_, buf_) do { *(LAS v4u*)(Ks + (buf_) * 64 * AP + srow * AP + sdc) = kreg[S_]; *(LAS v4u*)(Vt + (buf_) * 64 * AP + srow * AP + sdc) = vreg[S_]; } while (0)
    A2_LOAD(0, ks_begin); A2_LOAD(1, ks_begin + 64);
    A2_STAGE(0, 0);
    if (ks_begin + 128 < ks_end) A2_LOAD(0, ks_begin + 128);
    float m_run = -1e30f, l_run = 0.f;
    f32x16 o0, o1, cqv;
#pragma unroll
    for (int r = 0; r < 16; ++r) { o0[r] = 0.f; o1[r] = 0.f; cqv[r] = 0.f; }
    const int qmax = q0 + 32 * wave + 31, qmin = q0 + 32 * wave;
    int buf = 0;
    for (int ks = ks_begin; ks < ks_end; ks += 64, buf ^= 1) {
        LBAR();
        if (MODE == 1 && ks == ks_begin) { const float cq = cum[qp];
#pragma unroll
            for (int r = 0; r < 16; ++r) cqv[r] = cq; }
        if (ks + 64 < ks_end) { if (buf == 0) { A2_STAGE(1, 1); if (ks + 192 < ks_end) A2_LOAD(1, ks + 192); } else { A2_STAGE(0, 0); if (ks + 192 < ks_end) A2_LOAD(0, ks + 192); } }
        const bool live = (MODE == 1) ? (ks <= qmax) : (ks <= qmax && ks + 63 > qmin - 128);
        if (live) {
            const LAS bf16* kb = Ks + buf * 64 * AP + r32 * AP + 8 * hi;
            f32x16 p0, p1;
            __builtin_amdgcn_s_setprio(1);
#pragma unroll
            for (int s4 = 0; s4 < 4; ++s4) { const bf16x8 k0 = *(const LAS bf16x8*)(kb + 16 * s4), k1 = *(const LAS bf16x8*)(kb + 32 * AP + 16 * s4);
                if (s4 == 0) { p0 = __builtin_amdgcn_mfma_f32_32x32x16_bf16(k0, qf[0], cqv, 0, 0, 0); p1 = __builtin_amdgcn_mfma_f32_32x32x16_bf16(k1, qf[0], cqv, 0, 0, 0); }
                else { p0 = __builtin_amdgcn_mfma_f32_32x32x16_bf16(k0, qf[s4], p0, 0, 0, 0); p1 = __builtin_amdgcn_mfma_f32_32x32x16_bf16(k1, qf[s4], p1, 0, 0, 0); } }
            __builtin_amdgcn_s_setprio(0);
            if (MODE == 1) {
#pragma unroll
                for (int q4 = 0; q4 < 4; ++q4) { const f32x4 c0 = *(const LAS f32x4*)(cum + ks + 8 * q4 + 4 * hi), c1 = *(const LAS f32x4*)(cum + ks + 32 + 8 * q4 + 4 * hi);
                    p0[4 * q4] -= c0.x; p0[4 * q4 + 1] -= c0.y; p0[4 * q4 + 2] -= c0.z; p0[4 * q4 + 3] -= c0.w;
                    p1[4 * q4] -= c1.x; p1[4 * q4 + 1] -= c1.y; p1[4 * q4 + 2] -= c1.z; p1[4 * q4 + 3] -= c1.w; }
            }
            const bool edge = (MODE == 1) ? (ks + 63 > qmin) : true;
            if (edge) {
#pragma unroll
                for (int r = 0; r < 16; ++r) { const int k0p = ks + crow(r, hi), k1p = k0p + 32;
                    const bool ok0 = (MODE == 1) ? (k0p <= qp) : (k0p <= qp && k0p > qp - 128), ok1 = (MODE == 1) ? (k1p <= qp) : (k1p <= qp && k1p > qp - 128);
                    p0[r] = ok0 ? p0[r] : -1e30f; p1[r] = ok1 ? p1[r] : -1e30f; }
            }
            float mx = max3f(p0[0], p1[0], p0[1]);
#pragma unroll
            for (int r = 1; r < 15; r += 2) mx = max3f(mx, p1[r], p0[r + 1]), mx = max3f(mx, p1[r + 1], (r + 2 < 16) ? p0[r + 2] : p1[r + 1]);
            mx = max3f(mx, p1[15], p1[15]);
            mx = max_halves(mx);
            const float m_new = (mx > m_run + 8.0f) ? mx : m_run;
            float rsum = 0.f;
            if (MODE == 1) {
#pragma unroll
                for (int r = 0; r < 16; ++r) { p0[r] = __builtin_amdgcn_exp2f(p0[r] - m_new); p1[r] = __builtin_amdgcn_exp2f(p1[r] - m_new); }
                float ra = 0.f, rb = 0.f, rc = 0.f, rd = 0.f;
#pragma unroll
                for (int r = 0; r < 16; r += 2) { ra += p0[r]; rb += p1[r]; rc += p0[r + 1]; rd += p1[r + 1]; }
                rsum = (ra + rb) + (rc + rd);
            } else {
#pragma unroll
                for (int r = 0; r < 16; ++r) { p0[r] = (p0[r] > -1e29f) ? __builtin_amdgcn_exp2f(p0[r] - m_new) : 0.f; p1[r] = (p1[r] > -1e29f) ? __builtin_amdgcn_exp2f(p1[r] - m_new) : 0.f; rsum += p0[r] + p1[r]; }
            }
            if (__any(m_new != m_run)) {
                const float alpha = __builtin_amdgcn_exp2f(m_run - m_new);
                l_run *= alpha;
#pragma unroll
                for (int r = 0; r < 16; ++r) { o0[r] *= alpha; o1[r] *= alpha; }
                m_run = m_new;
            }
            l_run += rsum;
            bf16x8 pf[4];
            { v4u w;
              w.x = pk2(p0[0], p0[1]); w.y = pk2(p0[2], p0[3]); w.z = pk2(p0[4], p0[5]); w.w = pk2(p0[6], p0[7]); pf[0] = __builtin_bit_cast(bf16x8, w);
              w.x = pk2(p0[8], p0[9]); w.y = pk2(p0[10], p0[11]); w.z = pk2(p0[12], p0[13]); w.w = pk2(p0[14], p0[15]); pf[1] = __builtin_bit_cast(bf16x8, w);
              w.x = pk2(p1[0], p1[1]); w.y = pk2(p1[2], p1[3]); w.z = pk2(p1[4], p1[5]); w.w = pk2(p1[6], p1[7]); pf[2] = __builtin_bit_cast(bf16x8, w);
              w.x = pk2(p1[8], p1[9]); w.y = pk2(p1[10], p1[11]); w.z = pk2(p1[12], p1[13]); w.w = pk2(p1[14], p1[15]); pf[3] = __builtin_bit_cast(bf16x8, w); }
            const LAS bf16* vb = Vt + buf * 64 * AP + r32 * AP + 4 * hi;
            __builtin_amdgcn_s_setprio(1);
#pragma unroll
            for (int ks4 = 0; ks4 < 4; ++ks4) {
                const v2u a0 = *(const LAS v2u*)(vb + 16 * ks4), a1 = *(const LAS v2u*)(vb + 16 * ks4 + 8), b0 = *(const LAS v2u*)(vb + 32 * AP + 16 * ks4), b1 = *(const LAS v2u*)(vb + 32 * AP + 16 * ks4 + 8);
                const v4u fa = {a0.x, a0.y, a1.x, a1.y}, fb = {b0.x, b0.y, b1.x, b1.y};
                o0 = __builtin_amdgcn_mfma_f32_32x32x16_bf16(__builtin_bit_cast(bf16x8, fa), pf[ks4], o0, 0, 0, 0);
                o1 = __builtin_amdgcn_mfma_f32_32x32x16_bf16(__builtin_bit_cast(bf16x8, fb), pf[ks4], o1, 0, 0, 0); }
            __builtin_amdgcn_s_setprio(0);
        }
    }
#undef A2_LOAD
#undef A2_STAGE
    float l_tot = sum_halves(l_run);
    if (MODE == 0) l_tot += __builtin_amdgcn_exp2f(A.in[I_SSINK][l * NH + h] * LOG2E - m_run);
    const float inv = 1.0f / l_tot;
    const size_t m = rowb + qp; bf16* orow = ycat + m * D + (MODE == 0 ? YC_B : YC_D) + h * 64;
    v2u gq0[4], gq1[4];
    if (MODE == 1) { const bf16* gp = proj + m * NP + PC_FG + h * 64;
#pragma unroll
        for (int q4 = 0; q4 < 4; ++q4) { gq0[q4] = *(const v2u*)(gp + 8 * q4 + 4 * hi); gq1[q4] = *(const v2u*)(gp + 32 + 8 * q4 + 4 * hi); } }
#pragma unroll
    for (int q4 = 0; q4 < 4; ++q4) {
        float v0[4] = {o0[4 * q4] * inv, o0[4 * q4 + 1] * inv, o0[4 * q4 + 2] * inv, o0[4 * q4 + 3] * inv}, v1[4] = {o1[4 * q4] * inv, o1[4 * q4 + 1] * inv, o1[4 * q4 + 2] * inv, o1[4 * q4 + 3] * inv};
        const int d0 = 8 * q4 + 4 * hi;
        if (MODE == 1) { const v2u g0 = gq0[q4], g1 = gq1[q4];
            v0[0] *= sigmoidf_(bflo(g0.x)); v0[1] *= sigmoidf_(bfhi(g0.x)); v0[2] *= sigmoidf_(bflo(g0.y)); v0[3] *= sigmoidf_(bfhi(g0.y));
            v1[0] *= sigmoidf_(bflo(g1.x)); v1[1] *= sigmoidf_(bfhi(g1.x)); v1[2] *= sigmoidf_(bflo(g1.y)); v1[3] *= sigmoidf_(bfhi(g1.y)); }
        v2u w0, w1; w0.x = pk2(v0[0], v0[1]); w0.y = pk2(v0[2], v0[3]); w1.x = pk2(v1[0], v1[1]); w1.y = pk2(v1[2], v1[3]);
        *(v2u*)(orow + d0) = w0; *(v2u*)(orow + 32 + d0) = w1; }
}
constexpr int GP = 136;
constexpr int G_W = 0, G_VT = 34816, G_ST = 52224;
__device__ __forceinline__ void sgu_unit(const Ctx& C, int l, int b, int chunk, int ghalf) {
    KA_DECL; asm volatile("" : "+s"(l));
    const bf16* proj = (const bf16*)(A.ws + WS_PROJ); bf16* ycat = (bf16*)(A.ws + WS_YCAT);
    int tid = C.tid; asm volatile("" : "+v"(tid));
    const int lane = tid & 63, wave = C.wave, r32 = lane & 31, hi = lane >> 5;
    const size_t m0 = (size_t)b * T + chunk * 128;
    LAS bf16* Wd = (LAS bf16*)(C.lds + G_W); LAS bf16* Vt = (LAS bf16*)(C.lds + G_VT); LAS float* ST = (LAS float*)(C.lds + G_ST);
    LBAR();
    {
        const int tok = tid >> 2, part = tid & 3; const v4u* src = (const v4u*)(proj + (m0 + tok) * NP + PC_GV + part * 128);
        float s1 = 0.f, s2 = 0.f;
#pragma unroll 4
        for (int i = 0; i < 16; ++i) { const v4u w = src[i];
            const float e0 = gelu_f(bflo(w.x)), e1 = gelu_f(bfhi(w.x)), e2 = gelu_f(bflo(w.y)), e3 = gelu_f(bfhi(w.y)), e4 = gelu_f(bflo(w.z)), e5 = gelu_f(bfhi(w.z)), e6 = gelu_f(bflo(w.w)), e7 = gelu_f(bfhi(w.w));
            s1 += ((e0 + e1) + (e2 + e3)) + ((e4 + e5) + (e6 + e7));
            s2 += ((e0 * e0 + e1 * e1) + (e2 * e2 + e3 * e3)) + ((e4 * e4 + e5 * e5) + (e6 * e6 + e7 * e7)); }
        s1 += __shfl_xor(s1, 1); s1 += __shfl_xor(s1, 2); s2 += __shfl_xor(s2, 1); s2 += __shfl_xor(s2, 2);
        const float mean = s1 * (1.0f / 512.0f), var = fmaxf(s2 * (1.0f / 512.0f) - mean * mean, 0.f);
        if (part == 0) { ST[2 * tok] = mean; ST[2 * tok + 1] = 1.0f / sqrtf(var + 1e-5f); }
    }
    LBAR();
    const int ti = wave >> 1, cj = wave & 1;
    for (int gi = 0; gi < 4; ++gi) {
        const int g = ghalf * 4 + gi;
        {
            const int row = tid >> 2, s0 = (tid & 3) * 32; const float* wsrc = A.in[I_GWS] + (size_t)(l * NH + g) * SGU_TRI + (row * (row + 1)) / 2;
            float wv[32];
#pragma unroll
            for (int i = 0; i < 32; ++i) { const int s_ = s0 + i; wv[i] = wsrc[s_ <= row ? s_ : row]; }
#pragma unroll
            for (int i = 0; i < 32; i += 2) { const int s_ = s0 + i; *(LAS unsigned*)(Wd + row * GP + s_) = pk2((s_ <= row) ? wv[i] : 0.f, (s_ + 1 <= row) ? wv[i + 1] : 0.f); }
        }
        {
            const int tok = tid >> 2, c0 = (tid & 3) * 16; const v4u* src = (const v4u*)(proj + (m0 + tok) * NP + PC_GV + g * 64 + c0);
            const v4u r0 = src[0], r1 = src[1]; const float mean = ST[2 * tok], rstd = ST[2 * tok + 1];
            const float* lg = A.in[I_GLG] + l * GW + g * 64 + c0; const float* lb = A.in[I_GLB] + l * GW + g * 64 + c0;
            float f[16];
            f[0] = bflo(r0.x); f[1] = bfhi(r0.x); f[2] = bflo(r0.y); f[3] = bfhi(r0.y); f[4] = bflo(r0.z); f[5] = bfhi(r0.z); f[6] = bflo(r0.w); f[7] = bfhi(r0.w);
            f[8] = bflo(r1.x); f[9] = bfhi(r1.x); f[10] = bflo(r1.y); f[11] = bfhi(r1.y); f[12] = bflo(r1.z); f[13] = bfhi(r1.z); f[14] = bflo(r1.w); f[15] = bfhi(r1.w);
#pragma unroll
            for (int i = 0; i < 16; ++i) { const float y = (gelu_f(f[i]) - mean) * rstd * lg[i] + lb[i]; Vt[(c0 + i) * GP + tok] = (bf16)f2bf(y); }
        }
        bf16 ur[16]; float bsv[16];
        {
            const float* bs = A.in[I_GB] + (size_t)(l * NH + g) * 128;
#pragma unroll
            for (int r = 0; r < 16; ++r) { ur[r] = proj[(m0 + 32 * ti + crow(r, hi)) * NP + PC_GU + g * 64 + 32 * cj + r32]; bsv[r] = bs[32 * ti + crow(r, hi)]; }
        }
        LBAR();
        {
            f32x16 acc;
#pragma unroll
            for (int r = 0; r < 16; ++r) acc[r] = 0.f;
            acc = mma32(Wd + (32 * ti + r32) * GP + 8 * hi, Vt + (32 * cj + r32) * GP + 8 * hi, 2 * (ti + 1), acc);
#pragma unroll
            for (int r = 0; r < 16; ++r) { const int t = 32 * ti + crow(r, hi), c = 32 * cj + r32; const size_t m = m0 + t;
                const float z = acc[r] + bsv[r], u = gelu_f(bf2f(ur[r]));
                ycat[m * D + YC_C + g * 64 + c] = (bf16)f2bf(u * z); }
        }
        LBAR();
    }
}
constexpr int TP = 72;
constexpr int LP = 168;
constexpr int R_AH = 0, R_RH = 9216, R_BT = 18432, R_KT = 27648, R_VT = 36864, R_BH = 46080, R_KH = 55296, R_RHS = 46080  ;
constexpr int R_LR = 64512  , R_NP = 64512  , R_NK = 80896, R_BR = 90112, R_KR = 99328, R_W1 = 108544, R_W2 = 117760, R_GT = 126976;
__device__ __forceinline__ float shifted(const bf16* proj, size_t m, int t, int col, float mu) {
    const float p = bf2f(proj[m * NP + col]); const float pp = (t > 0) ? bf2f(proj[(m - 1) * NP + col]) : 0.f; return p + (pp - p) * mu;
}
__device__ __forceinline__ void subst_cols(const bool FROM_RHS, const LAS float* NPm, const LAS float* RHS, const LAS bf16* tAH, LAS bf16* tW, int wave, int lane) {
    const int cl = lane >> 2, p = lane & 3, col = (16 * wave + cl) & 63;
    float xs[16], rh[16];
#pragma unroll
    for (int q = 0; q < 16; ++q) xs[q] = 0.f;
    if (FROM_RHS) {
#pragma unroll
        for (int q = 0; q < 16; ++q) rh[q] = RHS[(4 * q + p) * 64 + col];
    } else {
#pragma unroll
        for (int q = 0; q < 16; ++q) rh[q] = bf2f(tAH[(4 * q + p) * TP + col]);
    }
    const LAS float* np_ = NPm + p * 16;
    f32x4 nv[4], nn[4];
#pragma unroll
    for (int q4 = 0; q4 < 4; ++q4) nv[q4] = (f32x4){0.f, 0.f, 0.f, 0.f};
#pragma unroll
    for (int t = 0; t < 64; ++t) {
        if (t + 1 < 64) {
#pragma unroll
            for (int q4 = 0; q4 < (t + 16) / 16; ++q4) nn[q4] = *(const LAS f32x4*)(np_ + (t + 1) * 64 + 4 * q4);
        }
        float part = 0.f, part2 = 0.f;
#pragma unroll
        for (int q4 = 0; q4 < (t + 15) / 16; ++q4) {
            if (q4 & 1) part2 += (nv[q4].x * xs[4 * q4] + nv[q4].y * xs[4 * q4 + 1]) + (nv[q4].z * xs[4 * q4 + 2] + nv[q4].w * xs[4 * q4 + 3]);
            else part += (nv[q4].x * xs[4 * q4] + nv[q4].y * xs[4 * q4 + 1]) + (nv[q4].z * xs[4 * q4 + 2] + nv[q4].w * xs[4 * q4 + 3]); }
        part += part2;
        part += dpp_xor1(part); part += dpp_xor2(part);
        xs[t >> 2] = (p == (t & 3)) ? rh[t >> 2] + part : xs[t >> 2];
#pragma unroll
        for (int q4 = 0; q4 < 4; ++q4) nv[q4] = nn[q4];
        asm volatile("" ::: "memory");
    }
    LAS bf16* wt = tW + col * TP;
#pragma unroll
    for (int q = 0; q < 16; ++q) wt[4 * q + p] = (bf16)f2bf(xs[q]);
}
__device__ __forceinline__ void rwkv_chunk_unit(const Ctx& C, int l, int b, int c, int h) {
    KA_DECL; asm volatile("" : "+s"(l));
    const bf16* proj = (const bf16*)(A.ws + WS_PROJ);
    int tid = C.tid; asm volatile("" : "+v"(tid));
    const int lane = tid & 63, wave = C.wave, r32 = lane & 31, hi = lane >> 5;
    const size_t m0 = (size_t)b * T + 64 * c; const int t0 = 64 * c; const size_t pair = (size_t)(b * NH + h) * 64 + c;
    LAS unsigned char* L = C.lds;
    LAS bf16* tAH = (LAS bf16*)(L + R_AH); LAS bf16* tRH = (LAS bf16*)(L + R_RH); LAS bf16* tBT = (LAS bf16*)(L + R_BT); LAS bf16* tKT = (LAS bf16*)(L + R_KT); LAS bf16* tVT = (LAS bf16*)(L + R_VT);
    LAS bf16* tBH = (LAS bf16*)(L + R_BH); LAS bf16* tKH = (LAS bf16*)(L + R_KH); LAS float* RHS = (LAS float*)(L + R_RHS); LAS float* LR = (LAS float*)(L + R_LR); LAS float* NPm = (LAS float*)(L + R_NP);
    LAS bf16* tNK = (LAS bf16*)(L + R_NK); LAS bf16* tBR = (LAS bf16*)(L + R_BR); LAS bf16* tKR = (LAS bf16*)(L + R_KR); LAS bf16* tW1 = (LAS bf16*)(L + R_W1); LAS bf16* tW2 = (LAS bf16*)(L + R_W2);
    LAS float* GT = (LAS float*)(L + R_GT);
    const float* mu = A.in[I_RMU] + l * 1696;
    bf16 rraw[9], kraw[9], vraw[9];
    { const int tfirst = t0 + 8 * wave; const size_t mfirst = m0 + 8 * wave; const int cgl = h * 64 + lane;
#pragma unroll
        for (int k = 0; k < 9; ++k) { const size_t mr = (k == 0 && tfirst == 0) ? mfirst : mfirst + k - 1;
            rraw[k] = proj[mr * NP + PC_RR + cgl]; kraw[k] = proj[mr * NP + PC_RK + cgl]; vraw[k] = proj[mr * NP + PC_RV + cgl]; } }
    LAS bf16* LRb = (LAS bf16*)(L + R_LR);
    LAS bf16* Wt = (LAS bf16*)(L + R_LR + 64 * LP * 2);
    LAS float* OUT = (LAS float*)L;
    LBAR();
    {
        float xv[12];
#pragma unroll
        for (int i = 0; i < 4; ++i) { const int e = tid + NTHREADS * i, tok = e >> 5, j = e & 31; xv[i] = shifted(proj, m0 + tok, t0 + tok, PC_RW + j, mu[1536 + j]); }
#pragma unroll
        for (int i = 0; i < 4; ++i) { const int e = tid + NTHREADS * i, tok = e >> 5, j = e & 31;
            LRb[tok * LP + j] = (bf16)f2bf(1.0f - 2.0f * __builtin_amdgcn_rcpf(__expf(2.0f * xv[i]) + 1.0f)); }
#pragma unroll
        for (int i = 0; i < 4; ++i) { const int e = tid + NTHREADS * i, tok = e >> 5, j = 32 + (e & 31); xv[i] = shifted(proj, m0 + tok, t0 + tok, PC_RW + j, mu[1536 + j]); }
#pragma unroll
        for (int i = 0; i < 4; ++i) { const int e = tid + NTHREADS * i, tok = e >> 5, j = 32 + (e & 31); LRb[tok * LP + j] = (bf16)f2bf(xv[i]); }
#pragma unroll
        for (int i = 0; i < 12; ++i) { const int e = tid + NTHREADS * i, tok = e / 96, j = 64 + e % 96; xv[i] = shifted(proj, m0 + tok, t0 + tok, PC_RW + j, mu[1536 + j]); }
#pragma unroll
        for (int i = 0; i < 12; ++i) { const int e = tid + NTHREADS * i, tok = e / 96, j = 64 + e % 96; LRb[tok * LP + j] = (bf16)f2bf(sigmoidf_(xv[i])); }
        float wv[20];
#pragma unroll
        for (int i = 0; i < 20; ++i) { const int e = tid + NTHREADS * i, ch = e & 63, m = e >> 6;
            wv[i] = (m < 32) ? A.in[I_RW2][((size_t)l * 32 + m) * GW + h * 64 + ch] : ((m < 64) ? A.in[I_RA2][((size_t)l * 32 + (m - 32)) * GW + h * 64 + ch] : A.in[I_RG2][((size_t)l * 96 + (m - 64)) * GW + h * 64 + ch]); }
#pragma unroll
        for (int i = 0; i < 20; ++i) { const int e = tid + NTHREADS * i, ch = e & 63, m = e >> 6; Wt[ch * LP + m] = (bf16)f2bf(wv[i]); }
    }
    LBAR();
    {
        const int rt = (wave >> 1) & 1, ct = wave & 1;
        const LAS bf16* Ap = LRb + (32 * rt + r32) * LP + 8 * hi; const LAS bf16* Bp = Wt + (32 * ct + r32) * LP + 8 * hi;
        f32x16 acc, acc2;
#pragma unroll
        for (int r = 0; r < 16; ++r) { acc[r] = 0.f; acc2[r] = 0.f; }
        if (wave < 4) { acc = mma32(Ap, Bp, 2, acc); acc2 = mma32(Ap + 32, Bp + 32, 2, acc2); }
        else acc = mma32(Ap + 64, Bp + 64, 6, acc);
#pragma unroll
        for (int r = 0; r < 16; ++r) { const int o = (32 * rt + crow(r, hi)) * 64 + 32 * ct + r32;
            if (wave < 4) { OUT[o] = acc[r]; OUT[4096 + o] = acc2[r]; } else OUT[8192 + o] = acc[r]; }
    }
    LBAR();
    const int cg = h * 64 + lane, tg = wave;
    float rr[8], kp[8], vv[8], na[8], bb[8], pg[8];
    {
        float aw[8], aa[8], ag[8];
#pragma unroll
        for (int k = 0; k < 8; ++k) { const int o = (8 * tg + k) * 64 + lane; aw[k] = OUT[o]; aa[k] = OUT[4096 + o]; ag[k] = OUT[8192 + o]; }
        const float w0 = A.in[I_RW0][l * GW + cg], a0 = A.in[I_RA0][l * GW + cg], kkc = A.in[I_RKK][l * GW + cg], kac = A.in[I_RKA][l * GW + cg], rkc = A.in[I_RRK][l * GW + cg];
        const float mur = mu[cg], muk = mu[512 + cg], muv = mu[1024 + cg];
        float* rg = (float*)(A.ws + WS_RG); float* rbv = (float*)(A.ws + WS_RBV);
        float run = 0.f;
#pragma unroll
        for (int k = 0; k < 8; ++k) { const size_t m = m0 + 8 * tg + k; const int t = t0 + 8 * tg + k;
            const float hasp = (t > 0) ? 1.0f : 0.0f;
            const float rp_ = bf2f(rraw[k + 1]), kp_ = bf2f(kraw[k + 1]), vp_ = bf2f(vraw[k + 1]);
            const float r = rp_ + (bf2f(rraw[k]) * hasp - rp_) * mur, kx = kp_ + (bf2f(kraw[k]) * hasp - kp_) * muk, v = vp_ + (bf2f(vraw[k]) * hasp - vp_) * muv;
            run += -0.6065306597126334f * sigmoidf_(w0 + aw[k]); pg[k] = run;
            const float ia = sigmoidf_(a0 + aa[k]);
            float kk = kx * kkc; const float n2 = wave_sum_dpp(kk * kk); kk = kk * __builtin_amdgcn_rsqf(fmaxf(n2, 1e-24f));
            const float kpv = kx * (1.0f + (ia - 1.0f) * kac);
            const float bonus = wave_sum_dpp(r * kpv * rkc);
            rg[m * GW + cg] = ag[k]; rbv[m * GW + cg] = bonus * v * ag[k];
            rr[k] = r; kp[k] = kpv; vv[k] = v; na[k] = -kk; bb[k] = kk * ia; }
        GT[tg * 64 + lane] = run;
    }
    LBAR();
    {
        float off = 0.f, gL = 0.f;
#pragma unroll
        for (int w = 0; w < 8; ++w) { const float x = GT[w * 64 + lane]; gL += x; off += (w < tg) ? x : 0.f; }
        float bt[8], kt[8];
#pragma unroll
        for (int k = 0; k < 8; ++k) { const int t = 8 * tg + k; const float g = off + pg[k], gp = off + (k > 0 ? pg[k - 1] : 0.f);
            const float eg = __expf(g), egp = __expf(gp), ei = __expf(-g), eL = __expf(gL - g);
            tAH[t * TP + lane] = (bf16)f2bf(na[k] * egp); tRH[t * TP + lane] = (bf16)f2bf(rr[k] * eg); tBH[t * TP + lane] = (bf16)f2bf(bb[k] * ei); tKH[t * TP + lane] = (bf16)f2bf(kp[k] * ei);
            bt[k] = bb[k] * eL; kt[k] = kp[k] * eL; }
        v4u o; o.x = pk2(bt[0], bt[1]); o.y = pk2(bt[2], bt[3]); o.z = pk2(bt[4], bt[5]); o.w = pk2(bt[6], bt[7]); *(LAS v4u*)(tBT + lane * TP + 8 * tg) = o;
        o.x = pk2(kt[0], kt[1]); o.y = pk2(kt[2], kt[3]); o.z = pk2(kt[4], kt[5]); o.w = pk2(kt[6], kt[7]); *(LAS v4u*)(tKT + lane * TP + 8 * tg) = o;
        o.x = pk2(vv[0], vv[1]); o.y = pk2(vv[2], vv[3]); o.z = pk2(vv[4], vv[5]); o.w = pk2(vv[6], vv[7]); *(LAS v4u*)(tVT + lane * TP + 8 * tg) = o;
        if (tg == 0) ((float*)(A.ws + WS_GL))[pair * 64 + lane] = __expf(gL);
    }
    LBAR();
    {
        const int mi = wave >> 1, rt = wave & 1;
        const LAS bf16* Am = (mi < 2) ? tAH : tRH; const LAS bf16* Bm = (mi & 1) ? tKH : tBH;
        for (int ct = 0; ct < 2; ++ct) {
            f32x16 acc;
#pragma unroll
            for (int r = 0; r < 16; ++r) acc[r] = 0.f;
            if (!(rt == 0 && ct == 1)) acc = mma32(Am + (32 * rt + r32) * TP + 8 * hi, Bm + (32 * ct + r32) * TP + 8 * hi, 4, acc);
#pragma unroll
            for (int r = 0; r < 16; ++r) { const int t = 32 * rt + crow(r, hi), s = 32 * ct + r32;
                const bool keep = (mi < 2) ? (s < t) : (s <= t); const float val = keep ? acc[r] : 0.f;
                if (mi == 0) NPm[t * 64 + (s & 3) * 16 + (s >> 2)] = val;
                else { LAS bf16* dst = (mi == 1) ? tNK : ((mi == 2) ? tBR : tKR); dst[t * TP + s] = (bf16)f2bf(val); } }
        }
    }
    LBAR();
    if (wave < 4) {
        const int rt = wave >> 1, ct = wave & 1;
        f32x16 acc;
#pragma unroll
        for (int r = 0; r < 16; ++r) acc[r] = 0.f;
        acc = mma32(tNK + (32 * rt + r32) * TP + 8 * hi, tVT + (32 * ct + r32) * TP + 8 * hi, 2 * (rt + 1), acc);
#pragma unroll
        for (int r = 0; r < 16; ++r) RHS[(32 * rt + crow(r, hi)) * 64 + 32 * ct + r32] = acc[r];
    }
    LBAR();
    subst_cols(wave < 4, NPm, RHS, tAH, (wave < 4) ? tW1 : tW2, wave, lane);
    LBAR();
    {
        const int kind = wave >> 1, rt = wave & 1;
        bf16* RTg = (bf16*)(A.ws + WS_RT) + pair * 4096; bf16* PAg = (bf16*)(A.ws + WS_PA) + pair * 4096;
        float* YFg = (float*)(A.ws + WS_YF) + pair * 4096; float* QFg = (float*)(A.ws + WS_QF) + pair * 4096;
        for (int ct = 0; ct < 2; ++ct) {
            f32x16 acc;
            if (kind == 0) {
#pragma unroll
                for (int r = 0; r < 16; ++r) acc[r] = bf2f(tRH[(32 * rt + crow(r, hi)) * TP + 32 * ct + r32]);
                acc = mma32(tBR + (32 * rt + r32) * TP + 8 * hi, tW2 + (32 * ct + r32) * TP + 8 * hi, 2 * (rt + 1), acc);
#pragma unroll
                for (int r = 0; r < 16; ++r) RTg[(32 * rt + crow(r, hi)) * 64 + 32 * ct + r32] = (bf16)f2bf(acc[r]);
            } else if (kind == 1) {
#pragma unroll
                for (int r = 0; r < 16; ++r) acc[r] = 0.f;
                acc = mma32(tBR + (32 * rt + r32) * TP + 8 * hi, tW1 + (32 * ct + r32) * TP + 8 * hi, 2 * (rt + 1), acc);
                acc = mma32(tKR + (32 * rt + r32) * TP + 8 * hi, tVT + (32 * ct + r32) * TP + 8 * hi, 2 * (rt + 1), acc);
                f32x4* dst = (f32x4*)(YFg + (rt * 2 + ct) * 1024 + lane * 16);
#pragma unroll
                for (int q = 0; q < 4; ++q) dst[q] = (f32x4){acc[4 * q], acc[4 * q + 1], acc[4 * q + 2], acc[4 * q + 3]};
            } else if (kind == 2) {
#pragma unroll
                for (int r = 0; r < 16; ++r) acc[r] = 0.f;
                acc = mma32(tBT + (32 * rt + r32) * TP + 8 * hi, tW2 + (32 * ct + r32) * TP + 8 * hi, 4, acc);
#pragma unroll
                for (int r = 0; r < 16; ++r) PAg[(32 * rt + crow(r, hi)) * 64 + 32 * ct + r32] = (bf16)f2bf(acc[r]);
            } else {
#pragma unroll
                for (int r = 0; r < 16; ++r) acc[r] = 0.f;
                acc = mma32(tBT + (32 * rt + r32) * TP + 8 * hi, tW1 + (32 * ct + r32) * TP + 8 * hi, 4, acc);
                acc = mma32(tKT + (32 * rt + r32) * TP + 8 * hi, tVT + (32 * ct + r32) * TP + 8 * hi, 4, acc);
                f32x4* dst = (f32x4*)(QFg + (rt * 2 + ct) * 1024 + lane * 16);
#pragma unroll
                for (int q = 0; q < 4; ++q) dst[q] = (f32x4){acc[4 * q], acc[4 * q + 1], acc[4 * q + 2], acc[4 * q + 3]};
            }
        }
    }
}
__device__ __forceinline__ void rwkv_seq_unit(const Ctx& C, int bh) {
    KA_DECL;
    const int tid = C.tid, lane = C.lane, wave = C.wave, r32 = lane & 31, hi = lane >> 5;
    const bool zw = wave < 4; const int w4 = wave & 3, rt = w4 >> 1, ct = w4 & 1;
    LAS bf16* Zb = (LAS bf16*)C.lds;
    const bf16* Ag = (const bf16*)(A.ws + (zw ? WS_PA : WS_RT)) + (size_t)bh * 64 * 4096 + (32 * rt + r32) * 64 + 8 * hi;
    const float* Cg = (const float*)(A.ws + (zw ? WS_QF : WS_YF)) + (size_t)bh * 64 * 4096 + (rt * 2 + ct) * 1024 + lane * 16;
    const float* GLg = (const float*)(A.ws + WS_GL) + (size_t)bh * 64 * 64 + 32 * rt + 4 * hi;
    float* ry = (float*)(A.ws + WS_RY) + (size_t)(bh >> 3) * T * GW + (bh & 7) * 64;
    f32x16 Z;
#pragma unroll
    for (int r = 0; r < 16; ++r) Z[r] = 0.f;
    LBAR();
    for (int i = tid; i < 64 * TP; i += NTHREADS) Zb[i] = 0;
    LBAR();
    LAS float* GLs = (LAS float*)(C.lds + 2 * 64 * TP * 2);
    { const float* gsrc = (const float*)(A.ws + WS_GL) + (size_t)bh * 64 * 64; for (int i = tid; i < 64 * 64 / 4; i += NTHREADS) *(LAS f32x4*)(GLs + 4 * i) = *(const f32x4*)(gsrc + 4 * i); }
    LBAR();
    const LAS float* glp = GLs + 32 * rt + 4 * hi;
    LAS float* ypatch = (LAS float*)(C.lds + 2 * 64 * TP * 2 + 64 * 64 * 4) + (wave & 3) * (32 * 36);
    float* ryl = ry + (size_t)(32 * rt + (lane >> 3)) * GW + 32 * ct + 4 * (lane & 7); const LAS float* ypl = ypatch + (lane >> 3) * 36 + 4 * (lane & 7);
    bf16x8 af[4][4]; f32x4 ci[4][4];
#define SEQ_LOAD(S, cc) do { const int c_ = (cc) < 64 ? (cc) : 63; _Pragma("unroll") for (int k = 0; k < 4; ++k) { af[S][k] = *(const bf16x8*)(Ag + (size_t)c_ * 4096 + 16 * k); \
        ci[S][k] = *(const f32x4*)(Cg + (size_t)c_ * 4096 + 4 * k); } } while (0)
#define SEQ_STEP(c, S, SN) do { \
        if ((c) + 3 < 64) SEQ_LOAD(SN, (c) + 3); \
        f32x16 acc; \
        _Pragma("unroll") for (int q = 0; q < 4; ++q) { acc[4 * q] = ci[S][q].x; acc[4 * q + 1] = ci[S][q].y; acc[4 * q + 2] = ci[S][q].z; acc[4 * q + 3] = ci[S][q].w; } \
        if (zw) { _Pragma("unroll") for (int q = 0; q < 4; ++q) { const f32x4 g4 = *(const LAS f32x4*)(glp + (c) * 64 + 8 * q); \
            acc[4 * q] += g4.x * Z[4 * q]; acc[4 * q + 1] += g4.y * Z[4 * q + 1]; acc[4 * q + 2] += g4.z * Z[4 * q + 2]; acc[4 * q + 3] += g4.w * Z[4 * q + 3]; } } \
        const LAS bf16* Bp = Zb + ((c) & 1) * 64 * TP + (32 * ct + r32) * TP + 8 * hi; \
        _Pragma("unroll") for (int k = 0; k < 4; ++k) { const bf16x8 bfr = *(const LAS bf16x8*)(Bp + 16 * k); acc = __builtin_amdgcn_mfma_f32_32x32x16_bf16(af[S][k], bfr, acc, 0, 0, 0); } \
        if (zw) { Z = acc; LAS bf16* Zn = Zb + (((c) + 1) & 1) * 64 * TP + (32 * ct + r32) * TP + 32 * rt + 4 * hi; \
            _Pragma("unroll") for (int q = 0; q < 4; ++q) { v2u w; w.x = pk2(acc[4 * q], acc[4 * q + 1]); w.y = pk2(acc[4 * q + 2], acc[4 * q + 3]); *(LAS v2u*)(Zn + 8 * q) = w; } } \
        else {   \
            _Pragma("unroll") for (int r = 0; r < 16; ++r) ypatch[crow(r, hi) * 36 + r32] = acc[r]; \
            asm volatile("s_waitcnt lgkmcnt(0)" ::: "memory"); \
            GAS float* ryc = (GAS float*)(ryl + (size_t)(64 * (c)) * GW); asm volatile("" : "+v"(ryc));     \
            _Pragma("unroll") for (int j = 0; j < 4; ++j) *(GAS f32x4*)(ryc + (size_t)(8 * j) * GW) = *(const LAS f32x4*)(ypl + 8 * j * 36); \
            asm volatile("s_waitcnt lgkmcnt(0)" ::: "memory"); } \
        asm volatile("s_waitcnt lgkmcnt(0)" ::: "memory"); __builtin_amdgcn_s_barrier(); asm volatile("" ::: "memory"); } while (0)
    SEQ_LOAD(0, 0); SEQ_LOAD(1, 1); SEQ_LOAD(2, 2);
#define SEQ_4(c) SEQ_STEP(c, 0, 3); SEQ_STEP((c) + 1, 1, 0); SEQ_STEP((c) + 2, 2, 1); SEQ_STEP((c) + 3, 3, 2);
    SEQ_4(0) SEQ_4(4) SEQ_4(8) SEQ_4(12) SEQ_4(16) SEQ_4(20) SEQ_4(24) SEQ_4(28) SEQ_4(32) SEQ_4(36) SEQ_4(40) SEQ_4(44) SEQ_4(48) SEQ_4(52) SEQ_4(56) SEQ_4(60)
#undef SEQ_4
#undef SEQ_LOAD
#undef SEQ_STEP
}
__device__ __forceinline__ void rwkv_post_bh(const Ctx& C, int l, int bh, int tbeg, int tend) {
    KA_DECL;
    const int lane = C.lane, wave = C.wave, b = bh >> 3, h = bh & 7, ch = h * 64 + lane;
    const float* RY = (const float*)(A.ws + WS_RY) + (size_t)b * T * GW + ch; const float* RG = (const float*)(A.ws + WS_RG) + (size_t)b * T * GW + ch; const float* RBV = (const float*)(A.ws + WS_RBV) + (size_t)b * T * GW + ch;
    bf16* yc = (bf16*)(A.ws + WS_YCAT) + (size_t)b * T * D + YC_A + ch;
    const float lg = A.in[I_RLG][l * GW + ch], lb = A.in[I_RLB][l * GW + ch];
    for (int t0 = tbeg + 16 * wave; t0 < tend; t0 += 16 * NWAVES) {
        float y[16], g[16], bv[16];
#pragma unroll
        for (int k = 0; k < 16; ++k) { y[k] = RY[(size_t)(t0 + k) * GW]; g[k] = RG[(size_t)(t0 + k) * GW]; bv[k] = RBV[(size_t)(t0 + k) * GW]; }
#pragma unroll
        for (int k = 0; k < 16; ++k) {
            const float mean = wave_sum_dpp(y[k]) * (1.0f / 64.0f), d = y[k] - mean, var = wave_sum_dpp(d * d) * (1.0f / 64.0f);
            const float yn = d * __builtin_amdgcn_rsqf(var + 64e-5f) * lg + lb;
            yc[(size_t)(t0 + k) * D] = (bf16)f2bf(yn * g[k] + bv[k]); }
    }
}
#ifndef REP_CHUNK
#define REP_CHUNK 1
#endif
#ifndef REP_SWA
#define REP_SWA 1
#endif
#ifndef REP_SGU
#define REP_SGU 1
#endif
#ifndef REP_GIN
#define REP_GIN 1
#endif
#ifndef REP_SCAN
#define REP_SCAN 1
#endif
#ifndef REP_FOX
#define REP_FOX 1
#endif
__device__ __forceinline__ void ph_mix1(const Ctx& C, int l) {
    for (int rep = 0; rep < REP_CHUNK; ++rep) for (int u = C.bid; u < 2048; u += C.G) rwkv_chunk_unit(C, l, u >> 9, (u >> 3) & 63, u & 7);
    for (int v = C.bid; v < 256; v += C.G) kvprep_unit(C, l, v);
    for (int v = C.bid; v < 32; v += C.G) cumprep_unit(C, l, v);
}
constexpr int CW_Q = 8192;
constexpr int CW_SEQF = 9216;
__device__ __forceinline__ void ph_mix2(const Ctx& C, int l) {
    KA_DECL;
    unsigned* ctl = (unsigned*)(A.ws + WS_CTL);
    for (int rep = 0; rep < REP_SCAN; ++rep)
    for (int u = C.bid; u < 32; u += C.G) {
        rwkv_seq_unit(C, u);
        asm volatile("s_waitcnt vmcnt(0)" ::: "memory"); __syncthreads();
        if (C.tid == 0) { __builtin_amdgcn_fence(__ATOMIC_RELEASE, "agent"); asm volatile("s_waitcnt vmcnt(0)" ::: "memory");
            __hip_atomic_store(ctl + CW_SEQF + (l * 32 + u) * 64, 1u, __ATOMIC_RELAXED, __HIP_MEMORY_SCOPE_AGENT); }
    }
    unsigned* head = ctl + CW_Q + 64 * l;
    volatile LAS unsigned* slot = (volatile LAS unsigned*)(C.lds + LDSCTL_OFF + 64);
    for (;;) {
        if (C.tid == 0) *slot = __hip_atomic_fetch_add(head, 1u, __ATOMIC_RELAXED, __HIP_MEMORY_SCOPE_AGENT);
        LBAR();
        const unsigned u = *slot;
        if (u >= 1024u * REP_FOX + 512u) break;
        if (u < 1024u * REP_FOX) {
            const unsigned w = u % 1024u;
            if (w < 512u) { const int qb = 15 - (int)(w >> 5), bh = (int)(w & 31u); attn2_unit<1>(C, l, bh >> 3, bh & 7, qb); }
            else { const int v = (int)w - 512; attn2_unit<0>(C, l, v >> 7, (v >> 4) & 7, v & 15); }
        } else if (u < 1024u * REP_FOX + 256u) { const int v = (int)(u - 1024u * REP_FOX); sgu_unit(C, l, v >> 6, (v >> 1) & 31, v & 1);
        } else {
            const int v = (int)(u - 1024u * REP_FOX - 256u), bh = v >> 3, part = v & 7;
            if (C.tid == 0) {
                unsigned spins = 0;
                while (__hip_atomic_load(ctl + CW_SEQF + (l * 32 + bh) * 64, __ATOMIC_RELAXED, __HIP_MEMORY_SCOPE_AGENT) == 0u && ++spins < (1u << 22)) __builtin_amdgcn_s_sleep(2);
                __builtin_amdgcn_fence(__ATOMIC_ACQUIRE, "agent"); asm volatile("s_waitcnt vmcnt(0)" ::: "memory");
            }
            __syncthreads();
            rwkv_post_bh(C, l, bh, part * 512, part * 512 + 512);
        }
    }
    LBAR();
}
constexpr int N_PHASES = 2 + 9 * DEPTH;
#define IN(k) (lo <= (k) && (k) < hi)
#ifndef REP_PRO
#define REP_PRO 1
#endif
#ifndef REP_NORM
#define REP_NORM 1
#endif
#ifndef REP_MIX1
#define REP_MIX1 1
#endif
#ifndef REP_POST
#define REP_POST 1
#endif
#ifndef REP_GUP
#define REP_GUP 1
#endif
#ifndef PROBE_STAMP
#define PROBE_STAMP (-100)
#endif
#define STAMP(k) do { if (PROBE_STAMP > -100 && C.bid == 0 && C.tid == 0) ((volatile LAS unsigned long long*)(C.lds + LDSCTL_OFF + 1024))[(k) + 1] = __builtin_amdgcn_s_memrealtime(); } while (0)
#define SEAM(k) do { if (IN((k) + 1) || PROBE_STAMP > -100) xcd_barrier(bar); STAMP(k); } while (0)
template <int l>
__device__ __forceinline__ void layer_phases(const Args& A, const Ctx& C, const XcdBarrier& bar, const int lo, const int hi) {
    bf16* const H = (bf16*)(A.ws + WS_H); bf16* const PROJ = (bf16*)(A.ws + WS_PROJ); bf16* const YCAT = (bf16*)(A.ws + WS_YCAT); bf16* const FB = (bf16*)(A.ws + WS_F);
    constexpr int p0 = 2 + 9 * l;
    const float* xin = (l == 0) ? A.in[I_X] : A.out;
    const float* modl = (const float*)(A.ws + WS_MOD) + (size_t)l * NB * MODW;
    if (IN(p0 + 0)) { for (int rep = 0; rep < REP_NORM; ++rep) ph_norm(C, xin, A.in[I_N1G] + l * D, modl + 0 * D, modl + 1 * D, H); SEAM(p0 + 0); }
    if (IN(p0 + 1)) {
        pg8::Gemm g{H, (const bf16*)(A.ws + WS_WIN) + (size_t)l * NP * D, M, NP, D}; pg8::StaticOrder S; S.init(M, NP, C.G, C.bid);
        pg8::EpiStoreBf16 E{PROJ, NP};
        for (int rep = 0; rep < REP_GIN; ++rep) { if (rep) __syncthreads(); pg8::gemm_phase<pg8::EpiStoreBf16, pg8::StaticOrder, true, true>(C.lds, g, S, E); }
        SEAM(p0 + 1); }
    if (IN(p0 + 2)) { for (int rep = 0; rep < REP_MIX1; ++rep) ph_mix1(C, l); SEAM(p0 + 2); }
    if (IN(p0 + 3)) { ph_mix2(C, l); SEAM(p0 + 3); }
    if (IN(p0 + 5)) {
        pg8::Gemm g{YCAT, (const bf16*)(A.ws + WS_WOUT) + (size_t)l * D * D, M, D, D}; pg8::StaticOrder S; S.init(M, D, C.G, C.bid);
        pg8::EpiResid E{xin, A.out, D, modl + 2 * D, MODW, T};
        pg8::gemm_phase<pg8::EpiResid, pg8::StaticOrder, true, true>(C.lds, g, S, E);
        SEAM(p0 + 5); }
    if (IN(p0 + 6)) { for (int rep = 0; rep < REP_NORM; ++rep) ph_norm(C, A.out, A.in[I_N2G] + l * D, modl + 3 * D, modl + 4 * D, H); SEAM(p0 + 6); }
    if (IN(p0 + 7)) {
        pg8::Gemm g{H, (const bf16*)(A.ws + WS_W13) + (size_t)l * 2 * FF * D, M, 2 * FF, D}; pg8::StaticOrder S; S.init(M, 2 * FF, C.G, C.bid);
        pg8::EpiSwiGLU E{FB, FF};
        for (int rep = 0; rep < REP_GUP; ++rep) { if (rep) __syncthreads(); pg8::gemm_phase<pg8::EpiSwiGLU, pg8::StaticOrder, true, true>(C.lds, g, S, E); }
        SEAM(p0 + 7); }
    if (IN(p0 + 8)) {
        pg8::Gemm g{FB, (const bf16*)(A.ws + WS_W2) + (size_t)l * D * FF, M, D, FF}; pg8::StaticOrder S; S.init(M, D, C.G, C.bid);
        pg8::EpiResid E{A.out, A.out, D, modl + 5 * D, MODW, T};
        pg8::gemm_phase<pg8::EpiResid, pg8::StaticOrder, true, true>(C.lds, g, S, E);
        SEAM(p0 + 8); }
}
__global__ void __launch_bounds__(NTHREADS, 2) fwd_kernel(Args A) {
    extern __shared__ __attribute__((aligned(16))) unsigned char lds_raw[];
    Ctx C; C.lds = (LAS unsigned char*)lds_raw; C.tid = threadIdx.x; C.lane = C.tid & 63; C.wave = __builtin_amdgcn_readfirstlane(C.tid >> 6); C.G = gridDim.x; C.bid = blockIdx.x;
    volatile LAS unsigned* MISC = (volatile LAS unsigned*)(C.lds + MISC_OFF);
    for (int u = C.tid; u < (LDS_BYTES - LDSCTL_OFF) / 4; u += NTHREADS) ((LAS unsigned*)(C.lds + LDSCTL_OFF))[u] = 0u;
    __syncthreads();
    const int lo = A.ph_lo, hi = A.ph_hi;
    const bool multi = (hi - lo) > 1;
    XcdBarrier bar; bar.bar = (unsigned*)(A.ws + WS_CTL) + CW_BAR; bar.x = 0; bar.st = nullptr;
    if (multi) bar = xcd_barrier_post((unsigned*)(A.ws + WS_CTL) + CW_BAR, MISC + 8);
    if (PROBE_STAMP > -100 && C.bid == 0 && C.tid == 0) ((volatile LAS unsigned long long*)(C.lds + LDSCTL_OFF + 1024))[0] = __builtin_amdgcn_s_memrealtime();
    if (IN(0)) { for (int rep = 0; rep < REP_PRO; ++rep) { if (rep) __syncthreads(); ph_prologue(C); } SEAM(0); }
    if (IN(1)) { ph_modreduce(C); SEAM(1); }
    layer_phases<0>(A, C, bar, lo, hi);
    layer_phases<1>(A, C, bar, lo, hi);
    layer_phases<2>(A, C, bar, lo, hi);
    layer_phases<3>(A, C, bar, lo, hi);
    if (PROBE_STAMP > -100 && C.bid == 0 && C.tid == 0) {
        volatile LAS unsigned long long* st = (volatile LAS unsigned long long*)(C.lds + LDSCTL_OFF + 1024);
        unsigned long long tot = 0;
        if (PROBE_STAMP < 0) tot = st[2] - st[0];
        else for (int l = 0; l < DEPTH; ++l) tot += st[2 + 9 * l + PROBE_STAMP + 1] - st[2 + 9 * l + PROBE_STAMP];
        A.out[0] = (float)tot * 0.01f;
    }
}
#undef IN
#undef SEAM

extern "C" void kernel_launch(void* const* d_in, const int* in_sizes, int n_in, void* d_out, int out_size, void* d_ws, size_t ws_size, hipStream_t stream) {
    static int grid = 0;
    if (grid == 0) {
        if (n_in != N_INPUTS || out_size != M * D || ws_size < WS_END) { fprintf(stderr, "kernel_launch: unexpected problem (n_in %d, out %d, ws %zu; need %zu)\n", n_in, out_size, ws_size, (size_t)WS_END); grid = -1; return; }
        int dev = 0, cus = 0, per_cu = 0;
        if (hipGetDevice(&dev) != hipSuccess || hipDeviceGetAttribute(&cus, hipDeviceAttributeMultiprocessorCount, dev) != hipSuccess) { grid = -1; return; }
        if (hipFuncSetAttribute((const void*)fwd_kernel, hipFuncAttributeMaxDynamicSharedMemorySize, LDS_BYTES) != hipSuccess) { fprintf(stderr, "kernel_launch: hipFuncSetAttribute failed\n"); grid = -1; return; }
        if (hipOccupancyMaxActiveBlocksPerMultiprocessor(&per_cu, (const void*)fwd_kernel, NTHREADS, LDS_BYTES) != hipSuccess || per_cu < 1) fprintf(stderr, "kernel_launch: occupancy query reports %d\n", per_cu);
        (void)hipGetLastError();
        grid = cus;
    }
    if (grid < 0) return;
    (void)hipMemsetAsync((char*)d_ws + WS_CTL, 0, CTL_ZERO_BYTES, stream);
    Args a{};
    for (int i = 0; i < N_INPUTS; ++i) a.in[i] = (const float*)d_in[i];
    a.out = (float*)d_out; a.ws = (unsigned char*)d_ws;
#if MK_ONE_LAUNCH
    a.ph_lo = 0; a.ph_hi = N_PHASES;
    hipLaunchKernelGGL(fwd_kernel, dim3(grid), dim3(NTHREADS), LDS_BYTES, stream, a);
#else
    for (int p = 0; p < N_PHASES; ++p) { a.ph_lo = p; a.ph_hi = p + 1; hipLaunchKernelGGL(fwd_kernel, dim3(grid), dim3(NTHREADS), LDS_BYTES, stream, a); }
#endif
    const hipError_t le = hipPeekAtLastError();
    if (le != hipSuccess) fprintf(stderr, "kernel_launch: launch failed: %s\n", hipGetErrorName(le));
}
```

```cpp
#include <hip/hip_runtime.h>
#include <cstdio>
#include <cstdint>
#ifndef MK_ONE_LAUNCH
#define MK_ONE_LAUNCH 1
#endif
namespace pg8 {
#define PG8_LAS __attribute__((address_space(3)))
typedef unsigned short bf16_t;
typedef short bf16x8 __attribute__((ext_vector_type(8)));
typedef float f32x4 __attribute__((ext_vector_type(4)));
typedef unsigned u32x4 __attribute__((ext_vector_type(4)));
constexpr int BM = 256, BK = 64, HALF = 128, HTB = HALF * BK * 2  , STAGE_BYTES = 8 * HTB, NXCD = 8, WGM = 8;

__host__ __device__ __forceinline__ int lds_byte(int r, int c) { const int st = (r >> 4) * 2 + (c >> 5), rr = r & 15, cc = c & 31, ob = rr * 64 + cc * 2; return st * 1024 + (ob ^ (((ob >> 9) & 1) << 5)); }
__host__ __device__ __forceinline__ void stage_rc(int b, int& R, int& C) { const int st = b / 1024, sb = b % 1024, swz = sb ^ (((sb >> 9) & 1) << 5); R = (st >> 1) * 16 + swz / 64; C = (st & 1) * 32 + (swz % 64) / 2; }
__host__ __device__ __forceinline__ int perm32(int rho) { const int n = rho >> 4, i = rho & 15; return 8 * (i >> 2) + 4 * n + (i & 3); }

struct Unit { int pm, pn; };
struct Gemm { const bf16_t* A; const bf16_t* Bt; int M, N, K; };

struct StaticOrder {
    int nM, nN, nwg, G, c, wgm;
    __host__ __device__ void init(int M, int N, int G_, int c_, int wgm_ = WGM) { nM = M / BM; nN = N / BM; nwg = nM * nN; G = G_; c = c_; wgm = wgm_; }
    __host__ __device__ bool next(int i, Unit& u) const {
        const long L = (long)i * G + c; if (L >= nwg) return false;
        int wgid = (int)L; { const int q = nwg / NXCD, r = nwg % NXCD, xcd = wgid % NXCD, off = wgid / NXCD; wgid = (xcd < r ? xcd * (q + 1) : r * (q + 1) + (xcd - r) * q) + off; }
        const int nig = wgm * nN, gid = wgid / nig, fm = gid * wgm, gsz = (nM - fm) < wgm ? (nM - fm) : wgm;
        u.pm = fm + ((wgid % nig) % gsz); u.pn = (wgid % nig) / gsz; return true;
    }
    __device__ __forceinline__ void a_ready(const Unit&) const {}
    __device__ __forceinline__ void done(const Unit&) const {}
};

__device__ __forceinline__ unsigned cvt_pk_bf16(float lo, float hi) { unsigned r; asm volatile("v_cvt_pk_bf16_f32 %0, %1, %2" : "=v"(r) : "v"(lo), "v"(hi)); return r; }
typedef float f32x2 __attribute__((ext_vector_type(2)));
__device__ __forceinline__ f32x2 gelu_pk(f32x2 v) {
    const f32x2 av = __builtin_elementwise_abs(v), d = av * 0.2316418882f + 1.0f;
    f32x2 t; t.x = __builtin_amdgcn_rcpf(d.x); t.y = __builtin_amdgcn_rcpf(d.y);
    f32x2 q = t * 0.5307027145f + (-0.7265760135f); q = q * t + 0.7107068705f; q = q * t + (-0.142248368f); q = q * t + 0.127414796f; q = q * t;
    const f32x2 s = (v * v) * (-0.72134752044f);
    f32x2 e; e.x = __builtin_amdgcn_exp2f(s.x); e.y = __builtin_amdgcn_exp2f(s.y);
    const f32x2 m = v * (q * e), r = v - m;
    f32x2 o; o.x = v.x < 0.f ? m.x : r.x; o.y = v.y < 0.f ? m.y : r.y; return o;
}

struct EpiStoreBf16 {
    static constexpr bool PERM = true, AFTER_DRAIN = false;
    bf16_t* O; int ldc;
    __device__ __forceinline__ void operator()(const f32x4 (&acc)[2][2][4][2], const Unit& u, int wr, int wc, int fr, int fq) const {
        const int row0 = u.pm * BM + wr * 64 + fr, col0 = u.pn * BM + wc * 32 + 8 * fq;
#pragma unroll
        for (int ai = 0; ai < 2; ++ai)
#pragma unroll
            for (int m = 0; m < 4; ++m) { bf16_t* rowp = O + (size_t)(row0 + ai * HALF + m * 16) * ldc + col0;
#pragma unroll
                for (int bj = 0; bj < 2; ++bj) { const f32x4 v0 = acc[ai][bj][m][0], v1 = acc[ai][bj][m][1];
                    u32x4 w; w.x = cvt_pk_bf16(v0[0], v0[1]); w.y = cvt_pk_bf16(v0[2], v0[3]); w.z = cvt_pk_bf16(v1[0], v1[1]); w.w = cvt_pk_bf16(v1[2], v1[3]);
                    *(u32x4*)(rowp + bj * HALF) = w; } }
    }
};
struct EpiResid {
    static constexpr bool PERM = false, AFTER_DRAIN = false;
    const float* base; float* out; int ldc; const float* gate; int gate_stride; int rows_per_batch;
    __device__ __forceinline__ void operator()(const f32x4 (&acc)[2][2][4][2], const Unit& u, int wr, int wc, int fr, int fq) const {
        const int row0 = u.pm * BM + wr * 64 + fr, col0 = u.pn * BM + wc * 32 + 4 * fq;
        const float* gp = gate + (size_t)((u.pm * BM) / rows_per_batch) * gate_stride + col0;
        f32x4 gv[2][2];
#pragma unroll
        for (int bj = 0; bj < 2; ++bj)
#pragma unroll
            for (int n = 0; n < 2; ++n) gv[bj][n] = *(const f32x4*)(gp + bj * HALF + n * 16);
        f32x4 xb[3][2][2];
#define ER_LOAD(g) do { const size_t off = (size_t)(row0 + ((g) >> 2) * HALF + ((g) & 3) * 16) * ldc + col0; \
            _Pragma("unroll") for (int bj = 0; bj < 2; ++bj) _Pragma("unroll") for (int n = 0; n < 2; ++n) xb[(g) % 3][bj][n] = *(const f32x4*)(base + off + bj * HALF + n * 16); } while (0)
#define ER_STORE(g) do { const size_t off = (size_t)(row0 + ((g) >> 2) * HALF + ((g) & 3) * 16) * ldc + col0; \
            _Pragma("unroll") for (int bj = 0; bj < 2; ++bj) _Pragma("unroll") for (int n = 0; n < 2; ++n) \
                *(f32x4*)(out + off + bj * HALF + n * 16) = xb[(g) % 3][bj][n] + gv[bj][n] * acc[(g) >> 2][bj][(g) & 3][n]; } while (0)
        ER_LOAD(0); ER_LOAD(1); ER_LOAD(2); ER_STORE(0); ER_LOAD(3); ER_STORE(1); ER_LOAD(4); ER_STORE(2); ER_LOAD(5); ER_STORE(3); ER_LOAD(6); ER_STORE(4); ER_LOAD(7); ER_STORE(5); ER_STORE(6); ER_STORE(7);
#undef ER_LOAD
#undef ER_STORE
    }
};
struct EpiSwiGLU {
    static constexpr bool PERM = true, AFTER_DRAIN = false;
    bf16_t* O; int ldc;
    __device__ __forceinline__ void operator()(const f32x4 (&acc)[2][2][4][2], const Unit& u, int wr, int wc, int fr, int fq) const {
        const int row0 = u.pm * BM + wr * 64 + fr, col0 = u.pn * HALF + wc * 32 + 8 * fq;
#pragma unroll
        for (int ai = 0; ai < 2; ++ai)
#pragma unroll
            for (int m = 0; m < 4; ++m) { bf16_t* rowp = O + (size_t)(row0 + ai * HALF + m * 16) * ldc + col0;
                float f[8];
#pragma unroll
                for (int n = 0; n < 2; ++n)
#pragma unroll
                    for (int e = 0; e < 4; ++e) { const float g = acc[ai][0][m][n][e], up = acc[ai][1][m][n][e];
                        f[n * 4 + e] = g * up * __builtin_amdgcn_rcpf(1.0f + __builtin_amdgcn_exp2f(-1.4426950408889634f * g)); }
                u32x4 w; w.x = cvt_pk_bf16(f[0], f[1]); w.y = cvt_pk_bf16(f[2], f[3]); w.z = cvt_pk_bf16(f[4], f[5]); w.w = cvt_pk_bf16(f[6], f[7]);
                *(u32x4*)rowp = w; }
    }
};

template <class Epi, class Sched, bool ALIGN_EPI = false, bool SP2 = false>
__device__ __forceinline__ void gemm_phase(PG8_LAS unsigned char* lds, const Gemm g, const Sched& S, const Epi& E) {
    const int tid = threadIdx.x, wid = __builtin_amdgcn_readfirstlane(tid >> 6), lane = tid & 63, wr = wid >> 2, wc = wid & 3, fr = lane & 15, fq = lane >> 4;
    const int K = g.K, nt = K / BK;
    unsigned voffA[2], voffB[2];
#pragma unroll
    for (int i = 0; i < 2; ++i) { int R, C; stage_rc(tid * 16 + i * 8192, R, C); const int Rb = Epi::PERM ? ((R & ~31) + perm32(R & 31)) : R;
        voffA[i] = (unsigned)(R * K + C) * 2u; voffB[i] = (unsigned)(Rb * K + C) * 2u; }
    const size_t kstep = (size_t)(BK * 2);
    const size_t hstep = (size_t)HALF * K * 2;
    const size_t tstep = 2 * hstep;
    const unsigned ldsw = (unsigned)wid * 1024u;
    const int aoff = lds_byte(wr * 64 + fr, fq * 8), boff = lds_byte(wc * 32 + fr, fq * 8);
#define PG8_SA(b, h) (((b) * 2 + (h)) * HTB)
#define PG8_SB(b, h) ((4 + (b) * 2 + (h)) * HTB)
#define PG8_STAGE(bufoff, gbase, voff) do { _Pragma("unroll") for (int _i = 0; _i < 2; ++_i) \
        __builtin_amdgcn_global_load_lds((const unsigned*)((const char*)(gbase) + (voff)[_i]), (PG8_LAS unsigned*)(lds + (bufoff) + ldsw + _i * 8192), 16, 0, 0); } while (0)
#define PG8_LDA(dst, b, h) do { _Pragma("unroll") for (int m = 0; m < 4; ++m) _Pragma("unroll") for (int k = 0; k < 2; ++k) dst[m][k] = *(const PG8_LAS bf16x8*)(lds + PG8_SA(b, h) + aoff + m * 2048 + k * 1024); } while (0)
#define PG8_LDB(dst, b, h) do { _Pragma("unroll") for (int n = 0; n < 2; ++n) _Pragma("unroll") for (int k = 0; k < 2; ++k) dst[n][k] = *(const PG8_LAS bf16x8*)(lds + PG8_SB(b, h) + boff + n * 2048 + k * 1024); } while (0)
#define PG8_MMA(ai, bj, At, Bt) do { __builtin_amdgcn_s_setprio(1); _Pragma("unroll") for (int m = 0; m < 4; ++m) _Pragma("unroll") for (int n = 0; n < 2; ++n) _Pragma("unroll") for (int k = 0; k < 2; ++k) \
        acc[ai][bj][m][n] = __builtin_amdgcn_mfma_f32_16x16x32_bf16(Bt[n][k], At[m][k], acc[ai][bj][m][n], 0, 0, 0); __builtin_amdgcn_s_setprio(0); } while (0)
#define PG8_WAIT_V(n) asm volatile("s_waitcnt vmcnt(" #n ")" ::: "memory")
#define PG8_WAIT_L(n) asm volatile("s_waitcnt lgkmcnt(" #n ")" ::: "memory")
#define PG8_BAR __builtin_amdgcn_s_barrier()
#define PG8_SCHED __builtin_amdgcn_sched_barrier(0)
    Unit cur, nxt; int ui = 0;
    if (!S.next(0, cur)) return;
    f32x4 acc[2][2][4][2];
#pragma unroll
    for (int a = 0; a < 2; ++a)
#pragma unroll
        for (int b = 0; b < 2; ++b)
#pragma unroll
            for (int m = 0; m < 4; ++m)
#pragma unroll
                for (int n = 0; n < 2; ++n) acc[a][b][m][n] = (f32x4){0.f, 0.f, 0.f, 0.f};
    bf16x8 At[4][2], B0[2][2], B1[2][2];
    const char* cA = (const char*)g.A + (size_t)cur.pm * tstep; const char* cB = (const char*)g.Bt + (size_t)cur.pn * tstep;
    S.a_ready(cur);
    if constexpr (SP2) {
        PG8_STAGE(PG8_SB(0, 0), cB, voffB); PG8_STAGE(PG8_SB(0, 1), cB + hstep, voffB); PG8_STAGE(PG8_SA(0, 0), cA, voffA); PG8_STAGE(PG8_SA(0, 1), cA + hstep, voffA);
        if (wr == 1) PG8_BAR;
        PG8_WAIT_V(2); PG8_BAR;
        PG8_STAGE(PG8_SB(1, 0), cB + kstep, voffB); PG8_STAGE(PG8_SA(1, 0), cA + kstep, voffA); PG8_STAGE(PG8_SB(1, 1), cB + hstep + kstep, voffB);
        PG8_WAIT_V(6); PG8_BAR;
    } else {
        PG8_STAGE(PG8_SB(0, 0), cB, voffB); PG8_STAGE(PG8_SA(0, 0), cA, voffA); PG8_STAGE(PG8_SB(0, 1), cB + hstep, voffB); PG8_STAGE(PG8_SA(0, 1), cA + hstep, voffA);
        if (wr == 1) PG8_BAR;
        PG8_WAIT_V(4); PG8_BAR;
        PG8_STAGE(PG8_SB(1, 0), cB + kstep, voffB); PG8_STAGE(PG8_SA(1, 0), cA + kstep, voffA); PG8_STAGE(PG8_SB(1, 1), cB + hstep + kstep, voffB);
        PG8_WAIT_V(6); PG8_BAR;
    }
    for (;;) {
        const bool has_next = S.next(ui + 1, nxt);
        const char* nA = has_next ? (const char*)g.A + (size_t)nxt.pm * tstep : cA; const char* nB = has_next ? (const char*)g.Bt + (size_t)nxt.pn * tstep : cB;
        for (int t = 0; t < nt; t += 2) {
            const bool last = (t == nt - 2);
            const char* a1 = cA + (size_t)(t + 1) * kstep;
            const char* a2 = last ? nA : cA + (size_t)(t + 2) * kstep; const char* b2 = last ? nB : cB + (size_t)(t + 2) * kstep;
            const char* a3 = a2 + kstep; const char* b3 = b2 + kstep;
            if (last && has_next) S.a_ready(nxt);
            if constexpr (SP2) {
            PG8_LDB(B0, 0, 0); PG8_LDB(B1, 0, 1); PG8_SCHED; PG8_LDA(At, 0, 0); PG8_STAGE(PG8_SA(1, 1), a1 + hstep, voffA);
            PG8_WAIT_V(8); PG8_WAIT_L(0); PG8_BAR; PG8_MMA(0, 0, At, B0); PG8_MMA(0, 1, At, B1); PG8_BAR; PG8_SCHED;
            PG8_LDA(At, 0, 1); PG8_STAGE(PG8_SB(0, 0), b2, voffB); PG8_STAGE(PG8_SB(0, 1), b2 + hstep, voffB); PG8_STAGE(PG8_SA(0, 0), a2, voffA);
            PG8_WAIT_V(8); PG8_WAIT_L(0); PG8_BAR; PG8_MMA(1, 0, At, B0); PG8_MMA(1, 1, At, B1); PG8_BAR; PG8_SCHED;
            PG8_LDB(B0, 1, 0); PG8_LDB(B1, 1, 1); PG8_SCHED; PG8_LDA(At, 1, 0); PG8_STAGE(PG8_SA(0, 1), a2 + hstep, voffA);
            PG8_WAIT_V(8); PG8_WAIT_L(0); PG8_BAR; PG8_MMA(0, 0, At, B0); PG8_MMA(0, 1, At, B1); PG8_BAR; PG8_SCHED;
            PG8_LDA(At, 1, 1); PG8_STAGE(PG8_SB(1, 0), b3, voffB); PG8_STAGE(PG8_SB(1, 1), b3 + hstep, voffB); PG8_STAGE(PG8_SA(1, 0), a3, voffA);
            PG8_WAIT_V(8); PG8_WAIT_L(0); PG8_BAR; PG8_MMA(1, 0, At, B0); PG8_MMA(1, 1, At, B1); PG8_BAR; PG8_SCHED;
            } else {
            PG8_LDB(B0, 0, 0); PG8_SCHED; PG8_LDA(At, 0, 0); PG8_STAGE(PG8_SA(1, 1), a1 + hstep, voffA);
            PG8_WAIT_L(8); PG8_BAR; PG8_WAIT_L(0); PG8_MMA(0, 0, At, B0); PG8_BAR; PG8_SCHED;
            PG8_LDB(B1, 0, 1); PG8_STAGE(PG8_SB(0, 0), b2, voffB);
            PG8_BAR; PG8_WAIT_L(0); PG8_MMA(0, 1, At, B1); PG8_BAR;
            PG8_LDA(At, 0, 1); PG8_STAGE(PG8_SA(0, 0), a2, voffA);
            PG8_BAR; PG8_WAIT_L(0); PG8_MMA(1, 0, At, B0); PG8_BAR; PG8_SCHED;
            PG8_STAGE(PG8_SB(0, 1), b2 + hstep, voffB);
            PG8_WAIT_V(6); PG8_BAR; PG8_MMA(1, 1, At, B1); PG8_BAR;
            PG8_LDB(B0, 1, 0); PG8_SCHED; PG8_LDA(At, 1, 0); PG8_STAGE(PG8_SA(0, 1), a2 + hstep, voffA);
            PG8_WAIT_L(8); PG8_BAR; PG8_WAIT_L(0); PG8_MMA(0, 0, At, B0); PG8_BAR; PG8_SCHED;
            PG8_LDB(B1, 1, 1); PG8_STAGE(PG8_SB(1, 0), b3, voffB);
            PG8_BAR; PG8_WAIT_L(0); PG8_MMA(0, 1, At, B1); PG8_BAR;
            PG8_LDA(At, 1, 1); PG8_STAGE(PG8_SA(1, 0), a3, voffA);
            PG8_BAR; PG8_WAIT_L(0); PG8_MMA(1, 0, At, B0); PG8_BAR; PG8_SCHED;
            PG8_STAGE(PG8_SB(1, 1), b3 + hstep, voffB);
            PG8_WAIT_V(6); PG8_BAR; PG8_MMA(1, 1, At, B1); PG8_BAR;
            }
        }
        if constexpr (ALIGN_EPI) { if (wr == 0) PG8_BAR; }
        if constexpr (!Epi::AFTER_DRAIN) { E(acc, cur, wr, wc, fr, fq); S.done(cur); }
        if (!has_next) break;
#pragma unroll
        for (int a = 0; a < 2; ++a)
#pragma unroll
            for (int b = 0; b < 2; ++b)
#pragma unroll
                for (int m = 0; m < 4; ++m)
#pragma unroll
                    for (int n = 0; n < 2; ++n) acc[a][b][m][n] = (f32x4){0.f, 0.f, 0.f, 0.f};
        cur = nxt; cA = nA; cB = nB; ++ui;
        if constexpr (ALIGN_EPI) { if (wr == 1) PG8_BAR; }
    }
    PG8_WAIT_V(0);
    if constexpr (!ALIGN_EPI) { if (wr == 0) PG8_BAR; }
    PG8_BAR;
    if constexpr (Epi::AFTER_DRAIN) { E.fused(acc, cur, wr, wc, fr, fq, lds, wid, lane); S.done(cur); }
#undef PG8_SA
#undef PG8_SB
#undef PG8_STAGE
#undef PG8_LDA
#undef PG8_LDB
#undef PG8_MMA
#undef PG8_WAIT_V
#undef PG8_WAIT_L
#undef PG8_BAR
#undef PG8_SCHED
}
}
constexpr int NWAVES = 8, NTHREADS = 512;
constexpr int D = 2048, NB = 4, T = 4096, M = NB * T, DEPTH = 4, GW = 512, NH = 8, HD = 64;
constexpr int NIN = 5544, NP = 5632, FF = 5632, MODW = 6 * D;
constexpr int PC_RR = 0, PC_RK = 512, PC_RV = 1024, PC_SQ = 1536, PC_SK = 2048, PC_SV = 2176, PC_GU = 2304, PC_GV = 2816;
constexpr int PC_FQ = 3328, PC_FK = 3840, PC_FV = 4352, PC_FG = 4864, PC_RW = 5376, PC_FL = 5536;
constexpr int YC_A = 0, YC_B = 512, YC_C = 1024, YC_D = 1536;
constexpr int SGU_TRI = 8256;
enum { I_X = 0, I_C, I_WMOD, I_BMOD, I_N1G, I_N2G, I_WIN, I_WOUT, I_RMU, I_RW0, I_RW2, I_RA0, I_RA2, I_RG2, I_RKK, I_RKA, I_RRK, I_RLG, I_RLB,
       I_SQG, I_SKG, I_SSINK, I_GLG, I_GLB, I_GWS, I_GB, I_FQG, I_FKG, I_FFB, I_W1, I_W3, I_W2, N_INPUTS };

constexpr size_t MiB = 1u << 20;
constexpr size_t WS_CTL = 0, CTL_ZERO_BYTES = 1 * MiB;
constexpr size_t WS_MOD = 1 * MiB;
constexpr size_t WS_MODP = 2 * MiB;
constexpr size_t WS_WIN = 8 * MiB;
constexpr size_t WS_WOUT = 96 * MiB;
constexpr size_t WS_W13 = 128 * MiB;
constexpr size_t WS_W2 = 304 * MiB;
constexpr size_t WS_H = 392 * MiB;
constexpr size_t WS_PROJ = 456 * MiB;
constexpr size_t WS_YCAT = 632 * MiB;
constexpr size_t WS_F = 696 * MiB;
constexpr size_t WS_RIN = 872 * MiB;
constexpr size_t WS_RG = 1064 * MiB;
constexpr size_t WS_RY = 1096 * MiB;
constexpr size_t WS_END = 1128 * MiB;
constexpr int CW_BAR = 4096;

constexpr int RING_BYTES = 131072;
constexpr int LDSCTL_OFF = RING_BYTES, MISC_OFF = LDSCTL_OFF + 320;
constexpr int LDS_BYTES = 147456;

#define GAS __attribute__((address_space(1)))
#define LAS __attribute__((address_space(3)))
typedef unsigned short bf16;
typedef short bf16x8 __attribute__((ext_vector_type(8)));
typedef float f32x4 __attribute__((ext_vector_type(4)));
typedef float f32x16 __attribute__((ext_vector_type(16)));
typedef unsigned v4u __attribute__((ext_vector_type(4)));
typedef unsigned v2u __attribute__((ext_vector_type(2)));
#define LDS_WAIT() asm volatile("s_waitcnt lgkmcnt(0)" ::: "memory")
__device__ __forceinline__ float bf2f(unsigned short b) { return __uint_as_float(((unsigned)b) << 16); }
__device__ __forceinline__ unsigned f2bf(float f) { unsigned u = __float_as_uint(f); return (u + 0x7fffu + ((u >> 16) & 1u)) >> 16; }
typedef float f32x2_t __attribute__((ext_vector_type(2))); typedef __bf16 bf16x2_t __attribute__((ext_vector_type(2)));
__device__ __forceinline__ unsigned pk2(float lo, float hi) { const f32x2_t v = {lo, hi}; const bf16x2_t b = __builtin_convertvector(v, bf16x2_t); return __builtin_bit_cast(unsigned, b); }
__device__ __forceinline__ float bflo(unsigned w) { return __uint_as_float(w << 16); }
__device__ __forceinline__ float bfhi(unsigned w) { return __uint_as_float(w & 0xffff0000u); }
__device__ __forceinline__ float wave_sum(float v) {
#pragma unroll
    for (int o = 1; o < 64; o <<= 1) v += __shfl_xor(v, o);
    return v;
}
__device__ __forceinline__ float sigmoidf_(float x) { return __builtin_amdgcn_rcpf(1.0f + __expf(-x)); }
__device__ __forceinline__ float gelu_f(float v) {
    const float av = fabsf(v), t = __builtin_amdgcn_rcpf(av * 0.2316418882f + 1.0f);
    float q = t * 0.5307027145f + (-0.7265760135f); q = q * t + 0.7107068705f; q = q * t + (-0.142248368f); q = q * t + 0.127414796f; q = q * t;
    const float e = __builtin_amdgcn_exp2f((v * v) * (-0.72134752044f));
    const float m = v * (q * e);
    return v < 0.f ? m : v - m;
}
__device__ __forceinline__ int crow(int r, int hi) { return (r & 3) + 8 * (r >> 2) + 4 * hi; }

#define XB_TMO      128
#define XB_XCNT(j)  (256  + 64 * (j))
#define XB_XSUB(j)  (1280 + 64 * (j))
#define XB_XGEN(j)  (2304 + 64 * (j))
#define XB_TOP      3328
#define XB_TOPGEN   3392
#define XCD_BAR_WORDS 3456
#define XB_SPIN_CAP (1u << 18)

__device__ __forceinline__ unsigned xb_ld(unsigned* p)              { return __hip_atomic_load(p, __ATOMIC_RELAXED, __HIP_MEMORY_SCOPE_AGENT); }
__device__ __forceinline__ unsigned xb_add(unsigned* p, unsigned v) { return __hip_atomic_fetch_add(p, v, __ATOMIC_RELAXED, __HIP_MEMORY_SCOPE_AGENT); }
__device__ __forceinline__ unsigned xb_xcc_id() { return (unsigned)__builtin_amdgcn_s_getreg((3 << 11) | 20) & 0xFu; }
#define XB_SPIN(cond, bar) do { unsigned _sp = 0; while (cond) { __builtin_amdgcn_s_sleep(1); \
    if ((++_sp & 255u) == 0u) { if (xb_ld(&(bar)[XB_TMO])) break; if (_sp > XB_SPIN_CAP) { atomicAdd(&(bar)[XB_TMO], 1u); break; } } } } while (0)

struct XcdBarrier {
    unsigned* bar; unsigned x;
    volatile LAS unsigned* st;
};

__device__ __forceinline__ XcdBarrier xcd_barrier_post(unsigned* bar, volatile LAS unsigned* st) {
    XcdBarrier b; b.bar = bar; b.x = xb_xcc_id(); b.st = st;
    if (threadIdx.x == 0) (void)xb_add(&bar[XB_XCNT(b.x)], 1u);
    return b;
}
__device__ __forceinline__ void xcd_barrier_complete(unsigned* bar, unsigned x, unsigned& nloc, unsigned& nx) {
    const unsigned G = gridDim.x * gridDim.y * gridDim.z;
    unsigned sum, cnt, mine, sp = 0u;
    for (;;) {
        sum = 0u; cnt = 0u; mine = 0u;
#pragma unroll
        for (unsigned j = 0; j < 16; ++j) { const unsigned c = xb_ld(&bar[XB_XCNT(j)]); sum += c; cnt += (c > 0u) ? 1u : 0u; mine = (j == x) ? c : mine; }
        if (sum == G) break;
        __builtin_amdgcn_s_sleep(1);
        if ((++sp & 255u) == 0u) { if (xb_ld(&bar[XB_TMO])) break; if (sp > XB_SPIN_CAP) { atomicAdd(&bar[XB_TMO], 1u); break; } }
    }
    nloc = mine > 0u ? mine : 1u; nx = cnt > 0u ? cnt : 1u;
}

__device__ __forceinline__ void xcd_barrier(const XcdBarrier& b) {
    asm volatile("s_waitcnt vmcnt(0)" ::: "memory");
    __syncthreads();
    if (threadIdx.x == 0) {
        unsigned* bar = b.bar;
        __builtin_amdgcn_s_waitcnt(0);
        unsigned nloc = b.st[0], nx = b.st[1];
        if (nloc == 0u) { xcd_barrier_complete(bar, b.x, nloc, nx); b.st[0] = nloc; b.st[1] = nx; }
        const unsigned old = xb_add(&bar[XB_XSUB(b.x)], 1u);
        const unsigned gen = old / nloc;
        if (old + 1u == (gen + 1u) * nloc) {
            __builtin_amdgcn_fence(__ATOMIC_RELEASE, "agent");
            asm volatile("s_waitcnt vmcnt(0)" ::: "memory");
            const unsigned og = xb_add(&bar[XB_TOP], 1u);
            const unsigned tg = og / nx;
            if (og + 1u == (tg + 1u) * nx) xb_add(&bar[XB_TOPGEN], 1u);
            else XB_SPIN(xb_ld(&bar[XB_TOPGEN]) == tg, bar);
            __builtin_amdgcn_fence(__ATOMIC_ACQUIRE, "agent");
            xb_add(&bar[XB_XGEN(b.x)], 1u);
            asm volatile("s_waitcnt vmcnt(0)" ::: "memory");
        } else {
            XB_SPIN(xb_ld(&bar[XB_XGEN(b.x)]) == gen, bar);
            __builtin_amdgcn_fence(__ATOMIC_ACQUIRE, "agent");
            asm volatile("s_waitcnt vmcnt(0)" ::: "memory");
        }
    }
    __syncthreads();
}

struct Args { const float* in[N_INPUTS]; float* out; unsigned char* ws; int ph_lo, ph_hi; };
static_assert(sizeof(Args) == (N_INPUTS + 2) * 8 + 8, "Args has no padding");

struct Ctx {
    LAS unsigned char* lds; int tid, lane, wave, G, bid;
};
typedef const Args __attribute__((address_space(4))) KArgs;
__device__ __forceinline__ KArgs* ka_ptr() { KArgs* p = (KArgs*)__builtin_amdgcn_kernarg_segment_ptr(); asm volatile("" : "+s"(p)); return p; }
#define KA_DECL KArgs& A = *ka_ptr()
#define LBAR() do { asm volatile("s_waitcnt lgkmcnt(0)" ::: "memory"); __builtin_amdgcn_s_barrier(); asm volatile("" ::: "memory"); } while (0)

__device__ __forceinline__ void tr_item(const float* __restrict__ W, int N, int col0, int nvalid, int k0, bf16* __restrict__ WT, int K, int n0, LAS float* scr, int lane) {
    float wv[32];
    const int nn = lane & 31; const bool okc = nn < nvalid; const float* wp = W + (size_t)(k0 + (lane >> 5)) * N + col0 + (okc ? nn : 0);
#pragma unroll
    for (int i = 0; i < 32; ++i) wv[i] = wp[(size_t)(2 * i) * N];
#pragma unroll
    for (int i = 0; i < 32; ++i) scr[(2 * i + (lane >> 5)) * 33 + nn] = okc ? wv[i] : 0.f;
    LDS_WAIT(); asm volatile("" ::: "memory");
    const int c = lane & 7;
#pragma unroll
    for (int j = 0; j < 4; ++j) { const int n = (lane >> 3) + 8 * j; const LAS float* s = scr + (8 * c) * 33 + n;
        v4u o; o.x = pk2(s[0 * 33], s[1 * 33]); o.y = pk2(s[2 * 33], s[3 * 33]); o.z = pk2(s[4 * 33], s[5 * 33]); o.w = pk2(s[6 * 33], s[7 * 33]);
        *(v4u*)(WT + (size_t)(n0 + n) * K + k0 + 8 * c) = o; }
    LDS_WAIT(); asm volatile("" ::: "memory");
}
__device__ __forceinline__ void ph_prologue(const Ctx& C) {
    KA_DECL;
    LAS float* csilu = (LAS float*)(C.lds + 73728);
    for (int i = C.tid; i < NB * D; i += NTHREADS) { const float c = A.in[I_C][i]; csilu[i] = c / (1.0f + __expf(-c)); }
    __syncthreads();
    LAS float* scr = (LAS float*)(C.lds + C.wave * 8704);
    const int gw = C.bid * NWAVES + C.wave, NGW = C.G * NWAVES;
    constexpr int I_IN = (D / 64) * (NP / 32), I_OUT = (D / 64) * (D / 32), I_13 = (D / 64) * (2 * FF / 32), I_2 = (FF / 64) * (D / 32), PER_L = I_IN + I_OUT + I_13 + I_2;
    for (int it = gw; it < DEPTH * PER_L; it += NGW) {
        const int l = it / PER_L; int r = it % PER_L;
        if (r < I_IN) { const int kb = r / (NP / 32), nb = r % (NP / 32), n0 = 32 * nb; int col0, nv = 32;
            if (n0 < 1536) col0 = n0; else if (n0 < 4864) col0 = n0 + 160; else if (n0 < 5376) col0 = n0 + 168; else if (n0 < 5536) col0 = n0 - 3840;
            else if (n0 == 5536) { col0 = 5024; nv = 8; } else { col0 = 0; nv = 0; }
            tr_item(A.in[I_WIN] + (size_t)l * D * NIN, NIN, col0, nv, 64 * kb, (bf16*)(A.ws + WS_WIN) + (size_t)l * NP * D, D, n0, scr, C.lane); continue; }
        r -= I_IN;
        if (r < I_OUT) { const int kb = r / (D / 32), nb = r % (D / 32);
            tr_item(A.in[I_WOUT] + (size_t)l * D * D, D, 32 * nb, 32, 64 * kb, (bf16*)(A.ws + WS_WOUT) + (size_t)l * D * D, D, 32 * nb, scr, C.lane); continue; }
        r -= I_OUT;
        if (r < I_13) { const int kb = r / (2 * FF / 32), nb = r % (2 * FF / 32), n0 = 32 * nb, pn = n0 >> 8, j = n0 & 255;
            const float* src = (j < 128 ? A.in[I_W1] : A.in[I_W3]) + (size_t)l * D * FF;
            tr_item(src, FF, 128 * pn + (j & 127), 32, 64 * kb, (bf16*)(A.ws + WS_W13) + (size_t)l * 2 * FF * D, D, n0, scr, C.lane); continue; }
        r -= I_13;
        { const int kb = r / (D / 32), nb = r % (D / 32);
            tr_item(A.in[I_W2] + (size_t)l * FF * D, D, 32 * nb, 32, 64 * kb, (bf16*)(A.ws + WS_W2) + (size_t)l * D * FF, FF, 32 * nb, scr, C.lane); }
    }
    for (int it = gw; it < 8 * DEPTH * (MODW / 256); it += NGW) {
        const int cg = it % (DEPTH * (MODW / 256)), ks = it / (DEPTH * (MODW / 256)), l = cg / (MODW / 256), n0 = (cg % (MODW / 256)) * 256, k0 = ks * 256;
        const float* wp = A.in[I_WMOD] + ((size_t)l * D + k0) * MODW + n0 + 4 * C.lane;
        f32x4 a0 = {0.f, 0.f, 0.f, 0.f}, a1 = a0, a2 = a0, a3 = a0;
#pragma unroll 16
        for (int k = 0; k < 256; ++k) { const f32x4 w = *(const f32x4*)(wp + (size_t)k * MODW);
            a0 += w * csilu[0 * D + k0 + k]; a1 += w * csilu[1 * D + k0 + k]; a2 += w * csilu[2 * D + k0 + k]; a3 += w * csilu[3 * D + k0 + k]; }
        float* mp = (float*)(A.ws + WS_MODP) + ((size_t)(ks * DEPTH + l) * NB) * MODW + n0 + 4 * C.lane;
        *(f32x4*)(mp + 0 * MODW) = a0; *(f32x4*)(mp + 1 * MODW) = a1; *(f32x4*)(mp + 2 * MODW) = a2; *(f32x4*)(mp + 3 * MODW) = a3;
    }
}
__device__ __forceinline__ void ph_modreduce(const Ctx& C) {
    KA_DECL;
    const float* mp = (const float*)(A.ws + WS_MODP); float* mod = (float*)(A.ws + WS_MOD);
    for (int i = C.bid * NTHREADS + C.tid; i < DEPTH * NB * MODW; i += C.G * NTHREADS) {
        const int l = i / (NB * MODW), n = i % MODW; float s = A.in[I_BMOD][l * MODW + n];
#pragma unroll
        for (int ks = 0; ks < 8; ++ks) s += mp[(size_t)ks * DEPTH * NB * MODW + i];
        mod[i] = s;
    }
}
__device__ __forceinline__ void ph_norm(const Ctx& C, const float* x, const float* g, const float* shift, const float* scale, bf16* H) {
    const int gw = C.bid * NWAVES + C.wave, NGW = C.G * NWAVES;
    for (int m = gw; m < M; m += NGW) {
        const int b = m / T; const f32x4* xr = (const f32x4*)(x + (size_t)m * D) + C.lane;
        f32x4 v[8]; float ss = 0.f;
#pragma unroll
        for (int j = 0; j < 8; ++j) { v[j] = xr[64 * j]; ss += (v[j].x * v[j].x + v[j].y * v[j].y) + (v[j].z * v[j].z + v[j].w * v[j].w); }
        const float rstd = 1.0f / sqrtf(wave_sum(ss) * (1.0f / D) + 1e-6f);
        unsigned long long* o8 = (unsigned long long*)(H + (size_t)m * D) + C.lane;
        f32x4 cv[8], sh[8];
#pragma unroll
        for (int j = 0; j < 8; ++j) { const int c = 4 * (C.lane + 64 * j);
            const f32x4 gg = *(const f32x4*)(g + c), sc = *(const f32x4*)(scale + (size_t)b * MODW + c); sh[j] = *(const f32x4*)(shift + (size_t)b * MODW + c); cv[j] = gg * (sc + 1.0f); }
#pragma unroll
        for (int j = 0; j < 8; ++j) { const f32x4 y = v[j] * rstd * cv[j] + sh[j];
            o8[64 * j] = (unsigned long long)pk2(y.x, y.y) | ((unsigned long long)pk2(y.z, y.w) << 32); }
    }
}

__device__ __forceinline__ float dpp_xor1(float v) { return __builtin_bit_cast(float, __builtin_amdgcn_update_dpp(0, __builtin_bit_cast(int, v), 0xB1, 0xF, 0xF, true)); }
__device__ __forceinline__ float dpp_xor2(float v) { return __builtin_bit_cast(float, __builtin_amdgcn_update_dpp(0, __builtin_bit_cast(int, v), 0x4E, 0xF, 0xF, true)); }
__device__ __forceinline__ float wave_sum_dpp(float v) {
    v += dpp_xor1(v); v += dpp_xor2(v);
    v += __builtin_bit_cast(float, __builtin_amdgcn_update_dpp(0, __builtin_bit_cast(int, v), 0x141, 0xF, 0xF, true));
    v += __builtin_bit_cast(float, __builtin_amdgcn_update_dpp(0, __builtin_bit_cast(int, v), 0x140, 0xF, 0xF, true));
    const int b = __builtin_bit_cast(int, v);
    return (__builtin_bit_cast(float, __builtin_amdgcn_readlane(b, 0)) + __builtin_bit_cast(float, __builtin_amdgcn_readlane(b, 16))) +
           (__builtin_bit_cast(float, __builtin_amdgcn_readlane(b, 32)) + __builtin_bit_cast(float, __builtin_amdgcn_readlane(b, 48)));
}

__device__ __forceinline__ f32x16 mma32(const LAS bf16* Ap, const LAS bf16* Bp, int ksteps, f32x16 acc) {
    for (int k = 0; k < ksteps; ++k) { const bf16x8 a = *(const LAS bf16x8*)(Ap + 16 * k), b = *(const LAS bf16x8*)(Bp + 16 * k);
        acc = __builtin_amdgcn_mfma_f32_32x32x16_bf16(a, b, acc, 0, 0, 0); }
    return acc;
}
constexpr int AP = 72;
constexpr size_t WS_QF = WS_RIN, WS_YF = WS_RIN + 32 * MiB, WS_PA = WS_RIN + 64 * MiB, WS_RT = WS_RIN + 80 * MiB, WS_GL = WS_RIN + 96 * MiB, WS_RBV = WS_RIN + 97 * MiB;
constexpr size_t WS_CUM = WS_RIN + 170 * MiB;
constexpr size_t WS_KNF = WS_RIN + 130 * MiB, WS_KNS = WS_RIN + 146 * MiB, WS_VTF = WS_RIN + 150 * MiB, WS_VTS = WS_RIN + 166 * MiB;
__device__ __forceinline__ void kvprep_unit(const Ctx& C, int l, int u) {
    KA_DECL; asm volatile("" : "+s"(l));
    const bf16* proj = (const bf16*)(A.ws + WS_PROJ);
    int tid = C.tid; asm volatile("" : "+v"(tid));
    const size_t m0 = (size_t)u * 64; const int b = (int)(m0 / T), t0 = (int)(m0 % T);
    bf16* KNF = (bf16*)(A.ws + WS_KNF); bf16* KNS = (bf16*)(A.ws + WS_KNS); bf16* VTF = (bf16*)(A.ws + WS_VTF); bf16* VTS = (bf16*)(A.ws + WS_VTS);
    LAS bf16* Vl = (LAS bf16*)C.lds;
    LBAR();
    float gF[8], gS[8];
#pragma unroll
    for (int i = 0; i < 8; ++i) { gF[i] = A.in[I_FKG][l * 64 + 8 * (tid & 7) + i]; gS[i] = A.in[I_SKG][l * 64 + 8 * (tid & 7) + i]; }
    for (int half = 0; half < 2; ++half) {
        v4u krr[5];
#pragma unroll
        for (int it = 0; it < 5; ++it) { const int i = tid + NTHREADS * (5 * half + it), tok = i / 80, ch = i % 80;
            krr[it] = *(const v4u*)(proj + (m0 + tok) * NP + ((ch < 64) ? PC_FK + 8 * ch : PC_SK + 8 * (ch - 64))); }
#pragma unroll
        for (int it = 0; it < 5; ++it) { const int i = tid + NTHREADS * (5 * half + it), tok = i / 80, ch = i % 80; const size_t m = m0 + tok;
            const bool fox = ch < 64;
            float g[8];
#pragma unroll
            for (int q = 0; q < 8; ++q) g[q] = fox ? gF[q] : gS[q];
            const v4u kr = krr[it];
            float f[8]; f[0] = bflo(kr.x); f[1] = bfhi(kr.x); f[2] = bflo(kr.y); f[3] = bfhi(kr.y); f[4] = bflo(kr.z); f[5] = bfhi(kr.z); f[6] = bflo(kr.w); f[7] = bfhi(kr.w);
            float ss = ((f[0] * f[0] + f[1] * f[1]) + (f[2] * f[2] + f[3] * f[3])) + ((f[4] * f[4] + f[5] * f[5]) + (f[6] * f[6] + f[7] * f[7]));
            ss += dpp_xor1(ss); ss += dpp_xor2(ss); ss += __shfl_xor(ss, 4);
            const float rs = __builtin_amdgcn_rsqf(ss * (1.0f / 64.0f) + 1e-6f);
            v4u ko; ko.x = pk2(f[0] * rs * g[0], f[1] * rs * g[1]); ko.y = pk2(f[2] * rs * g[2], f[3] * rs * g[3]); ko.z = pk2(f[4] * rs * g[4], f[5] * rs * g[5]); ko.w = pk2(f[6] * rs * g[6], f[7] * rs * g[7]);
            if (fox) *(v4u*)(KNF + m * 512 + 8 * ch) = ko; else *(v4u*)(KNS + m * 128 + 8 * (ch - 64)) = ko; }
    }
#pragma unroll
    for (int it = 0; it < 10; ++it) { const int i = tid + NTHREADS * it, head = i >> 9, rem = i & 511, tok = rem >> 3, dc = rem & 7;
        const int scol = (head < 8) ? PC_FV + head * 64 + 8 * dc : PC_SV + (head - 8) * 64 + 8 * dc;
        *(LAS v4u*)(Vl + (head * 64 + tok) * AP + 8 * dc) = *(const v4u*)(proj + (m0 + tok) * NP + scol); }
    LBAR();
    for (int it = 0; it < 10; ++it) { const int i = tid + NTHREADS * it, head = i >> 9, rem = i & 511, d = rem >> 3, tc = rem & 7;
        const LAS bf16* src = Vl + (head * 64 + 8 * tc) * AP + d;
        v4u o; o.x = (unsigned)src[0] | ((unsigned)src[AP] << 16); o.y = (unsigned)src[2 * AP] | ((unsigned)src[3 * AP] << 16); o.z = (unsigned)src[4 * AP] | ((unsigned)src[5 * AP] << 16); o.w = (unsigned)src[6 * AP] | ((unsigned)src[7 * AP] << 16);
        bf16* dst = (head < 8) ? VTF + ((size_t)(b * 8 + head) * 64 + d) * T : VTS + ((size_t)(b * 2 + head - 8) * 64 + d) * T;
        *(v4u*)(dst + t0 + 8 * tc) = o; }
}
__device__ __forceinline__ void cumprep_unit(const Ctx& C, int l, int bh) {
    KA_DECL; asm volatile("" : "+s"(l));
    const bf16* proj = (const bf16*)(A.ws + WS_PROJ); float* cumg = (float*)(A.ws + WS_CUM) + (size_t)bh * T;
    const int tid = C.tid, lane = C.lane, wave = C.wave, b = bh >> 3, h = bh & 7; const size_t rowb = (size_t)b * T;
    LAS float* WT = (LAS float*)C.lds;
    const float fb = A.in[I_FFB][l * NH + h];
    LBAR();
    float loc[8]; float s = 0.f;
    bf16 xr[8];
#pragma unroll
    for (int i = 0; i < 8; ++i) xr[i] = proj[(rowb + 8 * tid + i) * NP + PC_FL + h];
#pragma unroll
    for (int i = 0; i < 8; ++i) { const float x = bf2f(xr[i]) + fb;
        const float e_ = __expf(-fabsf(x)); const float v = fminf(x, 0.f) - __logf(1.0f + e_); s += v; loc[i] = s; }
    float ws_ = s;
#pragma unroll
    for (int o = 1; o < 64; o <<= 1) { const float t_ = __shfl_up(ws_, o); if (lane >= o) ws_ += t_; }
    if (lane == 63) WT[wave] = ws_;
    LBAR();
    float base = ws_ - s;
    for (int w = 0; w < wave; ++w) base += WT[w];
    f32x4 o0 = {(base + loc[0]) * 1.4426950408889634f, (base + loc[1]) * 1.4426950408889634f, (base + loc[2]) * 1.4426950408889634f, (base + loc[3]) * 1.4426950408889634f};
    f32x4 o1 = {(base + loc[4]) * 1.4426950408889634f, (base + loc[5]) * 1.4426950408889634f, (base + loc[6]) * 1.4426950408889634f, (base + loc[7]) * 1.4426950408889634f};
    *(f32x4*)(cumg + 8 * tid) = o0; *(f32x4*)(cumg + 8 * tid + 4) = o1;
}
constexpr int B_K = 0, B_VT = 18432, B_CUM = 36864, B_WT = 53248;
__device__ __forceinline__ float max3f(float a, float b, float c) { float r; asm("v_max3_f32 %0, %1, %2, %3" : "=v"(r) : "v"(a), "v"(b), "v"(c)); return r; }
__device__ __forceinline__ float max_halves(float m) { auto rr = __builtin_amdgcn_permlane32_swap(__float_as_uint(m), __float_as_uint(m), false, false); return fmaxf(__uint_as_float(rr[0]), __uint_as_float(rr[1])); }
__device__ __forceinline__ float sum_halves(float m) { auto rr = __builtin_amdgcn_permlane32_swap(__float_as_uint(m), __float_as_uint(m), false, false); return __uint_as_float(rr[0]) + __uint_as_float(rr[1]); }
template <int MODE>
__device__ __forceinline__ void attn2_unit(const Ctx& C, int l, int b, int h, int qb) {
    KA_DECL; asm volatile("" : "+s"(l));
    const bf16* proj = (const bf16*)(A.ws + WS_PROJ); bf16* ycat = (bf16*)(A.ws + WS_YCAT);
    int tid = C.tid; asm volatile("" : "+v"(tid));
    const int lane = tid & 63, wave = C.wave, r32 = lane & 31, hi = lane >> 5;
    const int q0 = qb * 256; const size_t rowb = (size_t)b * T;
    const int qcol = (MODE == 0 ? PC_SQ : PC_FQ) + h * 64;
    const bf16* KN = (MODE == 0) ? (const bf16*)(A.ws + WS_KNS) + (h >> 2) * 64 : (const bf16*)(A.ws + WS_KNF) + h * 64;
    constexpr int KPI = (MODE == 0) ? 128 : 512;
    const bf16* VT = (MODE == 0) ? (const bf16*)(A.ws + WS_VTS) + (size_t)(b * 2 + (h >> 2)) * 64 * T : (const bf16*)(A.ws + WS_VTF) + (size_t)(b * 8 + h) * 64 * T;
    const float* qg = A.in[MODE == 0 ? I_SQG : I_FQG] + l * 64;
    LAS bf16* Ks = (LAS bf16*)(C.lds + B_K); LAS bf16* Vt = (LAS bf16*)(C.lds + B_VT); LAS float* cum = (LAS float*)(C.lds + B_CUM); LAS float* WT = (LAS float*)(C.lds + B_WT);
    constexpr float LOG2E = 1.4426950408889634f;
    LBAR();
    if (MODE == 1) {
        const float* cumg = (const float*)(A.ws + WS_CUM) + (size_t)(b * NH + h) * T;
        for (int i = tid; i < (q0 + 256) / 4; i += NTHREADS) *(LAS f32x4*)(cum + 4 * i) = *(const f32x4*)(cumg + 4 * i);
    }
    const int qp = q0 + 32 * wave + r32;
    bf16x8 qf[4];
    {
        const bf16* src = proj + (rowb + qp) * NP + qcol + 8 * hi;
        v4u raw[4]; float ss = 0.f;
#pragma unroll
        for (int s4 = 0; s4 < 4; ++s4) { raw[s4] = *(const v4u*)(src + 16 * s4);
            const float f0 = bflo(raw[s4].x), f1 = bfhi(raw[s4].x), f2 = bflo(raw[s4].y), f3 = bfhi(raw[s4].y), f4 = bflo(raw[s4].z), f5 = bfhi(raw[s4].z), f6 = bflo(raw[s4].w), f7 = bfhi(raw[s4].w);
            ss += ((f0 * f0 + f1 * f1) + (f2 * f2 + f3 * f3)) + ((f4 * f4 + f5 * f5) + (f6 * f6 + f7 * f7)); }
        ss = sum_halves(ss);
        const float rs = (0.125f * LOG2E) / sqrtf(ss * (1.0f / 64.0f) + 1e-6f);
#pragma unroll
        for (int s4 = 0; s4 < 4; ++s4) { const float* g8 = qg + 16 * s4 + 8 * hi; v4u o;
            o.x = pk2(bflo(raw[s4].x) * rs * g8[0], bfhi(raw[s4].x) * rs * g8[1]); o.y = pk2(bflo(raw[s4].y) * rs * g8[2], bfhi(raw[s4].y) * rs * g8[3]);
            o.z = pk2(bflo(raw[s4].z) * rs * g8[4], bfhi(raw[s4].z) * rs * g8[5]); o.w = pk2(bflo(raw[s4].w) * rs * g8[6], bfhi(raw[s4].w) * rs * g8[7]);
            qf[s4] = __builtin_bit_cast(bf16x8, o); }
    }
    int ks_begin = (MODE == 0) ? (q0 >= 128 ? q0 - 128 : 0) : 0; const int ks_end = q0 + 256;
    if (MODE == 1) {
        const float* cumg = (const float*)(A.ws + WS_CUM) + (size_t)(b * NH + h) * T;
        float gq = fabsf(qg[lane]), gk = fabsf(A.in[I_FKG][l * 64 + lane]);
#pragma unroll
        for (int o = 1; o < 64; o <<= 1) { gq = fmaxf(gq, __shfl_xor(gq, o)); gk = fmaxf(gk, __shfl_xor(gk, o)); }
        const float B2 = 8.0f * LOG2E * gq * gk * 1.05f;
        const int ntile = q0 >> 6;
        const bool skip = (lane < ntile) && (cumg[q0] - cumg[64 * lane + 63] + 2.0f * B2 < -172.0f);
        ks_begin = 64 * __builtin_popcountll(__ballot(skip));
    }
    const int srow = tid >> 3, sdc = (tid & 7) * 8;
    v4u kreg[2], vreg[2];
#define A2_LOAD(S_, ks_) do { kreg[S_] = *(const v4u*)(KN + (rowb + (ks_) + srow) * KPI + sdc); vreg[S_] = *(const v4u*)(VT + (size_t)srow * T + (ks_) + sdc); } while (0)
#define A2_STAGE(S_, buf_) do { *(LAS v4u*)(Ks + (buf_) * 64 * AP + srow * AP + sdc) = kreg[S_]; *(LAS v4u*)(Vt + (buf_) * 64 * AP + srow * AP + sdc) = vreg[S_]; } while (0)
    A2_LOAD(0, ks_begin); A2_LOAD(1, ks_begin + 64);
    A2_STAGE(0, 0);
    if (ks_begin + 128 < ks_end) A2_LOAD(0, ks_begin + 128);
    float m_run = -1e30f, l_run = 0.f;
    f32x16 o0, o1, cqv;
#pragma unroll
    for (int r = 0; r < 16; ++r) { o0[r] = 0.f; o1[r] = 0.f; cqv[r] = 0.f; }
    const int qmax = q0 + 32 * wave + 31, qmin = q0 + 32 * wave;
    int buf = 0;
    for (int ks = ks_begin; ks < ks_end; ks += 64, buf ^= 1) {
        LBAR();
        if (MODE == 1 && ks == ks_begin) { const float cq = cum[qp];
#pragma unroll
            for (int r = 0; r < 16; ++r) cqv[r] = cq; }
        if (ks + 64 < ks_end) { if (buf == 0) { A2_STAGE(1, 1); if (ks + 192 < ks_end) A2_LOAD(1, ks + 192); } else { A2_STAGE(0, 0); if (ks + 192 < ks_end) A2_LOAD(0, ks + 192); } }
        const bool live = (MODE == 1) ? (ks <= qmax) : (ks <= qmax && ks + 63 > qmin - 128);
        if (live) {
            const LAS bf16* kb = Ks + buf * 64 * AP + r32 * AP + 8 * hi;
            f32x16 p0, p1;
            __builtin_amdgcn_s_setprio(1);
#pragma unroll
            for (int s4 = 0; s4 < 4; ++s4) { const bf16x8 k0 = *(const LAS bf16x8*)(kb + 16 * s4), k1 = *(const LAS bf16x8*)(kb + 32 * AP + 16 * s4);
                if (s4 == 0) { p0 = __builtin_amdgcn_mfma_f32_32x32x16_bf16(k0, qf[0], cqv, 0, 0, 0); p1 = __builtin_amdgcn_mfma_f32_32x32x16_bf16(k1, qf[0], cqv, 0, 0, 0); }
                else { p0 = __builtin_amdgcn_mfma_f32_32x32x16_bf16(k0, qf[s4], p0, 0, 0, 0); p1 = __builtin_amdgcn_mfma_f32_32x32x16_bf16(k1, qf[s4], p1, 0, 0, 0); } }
            __builtin_amdgcn_s_setprio(0);
            if (MODE == 1) {
#pragma unroll
                for (int q4 = 0; q4 < 4; ++q4) { const f32x4 c0 = *(const LAS f32x4*)(cum + ks + 8 * q4 + 4 * hi), c1 = *(const LAS f32x4*)(cum + ks + 32 + 8 * q4 + 4 * hi);
                    p0[4 * q4] -= c0.x; p0[4 * q4 + 1] -= c0.y; p0[4 * q4 + 2] -= c0.z; p0[4 * q4 + 3] -= c0.w;
                    p1[4 * q4] -= c1.x; p1[4 * q4 + 1] -= c1.y; p1[4 * q4 + 2] -= c1.z; p1[4 * q4 + 3] -= c1.w; }
            }
            const bool edge = (MODE == 1) ? (ks + 63 > qmin) : true;
            if (edge) {
#pragma unroll
                for (int r = 0; r < 16; ++r) { const int k0p = ks + crow(r, hi), k1p = k0p + 32;
                    const bool ok0 = (MODE == 1) ? (k0p <= qp) : (k0p <= qp && k0p > qp - 128), ok1 = (MODE == 1) ? (k1p <= qp) : (k1p <= qp && k1p > qp - 128);
                    p0[r] = ok0 ? p0[r] : -1e30f; p1[r] = ok1 ? p1[r] : -1e30f; }
            }
            float mx = max3f(p0[0], p1[0], p0[1]);
#pragma unroll
            for (int r = 1; r < 15; r += 2) mx = max3f(mx, p1[r], p0[r + 1]), mx = max3f(mx, p1[r + 1], (r + 2 < 16) ? p0[r + 2] : p1[r + 1]);
            mx = max3f(mx, p1[15], p1[15]);
            mx = max_halves(mx);
            const float m_new = (mx > m_run + 8.0f) ? mx : m_run;
            float rsum = 0.f;
            if (MODE == 1) {
#pragma unroll
                for (int r = 0; r < 16; ++r) { p0[r] = __builtin_amdgcn_exp2f(p0[r] - m_new); p1[r] = __builtin_amdgcn_exp2f(p1[r] - m_new); }
                float ra = 0.f, rb = 0.f, rc = 0.f, rd = 0.f;
#pragma unroll
                for (int r = 0; r < 16; r += 2) { ra += p0[r]; rb += p1[r]; rc += p0[r + 1]; rd += p1[r + 1]; }
                rsum = (ra + rb) + (rc + rd);
            } else {
#pragma unroll
                for (int r = 0; r < 16; ++r) { p0[r] = (p0[r] > -1e29f) ? __builtin_amdgcn_exp2f(p0[r] - m_new) : 0.f; p1[r] = (p1[r] > -1e29f) ? __builtin_amdgcn_exp2f(p1[r] - m_new) : 0.f; rsum += p0[r] + p1[r]; }
            }
            if (__any(m_new != m_run)) {
                const float alpha = __builtin_amdgcn_exp2f(m_run - m_new);
                l_run *= alpha;
#pragma unroll
                for (int r = 0; r < 16; ++r) { o0[r] *= alpha; o1[r] *= alpha; }
                m_run = m_new;
            }
            l_run += rsum;
            bf16x8 pf[4];
            { v4u w;
              w.x = pk2(p0[0], p0[1]); w.y = pk2(p0[2], p0[3]); w.z = pk2(p0[4], p0[5]); w.w = pk2(p0[6], p0[7]); pf[0] = __builtin_bit_cast(bf16x8, w);
              w.x = pk2(p0[8], p0[9]); w.y = pk2(p0[10], p0[11]); w.z = pk2(p0[12], p0[13]); w.w = pk2(p0[14], p0[15]); pf[1] = __builtin_bit_cast(bf16x8, w);
              w.x = pk2(p1[0], p1[1]); w.y = pk2(p1[2], p1[3]); w.z = pk2(p1[4], p1[5]); w.w = pk2(p1[6], p1[7]); pf[2] = __builtin_bit_cast(bf16x8, w);
              w.x = pk2(p1[8], p1[9]); w.y = pk2(p1[10], p1[11]); w.z = pk2(p1[12], p1[13]); w.w = pk2(p1[14], p1[15]); pf[3] = __builtin_bit_cast(bf16x8, w); }
            const LAS bf16* vb = Vt + buf * 64 * AP + r32 * AP + 4 * hi;
            __builtin_amdgcn_s_setprio(1);
#pragma unroll
            for (int ks4 = 0; ks4 < 4; ++ks4) {
                const v2u a0 = *(const LAS v2u*)(vb + 16 * ks4), a1 = *(const LAS v2u*)(vb + 16 * ks4 + 8), b0 = *(const LAS v2u*)(vb + 32 * AP + 16 * ks4), b1 = *(const LAS v2u*)(vb + 32 * AP + 16 * ks4 + 8);
                const v4u fa = {a0.x, a0.y, a1.x, a1.y}, fb = {b0.x, b0.y, b1.x, b1.y};
                o0 = __builtin_amdgcn_mfma_f32_32x32x16_bf16(__builtin_bit_cast(bf16x8, fa), pf[ks4], o0, 0, 0, 0);
                o1 = __builtin_amdgcn_mfma_f32_32x32x16_bf16(__builtin_bit_cast(bf16x8, fb), pf[ks4], o1, 0, 0, 0); }
            __builtin_amdgcn_s_setprio(0);
        }
    }
#undef A2_LOAD
#undef A2_STAGE
    float l_tot = sum_halves(l_run);
    if (MODE == 0) l_tot += __builtin_amdgcn_exp2f(A.in[I_SSINK][l * NH + h] * LOG2E - m_run);
    const float inv = 1.0f / l_tot;
    const size_t m = rowb + qp; bf16* orow = ycat + m * D + (MODE == 0 ? YC_B : YC_D) + h * 64;
    v2u gq0[4], gq1[4];
    if (MODE == 1) { const bf16* gp = proj + m * NP + PC_FG + h * 64;
#pragma unroll
        for (int q4 = 0; q4 < 4; ++q4) { gq0[q4] = *(const v2u*)(gp + 8 * q4 + 4 * hi); gq1[q4] = *(const v2u*)(gp + 32 + 8 * q4 + 4 * hi); } }
#pragma unroll
    for (int q4 = 0; q4 < 4; ++q4) {
        float v0[4] = {o0[4 * q4] * inv, o0[4 * q4 + 1] * inv, o0[4 * q4 + 2] * inv, o0[4 * q4 + 3] * inv}, v1[4] = {o1[4 * q4] * inv, o1[4 * q4 + 1] * inv, o1[4 * q4 + 2] * inv, o1[4 * q4 + 3] * inv};
        const int d0 = 8 * q4 + 4 * hi;
        if (MODE == 1) { const v2u g0 = gq0[q4], g1 = gq1[q4];
            v0[0] *= sigmoidf_(bflo(g0.x)); v0[1] *= sigmoidf_(bfhi(g0.x)); v0[2] *= sigmoidf_(bflo(g0.y)); v0[3] *= sigmoidf_(bfhi(g0.y));
            v1[0] *= sigmoidf_(bflo(g1.x)); v1[1] *= sigmoidf_(bfhi(g1.x)); v1[2] *= sigmoidf_(bflo(g1.y)); v1[3] *= sigmoidf_(bfhi(g1.y)); }
        v2u w0, w1; w0.x = pk2(v0[0], v0[1]); w0.y = pk2(v0[2], v0[3]); w1.x = pk2(v1[0], v1[1]); w1.y = pk2(v1[2], v1[3]);
        *(v2u*)(orow + d0) = w0; *(v2u*)(orow + 32 + d0) = w1; }
}
constexpr int GP = 136;
constexpr int G_W = 0, G_VT = 34816, G_ST = 52224;
__device__ __forceinline__ void sgu_unit(const Ctx& C, int l, int b, int chunk, int ghalf) {
    KA_DECL; asm volatile("" : "+s"(l));
    const bf16* proj = (const bf16*)(A.ws + WS_PROJ); bf16* ycat = (bf16*)(A.ws + WS_YCAT);
    int tid = C.tid; asm volatile("" : "+v"(tid));
    const int lane = tid & 63, wave = C.wave, r32 = lane & 31, hi = lane >> 5;
    const size_t m0 = (size_t)b * T + chunk * 128;
    LAS bf16* Wd = (LAS bf16*)(C.lds + G_W); LAS bf16* Vt = (LAS bf16*)(C.lds + G_VT); LAS float* ST = (LAS float*)(C.lds + G_ST);
    LBAR();
    {
        const int tok = tid >> 2, part = tid & 3; const v4u* src = (const v4u*)(proj + (m0 + tok) * NP + PC_GV + part * 128);
        float s1 = 0.f, s2 = 0.f;
#pragma unroll 4
        for (int i = 0; i < 16; ++i) { const v4u w = src[i];
            const float e0 = gelu_f(bflo(w.x)), e1 = gelu_f(bfhi(w.x)), e2 = gelu_f(bflo(w.y)), e3 = gelu_f(bfhi(w.y)), e4 = gelu_f(bflo(w.z)), e5 = gelu_f(bfhi(w.z)), e6 = gelu_f(bflo(w.w)), e7 = gelu_f(bfhi(w.w));
            s1 += ((e0 + e1) + (e2 + e3)) + ((e4 + e5) + (e6 + e7));
            s2 += ((e0 * e0 + e1 * e1) + (e2 * e2 + e3 * e3)) + ((e4 * e4 + e5 * e5) + (e6 * e6 + e7 * e7)); }
        s1 += __shfl_xor(s1, 1); s1 += __shfl_xor(s1, 2); s2 += __shfl_xor(s2, 1); s2 += __shfl_xor(s2, 2);
        const float mean = s1 * (1.0f / 512.0f), var = fmaxf(s2 * (1.0f / 512.0f) - mean * mean, 0.f);
        if (part == 0) { ST[2 * tok] = mean; ST[2 * tok + 1] = 1.0f / sqrtf(var + 1e-5f); }
    }
    LBAR();
    const int ti = wave >> 1, cj = wave & 1;
    for (int gi = 0; gi < 4; ++gi) {
        const int g = ghalf * 4 + gi;
        {
            const int row = tid >> 2, s0 = (tid & 3) * 32; const float* wsrc = A.in[I_GWS] + (size_t)(l * NH + g) * SGU_TRI + (row * (row + 1)) / 2;
            float wv[32];
#pragma unroll
            for (int i = 0; i < 32; ++i) { const int s_ = s0 + i; wv[i] = wsrc[s_ <= row ? s_ : row]; }
#pragma unroll
            for (int i = 0; i < 32; i += 2) { const int s_ = s0 + i; *(LAS unsigned*)(Wd + row * GP + s_) = pk2((s_ <= row) ? wv[i] : 0.f, (s_ + 1 <= row) ? wv[i + 1] : 0.f); }
        }
        {
            const int tok = tid >> 2, c0 = (tid & 3) * 16; const v4u* src = (const v4u*)(proj + (m0 + tok) * NP + PC_GV + g * 64 + c0);
            const v4u r0 = src[0], r1 = src[1]; const float mean = ST[2 * tok], rstd = ST[2 * tok + 1];
            const float* lg = A.in[I_GLG] + l * GW + g * 64 + c0; const float* lb = A.in[I_GLB] + l * GW + g * 64 + c0;
            float f[16];
            f[0] = bflo(r0.x); f[1] = bfhi(r0.x); f[2] = bflo(r0.y); f[3] = bfhi(r0.y); f[4] = bflo(r0.z); f[5] = bfhi(r0.z); f[6] = bflo(r0.w); f[7] = bfhi(r0.w);
            f[8] = bflo(r1.x); f[9] = bfhi(r1.x); f[10] = bflo(r1.y); f[11] = bfhi(r1.y); f[12] = bflo(r1.z); f[13] = bfhi(r1.z); f[14] = bflo(r1.w); f[15] = bfhi(r1.w);
#pragma unroll
            for (int i = 0; i < 16; ++i) { const float y = (gelu_f(f[i]) - mean) * rstd * lg[i] + lb[i]; Vt[(c0 + i) * GP + tok] = (bf16)f2bf(y); }
        }
        bf16 ur[16]; float bsv[16];
        {
            const float* bs = A.in[I_GB] + (size_t)(l * NH + g) * 128;
#pragma unroll
            for (int r = 0; r < 16; ++r) { ur[r] = proj[(m0 + 32 * ti + crow(r, hi)) * NP + PC_GU + g * 64 + 32 * cj + r32]; bsv[r] = bs[32 * ti + crow(r, hi)]; }
        }
        LBAR();
        {
            f32x16 acc;
#pragma unroll
            for (int r = 0; r < 16; ++r) acc[r] = 0.f;
            acc = mma32(Wd + (32 * ti + r32) * GP + 8 * hi, Vt + (32 * cj + r32) * GP + 8 * hi, 2 * (ti + 1), acc);
#pragma unroll
            for (int r = 0; r < 16; ++r) { const int t = 32 * ti + crow(r, hi), c = 32 * cj + r32; const size_t m = m0 + t;
                const float z = acc[r] + bsv[r], u = gelu_f(bf2f(ur[r]));
                ycat[m * D + YC_C + g * 64 + c] = (bf16)f2bf(u * z); }
        }
        LBAR();
    }
}
constexpr int TP = 72;
constexpr int LP = 168;
constexpr int R_AH = 0, R_RH = 9216, R_BT = 18432, R_KT = 27648, R_VT = 36864, R_BH = 46080, R_KH = 55296, R_RHS = 46080  ;
constexpr int R_LR = 64512  , R_NP = 64512  , R_NK = 80896, R_BR = 90112, R_KR = 99328, R_W1 = 108544, R_W2 = 117760, R_GT = 126976;
__device__ __forceinline__ float shifted(const bf16* proj, size_t m, int t, int col, float mu) {
    const float p = bf2f(proj[m * NP + col]); const float pp = (t > 0) ? bf2f(proj[(m - 1) * NP + col]) : 0.f; return p + (pp - p) * mu;
}
__device__ __forceinline__ void subst_cols(const bool FROM_RHS, const LAS float* NPm, const LAS float* RHS, const LAS bf16* tAH, LAS bf16* tW, int wave, int lane) {
    const int cl = lane >> 2, p = lane & 3, col = (16 * wave + cl) & 63;
    float xs[16], rh[16];
#pragma unroll
    for (int q = 0; q < 16; ++q) xs[q] = 0.f;
    if (FROM_RHS) {
#pragma unroll
        for (int q = 0; q < 16; ++q) rh[q] = RHS[(4 * q + p) * 64 + col];
    } else {
#pragma unroll
        for (int q = 0; q < 16; ++q) rh[q] = bf2f(tAH[(4 * q + p) * TP + col]);
    }
    const LAS float* np_ = NPm + p * 16;
    f32x4 nv[4], nn[4];
#pragma unroll
    for (int q4 = 0; q4 < 4; ++q4) nv[q4] = (f32x4){0.f, 0.f, 0.f, 0.f};
#pragma unroll
    for (int t = 0; t < 64; ++t) {
        if (t + 1 < 64) {
#pragma unroll
            for (int q4 = 0; q4 < (t + 16) / 16; ++q4) nn[q4] = *(const LAS f32x4*)(np_ + (t + 1) * 64 + 4 * q4);
        }
        float part = 0.f, part2 = 0.f;
#pragma unroll
        for (int q4 = 0; q4 < (t + 15) / 16; ++q4) {
            if (q4 & 1) part2 += (nv[q4].x * xs[4 * q4] + nv[q4].y * xs[4 * q4 + 1]) + (nv[q4].z * xs[4 * q4 + 2] + nv[q4].w * xs[4 * q4 + 3]);
            else part += (nv[q4].x * xs[4 * q4] + nv[q4].y * xs[4 * q4 + 1]) + (nv[q4].z * xs[4 * q4 + 2] + nv[q4].w * xs[4 * q4 + 3]); }
        part += part2;
        part += dpp_xor1(part); part += dpp_xor2(part);
        xs[t >> 2] = (p == (t & 3)) ? rh[t >> 2] + part : xs[t >> 2];
#pragma unroll
        for (int q4 = 0; q4 < 4; ++q4) nv[q4] = nn[q4];
        asm volatile("" ::: "memory");
    }
    LAS bf16* wt = tW + col * TP;
#pragma unroll
    for (int q = 0; q < 16; ++q) wt[4 * q + p] = (bf16)f2bf(xs[q]);
}
__device__ __forceinline__ void rwkv_chunk_unit(const Ctx& C, int l, int b, int c, int h) {
    KA_DECL; asm volatile("" : "+s"(l));
    const bf16* proj = (const bf16*)(A.ws + WS_PROJ);
    int tid = C.tid; asm volatile("" : "+v"(tid));
    const int lane = tid & 63, wave = C.wave, r32 = lane & 31, hi = lane >> 5;
    const size_t m0 = (size_t)b * T + 64 * c; const int t0 = 64 * c; const size_t pair = (size_t)(b * NH + h) * 64 + c;
    LAS unsigned char* L = C.lds;
    LAS bf16* tAH = (LAS bf16*)(L + R_AH); LAS bf16* tRH = (LAS bf16*)(L + R_RH); LAS bf16* tBT = (LAS bf16*)(L + R_BT); LAS bf16* tKT = (LAS bf16*)(L + R_KT); LAS bf16* tVT = (LAS bf16*)(L + R_VT);
    LAS bf16* tBH = (LAS bf16*)(L + R_BH); LAS bf16* tKH = (LAS bf16*)(L + R_KH); LAS float* RHS = (LAS float*)(L + R_RHS); LAS float* LR = (LAS float*)(L + R_LR); LAS float* NPm = (LAS float*)(L + R_NP);
    LAS bf16* tNK = (LAS bf16*)(L + R_NK); LAS bf16* tBR = (LAS bf16*)(L + R_BR); LAS bf16* tKR = (LAS bf16*)(L + R_KR); LAS bf16* tW1 = (LAS bf16*)(L + R_W1); LAS bf16* tW2 = (LAS bf16*)(L + R_W2);
    LAS float* GT = (LAS float*)(L + R_GT);
    const float* mu = A.in[I_RMU] + l * 1696;
    bf16 rraw[9], kraw[9], vraw[9];
    { const int tfirst = t0 + 8 * wave; const size_t mfirst = m0 + 8 * wave; const int cgl = h * 64 + lane;
#pragma unroll
        for (int k = 0; k < 9; ++k) { const size_t mr = (k == 0 && tfirst == 0) ? mfirst : mfirst + k - 1;
            rraw[k] = proj[mr * NP + PC_RR + cgl]; kraw[k] = proj[mr * NP + PC_RK + cgl]; vraw[k] = proj[mr * NP + PC_RV + cgl]; } }
    LAS bf16* LRb = (LAS bf16*)(L + R_LR);
    LAS bf16* Wt = (LAS bf16*)(L + R_LR + 64 * LP * 2);
    LAS float* OUT = (LAS float*)L;
    LBAR();
    {
        float xv[12];
#pragma unroll
        for (int i = 0; i < 4; ++i) { const int e = tid + NTHREADS * i, tok = e >> 5, j = e & 31; xv[i] = shifted(proj, m0 + tok, t0 + tok, PC_RW + j, mu[1536 + j]); }
#pragma unroll
        for (int i = 0; i < 4; ++i) { const int e = tid + NTHREADS * i, tok = e >> 5, j = e & 31;
            LRb[tok * LP + j] = (bf16)f2bf(1.0f - 2.0f * __builtin_amdgcn_rcpf(__expf(2.0f * xv[i]) + 1.0f)); }
#pragma unroll
        for (int i = 0; i < 4; ++i) { const int e = tid + NTHREADS * i, tok = e >> 5, j = 32 + (e & 31); xv[i] = shifted(proj, m0 + tok, t0 + tok, PC_RW + j, mu[1536 + j]); }
#pragma unroll
        for (int i = 0; i < 4; ++i) { const int e = tid + NTHREADS * i, tok = e >> 5, j = 32 + (e & 31); LRb[tok * LP + j] = (bf16)f2bf(xv[i]); }
#pragma unroll
        for (int i = 0; i < 12; ++i) { const int e = tid + NTHREADS * i, tok = e / 96, j = 64 + e % 96; xv[i] = shifted(proj, m0 + tok, t0 + tok, PC_RW + j, mu[1536 + j]); }
#pragma unroll
        for (int i = 0; i < 12; ++i) { const int e = tid + NTHREADS * i, tok = e / 96, j = 64 + e % 96; LRb[tok * LP + j] = (bf16)f2bf(sigmoidf_(xv[i])); }
        float wv[20];
#pragma unroll
        for (int i = 0; i < 20; ++i) { const int e = tid + NTHREADS * i, ch = e & 63, m = e >> 6;
            wv[i] = (m < 32) ? A.in[I_RW2][((size_t)l * 32 + m) * GW + h * 64 + ch] : ((m < 64) ? A.in[I_RA2][((size_t)l * 32 + (m - 32)) * GW + h * 64 + ch] : A.in[I_RG2][((size_t)l * 96 + (m - 64)) * GW + h * 64 + ch]); }
#pragma unroll
        for (int i = 0; i < 20; ++i) { const int e = tid + NTHREADS * i, ch = e & 63, m = e >> 6; Wt[ch * LP + m] = (bf16)f2bf(wv[i]); }
    }
    LBAR();
    {
        const int rt = (wave >> 1) & 1, ct = wave & 1;
        const LAS bf16* Ap = LRb + (32 * rt + r32) * LP + 8 * hi; const LAS bf16* Bp = Wt + (32 * ct + r32) * LP + 8 * hi;
        f32x16 acc, acc2;
#pragma unroll
        for (int r = 0; r < 16; ++r) { acc[r] = 0.f; acc2[r] = 0.f; }
        if (wave < 4) { acc = mma32(Ap, Bp, 2, acc); acc2 = mma32(Ap + 32, Bp + 32, 2, acc2); }
        else acc = mma32(Ap + 64, Bp + 64, 6, acc);
#pragma unroll
        for (int r = 0; r < 16; ++r) { const int o = (32 * rt + crow(r, hi)) * 64 + 32 * ct + r32;
            if (wave < 4) { OUT[o] = acc[r]; OUT[4096 + o] = acc2[r]; } else OUT[8192 + o] = acc[r]; }
    }
    LBAR();
    const int cg = h * 64 + lane, tg = wave;
    float rr[8], kp[8], vv[8], na[8], bb[8], pg[8];
    {
        float aw[8], aa[8], ag[8];
#pragma unroll
        for (int k = 0; k < 8; ++k) { const int o = (8 * tg + k) * 64 + lane; aw[k] = OUT[o]; aa[k] = OUT[4096 + o]; ag[k] = OUT[8192 + o]; }
        const float w0 = A.in[I_RW0][l * GW + cg], a0 = A.in[I_RA0][l * GW + cg], kkc = A.in[I_RKK][l * GW + cg], kac = A.in[I_RKA][l * GW + cg], rkc = A.in[I_RRK][l * GW + cg];
        const float mur = mu[cg], muk = mu[512 + cg], muv = mu[1024 + cg];
        float* rg = (float*)(A.ws + WS_RG); float* rbv = (float*)(A.ws + WS_RBV);
        float run = 0.f;
#pragma unroll
        for (int k = 0; k < 8; ++k) { const size_t m = m0 + 8 * tg + k; const int t = t0 + 8 * tg + k;
            const float hasp = (t > 0) ? 1.0f : 0.0f;
            const float rp_ = bf2f(rraw[k + 1]), kp_ = bf2f(kraw[k + 1]), vp_ = bf2f(vraw[k + 1]);
            const float r = rp_ + (bf2f(rraw[k]) * hasp - rp_) * mur, kx = kp_ + (bf2f(kraw[k]) * hasp - kp_) * muk, v = vp_ + (bf2f(vraw[k]) * hasp - vp_) * muv;
            run += -0.6065306597126334f * sigmoidf_(w0 + aw[k]); pg[k] = run;
            const float ia = sigmoidf_(a0 + aa[k]);
            float kk = kx * kkc; const float n2 = wave_sum_dpp(kk * kk); kk = kk * __builtin_amdgcn_rsqf(fmaxf(n2, 1e-24f));
            const float kpv = kx * (1.0f + (ia - 1.0f) * kac);
            const float bonus = wave_sum_dpp(r * kpv * rkc);
            rg[m * GW + cg] = ag[k]; rbv[m * GW + cg] = bonus * v * ag[k];
            rr[k] = r; kp[k] = kpv; vv[k] = v; na[k] = -kk; bb[k] = kk * ia; }
        GT[tg * 64 + lane] = run;
    }
    LBAR();
    {
        float off = 0.f, gL = 0.f;
#pragma unroll
        for (int w = 0; w < 8; ++w) { const float x = GT[w * 64 + lane]; gL += x; off += (w < tg) ? x : 0.f; }
        float bt[8], kt[8];
#pragma unroll
        for (int k = 0; k < 8; ++k) { const int t = 8 * tg + k; const float g = off + pg[k], gp = off + (k > 0 ? pg[k - 1] : 0.f);
            const float eg = __expf(g), egp = __expf(gp), ei = __expf(-g), eL = __expf(gL - g);
            tAH[t * TP + lane] = (bf16)f2bf(na[k] * egp); tRH[t * TP + lane] = (bf16)f2bf(rr[k] * eg); tBH[t * TP + lane] = (bf16)f2bf(bb[k] * ei); tKH[t * TP + lane] = (bf16)f2bf(kp[k] * ei);
            bt[k] = bb[k] * eL; kt[k] = kp[k] * eL; }
        v4u o; o.x = pk2(bt[0], bt[1]); o.y = pk2(bt[2], bt[3]); o.z = pk2(bt[4], bt[5]); o.w = pk2(bt[6], bt[7]); *(LAS v4u*)(tBT + lane * TP + 8 * tg) = o;
        o.x = pk2(kt[0], kt[1]); o.y = pk2(kt[2], kt[3]); o.z = pk2(kt[4], kt[5]); o.w = pk2(kt[6], kt[7]); *(LAS v4u*)(tKT + lane * TP + 8 * tg) = o;
        o.x = pk2(vv[0], vv[1]); o.y = pk2(vv[2], vv[3]); o.z = pk2(vv[4], vv[5]); o.w = pk2(vv[6], vv[7]); *(LAS v4u*)(tVT + lane * TP + 8 * tg) = o;
        if (tg == 0) ((float*)(A.ws + WS_GL))[pair * 64 + lane] = __expf(gL);
    }
    LBAR();
    {
        const int mi = wave >> 1, rt = wave & 1;
        const LAS bf16* Am = (mi < 2) ? tAH : tRH; const LAS bf16* Bm = (mi & 1) ? tKH : tBH;
        for (int ct = 0; ct < 2; ++ct) {
            f32x16 acc;
#pragma unroll
            for (int r = 0; r < 16; ++r) acc[r] = 0.f;
            if (!(rt == 0 && ct == 1)) acc = mma32(Am + (32 * rt + r32) * TP + 8 * hi, Bm + (32 * ct + r32) * TP + 8 * hi, 4, acc);
#pragma unroll
            for (int r = 0; r < 16; ++r) { const int t = 32 * rt + crow(r, hi), s = 32 * ct + r32;
                const bool keep = (mi < 2) ? (s < t) : (s <= t); const float val = keep ? acc[r] : 0.f;
                if (mi == 0) NPm[t * 64 + (s & 3) * 16 + (s >> 2)] = val;
                else { LAS bf16* dst = (mi == 1) ? tNK : ((mi == 2) ? tBR : tKR); dst[t * TP + s] = (bf16)f2bf(val); } }
        }
    }
    LBAR();
    if (wave < 4) {
        const int rt = wave >> 1, ct = wave & 1;
        f32x16 acc;
#pragma unroll
        for (int r = 0; r < 16; ++r) acc[r] = 0.f;
        acc = mma32(tNK + (32 * rt + r32) * TP + 8 * hi, tVT + (32 * ct + r32) * TP + 8 * hi, 2 * (rt + 1), acc);
#pragma unroll
        for (int r = 0; r < 16; ++r) RHS[(32 * rt + crow(r, hi)) * 64 + 32 * ct + r32] = acc[r];
    }
    LBAR();
    subst_cols(wave < 4, NPm, RHS, tAH, (wave < 4) ? tW1 : tW2, wave, lane);
    LBAR();
    {
        const int kind = wave >> 1, rt = wave & 1;
        bf16* RTg = (bf16*)(A.ws + WS_RT) + pair * 4096; bf16* PAg = (bf16*)(A.ws + WS_PA) + pair * 4096;
        float* YFg = (float*)(A.ws + WS_YF) + pair * 4096; float* QFg = (float*)(A.ws + WS_QF) + pair * 4096;
        for (int ct = 0; ct < 2; ++ct) {
            f32x16 acc;
            if (kind == 0) {
#pragma unroll
                for (int r = 0; r < 16; ++r) acc[r] = bf2f(tRH[(32 * rt + crow(r, hi)) * TP + 32 * ct + r32]);
                acc = mma32(tBR + (32 * rt + r32) * TP + 8 * hi, tW2 + (32 * ct + r32) * TP + 8 * hi, 2 * (rt + 1), acc);
#pragma unroll
                for (int r = 0; r < 16; ++r) RTg[(32 * rt + crow(r, hi)) * 64 + 32 * ct + r32] = (bf16)f2bf(acc[r]);
            } else if (kind == 1) {
#pragma unroll
                for (int r = 0; r < 16; ++r) acc[r] = 0.f;
                acc = mma32(tBR + (32 * rt + r32) * TP + 8 * hi, tW1 + (32 * ct + r32) * TP + 8 * hi, 2 * (rt + 1), acc);
                acc = mma32(tKR + (32 * rt + r32) * TP + 8 * hi, tVT + (32 * ct + r32) * TP + 8 * hi, 2 * (rt + 1), acc);
                f32x4* dst = (f32x4*)(YFg + (rt * 2 + ct) * 1024 + lane * 16);
#pragma unroll
                for (int q = 0; q < 4; ++q) dst[q] = (f32x4){acc[4 * q], acc[4 * q + 1], acc[4 * q + 2], acc[4 * q + 3]};
            } else if (kind == 2) {
#pragma unroll
                for (int r = 0; r < 16; ++r) acc[r] = 0.f;
                acc = mma32(tBT + (32 * rt + r32) * TP + 8 * hi, tW2 + (32 * ct + r32) * TP + 8 * hi, 4, acc);
#pragma unroll
                for (int r = 0; r < 16; ++r) PAg[(32 * rt + crow(r, hi)) * 64 + 32 * ct + r32] = (bf16)f2bf(acc[r]);
            } else {
#pragma unroll
                for (int r = 0; r < 16; ++r) acc[r] = 0.f;
                acc = mma32(tBT + (32 * rt + r32) * TP + 8 * hi, tW1 + (32 * ct + r32) * TP + 8 * hi, 4, acc);
                acc = mma32(tKT + (32 * rt + r32) * TP + 8 * hi, tVT + (32 * ct + r32) * TP + 8 * hi, 4, acc);
                f32x4* dst = (f32x4*)(QFg + (rt * 2 + ct) * 1024 + lane * 16);
#pragma unroll
                for (int q = 0; q < 4; ++q) dst[q] = (f32x4){acc[4 * q], acc[4 * q + 1], acc[4 * q + 2], acc[4 * q + 3]};
            }
        }
    }
}
__device__ __forceinline__ void rwkv_seq_unit(const Ctx& C, int bh) {
    KA_DECL;
    const int tid = C.tid, lane = C.lane, wave = C.wave, r32 = lane & 31, hi = lane >> 5;
    const bool zw = wave < 4; const int w4 = wave & 3, rt = w4 >> 1, ct = w4 & 1;
    LAS bf16* Zb = (LAS bf16*)C.lds;
    const bf16* Ag = (const bf16*)(A.ws + (zw ? WS_PA : WS_RT)) + (size_t)bh * 64 * 4096 + (32 * rt + r32) * 64 + 8 * hi;
    const float* Cg = (const float*)(A.ws + (zw ? WS_QF : WS_YF)) + (size_t)bh * 64 * 4096 + (rt * 2 + ct) * 1024 + lane * 16;
    const float* GLg = (const float*)(A.ws + WS_GL) + (size_t)bh * 64 * 64 + 32 * rt + 4 * hi;
    float* ry = (float*)(A.ws + WS_RY) + (size_t)(bh >> 3) * T * GW + (bh & 7) * 64;
    f32x16 Z;
#pragma unroll
    for (int r = 0; r < 16; ++r) Z[r] = 0.f;
    LBAR();
    for (int i = tid; i < 64 * TP; i += NTHREADS) Zb[i] = 0;
    LBAR();
    LAS float* GLs = (LAS float*)(C.lds + 2 * 64 * TP * 2);
    { const float* gsrc = (const float*)(A.ws + WS_GL) + (size_t)bh * 64 * 64; for (int i = tid; i < 64 * 64 / 4; i += NTHREADS) *(LAS f32x4*)(GLs + 4 * i) = *(const f32x4*)(gsrc + 4 * i); }
    LBAR();
    const LAS float* glp = GLs + 32 * rt + 4 * hi;
    LAS float* ypatch = (LAS float*)(C.lds + 2 * 64 * TP * 2 + 64 * 64 * 4) + (wave & 3) * (32 * 36);
    float* ryl = ry + (size_t)(32 * rt + (lane >> 3)) * GW + 32 * ct + 4 * (lane & 7); const LAS float* ypl = ypatch + (lane >> 3) * 36 + 4 * (lane & 7);
    bf16x8 af[4][4]; f32x4 ci[4][4];
#define SEQ_LOAD(S, cc) do { const int c_ = (cc) < 64 ? (cc) : 63; _Pragma("unroll") for (int k = 0; k < 4; ++k) { af[S][k] = *(const bf16x8*)(Ag + (size_t)c_ * 4096 + 16 * k); \
        ci[S][k] = *(const f32x4*)(Cg + (size_t)c_ * 4096 + 4 * k); } } while (0)
#define SEQ_STEP(c, S, SN) do { \
        if ((c) + 3 < 64) SEQ_LOAD(SN, (c) + 3); \
        f32x16 acc; \
        _Pragma("unroll") for (int q = 0; q < 4; ++q) { acc[4 * q] = ci[S][q].x; acc[4 * q + 1] = ci[S][q].y; acc[4 * q + 2] = ci[S][q].z; acc[4 * q + 3] = ci[S][q].w; } \
        if (zw) { _Pragma("unroll") for (int q = 0; q < 4; ++q) { const f32x4 g4 = *(const LAS f32x4*)(glp + (c) * 64 + 8 * q); \
            acc[4 * q] += g4.x * Z[4 * q]; acc[4 * q + 1] += g4.y * Z[4 * q + 1]; acc[4 * q + 2] += g4.z * Z[4 * q + 2]; acc[4 * q + 3] += g4.w * Z[4 * q + 3]; } } \
        const LAS bf16* Bp = Zb + ((c) & 1) * 64 * TP + (32 * ct + r32) * TP + 8 * hi; \
        _Pragma("unroll") for (int k = 0; k < 4; ++k) { const bf16x8 bfr = *(const LAS bf16x8*)(Bp + 16 * k); acc = __builtin_amdgcn_mfma_f32_32x32x16_bf16(af[S][k], bfr, acc, 0, 0, 0); } \
        if (zw) { Z = acc; LAS bf16* Zn = Zb + (((c) + 1) & 1) * 64 * TP + (32 * ct + r32) * TP + 32 * rt + 4 * hi; \
            _Pragma("unroll") for (int q = 0; q < 4; ++q) { v2u w; w.x = pk2(acc[4 * q], acc[4 * q + 1]); w.y = pk2(acc[4 * q + 2], acc[4 * q + 3]); *(LAS v2u*)(Zn + 8 * q) = w; } } \
        else {   \
            _Pragma("unroll") for (int r = 0; r < 16; ++r) ypatch[crow(r, hi) * 36 + r32] = acc[r]; \
            asm volatile("s_waitcnt lgkmcnt(0)" ::: "memory"); \
            GAS float* ryc = (GAS float*)(ryl + (size_t)(64 * (c)) * GW); asm volatile("" : "+v"(ryc));     \
            _Pragma("unroll") for (int j = 0; j < 4; ++j) *(GAS f32x4*)(ryc + (size_t)(8 * j) * GW) = *(const LAS f32x4*)(ypl + 8 * j * 36); \
            asm volatile("s_waitcnt lgkmcnt(0)" ::: "memory"); } \
        asm volatile("s_waitcnt lgkmcnt(0)" ::: "memory"); __builtin_amdgcn_s_barrier(); asm volatile("" ::: "memory"); } while (0)
    SEQ_LOAD(0, 0); SEQ_LOAD(1, 1); SEQ_LOAD(2, 2);
#define SEQ_4(c) SEQ_STEP(c, 0, 3); SEQ_STEP((c) + 1, 1, 0); SEQ_STEP((c) + 2, 2, 1); SEQ_STEP((c) + 3, 3, 2);
    SEQ_4(0) SEQ_4(4) SEQ_4(8) SEQ_4(12) SEQ_4(16) SEQ_4(20) SEQ_4(24) SEQ_4(28) SEQ_4(32) SEQ_4(36) SEQ_4(40) SEQ_4(44) SEQ_4(48) SEQ_4(52) SEQ_4(56) SEQ_4(60)
#undef SEQ_4
#undef SEQ_LOAD
#undef SEQ_STEP
}
__device__ __forceinline__ void rwkv_post_bh(const Ctx& C, int l, int bh, int tbeg, int tend) {
    KA_DECL;
    const int lane = C.lane, wave = C.wave, b = bh >> 3, h = bh & 7, ch = h * 64 + lane;
    const float* RY = (const float*)(A.ws + WS_RY) + (size_t)b * T * GW + ch; const float* RG = (const float*)(A.ws + WS_RG) + (size_t)b * T * GW + ch; const float* RBV = (const float*)(A.ws + WS_RBV) + (size_t)b * T * GW + ch;
    bf16* yc = (bf16*)(A.ws + WS_YCAT) + (size_t)b * T * D + YC_A + ch;
    const float lg = A.in[I_RLG][l * GW + ch], lb = A.in[I_RLB][l * GW + ch];
    for (int t0 = tbeg + 16 * wave; t0 < tend; t0 += 16 * NWAVES) {
        float y[16], g[16], bv[16];
#pragma unroll
        for (int k = 0; k < 16; ++k) { y[k] = RY[(size_t)(t0 + k) * GW]; g[k] = RG[(size_t)(t0 + k) * GW]; bv[k] = RBV[(size_t)(t0 + k) * GW]; }
#pragma unroll
        for (int k = 0; k < 16; ++k) {
            const float mean = wave_sum_dpp(y[k]) * (1.0f / 64.0f), d = y[k] - mean, var = wave_sum_dpp(d * d) * (1.0f / 64.0f);
            const float yn = d * __builtin_amdgcn_rsqf(var + 64e-5f) * lg + lb;
            yc[(size_t)(t0 + k) * D] = (bf16)f2bf(yn * g[k] + bv[k]); }
    }
}
#ifndef REP_CHUNK
#define REP_CHUNK 1
#endif
#ifndef REP_SWA
#define REP_SWA 1
#endif
#ifndef REP_SGU
#define REP_SGU 1
#endif
#ifndef REP_GIN
#define REP_GIN 1
#endif
#ifndef REP_SCAN
#define REP_SCAN 1
#endif
#ifndef REP_FOX
#define REP_FOX 1
#endif
__device__ __forceinline__ void ph_mix1(const Ctx& C, int l) {
    for (int rep = 0; rep < REP_CHUNK; ++rep) for (int u = C.bid; u < 2048; u += C.G) rwkv_chunk_unit(C, l, u >> 9, (u >> 3) & 63, u & 7);
    for (int v = C.bid; v < 256; v += C.G) kvprep_unit(C, l, v);
    for (int v = C.bid; v < 32; v += C.G) cumprep_unit(C, l, v);
}
constexpr int CW_Q = 8192;
constexpr int CW_SEQF = 9216;
__device__ __forceinline__ void ph_mix2(const Ctx& C, int l) {
    KA_DECL;
    unsigned* ctl = (unsigned*)(A.ws + WS_CTL);
    for (int rep = 0; rep < REP_SCAN; ++rep)
    for (int u = C.bid; u < 32; u += C.G) {
        rwkv_seq_unit(C, u);
        asm volatile("s_waitcnt vmcnt(0)" ::: "memory"); __syncthreads();
        if (C.tid == 0) { __builtin_amdgcn_fence(__ATOMIC_RELEASE, "agent"); asm volatile("s_waitcnt vmcnt(0)" ::: "memory");
            __hip_atomic_store(ctl + CW_SEQF + (l * 32 + u) * 64, 1u, __ATOMIC_RELAXED, __HIP_MEMORY_SCOPE_AGENT); }
    }
    unsigned* head = ctl + CW_Q + 64 * l;
    volatile LAS unsigned* slot = (volatile LAS unsigned*)(C.lds + LDSCTL_OFF + 64);
    for (;;) {
        if (C.tid == 0) *slot = __hip_atomic_fetch_add(head, 1u, __ATOMIC_RELAXED, __HIP_MEMORY_SCOPE_AGENT);
        LBAR();
        const unsigned u = *slot;
        if (u >= 1024u * REP_FOX + 512u) break;
        if (u < 1024u * REP_FOX) {
            const unsigned w = u % 1024u;
            if (w < 512u) { const int qb = 15 - (int)(w >> 5), bh = (int)(w & 31u); attn2_unit<1>(C, l, bh >> 3, bh & 7, qb); }
            else { const int v = (int)w - 512; attn2_unit<0>(C, l, v >> 7, (v >> 4) & 7, v & 15); }
        } else if (u < 1024u * REP_FOX + 256u) { const int v = (int)(u - 1024u * REP_FOX); sgu_unit(C, l, v >> 6, (v >> 1) & 31, v & 1);
        } else {
            const int v = (int)(u - 1024u * REP_FOX - 256u), bh = v >> 3, part = v & 7;
            if (C.tid == 0) {
                unsigned spins = 0;
                while (__hip_atomic_load(ctl + CW_SEQF + (l * 32 + bh) * 64, __ATOMIC_RELAXED, __HIP_MEMORY_SCOPE_AGENT) == 0u && ++spins < (1u << 22)) __builtin_amdgcn_s_sleep(2);
                __builtin_amdgcn_fence(__ATOMIC_ACQUIRE, "agent"); asm volatile("s_waitcnt vmcnt(0)" ::: "memory");
            }
            __syncthreads();
            rwkv_post_bh(C, l, bh, part * 512, part * 512 + 512);
        }
    }
    LBAR();
}
constexpr int N_PHASES = 2 + 9 * DEPTH;
constexpr int WGM_IN = 8, WGM_OUT = 4, WGM_UP = 4, WGM_DN = 4;
#define IN(k) (lo <= (k) && (k) < hi)
#ifndef REP_PRO
#define REP_PRO 1
#endif
#ifndef REP_NORM
#define REP_NORM 1
#endif
#ifndef REP_MIX1
#define REP_MIX1 1
#endif
#ifndef REP_POST
#define REP_POST 1
#endif
#ifndef REP_GUP
#define REP_GUP 1
#endif
#ifndef PROBE_STAMP
#define PROBE_STAMP (-100)
#endif
#define STAMP(k) do { if (PROBE_STAMP > -100 && C.bid == 0 && C.tid == 0) ((volatile LAS unsigned long long*)(C.lds + LDSCTL_OFF + 1024))[(k) + 1] = __builtin_amdgcn_s_memrealtime(); } while (0)
#define SEAM(k) do { if (IN((k) + 1) || PROBE_STAMP > -100) xcd_barrier(bar); STAMP(k); } while (0)
template <int l>
__device__ __forceinline__ void layer_phases(const Args& A, const Ctx& C, const XcdBarrier& bar, const int lo, const int hi) {
    bf16* const H = (bf16*)(A.ws + WS_H); bf16* const PROJ = (bf16*)(A.ws + WS_PROJ); bf16* const YCAT = (bf16*)(A.ws + WS_YCAT); bf16* const FB = (bf16*)(A.ws + WS_F);
    constexpr int p0 = 2 + 9 * l;
    const float* xin = (l == 0) ? A.in[I_X] : A.out;
    const float* modl = (const float*)(A.ws + WS_MOD) + (size_t)l * NB * MODW;
    if (IN(p0 + 0)) { for (int rep = 0; rep < REP_NORM; ++rep) ph_norm(C, xin, A.in[I_N1G] + l * D, modl + 0 * D, modl + 1 * D, H); SEAM(p0 + 0); }
    if (IN(p0 + 1)) {
        pg8::Gemm g{H, (const bf16*)(A.ws + WS_WIN) + (size_t)l * NP * D, M, NP, D}; pg8::StaticOrder S; S.init(M, NP, C.G, C.bid, WGM_IN);
        pg8::EpiStoreBf16 E{PROJ, NP};
        for (int rep = 0; rep < REP_GIN; ++rep) { if (rep) __syncthreads(); pg8::gemm_phase<pg8::EpiStoreBf16, pg8::StaticOrder, true, true>(C.lds, g, S, E); }
        SEAM(p0 + 1); }
    if (IN(p0 + 2)) { for (int rep = 0; rep < REP_MIX1; ++rep) ph_mix1(C, l); SEAM(p0 + 2); }
    if (IN(p0 + 3)) { ph_mix2(C, l); SEAM(p0 + 3); }
    if (IN(p0 + 5)) {
        pg8::Gemm g{YCAT, (const bf16*)(A.ws + WS_WOUT) + (size_t)l * D * D, M, D, D}; pg8::StaticOrder S; S.init(M, D, C.G, C.bid, WGM_OUT);
        pg8::EpiResid E{xin, A.out, D, modl + 2 * D, MODW, T};
        pg8::gemm_phase<pg8::EpiResid, pg8::StaticOrder, true, true>(C.lds, g, S, E);
        SEAM(p0 + 5); }
    if (IN(p0 + 6)) { for (int rep = 0; rep < REP_NORM; ++rep) ph_norm(C, A.out, A.in[I_N2G] + l * D, modl + 3 * D, modl + 4 * D, H); SEAM(p0 + 6); }
    if (IN(p0 + 7)) {
        pg8::Gemm g{H, (const bf16*)(A.ws + WS_W13) + (size_t)l * 2 * FF * D, M, 2 * FF, D}; pg8::StaticOrder S; S.init(M, 2 * FF, C.G, C.bid, WGM_UP);
        pg8::EpiSwiGLU E{FB, FF};
        for (int rep = 0; rep < REP_GUP; ++rep) { if (rep) __syncthreads(); pg8::gemm_phase<pg8::EpiSwiGLU, pg8::StaticOrder, true, true>(C.lds, g, S, E); }
        SEAM(p0 + 7); }
    if (IN(p0 + 8)) {
        pg8::Gemm g{FB, (const bf16*)(A.ws + WS_W2) + (size_t)l * D * FF, M, D, FF}; pg8::StaticOrder S; S.init(M, D, C.G, C.bid, WGM_DN);
        pg8::EpiResid E{A.out, A.out, D, modl + 5 * D, MODW, T};
        pg8::gemm_phase<pg8::EpiResid, pg8::StaticOrder, true, true>(C.lds, g, S, E);
        SEAM(p0 + 8); }
}
__global__ void __launch_bounds__(NTHREADS, 2) fwd_kernel(Args A) {
    extern __shared__ __attribute__((aligned(16))) unsigned char lds_raw[];
    Ctx C; C.lds = (LAS unsigned char*)lds_raw; C.tid = threadIdx.x; C.lane = C.tid & 63; C.wave = __builtin_amdgcn_readfirstlane(C.tid >> 6); C.G = gridDim.x; C.bid = blockIdx.x;
    volatile LAS unsigned* MISC = (volatile LAS unsigned*)(C.lds + MISC_OFF);
    for (int u = C.tid; u < (LDS_BYTES - LDSCTL_OFF) / 4; u += NTHREADS) ((LAS unsigned*)(C.lds + LDSCTL_OFF))[u] = 0u;
    __syncthreads();
    const int lo = A.ph_lo, hi = A.ph_hi;
    const bool multi = (hi - lo) > 1;
    XcdBarrier bar; bar.bar = (unsigned*)(A.ws + WS_CTL) + CW_BAR; bar.x = 0; bar.st = nullptr;
    if (multi) bar = xcd_barrier_post((unsigned*)(A.ws + WS_CTL) + CW_BAR, MISC + 8);
    if (PROBE_STAMP > -100 && C.bid == 0 && C.tid == 0) ((volatile LAS unsigned long long*)(C.lds + LDSCTL_OFF + 1024))[0] = __builtin_amdgcn_s_memrealtime();
    if (IN(0)) { for (int rep = 0; rep < REP_PRO; ++rep) { if (rep) __syncthreads(); ph_prologue(C); } SEAM(0); }
    if (IN(1)) { ph_modreduce(C); SEAM(1); }
    layer_phases<0>(A, C, bar, lo, hi);
    layer_phases<1>(A, C, bar, lo, hi);
    layer_phases<2>(A, C, bar, lo, hi);
    layer_phases<3>(A, C, bar, lo, hi);
    if (PROBE_STAMP > -100 && C.bid == 0 && C.tid == 0) {
        volatile LAS unsigned long long* st = (volatile LAS unsigned long long*)(C.lds + LDSCTL_OFF + 1024);
        unsigned long long tot = 0;
        if (PROBE_STAMP < 0) tot = st[2] - st[0];
        else for (int l = 0; l < DEPTH; ++l) tot += st[2 + 9 * l + PROBE_STAMP + 1] - st[2 + 9 * l + PROBE_STAMP];
        A.out[0] = (float)tot * 0.01f;
    }
}
#undef IN
#undef SEAM

extern "C" void kernel_launch(void* const* d_in, const int* in_sizes, int n_in, void* d_out, int out_size, void* d_ws, size_t ws_size, hipStream_t stream) {
    static int grid = 0;
    if (grid == 0) {
        if (n_in != N_INPUTS || out_size != M * D || ws_size < WS_END) { fprintf(stderr, "kernel_launch: unexpected problem (n_in %d, out %d, ws %zu; need %zu)\n", n_in, out_size, ws_size, (size_t)WS_END); grid = -1; return; }
        int dev = 0, cus = 0, per_cu = 0;
        if (hipGetDevice(&dev) != hipSuccess || hipDeviceGetAttribute(&cus, hipDeviceAttributeMultiprocessorCount, dev) != hipSuccess) { grid = -1; return; }
        if (hipFuncSetAttribute((const void*)fwd_kernel, hipFuncAttributeMaxDynamicSharedMemorySize, LDS_BYTES) != hipSuccess) { fprintf(stderr, "kernel_launch: hipFuncSetAttribute failed\n"); grid = -1; return; }
        if (hipOccupancyMaxActiveBlocksPerMultiprocessor(&per_cu, (const void*)fwd_kernel, NTHREADS, LDS_BYTES) != hipSuccess || per_cu < 1) fprintf(stderr, "kernel_launch: occupancy query reports %d\n", per_cu);
        (void)hipGetLastError();
        grid = cus;
    }
    if (grid < 0) return;
    (void)hipMemsetAsync((char*)d_ws + WS_CTL, 0, CTL_ZERO_BYTES, stream);
    Args a{};
    for (int i = 0; i < N_INPUTS; ++i) a.in[i] = (const float*)d_in[i];
    a.out = (float*)d_out; a.ws = (unsigned char*)d_ws;
#if MK_ONE_LAUNCH
    a.ph_lo = 0; a.ph_hi = N_PHASES;
    hipLaunchKernelGGL(fwd_kernel, dim3(grid), dim3(NTHREADS), LDS_BYTES, stream, a);
#else
    for (int p = 0; p < N_PHASES; ++p) { a.ph_lo = p; a.ph_hi = p + 1; hipLaunchKernelGGL(fwd_kernel, dim3(grid), dim3(NTHREADS), LDS_BYTES, stream, a); }
#endif
    const hipError_t le = hipPeekAtLastError();
    if (le != hipSuccess) fprintf(stderr, "kernel_launch: launch failed: %s\n", hipGetErrorName(le));
}
```
